# Optimizing an MI355X kernel written in HIP

```python
import numpy as np
import jax
import jax.numpy as jnp
from jax import lax

D_MODEL = 1024
BATCH = 4
SEQ = 4096
DEPTH = 1

NSA_HEADS = 8
NSA_KV_GROUPS = 2
NSA_HEAD_DIM = 64
CMP_STRIDE = 16
CMP_LEN = 2 * CMP_STRIDE
CMP_HIDDEN = 128
SEL_BLOCK = 64
SEL_TOPN = 16
WINDOW = 512
Q_BLOCK = 128
ML_HEADS = 4
ML_HEAD_DIM = 128
ML_CHUNK = 64
CONV_WIDTH = 4
N_EXPERTS = 32
TOP_K = 4
D_EXPERT = 1024
SWIGLU_LIMIT = 7.0
SWIGLU_ALPHA = 1.702
MOE_ROWS = 256
NORM_EPS = 1e-6
NEG_INF = -1e30
FORCE_BONUS = 1e4

NSA_QW = NSA_HEADS * NSA_HEAD_DIM
NSA_KVW = NSA_KV_GROUPS * NSA_HEAD_DIM
ML_W = ML_HEADS * ML_HEAD_DIM
IN_SPLITS = (NSA_QW, 6 * NSA_KVW, 3 * NSA_HEADS, 2 * ML_W, ML_W, 2 * ML_HEADS, ML_W, 2 * D_MODEL)
IN_W = sum(IN_SPLITS)

kernel_name = 'hybrid_nsa_mlstm_moe_block'


def rms_norm(x, g):
    xf = x.astype(jnp.float32)
    y = xf * lax.rsqrt(jnp.mean(xf * xf, axis=-1, keepdims=True) + NORM_EPS)
    return (y * g.astype(jnp.float32)).astype(x.dtype)


def split_cols(t, sizes):
    cuts = [int(v) for v in np.cumsum(sizes)[:-1]]
    return jnp.split(t, cuts, axis=-1)


def causal_conv(x, w, b):
    C = x.shape[-1]
    y = lax.conv_general_dilated(x, w[:, None, :].astype(x.dtype), window_strides=(1,),
                                 padding=((CONV_WIDTH - 1, 0),),
                                 dimension_numbers=('NWC', 'WIO', 'NWC'),
                                 feature_group_count=C)
    return y + b


def nsa_compress(t, pe, w1, w2):
    B, G, S, dh = t.shape
    nc = S // CMP_STRIDE - 1
    t16 = t.reshape(B, G, S // CMP_STRIDE, CMP_STRIDE, dh)
    blocks = jnp.concatenate([t16[:, :, :-1], t16[:, :, 1:]], axis=3) + pe
    return jax.nn.gelu(blocks.reshape(B, G, nc, CMP_LEN * dh) @ w1) @ w2


def nsa_mixer(q, kv, gate_pre, pe_k, pe_v, w1_k, w2_k, w1_v, w2_v):
    B, S, _ = q.shape
    G, R, dh = NSA_KV_GROUPS, NSA_HEADS // NSA_KV_GROUPS, NSA_HEAD_DIM
    scale = dh ** -0.5
    f32 = jnp.float32
    qh = q.reshape(B, S, G, R, dh).transpose(0, 2, 3, 1, 4)
    kvh = kv.reshape(B, S, 6, G, dh).transpose(2, 0, 3, 1, 4)
    k_cmp, v_cmp, k_sel, v_sel, k_win, v_win = kvh[0], kvh[1], kvh[2], kvh[3], kvh[4], kvh[5]
    tpos = jnp.arange(S)

    kc = nsa_compress(k_cmp, pe_k, w1_k, w2_k)
    vc = nsa_compress(v_cmp, pe_v, w1_v, w2_v)
    nc = kc.shape[2]
    cmp_mask = (jnp.arange(nc) * CMP_STRIDE + CMP_LEN - 1)[None, :] <= tpos[:, None]
    s_c = jnp.einsum('bgrsd,bgnd->bgrsn', qh, kc).astype(f32) * scale
    p_c = jax.nn.softmax(jnp.where(cmp_mask, s_c, NEG_INF), axis=-1) * cmp_mask
    o_cmp = jnp.einsum('bgrsn,bgnd->bgrsd', p_c.astype(vc.dtype), vc)

    ns = S // SEL_BLOCK
    n_sel = min(SEL_TOPN, ns)
    c0 = np.arange(nc) * CMP_STRIDE
    s0 = np.arange(ns) * SEL_BLOCK
    overlap = np.clip(np.minimum(c0[:, None] + CMP_LEN, s0[None, :] + SEL_BLOCK)
                      - np.maximum(c0[:, None], s0[None, :]), 0, None) / CMP_LEN
    imp = jnp.einsum('bgsn,nj->bgsj', p_c.sum(axis=2), jnp.asarray(overlap, f32))
    cur = (tpos // SEL_BLOCK)[:, None]
    blk = jnp.arange(ns)[None, :]
    forced = (blk == 0) | (blk == cur) | (blk == cur - 1)
    imp = jnp.where(blk > cur, NEG_INF, imp + FORCE_BONUS * forced)
    _, sel_idx = lax.top_k(imp, n_sel)

    nqb = S // Q_BLOCK
    kb_sel = k_sel.reshape(B, G, ns, SEL_BLOCK, dh)
    vb_sel = v_sel.reshape(B, G, ns, SEL_BLOCK, dh)
    pad = jnp.zeros((B, G, WINDOW, dh), k_win.dtype)
    k_win_p = jnp.concatenate([pad, k_win], axis=2)
    v_win_p = jnp.concatenate([pad, v_win], axis=2)
    q_blocks = qh.reshape(B, G, R, nqb, Q_BLOCK, dh).transpose(3, 0, 1, 2, 4, 5)
    idx_blocks = sel_idx.reshape(B, G, nqb, Q_BLOCK, n_sel).transpose(2, 0, 1, 3, 4)
    gather_blocks = jax.vmap(jax.vmap(lambda blocks, idx: blocks[idx]))
    n_keys = n_sel * SEL_BLOCK

    def block_attn(args):
        qb, ib, bi = args
        tq = bi * Q_BLOCK + jnp.arange(Q_BLOCK)
        ks = gather_blocks(kb_sel, ib).reshape(B, G, Q_BLOCK, n_keys, dh)
        vs = gather_blocks(vb_sel, ib).reshape(B, G, Q_BLOCK, n_keys, dh)
        pos = (ib[..., None] * SEL_BLOCK + jnp.arange(SEL_BLOCK)).reshape(B, G, Q_BLOCK, n_keys)
        smask = (pos <= tq[:, None])[:, :, None]
        s = jnp.einsum('bgrqd,bgqkd->bgrqk', qb, ks).astype(f32) * scale
        p = jax.nn.softmax(jnp.where(smask, s, NEG_INF), axis=-1)
        o_s = jnp.einsum('bgrqk,bgqkd->bgrqd', p.astype(vs.dtype), vs)
        kw = lax.dynamic_slice_in_dim(k_win_p, bi * Q_BLOCK, Q_BLOCK + WINDOW, axis=2)
        vw = lax.dynamic_slice_in_dim(v_win_p, bi * Q_BLOCK, Q_BLOCK + WINDOW, axis=2)
        kpos = bi * Q_BLOCK - WINDOW + jnp.arange(Q_BLOCK + WINDOW)
        rel = tq[:, None] - kpos[None, :]
        wmask = (rel >= 0) & (rel < WINDOW) & (kpos[None, :] >= 0)
        s = jnp.einsum('bgrqd,bgkd->bgrqk', qb, kw).astype(f32) * scale
        p = jax.nn.softmax(jnp.where(wmask, s, NEG_INF), axis=-1)
        o_w = jnp.einsum('bgrqk,bgkd->bgrqd', p.astype(vw.dtype), vw)
        return o_s, o_w

    o_sel, o_win = lax.map(block_attn, (q_blocks, idx_blocks, jnp.arange(nqb)))
    o_sel = o_sel.transpose(1, 2, 3, 0, 4, 5).reshape(B, G, R, S, dh)
    o_win = o_win.transpose(1, 2, 3, 0, 4, 5).reshape(B, G, R, S, dh)

    g = jax.nn.sigmoid(gate_pre.astype(f32)).astype(q.dtype)
    g = g.reshape(B, S, 3, G, R).transpose(2, 0, 3, 4, 1)[..., None]
    o = g[0] * o_cmp + g[1] * o_sel + g[2] * o_win
    return o.transpose(0, 3, 1, 2, 4).reshape(B, S, NSA_QW)


def mlstm_mixer(q, k, v, i_pre, f_pre, o_pre, norm_g):
    B, S, _ = q.shape
    H, d, L = ML_HEADS, ML_HEAD_DIM, ML_CHUNK
    nch = S // L
    f32 = jnp.float32

    def heads(t):
        return t.reshape(B, nch, L, H, d).transpose(1, 0, 3, 2, 4).astype(f32)

    def gates(t):
        return t.reshape(B, nch, L, H).transpose(1, 0, 3, 2).astype(f32)

    qc, kc, vc = heads(q), heads(k) * (d ** -0.5), heads(v)
    li = gates(i_pre)
    bcum = jnp.cumsum(jax.nn.log_sigmoid(gates(f_pre)), axis=-1)
    causal = jnp.tril(jnp.ones((L, L), dtype=bool))

    def step(carry, xs):
        C, n, m = carry
        q_, k_, v_, li_, b_ = xs
        D = b_[..., :, None] - b_[..., None, :] + li_[..., None, :]
        D = jnp.where(causal, D, NEG_INF)
        inter = b_ + m[..., None]
        m_t = jnp.maximum(inter, D.max(axis=-1))
        Dw = jnp.exp(D - m_t[..., None])
        inter_w = jnp.exp(inter - m_t)
        qk = jnp.einsum('bhtd,bhsd->bhts', q_, k_) * Dw
        num = jnp.einsum('bhts,bhsd->bhtd', qk, v_) + inter_w[..., None] * jnp.einsum('bhtd,bhde->bhte', q_, C)
        den = qk.sum(axis=-1) + inter_w * jnp.einsum('bhtd,bhd->bht', q_, n)
        h = num / jnp.maximum(jnp.abs(den), jnp.exp(-m_t))[..., None]
        bL = b_[..., -1]
        a = bL[..., None] - b_ + li_
        m_new = jnp.maximum(bL + m, a.max(axis=-1))
        aw = jnp.exp(a - m_new[..., None])
        decay = jnp.exp(bL + m - m_new)
        C_new = decay[..., None, None] * C + jnp.einsum('bhs,bhsd,bhse->bhde', aw, k_, v_)
        n_new = decay[..., None] * n + jnp.einsum('bhs,bhsd->bhd', aw, k_)
        return (C_new, n_new, m_new), h

    init = (jnp.zeros((B, H, d, d), f32), jnp.zeros((B, H, d), f32), jnp.zeros((B, H), f32))
    _, h = lax.scan(step, init, (qc, kc, vc, li, bcum))
    h = h.transpose(1, 0, 3, 2, 4).reshape(B, S, H, d)
    h = h * lax.rsqrt(jnp.mean(h * h, axis=-1, keepdims=True) + NORM_EPS) * norm_g.reshape(H, d).astype(f32)
    h = h * jax.nn.sigmoid(o_pre.astype(f32)).reshape(B, S, H, d)
    return h.reshape(B, S, ML_W).astype(q.dtype)


def token_mixer(n, w_in, pe_k, pe_v, cw1_k, cw2_k, cw1_v, cw2_v, conv_w, conv_b, gate_b, norm_g,
                w_up_nsa, w_up_ml, w_out):
    proj = n @ w_in
    nsa_q, nsa_kv, nsa_g, ml_qk, ml_v, ml_if, ml_o, merge = split_cols(proj, IN_SPLITS)
    o_nsa = nsa_mixer(nsa_q, nsa_kv, nsa_g, pe_k, pe_v, cw1_k, cw2_k, cw1_v, cw2_v)
    ml_qk = jax.nn.silu(causal_conv(ml_qk, conv_w, conv_b))
    ml_q, ml_k = jnp.split(ml_qk, 2, axis=-1)
    ml_if = ml_if + gate_b
    o_ml = mlstm_mixer(ml_q, ml_k, ml_v, ml_if[..., :ML_HEADS], ml_if[..., ML_HEADS:], ml_o, norm_g)
    g_nsa, g_ml = jnp.split(jax.nn.sigmoid(merge.astype(jnp.float32)).astype(n.dtype), 2, axis=-1)
    return (g_nsa * (o_nsa @ w_up_nsa) + g_ml * (o_ml @ w_up_ml)) @ w_out


def moe_ffn(x, w_router, b_router, w1, b1, w2, b2):
    B, S, D = x.shape
    T = B * S
    A = T * TOP_K
    xt = x.reshape(T, D)
    logits = (xt @ w_router + b_router).astype(jnp.float32)
    top_v, top_i = lax.top_k(logits, TOP_K)
    gate = jax.nn.softmax(top_v, axis=-1)
    e_flat = top_i.reshape(A)
    tok_flat = jnp.arange(A) // TOP_K
    order = jnp.argsort(e_flat)
    e_s, tok_s, g_s = e_flat[order], tok_flat[order], gate.reshape(A)[order]
    counts = jnp.bincount(e_flat, length=N_EXPERTS)
    padded = (counts + MOE_ROWS - 1) // MOE_ROWS * MOE_ROWS
    grp_start = jnp.cumsum(counts) - counts
    pad_end = jnp.cumsum(padded)
    pad_start = pad_end - padded
    dest = pad_start[e_s] + jnp.arange(A) - grp_start[e_s]
    n_blk = -(-(A + N_EXPERTS * (MOE_ROWS - 1)) // MOE_ROWS)
    P = n_blk * MOE_ROWS
    row_tok = jnp.full((P,), T, dtype=jnp.int32).at[dest].set(tok_s.astype(jnp.int32))
    row_gate = jnp.zeros((P,), jnp.float32).at[dest].set(g_s)
    blk_expert = jnp.minimum(jnp.searchsorted(pad_end, jnp.arange(n_blk) * MOE_ROWS, side='right'),
                             N_EXPERTS - 1)
    x_pad = jnp.concatenate([xt, jnp.zeros((1, D), xt.dtype)], axis=0)
    x_rows = x_pad[row_tok].reshape(n_blk, MOE_ROWS, D)

    def expert_block(args):
        xb, e = args
        hcat = xb @ w1[e] + b1[e]
        glu = jnp.minimum(hcat[:, :D_EXPERT], SWIGLU_LIMIT)
        lin = jnp.clip(hcat[:, D_EXPERT:], -SWIGLU_LIMIT, SWIGLU_LIMIT)
        act = glu * jax.nn.sigmoid(SWIGLU_ALPHA * glu) * (lin + 1.0)
        return act @ w2[e] + b2[e]

    y_rows = lax.map(expert_block, (x_rows, blk_expert)).reshape(P, D)
    y_rows = y_rows * row_gate[:, None].astype(y_rows.dtype)
    y = jax.ops.segment_sum(y_rows, row_tok, num_segments=T + 1)[:T]
    return y.reshape(B, S, D)


def setup_inputs(seed: int = 0) -> dict:
    key = jax.random.key(seed)
    ks = jax.random.split(key, 32)
    f32 = jnp.float32

    def nrm(k, shape, scale):
        return jax.random.normal(k, shape, f32) * scale

    dh = NSA_HEAD_DIM
    return {
        'x': nrm(ks[0], (BATCH, SEQ, D_MODEL), 1.0),
        'c': nrm(ks[1], (BATCH, D_MODEL), 1.0),
        'ada_w': nrm(ks[2], (DEPTH, D_MODEL, 6 * D_MODEL), 0.5 * D_MODEL ** -0.5),
        'ada_b': nrm(ks[3], (DEPTH, 6 * D_MODEL), 0.02),
        'norm1_g': 1.0 + nrm(ks[4], (DEPTH, D_MODEL), 0.02),
        'w_in': nrm(ks[5], (DEPTH, D_MODEL, IN_W), D_MODEL ** -0.5),
        'nsa_pe_k': nrm(ks[6], (DEPTH, CMP_LEN, dh), 0.02),
        'nsa_pe_v': nrm(ks[7], (DEPTH, CMP_LEN, dh), 0.02),
        'nsa_cmp_w1_k': nrm(ks[8], (DEPTH, CMP_LEN * dh, CMP_HIDDEN), (CMP_LEN * dh) ** -0.5),
        'nsa_cmp_w2_k': nrm(ks[9], (DEPTH, CMP_HIDDEN, dh), CMP_HIDDEN ** -0.5),
        'nsa_cmp_w1_v': nrm(ks[10], (DEPTH, CMP_LEN * dh, CMP_HIDDEN), (CMP_LEN * dh) ** -0.5),
        'nsa_cmp_w2_v': nrm(ks[11], (DEPTH, CMP_HIDDEN, dh), CMP_HIDDEN ** -0.5),
        'ml_conv_w': nrm(ks[12], (DEPTH, CONV_WIDTH, 2 * ML_W), CONV_WIDTH ** -0.5),
        'ml_conv_b': nrm(ks[13], (DEPTH, 2 * ML_W), 0.02),
        'ml_gate_b': jnp.concatenate([nrm(ks[14], (DEPTH, ML_HEADS), 0.1),
                                      3.0 + nrm(ks[15], (DEPTH, ML_HEADS), 0.5)], axis=-1),
        'ml_norm_g': 1.0 + nrm(ks[16], (DEPTH, ML_W), 0.02),
        'w_up_nsa': nrm(ks[17], (DEPTH, NSA_QW, D_MODEL), NSA_QW ** -0.5),
        'w_up_ml': nrm(ks[18], (DEPTH, ML_W, D_MODEL), ML_W ** -0.5),
        'w_out': nrm(ks[19], (DEPTH, D_MODEL, D_MODEL), D_MODEL ** -0.5),
        'norm2_g': 1.0 + nrm(ks[20], (DEPTH, D_MODEL), 0.02),
        'router_w': nrm(ks[21], (DEPTH, D_MODEL, N_EXPERTS), D_MODEL ** -0.5),
        'router_b': nrm(ks[22], (DEPTH, N_EXPERTS), 0.01),
        'exp_w1': nrm(ks[23], (DEPTH, N_EXPERTS, D_MODEL, 2 * D_EXPERT), D_MODEL ** -0.5),
        'exp_b1': nrm(ks[24], (DEPTH, N_EXPERTS, 2 * D_EXPERT), 0.02),
        'exp_w2': nrm(ks[25], (DEPTH, N_EXPERTS, D_EXPERT, D_MODEL), D_EXPERT ** -0.5),
        'exp_b2': nrm(ks[26], (DEPTH, N_EXPERTS, D_MODEL), 0.02),
        'final_g': 1.0 + nrm(ks[27], (D_MODEL,), 0.02),
    }


def reference(x, c, ada_w, ada_b, norm1_g, w_in, nsa_pe_k, nsa_pe_v, nsa_cmp_w1_k, nsa_cmp_w2_k,
              nsa_cmp_w1_v, nsa_cmp_w2_v, ml_conv_w, ml_conv_b, ml_gate_b, ml_norm_g, w_up_nsa, w_up_ml,
              w_out, norm2_g, router_w, router_b, exp_w1, exp_b1, exp_w2, exp_b2, final_g):
    h = x
    c_act = jax.nn.silu(c)
    for layer in range(DEPTH):
        mod = (c_act @ ada_w[layer] + ada_b[layer])[:, None, :]
        sh1, sc1, gt1, sh2, sc2, gt2 = jnp.split(mod, 6, axis=-1)
        n = rms_norm(h, norm1_g[layer]) * (1.0 + sc1) + sh1
        mix = token_mixer(n, w_in[layer], nsa_pe_k[layer], nsa_pe_v[layer], nsa_cmp_w1_k[layer],
                          nsa_cmp_w2_k[layer], nsa_cmp_w1_v[layer], nsa_cmp_w2_v[layer], ml_conv_w[layer],
                          ml_conv_b[layer], ml_gate_b[layer], ml_norm_g[layer], w_up_nsa[layer],
                          w_up_ml[layer], w_out[layer])
        h = h + (1.0 + gt1) * mix
        n = rms_norm(h, norm2_g[layer]) * (1.0 + sc2) + sh2
        h = h + (1.0 + gt2) * moe_ffn(n, router_w[layer], router_b[layer], exp_w1[layer], exp_b1[layer],
                                      exp_w2[layer], exp_b2[layer])
    return rms_norm(h, final_g)
```

```cpp
#include <hip/hip_runtime.h>
#include <cstdio>
#include <cstdint>
namespace pg8 {
#define PG8_LAS __attribute__((address_space(3)))
typedef unsigned short bf16_t;
typedef short bf16x8 __attribute__((ext_vector_type(8)));
typedef float f32x4 __attribute__((ext_vector_type(4)));
typedef unsigned u32x4 __attribute__((ext_vector_type(4)));
constexpr int BM = 256, BK = 64, HALF = 128, HTB = HALF * BK * 2  , STAGE_BYTES = 8 * HTB, NXCD = 8, WGM = 8;

__host__ __device__ __forceinline__ int lds_byte(int r, int c) { const int st = (r >> 4) * 2 + (c >> 5), rr = r & 15, cc = c & 31, ob = rr * 64 + cc * 2; return st * 1024 + (ob ^ (((ob >> 9) & 1) << 5)); }
__host__ __device__ __forceinline__ void stage_rc(int b, int& R, int& C) { const int st = b / 1024, sb = b % 1024, swz = sb ^ (((sb >> 9) & 1) << 5); R = (st >> 1) * 16 + swz / 64; C = (st & 1) * 32 + (swz % 64) / 2; }
__host__ __device__ __forceinline__ int perm32(int rho) { const int n = rho >> 4, i = rho & 15; return 8 * (i >> 2) + 4 * n + (i & 3); }

struct Unit { int pm, pn; };
struct Gemm { const bf16_t* A; const bf16_t* Bt; int M, N, K; };

struct StaticOrder {
    int nM, nN, nwg, G, c;
    __host__ __device__ void init(int M, int N, int G_, int c_) { nM = M / BM; nN = N / BM; nwg = nM * nN; G = G_; c = c_; }
    __host__ __device__ bool next(int i, Unit& u) const {
        const long L = (long)i * G + c; if (L >= nwg) return false;
        int wgid = (int)L; { const int q = nwg / NXCD, r = nwg % NXCD, xcd = wgid % NXCD, off = wgid / NXCD; wgid = (xcd < r ? xcd * (q + 1) : r * (q + 1) + (xcd - r) * q) + off; }
        const int nig = WGM * nN, gid = wgid / nig, fm = gid * WGM, gsz = (nM - fm) < WGM ? (nM - fm) : WGM;
        u.pm = fm + ((wgid % nig) % gsz); u.pn = (wgid % nig) / gsz; return true;
    }
    __device__ __forceinline__ void a_ready(const Unit&) const {}
    __device__ __forceinline__ void done(const Unit&) const {}
};

__device__ __forceinline__ unsigned cvt_pk_bf16(float lo, float hi) { unsigned r; asm volatile("v_cvt_pk_bf16_f32 %0, %1, %2" : "=v"(r) : "v"(lo), "v"(hi)); return r; }
typedef float f32x2 __attribute__((ext_vector_type(2)));
template <class Epi, class Sched, bool ALIGN_EPI = false, bool SP2 = false>
__device__ __forceinline__ void gemm_phase(PG8_LAS unsigned char* lds, const Gemm g, const Sched& S, const Epi& E) {
    const int tid = threadIdx.x, wid = __builtin_amdgcn_readfirstlane(tid >> 6), lane = tid & 63, wr = wid >> 2, wc = wid & 3, fr = lane & 15, fq = lane >> 4;
    const int K = g.K, nt = K / BK;
    unsigned voffA[2], voffB[2];
#pragma unroll
    for (int i = 0; i < 2; ++i) { int R, C; stage_rc(tid * 16 + i * 8192, R, C); const int Rb = Epi::PERM ? ((R & ~31) + perm32(R & 31)) : R;
        voffA[i] = (unsigned)(R * K + C) * 2u; voffB[i] = (unsigned)(Rb * K + C) * 2u; }
    const size_t kstep = (size_t)(BK * 2);
    const size_t hstep = (size_t)HALF * K * 2;
    const size_t tstep = 2 * hstep;
    const unsigned ldsw = (unsigned)wid * 1024u;
    const int aoff = lds_byte(wr * 64 + fr, fq * 8), boff = lds_byte(wc * 32 + fr, fq * 8);
#define PG8_SA(b, h) (((b) * 2 + (h)) * HTB)
#define PG8_SB(b, h) ((4 + (b) * 2 + (h)) * HTB)
#define PG8_STAGE(bufoff, gbase, voff) do { _Pragma("unroll") for (int _i = 0; _i < 2; ++_i) \
        __builtin_amdgcn_global_load_lds((const unsigned*)((const char*)(gbase) + (voff)[_i]), (PG8_LAS unsigned*)(lds + (bufoff) + ldsw + _i * 8192), 16, 0, 0); } while (0)
#define PG8_LDA(dst, b, h) do { _Pragma("unroll") for (int m = 0; m < 4; ++m) _Pragma("unroll") for (int k = 0; k < 2; ++k) dst[m][k] = *(const PG8_LAS bf16x8*)(lds + PG8_SA(b, h) + aoff + m * 2048 + k * 1024); } while (0)
#define PG8_LDB(dst, b, h) do { _Pragma("unroll") for (int n = 0; n < 2; ++n) _Pragma("unroll") for (int k = 0; k < 2; ++k) dst[n][k] = *(const PG8_LAS bf16x8*)(lds + PG8_SB(b, h) + boff + n * 2048 + k * 1024); } while (0)
#define PG8_MMA(ai, bj, At, Bt) do { __builtin_amdgcn_s_setprio(1); _Pragma("unroll") for (int m = 0; m < 4; ++m) _Pragma("unroll") for (int n = 0; n < 2; ++n) _Pragma("unroll") for (int k = 0; k < 2; ++k) \
        acc[ai][bj][m][n] = __builtin_amdgcn_mfma_f32_16x16x32_bf16(Bt[n][k], At[m][k], acc[ai][bj][m][n], 0, 0, 0); __builtin_amdgcn_s_setprio(0); } while (0)
#define PG8_WAIT_V(n) asm volatile("s_waitcnt vmcnt(" #n ")" ::: "memory")
#define PG8_WAIT_L(n) asm volatile("s_waitcnt lgkmcnt(" #n ")" ::: "memory")
#define PG8_BAR __builtin_amdgcn_s_barrier()
#define PG8_SCHED __builtin_amdgcn_sched_barrier(0)
    Unit cur, nxt; int ui = 0;
    if (!S.next(0, cur)) return;
    f32x4 acc[2][2][4][2];
#pragma unroll
    for (int a = 0; a < 2; ++a)
#pragma unroll
        for (int b = 0; b < 2; ++b)
#pragma unroll
            for (int m = 0; m < 4; ++m)
#pragma unroll
                for (int n = 0; n < 2; ++n) acc[a][b][m][n] = (f32x4){0.f, 0.f, 0.f, 0.f};
    bf16x8 At[4][2], B0[2][2], B1[2][2];
    const char* cA = (const char*)g.A + (size_t)cur.pm * tstep; const char* cB = (const char*)g.Bt + (size_t)cur.pn * tstep;
    S.a_ready(cur);
    if constexpr (SP2) {
        PG8_STAGE(PG8_SB(0, 0), cB, voffB); PG8_STAGE(PG8_SB(0, 1), cB + hstep, voffB); PG8_STAGE(PG8_SA(0, 0), cA, voffA); PG8_STAGE(PG8_SA(0, 1), cA + hstep, voffA);
        if (wr == 1) PG8_BAR;
        PG8_WAIT_V(2); PG8_BAR;
        PG8_STAGE(PG8_SB(1, 0), cB + kstep, voffB); PG8_STAGE(PG8_SA(1, 0), cA + kstep, voffA); PG8_STAGE(PG8_SB(1, 1), cB + hstep + kstep, voffB);
        PG8_WAIT_V(6); PG8_BAR;
    } else {
        PG8_STAGE(PG8_SB(0, 0), cB, voffB); PG8_STAGE(PG8_SA(0, 0), cA, voffA); PG8_STAGE(PG8_SB(0, 1), cB + hstep, voffB); PG8_STAGE(PG8_SA(0, 1), cA + hstep, voffA);
        if (wr == 1) PG8_BAR;
        PG8_WAIT_V(4); PG8_BAR;
        PG8_STAGE(PG8_SB(1, 0), cB + kstep, voffB); PG8_STAGE(PG8_SA(1, 0), cA + kstep, voffA); PG8_STAGE(PG8_SB(1, 1), cB + hstep + kstep, voffB);
        PG8_WAIT_V(6); PG8_BAR;
    }
    for (;;) {
        const bool has_next = S.next(ui + 1, nxt);
        const char* nA = has_next ? (const char*)g.A + (size_t)nxt.pm * tstep : cA; const char* nB = has_next ? (const char*)g.Bt + (size_t)nxt.pn * tstep : cB;
        for (int t = 0; t < nt; t += 2) {
            const bool last = (t == nt - 2);
            const char* a1 = cA + (size_t)(t + 1) * kstep;
            const char* a2 = last ? nA : cA + (size_t)(t + 2) * kstep; const char* b2 = last ? nB : cB + (size_t)(t + 2) * kstep;
            const char* a3 = a2 + kstep; const char* b3 = b2 + kstep;
            if (last && has_next) S.a_ready(nxt);
            if constexpr (SP2) {
            PG8_LDB(B0, 0, 0); PG8_LDB(B1, 0, 1); PG8_SCHED; PG8_LDA(At, 0, 0); PG8_STAGE(PG8_SA(1, 1), a1 + hstep, voffA);
            PG8_WAIT_V(8); PG8_WAIT_L(0); PG8_BAR; PG8_MMA(0, 0, At, B0); PG8_MMA(0, 1, At, B1); PG8_BAR; PG8_SCHED;
            PG8_LDA(At, 0, 1); PG8_STAGE(PG8_SB(0, 0), b2, voffB); PG8_STAGE(PG8_SB(0, 1), b2 + hstep, voffB); PG8_STAGE(PG8_SA(0, 0), a2, voffA);
            PG8_WAIT_V(8); PG8_WAIT_L(0); PG8_BAR; PG8_MMA(1, 0, At, B0); PG8_MMA(1, 1, At, B1); PG8_BAR; PG8_SCHED;
            PG8_LDB(B0, 1, 0); PG8_LDB(B1, 1, 1); PG8_SCHED; PG8_LDA(At, 1, 0); PG8_STAGE(PG8_SA(0, 1), a2 + hstep, voffA);
            PG8_WAIT_V(8); PG8_WAIT_L(0); PG8_BAR; PG8_MMA(0, 0, At, B0); PG8_MMA(0, 1, At, B1); PG8_BAR; PG8_SCHED;
            PG8_LDA(At, 1, 1); PG8_STAGE(PG8_SB(1, 0), b3, voffB); PG8_STAGE(PG8_SB(1, 1), b3 + hstep, voffB); PG8_STAGE(PG8_SA(1, 0), a3, voffA);
            PG8_WAIT_V(8); PG8_WAIT_L(0); PG8_BAR; PG8_MMA(1, 0, At, B0); PG8_MMA(1, 1, At, B1); PG8_BAR; PG8_SCHED;
            } else {
            PG8_LDB(B0, 0, 0); PG8_SCHED; PG8_LDA(At, 0, 0); PG8_STAGE(PG8_SA(1, 1), a1 + hstep, voffA);
            PG8_WAIT_L(8); PG8_BAR; PG8_WAIT_L(0); PG8_MMA(0, 0, At, B0); PG8_BAR; PG8_SCHED;
            PG8_LDB(B1, 0, 1); PG8_STAGE(PG8_SB(0, 0), b2, voffB);
            PG8_BAR; PG8_WAIT_L(0); PG8_MMA(0, 1, At, B1); PG8_BAR;
            PG8_LDA(At, 0, 1); PG8_STAGE(PG8_SA(0, 0), a2, voffA);
            PG8_BAR; PG8_WAIT_L(0); PG8_MMA(1, 0, At, B0); PG8_BAR; PG8_SCHED;
            PG8_STAGE(PG8_SB(0, 1), b2 + hstep, voffB);
            PG8_WAIT_V(6); PG8_BAR; PG8_MMA(1, 1, At, B1); PG8_BAR;
            PG8_LDB(B0, 1, 0); PG8_SCHED; PG8_LDA(At, 1, 0); PG8_STAGE(PG8_SA(0, 1), a2 + hstep, voffA);
            PG8_WAIT_L(8); PG8_BAR; PG8_WAIT_L(0); PG8_MMA(0, 0, At, B0); PG8_BAR; PG8_SCHED;
            PG8_LDB(B1, 1, 1); PG8_STAGE(PG8_SB(1, 0), b3, voffB);
            PG8_BAR; PG8_WAIT_L(0); PG8_MMA(0, 1, At, B1); PG8_BAR;
            PG8_LDA(At, 1, 1); PG8_STAGE(PG8_SA(1, 0), a3, voffA);
            PG8_BAR; PG8_WAIT_L(0); PG8_MMA(1, 0, At, B0); PG8_BAR; PG8_SCHED;
            PG8_STAGE(PG8_SB(1, 1), b3 + hstep, voffB);
            PG8_WAIT_V(6); PG8_BAR; PG8_MMA(1, 1, At, B1); PG8_BAR;
            }
        }
        if constexpr (ALIGN_EPI) { if (wr == 0) PG8_BAR; }
        if constexpr (!Epi::AFTER_DRAIN) { E(acc, cur, wr, wc, fr, fq); S.done(cur); }
        if (!has_next) break;
#pragma unroll
        for (int a = 0; a < 2; ++a)
#pragma unroll
            for (int b = 0; b < 2; ++b)
#pragma unroll
                for (int m = 0; m < 4; ++m)
#pragma unroll
                    for (int n = 0; n < 2; ++n) acc[a][b][m][n] = (f32x4){0.f, 0.f, 0.f, 0.f};
        cur = nxt; cA = nA; cB = nB; ++ui;
        if constexpr (ALIGN_EPI) { if (wr == 1) PG8_BAR; }
    }
    PG8_WAIT_V(0);
    if constexpr (!ALIGN_EPI) { if (wr == 0) PG8_BAR; }
    PG8_BAR;
    if constexpr (Epi::AFTER_DRAIN) { E.fused(acc, cur, wr, wc, fr, fq, lds, wid, lane); S.done(cur); }
#undef PG8_SA
#undef PG8_SB
#undef PG8_STAGE
#undef PG8_LDA
#undef PG8_LDB
#undef PG8_MMA
#undef PG8_WAIT_V
#undef PG8_WAIT_L
#undef PG8_BAR
#undef PG8_SCHED
}
}

constexpr int NWAVES = 8, NTHREADS = 512;
constexpr int BATCH = 4, SEQ = 4096, DM = 1024, T = BATCH * SEQ;
constexpr int INW = 5408, PW = 5632;
constexpr int NEXP = 32, TOPK = 4, DE = 1024, NASSIGN = T * TOPK, MOE_ROWS = 256;
constexpr int MOE_MAXTILES = (NASSIGN + NEXP * (MOE_ROWS - 1) + MOE_ROWS - 1) / MOE_ROWS;
constexpr int MOE_P = MOE_MAXTILES * MOE_ROWS;
constexpr float NORM_EPS = 1e-6f;
constexpr int PC_Q = 0, PC_KV = 512, PC_MLQ = 1280, PC_MLK = 1792, PC_MLV = 2304, PC_MLO = 2816, PC_MGA = 3328, PC_MGB = 4352, PC_NSAG = 5376, PC_MLIF = 5400;
constexpr int ADA_SLICES = 16, PB_SLICES = 16;

constexpr size_t MiB = 1u << 20;
constexpr size_t WS_CTL = 0, CTL_ZERO_BYTES = 1 * MiB;
constexpr size_t WS_MODP = 1 * MiB;
constexpr size_t WS_MODF = 3 * MiB;
constexpr size_t WS_PBP  = 3 * MiB + 512 * 1024;
constexpr size_t WS_WIN  = 4 * MiB;
constexpr size_t WS_WUPA = 16 * MiB, WS_WUPB = 17 * MiB;
constexpr size_t WS_WOUT = 18 * MiB;
constexpr size_t WS_CW1K = 20 * MiB, WS_CW1V = 20 * MiB + 512 * 1024;
constexpr size_t WS_CW2K = 21 * MiB, WS_CW2V = 21 * MiB + 64 * 1024;
constexpr size_t WS_KC = 22 * MiB, WS_VC = 22 * MiB + 512 * 1024;
constexpr size_t WS_SELM = 23 * MiB;
constexpr size_t WS_TOPI = 24 * MiB, WS_GATE = 24 * MiB + 256 * 1024, WS_DEST = 24 * MiB + 512 * 1024;
constexpr size_t WS_ROWG = 25 * MiB;
constexpr size_t WS_MLB = 26 * MiB, WS_MLLI = 26 * MiB + 256 * 1024;
constexpr size_t WS_MLSC = 27 * MiB;
constexpr size_t WS_MLUN = 28 * MiB, WS_MLN = 29 * MiB;
constexpr size_t WS_W1T = 32 * MiB;
constexpr size_t WS_W2T = 160 * MiB;
constexpr size_t WS_H1 = 224 * MiB;
constexpr size_t WS_A1 = 288 * MiB;
constexpr size_t WS_PROJ = 320 * MiB;
constexpr size_t WS_XG = 320 * MiB;
constexpr size_t WS_OCMP = 496 * MiB, WS_ONSA = 512 * MiB, WS_OML = 528 * MiB, WS_MLQ = 544 * MiB, WS_MLKK = 560 * MiB;
constexpr size_t WS_MLU = 576 * MiB;
constexpr size_t WS_MLC = 640 * MiB;
constexpr size_t WS_U = 674 * MiB;
constexpr size_t WS_ACT = 496 * MiB;
constexpr size_t WS_YR = 640 * MiB;
constexpr size_t WS_END = 784 * MiB;
constexpr int CW_BAR = 4096;
constexpr int CW_ECNT = 16384;
constexpr int CW_EFILL = 16384 + 64 * 32;
constexpr int CW_MOETAB = 32768;

constexpr int RING_BYTES = 131072;
constexpr int LDSCTL_OFF = 146432, MISC_OFF = LDSCTL_OFF + 320;
constexpr int LDS_BYTES = 147456;

#define GAS __attribute__((address_space(1)))
#define LAS __attribute__((address_space(3)))
typedef unsigned short bf16;
typedef unsigned v4u __attribute__((ext_vector_type(4)));
typedef unsigned v2u __attribute__((ext_vector_type(2)));
typedef float f32x4 __attribute__((ext_vector_type(4)));
typedef short bf16x8 __attribute__((ext_vector_type(8)));
typedef short s16x4 __attribute__((ext_vector_type(4)));
#define LDS_WAIT() asm volatile("s_waitcnt lgkmcnt(0)" ::: "memory")
#define VM_WAIT() asm volatile("s_waitcnt vmcnt(0)" ::: "memory")
__device__ __forceinline__ unsigned f2bf(float f) { unsigned u = __builtin_bit_cast(unsigned, f); return (u + 0x7fffu + ((u >> 16) & 1u)) >> 16; }
__device__ __forceinline__ unsigned pk2(float lo, float hi) { return f2bf(lo) | (f2bf(hi) << 16); }
__device__ __forceinline__ float bf2f(unsigned short b) { return __builtin_bit_cast(float, (unsigned)b << 16); }
__device__ __forceinline__ float bflo(unsigned w) { return __builtin_bit_cast(float, w << 16); }
__device__ __forceinline__ float bfhi(unsigned w) { return __builtin_bit_cast(float, w & 0xffff0000u); }
__device__ __forceinline__ float sigmoidf_(float x) { return 1.0f / (1.0f + __expf(-x)); }
__device__ __forceinline__ float wave_sum(float v) {
#pragma unroll
    for (int o = 1; o < 64; o <<= 1) v += __shfl_xor(v, o);
    return v;
}
__device__ __forceinline__ float wave_max(float v) {
#pragma unroll
    for (int o = 1; o < 64; o <<= 1) v = fmaxf(v, __shfl_xor(v, o));
    return v;
}
#define XB_TMO      128
#define XB_XCNT(j)  (256  + 64 * (j))
#define XB_XSUB(j)  (1280 + 64 * (j))
#define XB_XGEN(j)  (2304 + 64 * (j))
#define XB_TOP      3328
#define XB_TOPGEN   3392
#define XCD_BAR_WORDS 3456
#define XB_SPIN_CAP (1u << 18)

__device__ __forceinline__ unsigned xb_ld(unsigned* p)              { return __hip_atomic_load(p, __ATOMIC_RELAXED, __HIP_MEMORY_SCOPE_AGENT); }
__device__ __forceinline__ unsigned xb_add(unsigned* p, unsigned v) { return __hip_atomic_fetch_add(p, v, __ATOMIC_RELAXED, __HIP_MEMORY_SCOPE_AGENT); }
__device__ __forceinline__ unsigned xb_xcc_id() { return (unsigned)__builtin_amdgcn_s_getreg((3 << 11) | 20) & 0xFu; }
#define XB_SPIN(cond, bar) do { unsigned _sp = 0; while (cond) { __builtin_amdgcn_s_sleep(1); \
    if ((++_sp & 255u) == 0u) { if (xb_ld(&(bar)[XB_TMO])) break; if (_sp > XB_SPIN_CAP) { atomicAdd(&(bar)[XB_TMO], 1u); break; } } } } while (0)

struct XcdBarrier {
    unsigned* bar; unsigned x;
    volatile LAS unsigned* st;
};

__device__ __forceinline__ XcdBarrier xcd_barrier_post(unsigned* bar, volatile LAS unsigned* st) {
    XcdBarrier b; b.bar = bar; b.x = xb_xcc_id(); b.st = st;
    if (threadIdx.x == 0) (void)xb_add(&bar[XB_XCNT(b.x)], 1u);
    return b;
}
__device__ __forceinline__ void xcd_barrier_complete(unsigned* bar, unsigned x, unsigned& nloc, unsigned& nx) {
    const unsigned G = gridDim.x * gridDim.y * gridDim.z;
    unsigned sum, cnt, mine, sp = 0u;
    for (;;) {
        sum = 0u; cnt = 0u; mine = 0u;
#pragma unroll
        for (unsigned j = 0; j < 16; ++j) { const unsigned c = xb_ld(&bar[XB_XCNT(j)]); sum += c; cnt += (c > 0u) ? 1u : 0u; mine = (j == x) ? c : mine; }
        if (sum == G) break;
        __builtin_amdgcn_s_sleep(1);
        if ((++sp & 255u) == 0u) { if (xb_ld(&bar[XB_TMO])) break; if (sp > XB_SPIN_CAP) { atomicAdd(&bar[XB_TMO], 1u); break; } }
    }
    nloc = mine > 0u ? mine : 1u; nx = cnt > 0u ? cnt : 1u;
}

__device__ __forceinline__ void xcd_barrier(const XcdBarrier& b) {
    asm volatile("s_waitcnt vmcnt(0)" ::: "memory");
    __syncthreads();
    if (threadIdx.x == 0) {
        unsigned* bar = b.bar;
        __builtin_amdgcn_s_waitcnt(0);
        unsigned nloc = b.st[0], nx = b.st[1];
        if (nloc == 0u) { xcd_barrier_complete(bar, b.x, nloc, nx); b.st[0] = nloc; b.st[1] = nx; }
        const unsigned old = xb_add(&bar[XB_XSUB(b.x)], 1u);
        const unsigned gen = old / nloc;
        if (old + 1u == (gen + 1u) * nloc) {
            __builtin_amdgcn_fence(__ATOMIC_RELEASE, "agent");
            asm volatile("s_waitcnt vmcnt(0)" ::: "memory");
            const unsigned og = xb_add(&bar[XB_TOP], 1u);
            const unsigned tg = og / nx;
            if (og + 1u == (tg + 1u) * nx) xb_add(&bar[XB_TOPGEN], 1u);
            else XB_SPIN(xb_ld(&bar[XB_TOPGEN]) == tg, bar);
            __builtin_amdgcn_fence(__ATOMIC_ACQUIRE, "agent");
            xb_add(&bar[XB_XGEN(b.x)], 1u);
            asm volatile("s_waitcnt vmcnt(0)" ::: "memory");
        } else {
            XB_SPIN(xb_ld(&bar[XB_XGEN(b.x)]) == gen, bar);
            __builtin_amdgcn_fence(__ATOMIC_ACQUIRE, "agent");
            asm volatile("s_waitcnt vmcnt(0)" ::: "memory");
        }
    }
    __syncthreads();
}

using pg8::Unit; using pg8::HALF; using pg8::BM;
struct EpiStoreBf16 {
    static constexpr bool PERM = true, AFTER_DRAIN = false;
    bf16* O; int ldc;
    __device__ __forceinline__ void operator()(const f32x4 (&acc)[2][2][4][2], const Unit& u, int wr, int wc, int fr, int fq) const {
        const int row0 = u.pm * BM + wr * 64 + fr, col0 = u.pn * BM + wc * 32 + 8 * fq;
#pragma unroll
        for (int ai = 0; ai < 2; ++ai)
#pragma unroll
            for (int m = 0; m < 4; ++m) { bf16* rowp = O + (size_t)(row0 + ai * HALF + m * 16) * ldc + col0;
#pragma unroll
                for (int bj = 0; bj < 2; ++bj) { const f32x4 v0 = acc[ai][bj][m][0], v1 = acc[ai][bj][m][1];
                    v4u w; w.x = pg8::cvt_pk_bf16(v0[0], v0[1]); w.y = pg8::cvt_pk_bf16(v0[2], v0[3]); w.z = pg8::cvt_pk_bf16(v1[0], v1[1]); w.w = pg8::cvt_pk_bf16(v1[2], v1[3]);
                    *(v4u*)(rowp + bj * HALF) = w; } }
    }
};
template <bool ADD> struct EpiUpGate {
    static constexpr bool PERM = true, AFTER_DRAIN = false;
    bf16* U; const bf16* G; int goff;
    __device__ __forceinline__ void operator()(const f32x4 (&acc)[2][2][4][2], const Unit& u, int wr, int wc, int fr, int fq) const {
        const int row0 = u.pm * BM + wr * 64 + fr, col0 = u.pn * BM + wc * 32 + 8 * fq;
#pragma unroll
        for (int ai = 0; ai < 2; ++ai)
#pragma unroll
            for (int m = 0; m < 4; ++m) { const size_t row = (size_t)(row0 + ai * HALF + m * 16);
#pragma unroll
                for (int bj = 0; bj < 2; ++bj) { const int col = col0 + bj * HALF;
                    const v4u gw = *(const v4u*)(G + row * PW + goff + col);
                    f32x4 v0 = acc[ai][bj][m][0], v1 = acc[ai][bj][m][1];
                    v0[0] *= sigmoidf_(bflo(gw.x)); v0[1] *= sigmoidf_(bfhi(gw.x)); v0[2] *= sigmoidf_(bflo(gw.y)); v0[3] *= sigmoidf_(bfhi(gw.y));
                    v1[0] *= sigmoidf_(bflo(gw.z)); v1[1] *= sigmoidf_(bfhi(gw.z)); v1[2] *= sigmoidf_(bflo(gw.w)); v1[3] *= sigmoidf_(bfhi(gw.w));
                    if (ADD) { const v4u uw = *(const v4u*)(U + row * DM + col);
                        v0[0] += bflo(uw.x); v0[1] += bfhi(uw.x); v0[2] += bflo(uw.y); v0[3] += bfhi(uw.y); v1[0] += bflo(uw.z); v1[1] += bfhi(uw.z); v1[2] += bflo(uw.w); v1[3] += bfhi(uw.w); }
                    v4u w; w.x = pg8::cvt_pk_bf16(v0[0], v0[1]); w.y = pg8::cvt_pk_bf16(v0[2], v0[3]); w.z = pg8::cvt_pk_bf16(v1[0], v1[1]); w.w = pg8::cvt_pk_bf16(v1[2], v1[3]);
                    *(v4u*)(U + row * DM + col) = w; } }
    }
};
struct EpiOutRes {
    static constexpr bool PERM = false, AFTER_DRAIN = false;
    const float* X; float* H; const float* modf;
    __device__ __forceinline__ void operator()(const f32x4 (&acc)[2][2][4][2], const Unit& u, int wr, int wc, int fr, int fq) const {
        const int row0 = u.pm * BM + wr * 64 + fr, col0 = u.pn * BM + wc * 32 + 4 * fq;
        const int b = (u.pm * BM) / SEQ; const float* gt = modf + (size_t)b * 6 * DM + 2 * DM;
        f32x4 gv[2][2];
#pragma unroll
        for (int bj = 0; bj < 2; ++bj)
#pragma unroll
            for (int n = 0; n < 2; ++n) gv[bj][n] = *(const f32x4*)(gt + col0 + bj * HALF + n * 16) + 1.0f;
#pragma unroll
        for (int ai = 0; ai < 2; ++ai)
#pragma unroll
            for (int m = 0; m < 4; ++m) { const size_t off = (size_t)(row0 + ai * HALF + m * 16) * DM + col0;
#pragma unroll
                for (int bj = 0; bj < 2; ++bj)
#pragma unroll
                    for (int n = 0; n < 2; ++n) { const f32x4 xv = *(const f32x4*)(X + off + bj * HALF + n * 16);
                        *(f32x4*)(H + off + bj * HALF + n * 16) = xv + gv[bj][n] * acc[ai][bj][m][n]; } }
    }
};
struct EpiMoe1 {
    static constexpr bool PERM = true, AFTER_DRAIN = false;
    bf16* ACT; const float* b1;
    __device__ __forceinline__ void operator()(const f32x4 (&acc)[2][2][4][2], const Unit& u, int wr, int wc, int fr, int fq) const {
        const int e = u.pn >> 3, pnl = u.pn & 7;
        const int row0 = u.pm * BM + wr * 64 + fr, c0 = pnl * 128 + wc * 32 + 8 * fq;
        const float* bg = b1 + (size_t)e * 2048 + c0; const float* bl = bg + 1024;
        const f32x4 bg0 = *(const f32x4*)bg, bg1 = *(const f32x4*)(bg + 4), bl0 = *(const f32x4*)bl, bl1 = *(const f32x4*)(bl + 4);
#pragma unroll
        for (int ai = 0; ai < 2; ++ai)
#pragma unroll
            for (int m = 0; m < 4; ++m) { bf16* rowp = ACT + (size_t)(row0 + ai * HALF + m * 16) * DE + c0;
                float o[8];
#pragma unroll
                for (int n = 0; n < 2; ++n) { const f32x4 g = acc[ai][0][m][n] + (n ? bg1 : bg0), l = acc[ai][1][m][n] + (n ? bl1 : bl0);
#pragma unroll
                    for (int i = 0; i < 4; ++i) { const float gg = fminf(g[i], 7.0f), ll = fminf(fmaxf(l[i], -7.0f), 7.0f);
                        o[n * 4 + i] = gg * sigmoidf_(1.702f * gg) * (ll + 1.0f); } }
                v4u w; w.x = pg8::cvt_pk_bf16(o[0], o[1]); w.y = pg8::cvt_pk_bf16(o[2], o[3]); w.z = pg8::cvt_pk_bf16(o[4], o[5]); w.w = pg8::cvt_pk_bf16(o[6], o[7]);
                *(v4u*)rowp = w; }
    }
};
struct EpiMoe2 {
    static constexpr bool PERM = true, AFTER_DRAIN = false;
    bf16* Y; const float* b2; const float* rg;
    __device__ __forceinline__ void operator()(const f32x4 (&acc)[2][2][4][2], const Unit& u, int wr, int wc, int fr, int fq) const {
        const int e = u.pn >> 2, pnl = u.pn & 3;
        const int row0 = u.pm * BM + wr * 64 + fr, col0 = pnl * BM + wc * 32 + 8 * fq;
        f32x4 bv[2][2];
#pragma unroll
        for (int bj = 0; bj < 2; ++bj)
#pragma unroll
            for (int n = 0; n < 2; ++n) bv[bj][n] = *(const f32x4*)(b2 + (size_t)e * DM + col0 + bj * HALF + 4 * n);
#pragma unroll
        for (int ai = 0; ai < 2; ++ai)
#pragma unroll
            for (int m = 0; m < 4; ++m) { const int row = row0 + ai * HALF + m * 16; const float g = rg[row]; bf16* rowp = Y + (size_t)row * DM + col0;
#pragma unroll
                for (int bj = 0; bj < 2; ++bj) { const f32x4 v0 = (acc[ai][bj][m][0] + bv[bj][0]) * g, v1 = (acc[ai][bj][m][1] + bv[bj][1]) * g;
                    v4u w; w.x = pg8::cvt_pk_bf16(v0[0], v0[1]); w.y = pg8::cvt_pk_bf16(v0[2], v0[3]); w.z = pg8::cvt_pk_bf16(v1[0], v1[1]); w.w = pg8::cvt_pk_bf16(v1[2], v1[3]);
                    *(v4u*)(rowp + bj * HALF) = w; } }
    }
};
struct MoeOrder {
    int nN, sh, G, v; const unsigned* tab;
    __device__ __forceinline__ bool next(int i, Unit& u) const {
        const int ntl = (int)tab[0]; const long L = (long)i * G + v; if (L >= (long)ntl * nN) return false;
        const int pm = (int)(L >> sh), pnl = (int)(L & (nN - 1)); const int e = (int)tab[64 + pm];
        u.pm = pm; u.pn = e * nN + pnl; return true;
    }
    __device__ __forceinline__ void a_ready(const Unit&) const {}
    __device__ __forceinline__ void done(const Unit&) const {}
};

struct Args { const float* in[27]; float* out; unsigned char* ws; int ph_lo, ph_hi; };
struct Ctx {
    LAS unsigned char* lds; unsigned char* ws; unsigned* ctl;
    int tid, lane, wave, vcu, G;
    const float* const* in; float* out;
};
enum { I_X = 0, I_C, I_ADAW, I_ADAB, I_N1G, I_WIN, I_PEK, I_PEV, I_CW1K, I_CW2K, I_CW1V, I_CW2V, I_CONVW, I_CONVB, I_GATEB, I_MLNG, I_WUPA, I_WUPB, I_WOUT, I_N2G, I_RW, I_RB, I_EW1, I_EB1, I_EW2, I_EB2, I_FG };

template <class DMap>
__device__ __forceinline__ void p0_transpose_item(const float* W, int K, int N, bf16* WT, const DMap& dmap, LAS float* scr, int item, int lane) {
    const int nblk = N / 32, kb = item / nblk, nb = item % nblk, k0 = 64 * kb, n0 = 32 * nb;
#pragma unroll 8
    for (int i = 0; i < 32; ++i) { const int kk = 2 * i + (lane >> 5); scr[kk * 33 + (lane & 31)] = W[(size_t)(k0 + kk) * N + n0 + (lane & 31)]; }
    LDS_WAIT(); asm volatile("" ::: "memory");
    const int c = lane & 7;
#pragma unroll
    for (int j = 0; j < 4; ++j) { const int n = (lane >> 3) + 8 * j; const LAS float* s = scr + (8 * c) * 33 + n;
        v4u o; o.x = pk2(s[0 * 33], s[1 * 33]); o.y = pk2(s[2 * 33], s[3 * 33]); o.z = pk2(s[4 * 33], s[5 * 33]); o.w = pk2(s[6 * 33], s[7 * 33]);
        *(GAS v4u*)(WT + (size_t)dmap(n0 + n) * K + k0 + 8 * c) = o; }
    LDS_WAIT(); asm volatile("" ::: "memory");
}
struct DMapId { __device__ __forceinline__ int operator()(int n) const { return n; } };
struct DMapWin { __device__ __forceinline__ int operator()(int n) const {
    if (n < 1280) return n;
    if (n < 1304) return PC_NSAG + (n - 1280);
    if (n < 2328) return PC_MLQ + (n - 1304);
    if (n < 2840) return PC_MLV + (n - 2328);
    if (n < 2848) return PC_MLIF + (n - 2840);
    if (n < 3360) return PC_MLO + (n - 2848);
    return PC_MGA + (n - 3360); } };
struct DMapW1 { __device__ __forceinline__ int operator()(int n) const { return n < 1024 ? ((n >> 7) << 8) + (n & 127) : (((n - 1024) >> 7) << 8) + 128 + (n & 127); } };

__device__ __forceinline__ void p0_prologue(Ctx& F) {
    LAS float* scr = (LAS float*)(F.lds + F.wave * 16384);
    const int gw = F.vcu * NWAVES + F.wave, NGW = F.G * NWAVES;
    constexpr int I_IN = (DM / 64) * (INW / 32), I_UP = (512 / 64) * (DM / 32), I_OUT = (DM / 64) * (DM / 32), I_C1 = (2048 / 64) * (128 / 32), I_C2 = (128 / 64) * (64 / 32);
    constexpr int I_E1 = (DM / 64) * (2048 / 32), I_E2 = (DE / 64) * (DM / 32);
    constexpr int NITEMS = I_IN + 2 * I_UP + I_OUT + 2 * I_C1 + 2 * I_C2 + NEXP * (I_E1 + I_E2);
    for (int it = gw; it < NITEMS; it += NGW) {
        int r = it;
        if (r < I_IN) { p0_transpose_item(F.in[I_WIN], DM, INW, (bf16*)(F.ws + WS_WIN), DMapWin(), scr, r, F.lane); continue; } r -= I_IN;
        if (r < I_UP) { p0_transpose_item(F.in[I_WUPA], 512, DM, (bf16*)(F.ws + WS_WUPA), DMapId(), scr, r, F.lane); continue; } r -= I_UP;
        if (r < I_UP) { p0_transpose_item(F.in[I_WUPB], 512, DM, (bf16*)(F.ws + WS_WUPB), DMapId(), scr, r, F.lane); continue; } r -= I_UP;
        if (r < I_OUT) { p0_transpose_item(F.in[I_WOUT], DM, DM, (bf16*)(F.ws + WS_WOUT), DMapId(), scr, r, F.lane); continue; } r -= I_OUT;
        if (r < I_C1) { p0_transpose_item(F.in[I_CW1K], 2048, 128, (bf16*)(F.ws + WS_CW1K), DMapId(), scr, r, F.lane); continue; } r -= I_C1;
        if (r < I_C1) { p0_transpose_item(F.in[I_CW1V], 2048, 128, (bf16*)(F.ws + WS_CW1V), DMapId(), scr, r, F.lane); continue; } r -= I_C1;
        if (r < I_C2) { p0_transpose_item(F.in[I_CW2K], 128, 64, (bf16*)(F.ws + WS_CW2K), DMapId(), scr, r, F.lane); continue; } r -= I_C2;
        if (r < I_C2) { p0_transpose_item(F.in[I_CW2V], 128, 64, (bf16*)(F.ws + WS_CW2V), DMapId(), scr, r, F.lane); continue; } r -= I_C2;
        if (r < NEXP * I_E1) { const int e = r / I_E1; p0_transpose_item(F.in[I_EW1] + (size_t)e * DM * 2048, DM, 2048, (bf16*)(F.ws + WS_W1T) + (size_t)e * 2048 * DM, DMapW1(), scr, r % I_E1, F.lane); continue; } r -= NEXP * I_E1;
        { const int e = r / I_E2; p0_transpose_item(F.in[I_EW2] + (size_t)e * DE * DM, DE, DM, (bf16*)(F.ws + WS_W2T) + (size_t)e * DM * DE, DMapId(), scr, r % I_E2, F.lane); }
    }
    {
        const int gt = F.vcu * NTHREADS + F.tid, NGT = F.G * NTHREADS;
        const float* c = F.in[I_C]; const float* aw = F.in[I_ADAW]; float* modp = (float*)(F.ws + WS_MODP);
        for (int w = gt; w < ADA_SLICES * 6144; w += NGT) {
            const int s = w / 6144, j = w % 6144; float a0 = 0.f, a1 = 0.f, a2 = 0.f, a3 = 0.f;
#pragma unroll 8
            for (int kk = 0; kk < 64; ++kk) { const int k = s * 64 + kk; const float wv = aw[(size_t)k * 6144 + j];
                const float c0 = c[k], c1 = c[DM + k], c2 = c[2 * DM + k], c3 = c[3 * DM + k];
                a0 += c0 * sigmoidf_(c0) * wv; a1 += c1 * sigmoidf_(c1) * wv; a2 += c2 * sigmoidf_(c2) * wv; a3 += c3 * sigmoidf_(c3) * wv; }
            modp[(size_t)(s * 4 + 0) * 6144 + j] = a0; modp[(size_t)(s * 4 + 1) * 6144 + j] = a1; modp[(size_t)(s * 4 + 2) * 6144 + j] = a2; modp[(size_t)(s * 4 + 3) * 6144 + j] = a3;
        }
        float* pbp = (float*)(F.ws + WS_PBP);
        for (int w = gt; w < PB_SLICES * 2 * 128; w += NGT) {
            const int s = w / 256, kv = (w >> 7) & 1, j = w & 127; const float* pe = F.in[kv ? I_PEV : I_PEK]; const float* w1 = F.in[kv ? I_CW1V : I_CW1K]; float a = 0.f;
#pragma unroll 8
            for (int ii = 0; ii < 128; ++ii) { const int i = s * 128 + ii; a += pe[i] * w1[(size_t)i * 128 + j]; }
            pbp[w] = a;
        }
    }
}

template <bool WITH_MOE>
__device__ __forceinline__ void p_final(Ctx& F, const float* H, const float* modf) {
    const int gw = F.vcu * NWAVES + F.wave, NGW = F.G * NWAVES;
    const bf16* Y = (const bf16*)(F.ws + WS_YR); const int* dest = (const int*)(F.ws + WS_DEST);
    const float* fg = F.in[I_FG];
    f32x4 g[4];
#pragma unroll
    for (int j = 0; j < 4; ++j) g[j] = *(const f32x4*)(fg + 4 * F.lane + 256 * j);
    for (int t = gw; t < T; t += NGW) {
        const int b = t / SEQ; f32x4 v[4]; float ss = 0.f;
#pragma unroll
        for (int j = 0; j < 4; ++j) v[j] = *(const f32x4*)(H + (size_t)t * DM + 4 * F.lane + 256 * j);
        if (WITH_MOE) {
            f32x4 m[4];
#pragma unroll
            for (int j = 0; j < 4; ++j) m[j] = (f32x4){0.f, 0.f, 0.f, 0.f};
#pragma unroll
            for (int k = 0; k < TOPK; ++k) { const int r = dest[t * 4 + k];
#pragma unroll
                for (int j = 0; j < 4; ++j) { const v2u w = *(const v2u*)(Y + (size_t)r * DM + 4 * F.lane + 256 * j);
                    m[j][0] += bflo(w.x); m[j][1] += bfhi(w.x); m[j][2] += bflo(w.y); m[j][3] += bfhi(w.y); } }
            const float* gt = modf + (size_t)b * 6 * DM + 5 * DM;
#pragma unroll
            for (int j = 0; j < 4; ++j) { const f32x4 gg = *(const f32x4*)(gt + 4 * F.lane + 256 * j) + 1.0f; v[j] = v[j] + gg * m[j]; }
        }
#pragma unroll
        for (int j = 0; j < 4; ++j) ss += (v[j][0] * v[j][0] + v[j][1] * v[j][1]) + (v[j][2] * v[j][2] + v[j][3] * v[j][3]);
        const float rs = rsqrtf(wave_sum(ss) * (1.0f / DM) + NORM_EPS);
#pragma unroll
        for (int j = 0; j < 4; ++j) *(f32x4*)(F.out + (size_t)t * DM + 4 * F.lane + 256 * j) = v[j] * rs * g[j];
    }
}

__device__ __forceinline__ void p1_norm1(Ctx& F) {
    const float* modp = (const float*)(F.ws + WS_MODP); const float* adab = F.in[I_ADAB]; float* modfw = (float*)(F.ws + WS_MODF);
    { const int gt = F.vcu * NTHREADS + F.tid, NGT = F.G * NTHREADS;
      for (int w = gt; w < 4 * 6144; w += NGT) { const int b = w / 6144, j = w % 6144; float a = adab[j];
#pragma unroll
          for (int s = 0; s < ADA_SLICES; ++s) a += modp[(size_t)(s * 4 + b) * 6144 + j];
          modfw[w] = a; } }
    LAS float* shs = (LAS float*)F.lds; LAS float* scs = shs + DM;
    const float* x = F.in[I_X]; const float* g1 = F.in[I_N1G]; bf16* A1 = (bf16*)(F.ws + WS_A1);
    int curb = -1;
    for (int blk = F.vcu; blk < T / 64; blk += F.G) {
        const int b = (blk * 64) / SEQ;
        if (b != curb) { __syncthreads();
            for (int j = F.tid; j < 2 * DM; j += NTHREADS) { float a = adab[j];
#pragma unroll
                for (int s = 0; s < ADA_SLICES; ++s) a += modp[(size_t)(s * 4 + b) * 6144 + j];
                if (j < DM) shs[j] = a; else scs[j - DM] = (1.0f + a) * g1[j - DM]; }
            __syncthreads(); curb = b; }
        for (int tt = F.wave; tt < 64; tt += NWAVES) { const int t = blk * 64 + tt;
            f32x4 v[4]; float ss = 0.f;
#pragma unroll
            for (int j = 0; j < 4; ++j) { v[j] = *(const f32x4*)(x + (size_t)t * DM + 4 * F.lane + 256 * j); ss += (v[j][0] * v[j][0] + v[j][1] * v[j][1]) + (v[j][2] * v[j][2] + v[j][3] * v[j][3]); }
            const float rs = rsqrtf(wave_sum(ss) * (1.0f / DM) + NORM_EPS);
#pragma unroll
            for (int j = 0; j < 4; ++j) { const f32x4 sc = *(const LAS f32x4*)(scs + 4 * F.lane + 256 * j), sh = *(const LAS f32x4*)(shs + 4 * F.lane + 256 * j);
                const f32x4 o = v[j] * rs * sc + sh; v2u w; w.x = pk2(o[0], o[1]); w.y = pk2(o[2], o[3]);
                *(v2u*)(A1 + (size_t)t * DM + 4 * F.lane + 256 * j) = w; }
        }
    }
    __syncthreads();
}

constexpr int RW_STRIDE = 1028;
__device__ __forceinline__ void p8_norm2_router(Ctx& F, const float* H, const float* modf) {
    LAS float* rwT = (LAS float*)F.lds;
    LAS int* hist = (LAS int*)(F.lds + 32 * RW_STRIDE * 4);
    const float* rw = F.in[I_RW]; const float* rb = F.in[I_RB]; const float* g2 = F.in[I_N2G];
    for (int i = F.tid; i < DM * NEXP; i += NTHREADS) rwT[(i & 31) * RW_STRIDE + (i >> 5)] = rw[i];
    if (F.tid < 32) hist[F.tid] = 0;
    __syncthreads();
    bf16* N2 = (bf16*)(F.ws + WS_A1); int* topi = (int*)(F.ws + WS_TOPI); float* gate = (float*)(F.ws + WS_GATE);
    const float rbl = rb[F.lane & 31];
    f32x4 gv[4];
#pragma unroll
    for (int j = 0; j < 4; ++j) gv[j] = *(const f32x4*)(g2 + 4 * F.lane + 256 * j);
    for (int blk = F.vcu; blk < T / 64; blk += F.G) {
        const int b = (blk * 64) / SEQ; const float* sh2 = modf + (size_t)b * 6 * DM + 3 * DM; const float* sc2 = sh2 + DM;
        for (int tt = F.wave; tt < 64; tt += NWAVES) { const int t = blk * 64 + tt;
            f32x4 v[4]; float ss = 0.f;
#pragma unroll
            for (int j = 0; j < 4; ++j) { v[j] = *(const f32x4*)(H + (size_t)t * DM + 4 * F.lane + 256 * j); ss += (v[j][0] * v[j][0] + v[j][1] * v[j][1]) + (v[j][2] * v[j][2] + v[j][3] * v[j][3]); }
            const float rs = rsqrtf(wave_sum(ss) * (1.0f / DM) + NORM_EPS);
#pragma unroll
            for (int j = 0; j < 4; ++j) { const f32x4 sc = *(const f32x4*)(sc2 + 4 * F.lane + 256 * j) + 1.0f, sh = *(const f32x4*)(sh2 + 4 * F.lane + 256 * j);
                v[j] = v[j] * rs * gv[j] * sc + sh; v2u w; w.x = pk2(v[j][0], v[j][1]); w.y = pk2(v[j][2], v[j][3]);
                *(v2u*)(N2 + (size_t)t * DM + 4 * F.lane + 256 * j) = w; }
            float mine = -3.0e38f;
#pragma unroll 4
            for (int e = 0; e < NEXP; ++e) { float p = 0.f;
#pragma unroll
                for (int j = 0; j < 4; ++j) { const f32x4 w = *(const LAS f32x4*)(rwT + e * RW_STRIDE + 4 * F.lane + 256 * j); p += (v[j][0] * w[0] + v[j][1] * w[1]) + (v[j][2] * w[2] + v[j][3] * w[3]); }
                p = wave_sum(p); if (F.lane == e) mine = p + rbl; }
            int si[4]; float sv[4];
#pragma unroll
            for (int k = 0; k < 4; ++k) { const float m = wave_max(mine); const unsigned long long bal = __ballot(mine == m); const int idx = __ffsll((long long)bal) - 1;
                si[k] = idx; sv[k] = m; if (F.lane == idx) mine = -3.0e38f; }
            const float e1 = __expf(sv[1] - sv[0]), e2 = __expf(sv[2] - sv[0]), e3 = __expf(sv[3] - sv[0]); const float inv = 1.0f / (1.0f + e1 + e2 + e3);
            if (F.lane < 4) { const int k = F.lane; const int ei = k == 0 ? si[0] : k == 1 ? si[1] : k == 2 ? si[2] : si[3]; const float gk = (k == 0 ? 1.0f : k == 1 ? e1 : k == 2 ? e2 : e3) * inv;
                topi[t * 4 + k] = ei; gate[t * 4 + k] = gk; __hip_atomic_fetch_add(&hist[ei], 1, __ATOMIC_RELAXED, __HIP_MEMORY_SCOPE_WORKGROUP); }
        }
    }
    __syncthreads();
    if (F.tid < 32) { const int h = hist[F.tid]; if (h) __hip_atomic_fetch_add(F.ctl + CW_ECNT + 64 * F.tid, (unsigned)h, __ATOMIC_RELAXED, __HIP_MEMORY_SCOPE_AGENT); }
    __syncthreads();
}

__device__ __forceinline__ void p9_permute(Ctx& F) {
    LAS int* sm = (LAS int*)F.lds; LAS int* cnt = sm, *pstart = sm + 32, *lhist = sm + 64, *lbase = sm + 96, *dl = sm + 128;
    if (F.tid < 32) cnt[F.tid] = (int)__hip_atomic_load(F.ctl + CW_ECNT + 64 * F.tid, __ATOMIC_RELAXED, __HIP_MEMORY_SCOPE_AGENT);
    __syncthreads();
    if (F.tid == 0) { int run = 0; unsigned* tab = F.ctl + CW_MOETAB; const bool w0 = (blockIdx.x == 0);
        for (int e = 0; e < NEXP; ++e) { pstart[e] = run; const int nt = (cnt[e] + MOE_ROWS - 1) / MOE_ROWS;
            if (w0) for (int i = 0; i < nt; ++i) tab[64 + run / MOE_ROWS + i] = (unsigned)e;
            run += nt * MOE_ROWS; }
        if (w0) tab[0] = (unsigned)(run / MOE_ROWS); }
    __syncthreads();
    const bf16* N2 = (const bf16*)(F.ws + WS_A1); bf16* XG = (bf16*)(F.ws + WS_XG);
    const int* topi = (const int*)(F.ws + WS_TOPI); const float* gate = (const float*)(F.ws + WS_GATE); int* dest = (int*)(F.ws + WS_DEST); float* rowg = (float*)(F.ws + WS_ROWG);
    for (int blk = F.vcu; blk < T / 64; blk += F.G) {
        if (F.tid < 32) lhist[F.tid] = 0;
        __syncthreads();
        int e = 0, rank = 0; const int a = blk * 256 + F.tid;
        if (F.tid < 256) { e = topi[a]; rank = __hip_atomic_fetch_add(&lhist[e], 1, __ATOMIC_RELAXED, __HIP_MEMORY_SCOPE_WORKGROUP); }
        __syncthreads();
        if (F.tid < 32) { const int h = lhist[F.tid]; lbase[F.tid] = pstart[F.tid] + (h ? (int)__hip_atomic_fetch_add(F.ctl + CW_EFILL + 64 * F.tid, (unsigned)h, __ATOMIC_RELAXED, __HIP_MEMORY_SCOPE_AGENT) : 0); }
        __syncthreads();
        if (F.tid < 256) { const int d = lbase[e] + rank; dest[a] = d; rowg[d] = gate[a]; dl[F.tid] = d; }
        __syncthreads();
        for (int tt = F.wave; tt < 64; tt += NWAVES) { const int t = blk * 64 + tt;
            const v4u r0 = *(const v4u*)(N2 + (size_t)t * DM + 8 * F.lane), r1 = *(const v4u*)(N2 + (size_t)t * DM + 512 + 8 * F.lane);
#pragma unroll
            for (int k = 0; k < 4; ++k) { const int d = dl[tt * 4 + k]; *(v4u*)(XG + (size_t)d * DM + 8 * F.lane) = r0; *(v4u*)(XG + (size_t)d * DM + 512 + 8 * F.lane) = r1; }
        }
        __syncthreads();
    }
}

__device__ __forceinline__ f32x4 mfma16(bf16x8 a, bf16x8 b, f32x4 c) { return __builtin_amdgcn_mfma_f32_16x16x32_bf16(a, b, c, 0, 0, 0); }
typedef short v4i16_t __attribute__((ext_vector_type(4)));
__device__ __forceinline__ s16x4 lds_tr4(const LAS unsigned char* p) { return __builtin_bit_cast(s16x4, __builtin_amdgcn_ds_read_tr16_b64_v4i16((LAS v4i16_t*)p)); }
__device__ __forceinline__ bf16x8 tr_frag(const LAS unsigned char* img, int sb, int r0, int r1, int n0, int lane) {
    const int q = (lane & 15) >> 2, p = lane & 3;
    const s16x4 lo = lds_tr4(img + (r0 + q) * sb + (n0 + 4 * p) * 2), hi = lds_tr4(img + (r1 + q) * sb + (n0 + 4 * p) * 2);
    return (bf16x8){lo[0], lo[1], lo[2], lo[3], hi[0], hi[1], hi[2], hi[3]};
}
__device__ __forceinline__ bf16x8 lds_row8(const LAS unsigned char* img, int sb, int row, int col) { return *(const LAS bf16x8*)(img + row * sb + col * 2); }
__device__ __forceinline__ bf16x8 pack8(const f32x4 a, const f32x4 b) {
    v4u w; w.x = pg8::cvt_pk_bf16(a[0], a[1]); w.y = pg8::cvt_pk_bf16(a[2], a[3]); w.z = pg8::cvt_pk_bf16(b[0], b[1]); w.w = pg8::cvt_pk_bf16(b[2], b[3]);
    return __builtin_bit_cast(bf16x8, w);
}
__device__ __forceinline__ float grp_max(float v) { v = fmaxf(v, __shfl_xor(v, 16)); return fmaxf(v, __shfl_xor(v, 32)); }
__device__ __forceinline__ float grp_sum(float v) { v += __shfl_xor(v, 16); return v + __shfl_xor(v, 32); }
constexpr float NEG_BIG = -1.0e30f;
constexpr float LOG2E = 1.4426950408889634f;
constexpr int KV_SB = 144;
constexpr int W128_SB = 272;

template <int MODE>
__device__ __forceinline__ void nsa_pass(Ctx& F, const bf16* proj, int b, int g, int qb, int kcol, int vcol, const bf16x8 (&qf)[2][2], const unsigned long long (&selm)[2],
                                         f32x4 (&ot)[2][4], float (&lsum)[2]) {
    LAS unsigned char* Kt = F.lds; LAS unsigned char* Vt = F.lds + 2 * 64 * KV_SB;
    const int lane = F.lane, gq = lane >> 4, th = F.wave >> 2;
    const int ntile = MODE == 0 ? qb + 1 : (qb < 8 ? qb + 1 : 9);
    const int lrow = F.tid >> 3, lch = F.tid & 7;
    const size_t rbase = (size_t)b * SEQ;
    float mrun[2] = {NEG_BIG, NEG_BIG};
#pragma unroll
    for (int qi = 0; qi < 2; ++qi) { lsum[qi] = 0.f;
#pragma unroll
        for (int db = 0; db < 4; ++db) ot[qi][db] = (f32x4){0.f, 0.f, 0.f, 0.f}; }
    auto tile_of = [&](int it) { return MODE == 0 ? it : qb - it; };
    v4u kreg, vreg;
    { const int j = tile_of(0); const bf16* src = proj + (rbase + (size_t)j * 64 + lrow) * PW + lch * 8; kreg = *(const v4u*)(src + kcol); vreg = *(const v4u*)(src + vcol); }
    __syncthreads();
    for (int it = 0; it < ntile; ++it) {
        const int buf = it & 1, j = tile_of(it);
        *(LAS v4u*)(Kt + buf * 64 * KV_SB + lrow * KV_SB + lch * 16) = kreg; *(LAS v4u*)(Vt + buf * 64 * KV_SB + lrow * KV_SB + lch * 16) = vreg;
        __syncthreads();
        if (it + 1 < ntile) { const int jn = tile_of(it + 1); const bf16* src = proj + (rbase + (size_t)jn * 64 + lrow) * PW + lch * 8; kreg = *(const v4u*)(src + kcol); vreg = *(const v4u*)(src + vcol); }
        const LAS unsigned char* Kb = Kt + buf * 64 * KV_SB; const LAS unsigned char* Vb = Vt + buf * 64 * KV_SB;
        f32x4 s[2][4];
#pragma unroll
        for (int kb = 0; kb < 4; ++kb) { const bf16x8 k0 = lds_row8(Kb, KV_SB, 16 * kb + (lane & 15), 8 * gq), k1 = lds_row8(Kb, KV_SB, 16 * kb + (lane & 15), 32 + 8 * gq);
#pragma unroll
            for (int qi = 0; qi < 2; ++qi) { f32x4 a = (f32x4){0.f, 0.f, 0.f, 0.f}; a = mfma16(k0, qf[qi][0], a); a = mfma16(k1, qf[qi][1], a); s[qi][kb] = a; } }
#pragma unroll
        for (int qi = 0; qi < 2; ++qi) {
            const int i = th * 32 + qi * 16 + (lane & 15);
            bool rowok = true; if (MODE == 0) rowok = (selm[qi] >> j) & 1ull;
            float mx = NEG_BIG;
#pragma unroll
            for (int kb = 0; kb < 4; ++kb)
#pragma unroll
                for (int r = 0; r < 4; ++r) { const int kvl = 16 * kb + 4 * gq + r; bool ok;
                    if (MODE == 0) ok = rowok && (j < qb || kvl <= i);
                    else { const int rel = (qb - j) * 64 + i - kvl; ok = rel >= 0 && rel < 512; }
                    const float v = ok ? s[qi][kb][r] * (0.125f * LOG2E) : NEG_BIG; s[qi][kb][r] = v; mx = fmaxf(mx, v); }
            mx = grp_max(mx);
            const float mnew = fmaxf(mrun[qi], mx), alpha = exp2f(mrun[qi] - mnew); mrun[qi] = mnew;
            float ps = 0.f;
#pragma unroll
            for (int kb = 0; kb < 4; ++kb)
#pragma unroll
                for (int r = 0; r < 4; ++r) { const float p = exp2f(s[qi][kb][r] - mnew); s[qi][kb][r] = p; ps += p; }
            lsum[qi] = lsum[qi] * alpha + ps;
#pragma unroll
            for (int db = 0; db < 4; ++db) ot[qi][db] *= alpha;
        }
#pragma unroll
        for (int st = 0; st < 2; ++st) {
            const bf16x8 p0 = pack8(s[0][2 * st], s[0][2 * st + 1]), p1 = pack8(s[1][2 * st], s[1][2 * st + 1]);
#pragma unroll
            for (int db = 0; db < 4; ++db) { const bf16x8 vf = tr_frag(Vb, KV_SB, 32 * st + 4 * gq, 32 * st + 16 + 4 * gq, 16 * db, lane);
                ot[0][db] = mfma16(vf, p0, ot[0][db]); ot[1][db] = mfma16(vf, p1, ot[1][db]); }
        }
    }
}

__device__ __forceinline__ void nsa_selwin_unit(Ctx& F, int b, int g, int qb) {
    const bf16* proj = (const bf16*)(F.ws + WS_PROJ); const bf16* ocmp = (const bf16*)(F.ws + WS_OCMP); bf16* onsa = (bf16*)(F.ws + WS_ONSA);
    const unsigned long long* selmask = (const unsigned long long*)(F.ws + WS_SELM);
    const int lane = F.lane, gq = lane >> 4, hr = F.wave & 3, th = F.wave >> 2, head = g * 4 + hr;
    bf16x8 qf[2][2]; unsigned long long selm[2]; size_t trow[2];
#pragma unroll
    for (int qi = 0; qi < 2; ++qi) { const int t = qb * 64 + th * 32 + qi * 16 + (lane & 15); trow[qi] = (size_t)b * SEQ + t;
        selm[qi] = selmask[(size_t)(b * 2 + g) * SEQ + t];
#pragma unroll
        for (int st = 0; st < 2; ++st) qf[qi][st] = *(const bf16x8*)(proj + trow[qi] * PW + PC_Q + head * 64 + 32 * st + 8 * gq); }
    f32x4 ot[2][4], res[2][4]; float lsum[2];
    nsa_pass<0>(F, proj, b, g, qb, PC_KV + 2 * 128 + g * 64, PC_KV + 3 * 128 + g * 64, qf, selm, ot, lsum);
#pragma unroll
    for (int qi = 0; qi < 2; ++qi) { const float gate = sigmoidf_(bf2f(proj[trow[qi] * PW + PC_NSAG + 8 + head])) / grp_sum(lsum[qi]);
#pragma unroll
        for (int db = 0; db < 4; ++db) res[qi][db] = ot[qi][db] * gate; }
    nsa_pass<1>(F, proj, b, g, qb, PC_KV + 4 * 128 + g * 64, PC_KV + 5 * 128 + g * 64, qf, selm, ot, lsum);
#pragma unroll
    for (int qi = 0; qi < 2; ++qi) { const float gate = sigmoidf_(bf2f(proj[trow[qi] * PW + PC_NSAG + 16 + head])) / grp_sum(lsum[qi]);
#pragma unroll
        for (int db = 0; db < 4; ++db) { const size_t o = trow[qi] * 512 + head * 64 + 16 * db + 4 * gq; const v2u c = *(const v2u*)(ocmp + o);
            f32x4 v = res[qi][db] + ot[qi][db] * gate; v[0] += bflo(c.x); v[1] += bfhi(c.x); v[2] += bflo(c.y); v[3] += bfhi(c.y);
            v2u w; w.x = pg8::cvt_pk_bf16(v[0], v[1]); w.y = pg8::cvt_pk_bf16(v[2], v[3]); *(v2u*)(onsa + o) = w; } }
}

__device__ __forceinline__ float gelu_tanh(float x) { const float u = 0.7978845608028654f * (x + 0.044715f * x * x * x); const float e = __expf(2.0f * u); const float th = 1.0f - 2.0f / (e + 1.0f); return 0.5f * x * (1.0f + th); }
__device__ __forceinline__ void nsa_compress_unit(Ctx& F, int unit) {
    const int nt = unit & 15, kv = (unit >> 4) & 1, bg = unit >> 5, b = bg >> 1, g = bg & 1, n0 = nt * 16;
    const bf16* proj = (const bf16*)(F.ws + WS_PROJ);
    const bf16* w1t = (const bf16*)(F.ws + (kv ? WS_CW1V : WS_CW1K)); const bf16* w2t = (const bf16*)(F.ws + (kv ? WS_CW2V : WS_CW2K));
    bf16* outp = (bf16*)(F.ws + (kv ? WS_VC : WS_KC)) + (size_t)bg * 256 * 64;
    const float* pbp = (const float*)(F.ws + WS_PBP);
    LAS unsigned char* Hs = F.lds;
    const int lane = F.lane, gq = lane >> 4, w = F.wave;
    const int col = PC_KV + kv * 128 + g * 64;
    int nrow = n0 + (lane & 15); if (nrow > 254) nrow = 254;
    const bf16* arow = proj + ((size_t)b * SEQ + 16 * nrow) * PW + col + 8 * gq;
    const bf16* brow = w1t + (size_t)(16 * w + (lane & 15)) * 2048 + 8 * gq;
    f32x4 acc = (f32x4){0.f, 0.f, 0.f, 0.f};
#pragma unroll 8
    for (int s = 0; s < 64; ++s) {
        const bf16x8 a = *(const bf16x8*)(arow + (size_t)(s >> 1) * PW + (s & 1) * 32);
        const bf16x8 bb = *(const bf16x8*)(brow + 32 * s);
        acc = mfma16(a, bb, acc);
    }
    { const int j = 16 * w + (lane & 15); float pb = 0.f;
#pragma unroll
      for (int s = 0; s < PB_SLICES; ++s) pb += pbp[(s * 2 + kv) * 128 + j];
      __syncthreads();
#pragma unroll
      for (int r = 0; r < 4; ++r) *(LAS unsigned short*)(Hs + (4 * gq + r) * W128_SB + j * 2) = (unsigned short)f2bf(gelu_tanh(acc[r] + pb));
    }
    __syncthreads();
    if (w < 4) {
        f32x4 o = (f32x4){0.f, 0.f, 0.f, 0.f};
#pragma unroll
        for (int s = 0; s < 4; ++s) { const bf16x8 a = lds_row8(Hs, W128_SB, lane & 15, 32 * s + 8 * gq); const bf16x8 bb = *(const bf16x8*)(w2t + (size_t)(16 * w + (lane & 15)) * 128 + 32 * s + 8 * gq); o = mfma16(a, bb, o); }
#pragma unroll
        for (int r = 0; r < 4; ++r) { const int n = n0 + 4 * gq + r; outp[(size_t)n * 64 + 16 * w + (lane & 15)] = (unsigned short)(n < 255 ? f2bf(o[r]) : 0u); }
    }
}

__device__ __forceinline__ void nsa_cmp_unit(Ctx& F, int unit) {
    const int tb = unit & 31, bg = unit >> 5, b = bg >> 1, g = bg & 1;
    const bf16* proj = (const bf16*)(F.ws + WS_PROJ); bf16* ocmp = (bf16*)(F.ws + WS_OCMP);
    const bf16* kc = (const bf16*)(F.ws + WS_KC) + (size_t)bg * 256 * 64; const bf16* vc = (const bf16*)(F.ws + WS_VC) + (size_t)bg * 256 * 64;
    unsigned long long* selmask = (unsigned long long*)(F.ws + WS_SELM);
    LAS unsigned char* Kt = F.lds; LAS unsigned char* Vt = F.lds + 256 * KV_SB; LAS float* IMP = (LAS float*)(F.lds + 2 * 256 * KV_SB);
    const int lane = F.lane, gq = lane >> 4, w = F.wave, tg = w >> 1, hp = w & 1;
    const int nvmax = 8 * tb + 7;
    const int nkb = (nvmax + 15) >> 4;
    __syncthreads();
    for (int i = F.tid; i < 256 * 8; i += NTHREADS) { const int row = i >> 3, ch = i & 7;
        if (row < nkb * 16) { *(LAS v4u*)(Kt + row * KV_SB + ch * 16) = *(const v4u*)(kc + row * 64 + ch * 8); *(LAS v4u*)(Vt + row * KV_SB + ch * 16) = *(const v4u*)(vc + row * 64 + ch * 8); } }
    __syncthreads();
    LAS float* IMPW = IMP + hp * 128 * 64;
#pragma unroll 1
    for (int qi = 0; qi < 2; ++qi) {
        const int tl = tg * 32 + qi * 16 + (lane & 15), t = tb * 128 + tl; const size_t trow = (size_t)b * SEQ + t;
        const int nv = ((t + 1) >> 4) - 1;
        float imp[16], carry[16];
#pragma unroll
        for (int kb = 0; kb < 16; ++kb) { imp[kb] = 0.f; carry[kb] = 0.f; }
#pragma unroll 1
        for (int hh = 0; hh < 2; ++hh) {
            const int head = g * 4 + hp * 2 + hh;
            const bf16x8 q0 = *(const bf16x8*)(proj + trow * PW + PC_Q + head * 64 + 8 * gq), q1 = *(const bf16x8*)(proj + trow * PW + PC_Q + head * 64 + 32 + 8 * gq);
            float ml = NEG_BIG, ll = 0.f;
#pragma unroll 2
            for (int kb = 0; kb < nkb; ++kb) { f32x4 a = (f32x4){0.f, 0.f, 0.f, 0.f};
                a = mfma16(lds_row8(Kt, KV_SB, 16 * kb + (lane & 15), 8 * gq), q0, a); a = mfma16(lds_row8(Kt, KV_SB, 16 * kb + (lane & 15), 32 + 8 * gq), q1, a);
                float v[4], tm = NEG_BIG;
#pragma unroll
                for (int r = 0; r < 4; ++r) { const int n = 16 * kb + 4 * gq + r; v[r] = (n < nv) ? a[r] * (0.125f * LOG2E) : NEG_BIG; tm = fmaxf(tm, v[r]); }
                const float mn = fmaxf(ml, tm); float ps = 0.f;
#pragma unroll
                for (int r = 0; r < 4; ++r) { const int n = 16 * kb + 4 * gq + r; ps += (n < nv) ? exp2f(v[r] - mn) : 0.f; }
                ll = ll * exp2f(ml - mn) + ps; ml = mn; }
            const float mx = grp_max(ml);
            const float ps = grp_sum(ll * exp2f(ml - mx));
            const float inv = ps > 0.f ? 1.0f / ps : 0.f;
            f32x4 o[4];
#pragma unroll
            for (int db = 0; db < 4; ++db) o[db] = (f32x4){0.f, 0.f, 0.f, 0.f};
#pragma unroll
            for (int st = 0; st < 8; ++st) if (2 * st < nkb) {
                f32x4 pp[2];
#pragma unroll
                for (int k2 = 0; k2 < 2; ++k2) { const int kb = 2 * st + k2; f32x4 a = (f32x4){0.f, 0.f, 0.f, 0.f};
                    a = mfma16(lds_row8(Kt, KV_SB, 16 * kb + (lane & 15), 8 * gq), q0, a); a = mfma16(lds_row8(Kt, KV_SB, 16 * kb + (lane & 15), 32 + 8 * gq), q1, a);
#pragma unroll
                    for (int r = 0; r < 4; ++r) { const int n = 16 * kb + 4 * gq + r; a[r] = (n < nv) ? exp2f(a[r] * (0.125f * LOG2E) - mx) * inv : 0.f; }
                    pp[k2] = a; imp[kb] += (a[0] + a[1]) + (a[2] + 0.5f * a[3]); carry[kb] += 0.5f * a[3]; }
                const bf16x8 pf = pack8(pp[0], pp[1]);
#pragma unroll
                for (int db = 0; db < 4; ++db) o[db] = mfma16(tr_frag(Vt, KV_SB, 32 * st + 4 * gq, 32 * st + 16 + 4 * gq, 16 * db, lane), pf, o[db]);
                asm volatile("" ::: "memory"); }
            const float gate = sigmoidf_(bf2f(proj[trow * PW + PC_NSAG + head]));
#pragma unroll
            for (int db = 0; db < 4; ++db) { const f32x4 v = o[db] * gate; v2u wv; wv.x = pg8::cvt_pk_bf16(v[0], v[1]); wv.y = pg8::cvt_pk_bf16(v[2], v[3]);
                *(v2u*)(ocmp + trow * 512 + head * 64 + 16 * db + 4 * gq) = wv; }
        }
#pragma unroll
        for (int kb = 0; kb < 16; ++kb) { const float c1 = __shfl(carry[kb], (lane + 48) & 63); const float c0 = kb > 0 ? __shfl(carry[kb > 0 ? kb - 1 : 0], (lane + 48) & 63) : 0.f;
            IMPW[tl * 64 + 4 * kb + gq] = imp[kb] + (gq > 0 ? c1 : c0); }
    }
    __syncthreads();
    for (int tl = w; tl < 128; tl += NWAVES) { const int t = tb * 128 + tl, cur = t >> 6;
        float v = IMP[tl * 64 + lane] + IMP[128 * 64 + tl * 64 + lane]; const bool forced = (lane == 0) || (lane == cur) || (lane == cur - 1);
        v = (lane > cur) ? NEG_BIG : v + (forced ? 1.0e4f : 0.f);
        int rank = 0;
#pragma unroll
        for (int jj = 0; jj < 64; ++jj) { const float o = __builtin_bit_cast(float, __builtin_amdgcn_readlane(__builtin_bit_cast(int, v), jj)); rank += (o > v || (o == v && jj < lane)) ? 1 : 0; }
        const unsigned long long m = __ballot(lane <= cur && rank < 16);
        if (lane == 0) selmask[(size_t)bg * SEQ + t] = m; }
}

constexpr int ML_H = 4, ML_D = 128, ML_L = 64, ML_NCH = SEQ / ML_L, ML_BH = BATCH * ML_H;
__device__ __forceinline__ float log_sigmoid(float x) { return fminf(x, 0.f) - log1pf(__expf(-fabsf(x))); }
__device__ __forceinline__ float siluf_(float x) { return x * sigmoidf_(x); }
__device__ __forceinline__ void ml_stage_a(Ctx& F, int unit) {
    const int c = unit & 63, bh = unit >> 6, b = bh >> 2, h = bh & 3;
    const bf16* proj = (const bf16*)(F.ws + WS_PROJ); bf16* mlq = (bf16*)(F.ws + WS_MLQ); bf16* mlk = (bf16*)(F.ws + WS_MLKK);
    float* mlb = (float*)(F.ws + WS_MLB); float* mlli = (float*)(F.ws + WS_MLLI); float* mlsc = (float*)(F.ws + WS_MLSC);
    float* mlu = (float*)(F.ws + WS_MLU) + (size_t)unit * ML_D * ML_D; float* mlun = (float*)(F.ws + WS_MLUN) + (size_t)unit * ML_D;
    const float* convw = F.in[I_CONVW]; const float* convb = F.in[I_CONVB]; const float* gateb = F.in[I_GATEB];
    LAS unsigned char* KW = F.lds; LAS unsigned char* Vs = F.lds + 64 * W128_SB; LAS float* wts = (LAS float*)(F.lds + 2 * 64 * W128_SB); LAS float* gsc = wts + 64;
    const int t0 = c * ML_L; const size_t row0 = (size_t)b * SEQ + t0;
    __syncthreads();
    if (F.tid < 64) { const int s = F.tid; const float ip = bf2f(proj[(row0 + s) * PW + PC_MLIF + h]) + gateb[h], fp = bf2f(proj[(row0 + s) * PW + PC_MLIF + 4 + h]) + gateb[4 + h];
        gsc[s] = log_sigmoid(fp); gsc[64 + s] = ip; }
    __syncthreads();
    if (F.tid < 64) {
        float v = gsc[F.tid];
#pragma unroll
        for (int o = 1; o < 64; o <<= 1) { const float u = __shfl_up(v, o); if (F.lane >= o) v += u; }
        const float bL = __shfl(v, 63); const float li = gsc[64 + F.tid]; const float a = bL - v + li; const float amax = wave_max(a);
        wts[F.tid] = __expf(a - amax); mlb[(size_t)bh * SEQ + t0 + F.tid] = v; mlli[(size_t)bh * SEQ + t0 + F.tid] = li;
        if (F.tid == 0) { mlsc[unit * 2 + 0] = amax; mlsc[unit * 2 + 1] = bL; } }
    __syncthreads();
    for (int it = F.tid; it < 2048; it += NTHREADS) { const int ch8 = it & 15, s = (it >> 4) & 63, which = it >> 10;
        const int cch = which * 512 + h * 128 + ch8 * 8;
        const int pcol = (which ? PC_MLK : PC_MLQ) + h * 128 + ch8 * 8;
        float acc[8];
#pragma unroll
        for (int j = 0; j < 8; ++j) acc[j] = convb[cch + j];
#pragma unroll
        for (int wv = 0; wv < 4; ++wv) { const int tt = t0 + s - 3 + wv; if (tt >= 0) { const v4u x = *(const v4u*)(proj + ((size_t)b * SEQ + tt) * PW + pcol);
            const f32x4 w0 = *(const f32x4*)(convw + wv * 1024 + cch), w1 = *(const f32x4*)(convw + wv * 1024 + cch + 4);
            acc[0] += bflo(x.x) * w0[0]; acc[1] += bfhi(x.x) * w0[1]; acc[2] += bflo(x.y) * w0[2]; acc[3] += bfhi(x.y) * w0[3];
            acc[4] += bflo(x.z) * w1[0]; acc[5] += bfhi(x.z) * w1[1]; acc[6] += bflo(x.w) * w1[2]; acc[7] += bfhi(x.w) * w1[3]; } }
        const float sc = which ? 0.08838834764831845f : 1.0f;
#pragma unroll
        for (int j = 0; j < 8; ++j) acc[j] = siluf_(acc[j]) * sc;
        v4u o; o.x = pk2(acc[0], acc[1]); o.y = pk2(acc[2], acc[3]); o.z = pk2(acc[4], acc[5]); o.w = pk2(acc[6], acc[7]);
        *(v4u*)((which ? mlk : mlq) + (row0 + s) * 512 + h * 128 + ch8 * 8) = o;
        if (which) { const float ws = wts[s]; v4u kw; kw.x = pk2(acc[0] * ws, acc[1] * ws); kw.y = pk2(acc[2] * ws, acc[3] * ws); kw.z = pk2(acc[4] * ws, acc[5] * ws); kw.w = pk2(acc[6] * ws, acc[7] * ws);
            *(LAS v4u*)(KW + s * W128_SB + ch8 * 16) = kw; } }
    for (int it = F.tid; it < 1024; it += NTHREADS) { const int ch8 = it & 15, s = it >> 4;
        *(LAS v4u*)(Vs + s * W128_SB + ch8 * 16) = *(const v4u*)(proj + (row0 + s) * PW + PC_MLV + h * 128 + ch8 * 8); }
    __syncthreads();
    { const int lane = F.lane, gq = lane >> 4, w = F.wave;
      const bf16x8 a0 = tr_frag(KW, W128_SB, 8 * gq, 8 * gq + 4, 16 * w, lane), a1 = tr_frag(KW, W128_SB, 32 + 8 * gq, 32 + 8 * gq + 4, 16 * w, lane);
#pragma unroll
      for (int eb = 0; eb < 8; ++eb) { f32x4 acc = (f32x4){0.f, 0.f, 0.f, 0.f};
          acc = mfma16(a0, tr_frag(Vs, W128_SB, 8 * gq, 8 * gq + 4, 16 * eb, lane), acc); acc = mfma16(a1, tr_frag(Vs, W128_SB, 32 + 8 * gq, 32 + 8 * gq + 4, 16 * eb, lane), acc);
          *(f32x4*)(mlu + (size_t)(16 * eb + (lane & 15)) * ML_D + 16 * w + 4 * gq) = acc; } }
    if (F.tid < ML_D) { float a = 0.f;
#pragma unroll 8
        for (int s = 0; s < 64; ++s) a += bf2f(*(const LAS unsigned short*)(KW + s * W128_SB + F.tid * 2));
        mlun[F.tid] = a; }
}
__device__ __forceinline__ void ml_stage_b(Ctx& F, int unit) {
    const int sl = unit & 15, bh = unit >> 4;
    const float* mlsc = (const float*)(F.ws + WS_MLSC); float* mlm = (float*)(F.ws + WS_MLSC) + 4096;
    const float* mlu = (const float*)(F.ws + WS_MLU) + (size_t)bh * 64 * ML_D * ML_D; bf16* mlc = (bf16*)(F.ws + WS_MLC) + (size_t)bh * 64 * ML_D * ML_D;
    const float* mlun = (const float*)(F.ws + WS_MLUN) + (size_t)bh * 64 * ML_D; float* mln = (float*)(F.ws + WS_MLN) + (size_t)bh * 64 * ML_D;
    LAS float* dec = (LAS float*)F.lds; LAS float* scl = dec + 64;
    __syncthreads();
    if (F.tid == 0) { float m = 0.f;
        for (int c = 0; c < 64; ++c) { const float amax = mlsc[(bh * 64 + c) * 2], bL = mlsc[(bh * 64 + c) * 2 + 1]; const float mn = fmaxf(bL + m, amax);
            dec[c] = __expf(bL + m - mn); scl[c] = __expf(amax - mn); if (sl == 0) mlm[bh * 64 + c] = m; m = mn; } }
    __syncthreads();
    { const int idx = sl * 1024 + F.tid * 2; float c0 = 0.f, c1 = 0.f;
#pragma unroll 8
      for (int c = 0; c < 64; ++c) { const pg8::f32x2 u = *(const pg8::f32x2*)(mlu + (size_t)c * ML_D * ML_D + idx);
          *(unsigned*)(mlc + (size_t)c * ML_D * ML_D + idx) = pk2(c0, c1);
          c0 = dec[c] * c0 + scl[c] * u.x; c1 = dec[c] * c1 + scl[c] * u.y; } }
    if (sl == 0 && F.tid < ML_D) { float n = 0.f;
        for (int c = 0; c < 64; ++c) { mln[c * ML_D + F.tid] = n; n = dec[c] * n + scl[c] * mlun[c * ML_D + F.tid]; } }
}
__device__ __forceinline__ void ml_stage_c(Ctx& F, int unit) {
    const int c = unit & 63, bh = unit >> 6, b = bh >> 2, h = bh & 3;
    const bf16* proj = (const bf16*)(F.ws + WS_PROJ); const bf16* mlq = (const bf16*)(F.ws + WS_MLQ); const bf16* mlk = (const bf16*)(F.ws + WS_MLKK);
    const float* mlb = (const float*)(F.ws + WS_MLB); const float* mlli = (const float*)(F.ws + WS_MLLI); const float* mlm = (const float*)(F.ws + WS_MLSC) + 4096;
    const bf16* mlc = (const bf16*)(F.ws + WS_MLC) + (size_t)unit * ML_D * ML_D; const float* mln = (const float*)(F.ws + WS_MLN) + (size_t)unit * ML_D;
    bf16* oml = (bf16*)(F.ws + WS_OML); const float* ng = F.in[I_MLNG];
    LAS unsigned char* Qs = F.lds; LAS unsigned char* Ks = Qs + 64 * W128_SB; LAS unsigned char* Vs = Ks + 64 * W128_SB; LAS unsigned char* Cs = Vs + 64 * W128_SB;
    LAS float* fb = (LAS float*)(Cs + 128 * W128_SB); LAS float* fli = fb + 64; LAS float* fn = fli + 64; LAS float* ssq = fn + 128;
    const int t0 = c * ML_L; const size_t row0 = (size_t)b * SEQ + t0;
    __syncthreads();
    for (int it = F.tid; it < 1024; it += NTHREADS) { const int ch8 = it & 15, s = it >> 4; const size_t go = (row0 + s) * 512 + h * 128 + ch8 * 8;
        *(LAS v4u*)(Qs + s * W128_SB + ch8 * 16) = *(const v4u*)(mlq + go); *(LAS v4u*)(Ks + s * W128_SB + ch8 * 16) = *(const v4u*)(mlk + go);
        *(LAS v4u*)(Vs + s * W128_SB + ch8 * 16) = *(const v4u*)(proj + (row0 + s) * PW + PC_MLV + h * 128 + ch8 * 8); }
    for (int it = F.tid; it < 2048; it += NTHREADS) { const int ch8 = it & 15, e = it >> 4; *(LAS v4u*)(Cs + e * W128_SB + ch8 * 16) = *(const v4u*)(mlc + e * ML_D + ch8 * 8); }
    if (F.tid < 64) { fb[F.tid] = mlb[(size_t)bh * SEQ + t0 + F.tid]; fli[F.tid] = mlli[(size_t)bh * SEQ + t0 + F.tid]; }
    if (F.tid < ML_D) fn[F.tid] = mln[F.tid];
    __syncthreads();
    const int lane = F.lane, gq = lane >> 4, w = F.wave, tb = w & 3, eh = w >> 2;
    const int t = 16 * tb + (lane & 15); const float mc = mlm[unit]; const float bt = fb[t];
    bf16x8 qf[4];
#pragma unroll
    for (int st = 0; st < 4; ++st) qf[st] = lds_row8(Qs, W128_SB, t, 32 * st + 8 * gq);
    f32x4 sT[4]; float dmax = NEG_BIG;
#pragma unroll
    for (int sb = 0; sb < 4; ++sb) { sT[sb] = (f32x4){0.f, 0.f, 0.f, 0.f};
        if (sb <= tb) {
#pragma unroll
            for (int st = 0; st < 4; ++st) sT[sb] = mfma16(lds_row8(Ks, W128_SB, 16 * sb + (lane & 15), 32 * st + 8 * gq), qf[st], sT[sb]);
#pragma unroll
            for (int r = 0; r < 4; ++r) { const int s = 16 * sb + 4 * gq + r; if (s <= t) dmax = fmaxf(dmax, bt - fb[s] + fli[s]); } } }
    dmax = grp_max(dmax);
    const float mt = fmaxf(bt + mc, dmax); const float iw = __expf(bt + mc - mt);
    float dsum = 0.f;
#pragma unroll
    for (int sb = 0; sb < 4; ++sb)
#pragma unroll
        for (int r = 0; r < 4; ++r) { const int s = 16 * sb + 4 * gq + r; const float p = (sb <= tb && s <= t) ? sT[sb][r] * __expf(bt - fb[s] + fli[s] - mt) : 0.f; sT[sb][r] = p; dsum += p; }
    dsum = grp_sum(dsum);
    float qn = 0.f;
#pragma unroll 8
    for (int dd = 0; dd < 32; ++dd) { const int d = gq * 32 + dd; qn += bf2f(*(const LAS unsigned short*)(Qs + t * W128_SB + d * 2)) * fn[d]; }
    qn = grp_sum(qn);
    const float den = dsum + iw * qn; const float rden = 1.0f / fmaxf(fabsf(den), __expf(-mt));
    const bf16x8 p0 = pack8(sT[0], sT[1]), p1 = pack8(sT[2], sT[3]);
    f32x4 hv[4]; float sq = 0.f;
#pragma unroll
    for (int ei = 0; ei < 4; ++ei) { const int eb = eh * 4 + ei;
        f32x4 intra = (f32x4){0.f, 0.f, 0.f, 0.f}, inter = (f32x4){0.f, 0.f, 0.f, 0.f};
        intra = mfma16(tr_frag(Vs, W128_SB, 4 * gq, 16 + 4 * gq, 16 * eb, lane), p0, intra);
        if (tb >= 2) intra = mfma16(tr_frag(Vs, W128_SB, 32 + 4 * gq, 48 + 4 * gq, 16 * eb, lane), p1, intra);
#pragma unroll
        for (int st = 0; st < 4; ++st) inter = mfma16(lds_row8(Cs, W128_SB, 16 * eb + (lane & 15), 32 * st + 8 * gq), qf[st], inter);
        hv[ei] = (intra + inter * iw) * rden; sq += (hv[ei][0] * hv[ei][0] + hv[ei][1] * hv[ei][1]) + (hv[ei][2] * hv[ei][2] + hv[ei][3] * hv[ei][3]); }
    sq = grp_sum(sq);
    if (gq == 0) ssq[eh * 64 + t] = sq;
    __syncthreads();
    const float rn = rsqrtf((ssq[t] + ssq[64 + t]) * (1.0f / ML_D) + NORM_EPS);
#pragma unroll
    for (int ei = 0; ei < 4; ++ei) { const int e0 = 16 * (eh * 4 + ei) + 4 * gq; const f32x4 gg = *(const f32x4*)(ng + h * 128 + e0);
        const v2u ow = *(const v2u*)(proj + (row0 + t) * PW + PC_MLO + h * 128 + e0);
        f32x4 v = hv[ei] * rn * gg; v[0] *= sigmoidf_(bflo(ow.x)); v[1] *= sigmoidf_(bfhi(ow.x)); v[2] *= sigmoidf_(bflo(ow.y)); v[3] *= sigmoidf_(bfhi(ow.y));
        v2u o; o.x = pg8::cvt_pk_bf16(v[0], v[1]); o.y = pg8::cvt_pk_bf16(v[2], v[3]); *(v2u*)(oml + (row0 + t) * 512 + h * 128 + e0) = o; }
}

#ifndef MILESTONE
#define MILESTONE 2
#endif
__global__ void __launch_bounds__(NTHREADS, 2) fwd_kernel(Args args) {
    extern __shared__ __attribute__((aligned(16))) unsigned char lds_raw[];
    Ctx F;
    F.lds = (LAS unsigned char*)lds_raw; F.ws = args.ws; F.ctl = (unsigned*)(args.ws + WS_CTL);
    F.tid = threadIdx.x; F.lane = F.tid & 63; F.wave = __builtin_amdgcn_readfirstlane(F.tid >> 6);
    F.G = gridDim.x; { const int bx = blockIdx.x; F.vcu = (F.G % 8 == 0) ? (bx % 8) * (F.G / 8) + bx / 8 : bx; }
    F.in = args.in; F.out = args.out;
    volatile LAS unsigned* MISC = (volatile LAS unsigned*)(F.lds + MISC_OFF);
    for (int u = F.tid; u < (LDS_BYTES - LDSCTL_OFF) / 4; u += NTHREADS) ((LAS unsigned*)(F.lds + LDSCTL_OFF))[u] = 0u;
    __syncthreads();
    XcdBarrier bar = xcd_barrier_post(F.ctl + CW_BAR, MISC + 8);
#define SEAM() xcd_barrier(bar)
    const float* modf = (const float*)(F.ws + WS_MODF);
    bf16* A1 = (bf16*)(F.ws + WS_A1);

    p0_prologue(F); SEAM();
    p1_norm1(F); SEAM();
#if MILESTONE >= 2
    {
        pg8::Gemm g{A1, (const bf16*)(F.ws + WS_WIN), T, PW, DM}; pg8::StaticOrder S; S.init(T, PW, F.G, (int)blockIdx.x);
        EpiStoreBf16 E{(bf16*)(F.ws + WS_PROJ), PW};
        pg8::gemm_phase<EpiStoreBf16, pg8::StaticOrder, true, true>(F.lds, g, S, E);
    }
    SEAM();
    #ifndef NO_3A
    for (int u = F.vcu; u < 256; u += F.G) nsa_compress_unit(F, u);
#endif
#ifndef NO_3B
    for (int u = F.vcu; u < ML_BH * ML_NCH; u += F.G) ml_stage_a(F, u);
#endif
    SEAM();
#ifndef NO_4A
    for (int u = F.vcu; u < 256; u += F.G) nsa_cmp_unit(F, u);
#endif
#ifndef NO_4B
    for (int u = F.vcu; u < ML_BH * 16; u += F.G) ml_stage_b(F, u);
#endif
    SEAM();
#ifndef NO_5A
    for (int p = F.vcu; p < 256; p += F.G) { const int bg = p >> 5, x = p & 31; nsa_selwin_unit(F, bg >> 1, bg & 1, x); nsa_selwin_unit(F, bg >> 1, bg & 1, 63 - x); }
#endif
#ifndef NO_5B
    for (int u = F.vcu; u < ML_BH * ML_NCH; u += F.G) ml_stage_c(F, u);
#endif
    SEAM();
    {
        pg8::StaticOrder S; S.init(T, DM, F.G, (int)blockIdx.x);
        { pg8::Gemm g{(const bf16*)(F.ws + WS_ONSA), (const bf16*)(F.ws + WS_WUPA), T, DM, 512}; EpiUpGate<false> E{(bf16*)(F.ws + WS_U), (const bf16*)(F.ws + WS_PROJ), PC_MGA};
          pg8::gemm_phase<EpiUpGate<false>, pg8::StaticOrder, true, true>(F.lds, g, S, E); }
        { pg8::Gemm g{(const bf16*)(F.ws + WS_OML), (const bf16*)(F.ws + WS_WUPB), T, DM, 512}; EpiUpGate<true> E{(bf16*)(F.ws + WS_U), (const bf16*)(F.ws + WS_PROJ), PC_MGB};
          pg8::gemm_phase<EpiUpGate<true>, pg8::StaticOrder, true, true>(F.lds, g, S, E); }
    }
    SEAM();
    {
        pg8::Gemm g{(const bf16*)(F.ws + WS_U), (const bf16*)(F.ws + WS_WOUT), T, DM, DM}; pg8::StaticOrder S; S.init(T, DM, F.G, (int)blockIdx.x);
        EpiOutRes E{F.in[I_X], (float*)(F.ws + WS_H1), modf};
        pg8::gemm_phase<EpiOutRes, pg8::StaticOrder, true, true>(F.lds, g, S, E);
    }
    SEAM();
#endif
    const float* H = (MILESTONE >= 2) ? (const float*)(F.ws + WS_H1) : F.in[I_X];
    p8_norm2_router(F, H, modf); SEAM();
    p9_permute(F); SEAM();
    {
        pg8::Gemm g{(const bf16*)(F.ws + WS_XG), (const bf16*)(F.ws + WS_W1T), MOE_P, NEXP * 2048, DM};
        MoeOrder S{8, 3, F.G, F.vcu, F.ctl + CW_MOETAB};
        EpiMoe1 E{(bf16*)(F.ws + WS_ACT), F.in[I_EB1]};
        pg8::gemm_phase<EpiMoe1, MoeOrder, true, true>(F.lds, g, S, E);
    }
    SEAM();
    {
        pg8::Gemm g{(const bf16*)(F.ws + WS_ACT), (const bf16*)(F.ws + WS_W2T), MOE_P, NEXP * DM, DE};
        MoeOrder S{4, 2, F.G, F.vcu, F.ctl + CW_MOETAB};
        EpiMoe2 E{(bf16*)(F.ws + WS_YR), F.in[I_EB2], (const float*)(F.ws + WS_ROWG)};
        pg8::gemm_phase<EpiMoe2, MoeOrder, true, true>(F.lds, g, S, E);
    }
    SEAM();
    p_final<true>(F, H, modf);
#undef SEAM
}

extern "C" void kernel_launch(void* const* d_in, const int* in_sizes, int n_in, void* d_out, int out_size, void* d_ws, size_t ws_size, hipStream_t stream) {
    static int grid = 0;
    if (grid == 0) {
        if (n_in != 27 || in_sizes[0] != T * DM || out_size != T * DM || ws_size < WS_END) { fprintf(stderr, "kernel_launch: unexpected shapes (n_in %d, in0 %d, out %d, ws %zu)\n", n_in, n_in > 0 ? in_sizes[0] : -1, out_size, ws_size); grid = -1; return; }
        int dev = 0, cus = 0, per_cu = 0;
        if (hipGetDevice(&dev) != hipSuccess || hipDeviceGetAttribute(&cus, hipDeviceAttributeMultiprocessorCount, dev) != hipSuccess) { grid = -1; return; }
        if (hipFuncSetAttribute((const void*)fwd_kernel, hipFuncAttributeMaxDynamicSharedMemorySize, LDS_BYTES) != hipSuccess) { fprintf(stderr, "kernel_launch: hipFuncSetAttribute failed\n"); grid = -1; return; }
        if (hipOccupancyMaxActiveBlocksPerMultiprocessor(&per_cu, (const void*)fwd_kernel, NTHREADS, LDS_BYTES) != hipSuccess || per_cu < 1) fprintf(stderr, "kernel_launch: occupancy query reports %d\n", per_cu);
        (void)hipGetLastError();
        grid = cus;
    }
    if (grid < 0) return;
    if (hipMemsetAsync((char*)d_ws + WS_CTL, 0, CTL_ZERO_BYTES, stream) != hipSuccess) return;
    Args a{};
    for (int i = 0; i < 27; ++i) a.in[i] = (const float*)d_in[i];
    a.out = (float*)d_out; a.ws = (unsigned char*)d_ws;
    a.ph_lo = 0; a.ph_hi = 64;
    hipLaunchKernelGGL(fwd_kernel, dim3(grid), dim3(NTHREADS), LDS_BYTES, stream, a);
}
```

```cpp
#include <hip/hip_runtime.h>
#include <cstdio>
#include <cstdint>
namespace pg8 {
#define PG8_LAS __attribute__((address_space(3)))
typedef unsigned short bf16_t;
typedef short bf16x8 __attribute__((ext_vector_type(8)));
typedef float f32x4 __attribute__((ext_vector_type(4)));
typedef unsigned u32x4 __attribute__((ext_vector_type(4)));
constexpr int BM = 256, BK = 64, HALF = 128, HTB = HALF * BK * 2  , STAGE_BYTES = 8 * HTB, NXCD = 8, WGM = 8;

__host__ __device__ __forceinline__ int lds_byte(int r, int c) { const int st = (r >> 4) * 2 + (c >> 5), rr = r & 15, cc = c & 31, ob = rr * 64 + cc * 2; return st * 1024 + (ob ^ (((ob >> 9) & 1) << 5)); }
__host__ __device__ __forceinline__ void stage_rc(int b, int& R, int& C) { const int st = b / 1024, sb = b % 1024, swz = sb ^ (((sb >> 9) & 1) << 5); R = (st >> 1) * 16 + swz / 64; C = (st & 1) * 32 + (swz % 64) / 2; }
__host__ __device__ __forceinline__ int perm32(int rho) { const int n = rho >> 4, i = rho & 15; return 8 * (i >> 2) + 4 * n + (i & 3); }

struct Unit { int pm, pn; };
struct Gemm { const bf16_t* A; const bf16_t* Bt; int M, N, K; };

struct StaticOrder {
    int nM, nN, nwg, G, c;
    __host__ __device__ void init(int M, int N, int G_, int c_) { nM = M / BM; nN = N / BM; nwg = nM * nN; G = G_; c = c_; }
    __host__ __device__ bool next(int i, Unit& u) const {
        const long L = (long)i * G + c; if (L >= nwg) return false;
        int wgid = (int)L; { const int q = nwg / NXCD, r = nwg % NXCD, xcd = wgid % NXCD, off = wgid / NXCD; wgid = (xcd < r ? xcd * (q + 1) : r * (q + 1) + (xcd - r) * q) + off; }
        const int nig = WGM * nN, gid = wgid / nig, fm = gid * WGM, gsz = (nM - fm) < WGM ? (nM - fm) : WGM;
        u.pm = fm + ((wgid % nig) % gsz); u.pn = (wgid % nig) / gsz; return true;
    }
    __device__ __forceinline__ void a_ready(const Unit&) const {}
    __device__ __forceinline__ void done(const Unit&) const {}
};

__device__ __forceinline__ unsigned cvt_pk_bf16(float lo, float hi) { unsigned r; asm volatile("v_cvt_pk_bf16_f32 %0, %1, %2" : "=v"(r) : "v"(lo), "v"(hi)); return r; }
typedef float f32x2 __attribute__((ext_vector_type(2)));
template <class Epi, class Sched, bool ALIGN_EPI = false, bool SP2 = false>
__device__ __forceinline__ void gemm_phase(PG8_LAS unsigned char* lds, const Gemm g, const Sched& S, const Epi& E) {
    const int tid = threadIdx.x, wid = __builtin_amdgcn_readfirstlane(tid >> 6), lane = tid & 63, wr = wid >> 2, wc = wid & 3, fr = lane & 15, fq = lane >> 4;
    const int K = g.K, nt = K / BK;
    unsigned voffA[2], voffB[2];
#pragma unroll
    for (int i = 0; i < 2; ++i) { int R, C; stage_rc(tid * 16 + i * 8192, R, C); const int Rb = Epi::PERM ? ((R & ~31) + perm32(R & 31)) : R;
        voffA[i] = (unsigned)(R * K + C) * 2u; voffB[i] = (unsigned)(Rb * K + C) * 2u; }
    const size_t kstep = (size_t)(BK * 2);
    const size_t hstep = (size_t)HALF * K * 2;
    const size_t tstep = 2 * hstep;
    const unsigned ldsw = (unsigned)wid * 1024u;
    const int aoff = lds_byte(wr * 64 + fr, fq * 8), boff = lds_byte(wc * 32 + fr, fq * 8);
#define PG8_SA(b, h) (((b) * 2 + (h)) * HTB)
#define PG8_SB(b, h) ((4 + (b) * 2 + (h)) * HTB)
#define PG8_STAGE(bufoff, gbase, voff) do { _Pragma("unroll") for (int _i = 0; _i < 2; ++_i) \
        __builtin_amdgcn_global_load_lds((const unsigned*)((const char*)(gbase) + (voff)[_i]), (PG8_LAS unsigned*)(lds + (bufoff) + ldsw + _i * 8192), 16, 0, 0); } while (0)
#define PG8_LDA(dst, b, h) do { _Pragma("unroll") for (int m = 0; m < 4; ++m) _Pragma("unroll") for (int k = 0; k < 2; ++k) dst[m][k] = *(const PG8_LAS bf16x8*)(lds + PG8_SA(b, h) + aoff + m * 2048 + k * 1024); } while (0)
#define PG8_LDB(dst, b, h) do { _Pragma("unroll") for (int n = 0; n < 2; ++n) _Pragma("unroll") for (int k = 0; k < 2; ++k) dst[n][k] = *(const PG8_LAS bf16x8*)(lds + PG8_SB(b, h) + boff + n * 2048 + k * 1024); } while (0)
#define PG8_MMA(ai, bj, At, Bt) do { __builtin_amdgcn_s_setprio(1); _Pragma("unroll") for (int m = 0; m < 4; ++m) _Pragma("unroll") for (int n = 0; n < 2; ++n) _Pragma("unroll") for (int k = 0; k < 2; ++k) \
        acc[ai][bj][m][n] = __builtin_amdgcn_mfma_f32_16x16x32_bf16(Bt[n][k], At[m][k], acc[ai][bj][m][n], 0, 0, 0); __builtin_amdgcn_s_setprio(0); } while (0)
#define PG8_WAIT_V(n) asm volatile("s_waitcnt vmcnt(" #n ")" ::: "memory")
#define PG8_WAIT_L(n) asm volatile("s_waitcnt lgkmcnt(" #n ")" ::: "memory")
#define PG8_BAR __builtin_amdgcn_s_barrier()
#define PG8_SCHED __builtin_amdgcn_sched_barrier(0)
    Unit cur, nxt; int ui = 0;
    if (!S.next(0, cur)) return;
    f32x4 acc[2][2][4][2];
#pragma unroll
    for (int a = 0; a < 2; ++a)
#pragma unroll
        for (int b = 0; b < 2; ++b)
#pragma unroll
            for (int m = 0; m < 4; ++m)
#pragma unroll
                for (int n = 0; n < 2; ++n) acc[a][b][m][n] = (f32x4){0.f, 0.f, 0.f, 0.f};
    bf16x8 At[4][2], B0[2][2], B1[2][2];
    const char* cA = (const char*)g.A + (size_t)cur.pm * tstep; const char* cB = (const char*)g.Bt + (size_t)cur.pn * tstep;
    S.a_ready(cur);
    if constexpr (SP2) {
        PG8_STAGE(PG8_SB(0, 0), cB, voffB); PG8_STAGE(PG8_SB(0, 1), cB + hstep, voffB); PG8_STAGE(PG8_SA(0, 0), cA, voffA); PG8_STAGE(PG8_SA(0, 1), cA + hstep, voffA);
        if (wr == 1) PG8_BAR;
        PG8_WAIT_V(2); PG8_BAR;
        PG8_STAGE(PG8_SB(1, 0), cB + kstep, voffB); PG8_STAGE(PG8_SA(1, 0), cA + kstep, voffA); PG8_STAGE(PG8_SB(1, 1), cB + hstep + kstep, voffB);
        PG8_WAIT_V(6); PG8_BAR;
    } else {
        PG8_STAGE(PG8_SB(0, 0), cB, voffB); PG8_STAGE(PG8_SA(0, 0), cA, voffA); PG8_STAGE(PG8_SB(0, 1), cB + hstep, voffB); PG8_STAGE(PG8_SA(0, 1), cA + hstep, voffA);
        if (wr == 1) PG8_BAR;
        PG8_WAIT_V(4); PG8_BAR;
        PG8_STAGE(PG8_SB(1, 0), cB + kstep, voffB); PG8_STAGE(PG8_SA(1, 0), cA + kstep, voffA); PG8_STAGE(PG8_SB(1, 1), cB + hstep + kstep, voffB);
        PG8_WAIT_V(6); PG8_BAR;
    }
    for (;;) {
        const bool has_next = S.next(ui + 1, nxt);
        const char* nA = has_next ? (const char*)g.A + (size_t)nxt.pm * tstep : cA; const char* nB = has_next ? (const char*)g.Bt + (size_t)nxt.pn * tstep : cB;
        for (int t = 0; t < nt; t += 2) {
            const bool last = (t == nt - 2);
            const char* a1 = cA + (size_t)(t + 1) * kstep;
            const char* a2 = last ? nA : cA + (size_t)(t + 2) * kstep; const char* b2 = last ? nB : cB + (size_t)(t + 2) * kstep;
            const char* a3 = a2 + kstep; const char* b3 = b2 + kstep;
            if (last && has_next) S.a_ready(nxt);
            if constexpr (SP2) {
            PG8_LDB(B0, 0, 0); PG8_LDB(B1, 0, 1); PG8_SCHED; PG8_LDA(At, 0, 0); PG8_STAGE(PG8_SA(1, 1), a1 + hstep, voffA);
            PG8_WAIT_V(8); PG8_WAIT_L(0); PG8_BAR; PG8_MMA(0, 0, At, B0); PG8_MMA(0, 1, At, B1); PG8_BAR; PG8_SCHED;
            PG8_LDA(At, 0, 1); PG8_STAGE(PG8_SB(0, 0), b2, voffB); PG8_STAGE(PG8_SB(0, 1), b2 + hstep, voffB); PG8_STAGE(PG8_SA(0, 0), a2, voffA);
            PG8_WAIT_V(8); PG8_WAIT_L(0); PG8_BAR; PG8_MMA(1, 0, At, B0); PG8_MMA(1, 1, At, B1); PG8_BAR; PG8_SCHED;
            PG8_LDB(B0, 1, 0); PG8_LDB(B1, 1, 1); PG8_SCHED; PG8_LDA(At, 1, 0); PG8_STAGE(PG8_SA(0, 1), a2 + hstep, voffA);
            PG8_WAIT_V(8); PG8_WAIT_L(0); PG8_BAR; PG8_MMA(0, 0, At, B0); PG8_MMA(0, 1, At, B1); PG8_BAR; PG8_SCHED;
            PG8_LDA(At, 1, 1); PG8_STAGE(PG8_SB(1, 0), b3, voffB); PG8_STAGE(PG8_SB(1, 1), b3 + hstep, voffB); PG8_STAGE(PG8_SA(1, 0), a3, voffA);
            PG8_WAIT_V(8); PG8_WAIT_L(0); PG8_BAR; PG8_MMA(1, 0, At, B0); PG8_MMA(1, 1, At, B1); PG8_BAR; PG8_SCHED;
            } else {
            PG8_LDB(B0, 0, 0); PG8_SCHED; PG8_LDA(At, 0, 0); PG8_STAGE(PG8_SA(1, 1), a1 + hstep, voffA);
            PG8_WAIT_L(8); PG8_BAR; PG8_WAIT_L(0); PG8_MMA(0, 0, At, B0); PG8_BAR; PG8_SCHED;
            PG8_LDB(B1, 0, 1); PG8_STAGE(PG8_SB(0, 0), b2, voffB);
            PG8_BAR; PG8_WAIT_L(0); PG8_MMA(0, 1, At, B1); PG8_BAR;
            PG8_LDA(At, 0, 1); PG8_STAGE(PG8_SA(0, 0), a2, voffA);
            PG8_BAR; PG8_WAIT_L(0); PG8_MMA(1, 0, At, B0); PG8_BAR; PG8_SCHED;
            PG8_STAGE(PG8_SB(0, 1), b2 + hstep, voffB);
            PG8_WAIT_V(6); PG8_BAR; PG8_MMA(1, 1, At, B1); PG8_BAR;
            PG8_LDB(B0, 1, 0); PG8_SCHED; PG8_LDA(At, 1, 0); PG8_STAGE(PG8_SA(0, 1), a2 + hstep, voffA);
            PG8_WAIT_L(8); PG8_BAR; PG8_WAIT_L(0); PG8_MMA(0, 0, At, B0); PG8_BAR; PG8_SCHED;
            PG8_LDB(B1, 1, 1); PG8_STAGE(PG8_SB(1, 0), b3, voffB);
            PG8_BAR; PG8_WAIT_L(0); PG8_MMA(0, 1, At, B1); PG8_BAR;
            PG8_LDA(At, 1, 1); PG8_STAGE(PG8_SA(1, 0), a3, voffA);
            PG8_BAR; PG8_WAIT_L(0); PG8_MMA(1, 0, At, B0); PG8_BAR; PG8_SCHED;
            PG8_STAGE(PG8_SB(1, 1), b3 + hstep, voffB);
            PG8_WAIT_V(6); PG8_BAR; PG8_MMA(1, 1, At, B1); PG8_BAR;
            }
        }
        if constexpr (ALIGN_EPI) { if (wr == 0) PG8_BAR; }
        if constexpr (!Epi::AFTER_DRAIN) { E(acc, cur, wr, wc, fr, fq); S.done(cur); }
        if (!has_next) break;
#pragma unroll
        for (int a = 0; a < 2; ++a)
#pragma unroll
            for (int b = 0; b < 2; ++b)
#pragma unroll
                for (int m = 0; m < 4; ++m)
#pragma unroll
                    for (int n = 0; n < 2; ++n) acc[a][b][m][n] = (f32x4){0.f, 0.f, 0.f, 0.f};
        cur = nxt; cA = nA; cB = nB; ++ui;
        if constexpr (ALIGN_EPI) { if (wr == 1) PG8_BAR; }
    }
    PG8_WAIT_V(0);
    if constexpr (!ALIGN_EPI) { if (wr == 0) PG8_BAR; }
    PG8_BAR;
    if constexpr (Epi::AFTER_DRAIN) { E.fused(acc, cur, wr, wc, fr, fq, lds, wid, lane); S.done(cur); }
#undef PG8_SA
#undef PG8_SB
#undef PG8_STAGE
#undef PG8_LDA
#undef PG8_LDB
#undef PG8_MMA
#undef PG8_WAIT_V
#undef PG8_WAIT_L
#undef PG8_BAR
#undef PG8_SCHED
}
}

constexpr int NWAVES = 8, NTHREADS = 512;
constexpr int BATCH = 4, SEQ = 4096, DM = 1024, T = BATCH * SEQ;
constexpr int INW = 5408, PW = 5632;
constexpr int NEXP = 32, TOPK = 4, DE = 1024, NASSIGN = T * TOPK, MOE_ROWS = 256;
constexpr int MOE_MAXTILES = (NASSIGN + NEXP * (MOE_ROWS - 1) + MOE_ROWS - 1) / MOE_ROWS;
constexpr int MOE_P = MOE_MAXTILES * MOE_ROWS;
constexpr float NORM_EPS = 1e-6f;
constexpr int PC_Q = 0, PC_KV = 512, PC_MLQ = 1280, PC_MLK = 1792, PC_MLV = 2304, PC_MLO = 2816, PC_MGA = 3328, PC_MGB = 4352, PC_NSAG = 5376, PC_MLIF = 5400;
constexpr int ADA_SLICES = 16, PB_SLICES = 16;

constexpr size_t MiB = 1u << 20;
constexpr size_t WS_CTL = 0, CTL_ZERO_BYTES = 1 * MiB;
constexpr size_t WS_MODP = 1 * MiB;
constexpr size_t WS_MODF = 3 * MiB;
constexpr size_t WS_PBP  = 3 * MiB + 512 * 1024;
constexpr size_t WS_WIN  = 4 * MiB;
constexpr size_t WS_WUPA = 16 * MiB, WS_WUPB = 17 * MiB;
constexpr size_t WS_WOUT = 18 * MiB;
constexpr size_t WS_CW1K = 20 * MiB, WS_CW1V = 20 * MiB + 512 * 1024;
constexpr size_t WS_CW2K = 21 * MiB, WS_CW2V = 21 * MiB + 64 * 1024;
constexpr size_t WS_KC = 22 * MiB, WS_VC = 22 * MiB + 512 * 1024;
constexpr size_t WS_SELM = 23 * MiB;
constexpr size_t WS_TOPI = 24 * MiB, WS_GATE = 24 * MiB + 256 * 1024, WS_DEST = 24 * MiB + 512 * 1024;
constexpr size_t WS_ROWG = 25 * MiB;
constexpr size_t WS_MLB = 26 * MiB, WS_MLLI = 26 * MiB + 256 * 1024;
constexpr size_t WS_RWHI = 25 * MiB + 512 * 1024, WS_RWLO = 25 * MiB + 768 * 1024;
constexpr size_t WS_MLSC = 27 * MiB;
constexpr size_t WS_MLUN = 28 * MiB, WS_MLN = 29 * MiB;
constexpr size_t WS_W1T = 32 * MiB;
constexpr size_t WS_W2T = 160 * MiB;
constexpr size_t WS_H1 = 224 * MiB;
constexpr size_t WS_A1 = 288 * MiB;
constexpr size_t WS_PROJ = 320 * MiB;
constexpr size_t WS_XG = 320 * MiB;
constexpr size_t WS_OCMP = 496 * MiB, WS_ONSA = 512 * MiB, WS_OML = 528 * MiB, WS_MLQ = 544 * MiB, WS_MLKK = 560 * MiB;
constexpr size_t WS_MLU = 576 * MiB;
constexpr size_t WS_MLC = 640 * MiB;
constexpr size_t WS_U = 674 * MiB;
constexpr size_t WS_ACT = 496 * MiB;
constexpr size_t WS_YR = 640 * MiB;
constexpr size_t WS_END = 784 * MiB;
constexpr int CW_BAR = 4096;
constexpr int CW_ECNT = 16384;
constexpr int CW_EFILL = 16384 + 64 * 32;
constexpr int CW_MOETAB = 32768;

constexpr int RING_BYTES = 131072;
constexpr int LDSCTL_OFF = 146432, MISC_OFF = LDSCTL_OFF + 320;
constexpr int LDS_BYTES = 147456;

#define GAS __attribute__((address_space(1)))
#define LAS __attribute__((address_space(3)))
typedef unsigned short bf16;
typedef unsigned v4u __attribute__((ext_vector_type(4)));
typedef unsigned v2u __attribute__((ext_vector_type(2)));
typedef float f32x4 __attribute__((ext_vector_type(4)));
typedef short bf16x8 __attribute__((ext_vector_type(8)));
typedef short s16x4 __attribute__((ext_vector_type(4)));
#define LDS_WAIT() asm volatile("s_waitcnt lgkmcnt(0)" ::: "memory")
#define VM_WAIT() asm volatile("s_waitcnt vmcnt(0)" ::: "memory")
__device__ __forceinline__ unsigned f2bf(float f) { unsigned u = __builtin_bit_cast(unsigned, f); return (u + 0x7fffu + ((u >> 16) & 1u)) >> 16; }
__device__ __forceinline__ unsigned pk2(float lo, float hi) { return f2bf(lo) | (f2bf(hi) << 16); }
__device__ __forceinline__ float bf2f(unsigned short b) { return __builtin_bit_cast(float, (unsigned)b << 16); }
__device__ __forceinline__ float bflo(unsigned w) { return __builtin_bit_cast(float, w << 16); }
__device__ __forceinline__ float bfhi(unsigned w) { return __builtin_bit_cast(float, w & 0xffff0000u); }
__device__ __forceinline__ float sigmoidf_(float x) { return 1.0f / (1.0f + __expf(-x)); }
__device__ __forceinline__ float wave_sum(float v) {
#pragma unroll
    for (int o = 1; o < 64; o <<= 1) v += __shfl_xor(v, o);
    return v;
}
__device__ __forceinline__ float wave_max(float v) {
#pragma unroll
    for (int o = 1; o < 64; o <<= 1) v = fmaxf(v, __shfl_xor(v, o));
    return v;
}
#define XB_TMO      128
#define XB_XCNT(j)  (256  + 64 * (j))
#define XB_XSUB(j)  (1280 + 64 * (j))
#define XB_XGEN(j)  (2304 + 64 * (j))
#define XB_TOP      3328
#define XB_TOPGEN   3392
#define XCD_BAR_WORDS 3456
#define XB_SPIN_CAP (1u << 18)

__device__ __forceinline__ unsigned xb_ld(unsigned* p)              { return __hip_atomic_load(p, __ATOMIC_RELAXED, __HIP_MEMORY_SCOPE_AGENT); }
__device__ __forceinline__ unsigned xb_add(unsigned* p, unsigned v) { return __hip_atomic_fetch_add(p, v, __ATOMIC_RELAXED, __HIP_MEMORY_SCOPE_AGENT); }
__device__ __forceinline__ unsigned xb_xcc_id() { return (unsigned)__builtin_amdgcn_s_getreg((3 << 11) | 20) & 0xFu; }
#define XB_SPIN(cond, bar) do { unsigned _sp = 0; while (cond) { __builtin_amdgcn_s_sleep(1); \
    if ((++_sp & 255u) == 0u) { if (xb_ld(&(bar)[XB_TMO])) break; if (_sp > XB_SPIN_CAP) { atomicAdd(&(bar)[XB_TMO], 1u); break; } } } } while (0)

struct XcdBarrier {
    unsigned* bar; unsigned x;
    volatile LAS unsigned* st;
};

__device__ __forceinline__ XcdBarrier xcd_barrier_post(unsigned* bar, volatile LAS unsigned* st) {
    XcdBarrier b; b.bar = bar; b.x = xb_xcc_id(); b.st = st;
    if (threadIdx.x == 0) (void)xb_add(&bar[XB_XCNT(b.x)], 1u);
    return b;
}
__device__ __forceinline__ void xcd_barrier_complete(unsigned* bar, unsigned x, unsigned& nloc, unsigned& nx) {
    const unsigned G = gridDim.x * gridDim.y * gridDim.z;
    unsigned sum, cnt, mine, sp = 0u;
    for (;;) {
        sum = 0u; cnt = 0u; mine = 0u;
#pragma unroll
        for (unsigned j = 0; j < 16; ++j) { const unsigned c = xb_ld(&bar[XB_XCNT(j)]); sum += c; cnt += (c > 0u) ? 1u : 0u; mine = (j == x) ? c : mine; }
        if (sum == G) break;
        __builtin_amdgcn_s_sleep(1);
        if ((++sp & 255u) == 0u) { if (xb_ld(&bar[XB_TMO])) break; if (sp > XB_SPIN_CAP) { atomicAdd(&bar[XB_TMO], 1u); break; } }
    }
    nloc = mine > 0u ? mine : 1u; nx = cnt > 0u ? cnt : 1u;
}

__device__ __forceinline__ void xcd_barrier(const XcdBarrier& b) {
    asm volatile("s_waitcnt vmcnt(0)" ::: "memory");
    __syncthreads();
    if (threadIdx.x == 0) {
        unsigned* bar = b.bar;
        __builtin_amdgcn_s_waitcnt(0);
        unsigned nloc = b.st[0], nx = b.st[1];
        if (nloc == 0u) { xcd_barrier_complete(bar, b.x, nloc, nx); b.st[0] = nloc; b.st[1] = nx; }
        const unsigned old = xb_add(&bar[XB_XSUB(b.x)], 1u);
        const unsigned gen = old / nloc;
        if (old + 1u == (gen + 1u) * nloc) {
            __builtin_amdgcn_fence(__ATOMIC_RELEASE, "agent");
            asm volatile("s_waitcnt vmcnt(0)" ::: "memory");
            const unsigned og = xb_add(&bar[XB_TOP], 1u);
            const unsigned tg = og / nx;
            if (og + 1u == (tg + 1u) * nx) xb_add(&bar[XB_TOPGEN], 1u);
            else XB_SPIN(xb_ld(&bar[XB_TOPGEN]) == tg, bar);
            __builtin_amdgcn_fence(__ATOMIC_ACQUIRE, "agent");
            xb_add(&bar[XB_XGEN(b.x)], 1u);
            asm volatile("s_waitcnt vmcnt(0)" ::: "memory");
        } else {
            XB_SPIN(xb_ld(&bar[XB_XGEN(b.x)]) == gen, bar);
            __builtin_amdgcn_fence(__ATOMIC_ACQUIRE, "agent");
            asm volatile("s_waitcnt vmcnt(0)" ::: "memory");
        }
    }
    __syncthreads();
}

using pg8::Unit; using pg8::HALF; using pg8::BM;
struct EpiStoreBf16 {
    static constexpr bool PERM = true, AFTER_DRAIN = false;
    bf16* O; int ldc;
    __device__ __forceinline__ void operator()(const f32x4 (&acc)[2][2][4][2], const Unit& u, int wr, int wc, int fr, int fq) const {
        const int row0 = u.pm * BM + wr * 64 + fr, col0 = u.pn * BM + wc * 32 + 8 * fq;
#pragma unroll
        for (int ai = 0; ai < 2; ++ai)
#pragma unroll
            for (int m = 0; m < 4; ++m) { bf16* rowp = O + (size_t)(row0 + ai * HALF + m * 16) * ldc + col0;
#pragma unroll
                for (int bj = 0; bj < 2; ++bj) { const f32x4 v0 = acc[ai][bj][m][0], v1 = acc[ai][bj][m][1];
                    v4u w; w.x = pg8::cvt_pk_bf16(v0[0], v0[1]); w.y = pg8::cvt_pk_bf16(v0[2], v0[3]); w.z = pg8::cvt_pk_bf16(v1[0], v1[1]); w.w = pg8::cvt_pk_bf16(v1[2], v1[3]);
                    *(v4u*)(rowp + bj * HALF) = w; } }
    }
};
template <bool ADD> struct EpiUpGate {
    static constexpr bool PERM = true, AFTER_DRAIN = false;
    bf16* U; const bf16* G; int goff;
    __device__ __forceinline__ void operator()(const f32x4 (&acc)[2][2][4][2], const Unit& u, int wr, int wc, int fr, int fq) const {
        const int row0 = u.pm * BM + wr * 64 + fr, col0 = u.pn * BM + wc * 32 + 8 * fq;
#pragma unroll
        for (int ai = 0; ai < 2; ++ai)
#pragma unroll
            for (int m = 0; m < 4; ++m) { const size_t row = (size_t)(row0 + ai * HALF + m * 16);
#pragma unroll
                for (int bj = 0; bj < 2; ++bj) { const int col = col0 + bj * HALF;
                    const v4u gw = *(const v4u*)(G + row * PW + goff + col);
                    f32x4 v0 = acc[ai][bj][m][0], v1 = acc[ai][bj][m][1];
                    v0[0] *= sigmoidf_(bflo(gw.x)); v0[1] *= sigmoidf_(bfhi(gw.x)); v0[2] *= sigmoidf_(bflo(gw.y)); v0[3] *= sigmoidf_(bfhi(gw.y));
                    v1[0] *= sigmoidf_(bflo(gw.z)); v1[1] *= sigmoidf_(bfhi(gw.z)); v1[2] *= sigmoidf_(bflo(gw.w)); v1[3] *= sigmoidf_(bfhi(gw.w));
                    if (ADD) { const v4u uw = *(const v4u*)(U + row * DM + col);
                        v0[0] += bflo(uw.x); v0[1] += bfhi(uw.x); v0[2] += bflo(uw.y); v0[3] += bfhi(uw.y); v1[0] += bflo(uw.z); v1[1] += bfhi(uw.z); v1[2] += bflo(uw.w); v1[3] += bfhi(uw.w); }
                    v4u w; w.x = pg8::cvt_pk_bf16(v0[0], v0[1]); w.y = pg8::cvt_pk_bf16(v0[2], v0[3]); w.z = pg8::cvt_pk_bf16(v1[0], v1[1]); w.w = pg8::cvt_pk_bf16(v1[2], v1[3]);
                    *(v4u*)(U + row * DM + col) = w; } }
    }
};
struct EpiOutRes {
    static constexpr bool PERM = false, AFTER_DRAIN = false;
    const float* X; float* H; const float* modf;
    __device__ __forceinline__ void operator()(const f32x4 (&acc)[2][2][4][2], const Unit& u, int wr, int wc, int fr, int fq) const {
        const int row0 = u.pm * BM + wr * 64 + fr, col0 = u.pn * BM + wc * 32 + 4 * fq;
        const int b = (u.pm * BM) / SEQ; const float* gt = modf + (size_t)b * 6 * DM + 2 * DM;
        f32x4 gv[2][2];
#pragma unroll
        for (int bj = 0; bj < 2; ++bj)
#pragma unroll
            for (int n = 0; n < 2; ++n) gv[bj][n] = *(const f32x4*)(gt + col0 + bj * HALF + n * 16) + 1.0f;
#pragma unroll
        for (int ai = 0; ai < 2; ++ai)
#pragma unroll
            for (int m = 0; m < 4; ++m) { const size_t off = (size_t)(row0 + ai * HALF + m * 16) * DM + col0;
#pragma unroll
                for (int bj = 0; bj < 2; ++bj)
#pragma unroll
                    for (int n = 0; n < 2; ++n) { const f32x4 xv = *(const f32x4*)(X + off + bj * HALF + n * 16);
                        *(f32x4*)(H + off + bj * HALF + n * 16) = xv + gv[bj][n] * acc[ai][bj][m][n]; } }
    }
};
struct EpiMoe1 {
    static constexpr bool PERM = true, AFTER_DRAIN = false;
    bf16* ACT; const float* b1;
    __device__ __forceinline__ void operator()(const f32x4 (&acc)[2][2][4][2], const Unit& u, int wr, int wc, int fr, int fq) const {
        const int e = u.pn >> 3, pnl = u.pn & 7;
        const int row0 = u.pm * BM + wr * 64 + fr, c0 = pnl * 128 + wc * 32 + 8 * fq;
        const float* bg = b1 + (size_t)e * 2048 + c0; const float* bl = bg + 1024;
        const f32x4 bg0 = *(const f32x4*)bg, bg1 = *(const f32x4*)(bg + 4), bl0 = *(const f32x4*)bl, bl1 = *(const f32x4*)(bl + 4);
#pragma unroll
        for (int ai = 0; ai < 2; ++ai)
#pragma unroll
            for (int m = 0; m < 4; ++m) { bf16* rowp = ACT + (size_t)(row0 + ai * HALF + m * 16) * DE + c0;
                float o[8];
#pragma unroll
                for (int n = 0; n < 2; ++n) { const f32x4 g = acc[ai][0][m][n] + (n ? bg1 : bg0), l = acc[ai][1][m][n] + (n ? bl1 : bl0);
#pragma unroll
                    for (int i = 0; i < 4; ++i) { const float gg = fminf(g[i], 7.0f), ll = fminf(fmaxf(l[i], -7.0f), 7.0f);
                        o[n * 4 + i] = gg * sigmoidf_(1.702f * gg) * (ll + 1.0f); } }
                v4u w; w.x = pg8::cvt_pk_bf16(o[0], o[1]); w.y = pg8::cvt_pk_bf16(o[2], o[3]); w.z = pg8::cvt_pk_bf16(o[4], o[5]); w.w = pg8::cvt_pk_bf16(o[6], o[7]);
                *(v4u*)rowp = w; }
    }
};
struct EpiMoe2 {
    static constexpr bool PERM = true, AFTER_DRAIN = false;
    bf16* Y; const float* b2; const float* rg;
    __device__ __forceinline__ void operator()(const f32x4 (&acc)[2][2][4][2], const Unit& u, int wr, int wc, int fr, int fq) const {
        const int e = u.pn >> 2, pnl = u.pn & 3;
        const int row0 = u.pm * BM + wr * 64 + fr, col0 = pnl * BM + wc * 32 + 8 * fq;
        f32x4 bv[2][2];
#pragma unroll
        for (int bj = 0; bj < 2; ++bj)
#pragma unroll
            for (int n = 0; n < 2; ++n) bv[bj][n] = *(const f32x4*)(b2 + (size_t)e * DM + col0 + bj * HALF + 4 * n);
#pragma unroll
        for (int ai = 0; ai < 2; ++ai)
#pragma unroll
            for (int m = 0; m < 4; ++m) { const int row = row0 + ai * HALF + m * 16; const float g = rg[row]; bf16* rowp = Y + (size_t)row * DM + col0;
#pragma unroll
                for (int bj = 0; bj < 2; ++bj) { const f32x4 v0 = (acc[ai][bj][m][0] + bv[bj][0]) * g, v1 = (acc[ai][bj][m][1] + bv[bj][1]) * g;
                    v4u w; w.x = pg8::cvt_pk_bf16(v0[0], v0[1]); w.y = pg8::cvt_pk_bf16(v0[2], v0[3]); w.z = pg8::cvt_pk_bf16(v1[0], v1[1]); w.w = pg8::cvt_pk_bf16(v1[2], v1[3]);
                    *(v4u*)(rowp + bj * HALF) = w; } }
    }
};
struct MoeOrder {
    int nN, sh, G, v; const unsigned* tab;
    __device__ __forceinline__ bool next(int i, Unit& u) const {
        const int ntl = (int)tab[0]; const long L = (long)i * G + v; if (L >= (long)ntl * nN) return false;
        const int pm = (int)(L >> sh), pnl = (int)(L & (nN - 1)); const int e = (int)tab[64 + pm];
        u.pm = pm; u.pn = e * nN + pnl; return true;
    }
    __device__ __forceinline__ void a_ready(const Unit&) const {}
    __device__ __forceinline__ void done(const Unit&) const {}
};

struct Args { const float* in[27]; float* out; unsigned char* ws; int ph_lo, ph_hi; };
struct Ctx {
    LAS unsigned char* lds; unsigned char* ws; unsigned* ctl;
    int tid, lane, wave, vcu, G;
    const float* const* in; float* out;
};
enum { I_X = 0, I_C, I_ADAW, I_ADAB, I_N1G, I_WIN, I_PEK, I_PEV, I_CW1K, I_CW2K, I_CW1V, I_CW2V, I_CONVW, I_CONVB, I_GATEB, I_MLNG, I_WUPA, I_WUPB, I_WOUT, I_N2G, I_RW, I_RB, I_EW1, I_EB1, I_EW2, I_EB2, I_FG };

template <class DMap>
__device__ __forceinline__ void p0_transpose_item(const float* W, int K, int N, bf16* WT, const DMap& dmap, LAS float* scr, int item, int lane) {
    const int nblk = N / 32, kb = item / nblk, nb = item % nblk, k0 = 64 * kb, n0 = 32 * nb;
    float tmp[16];
#pragma unroll
    for (int hh = 0; hh < 2; ++hh) {
#pragma unroll
    for (int i = 0; i < 16; ++i) tmp[i] = W[(size_t)(k0 + 2 * (16 * hh + i) + (lane >> 5)) * N + n0 + (lane & 31)];
#pragma unroll
    for (int i = 0; i < 16; ++i) scr[(2 * (16 * hh + i) + (lane >> 5)) * 33 + (lane & 31)] = tmp[i]; }
    LDS_WAIT(); asm volatile("" ::: "memory");
    const int c = lane & 7;
#pragma unroll
    for (int j = 0; j < 4; ++j) { const int n = (lane >> 3) + 8 * j; const LAS float* s = scr + (8 * c) * 33 + n;
        v4u o; o.x = pk2(s[0 * 33], s[1 * 33]); o.y = pk2(s[2 * 33], s[3 * 33]); o.z = pk2(s[4 * 33], s[5 * 33]); o.w = pk2(s[6 * 33], s[7 * 33]);
        *(GAS v4u*)(WT + (size_t)dmap(n0 + n) * K + k0 + 8 * c) = o; }
    LDS_WAIT(); asm volatile("" ::: "memory");
}
struct DMapId { __device__ __forceinline__ int operator()(int n) const { return n; } };
struct DMapWin { __device__ __forceinline__ int operator()(int n) const {
    if (n < 1280) return n;
    if (n < 1304) return PC_NSAG + (n - 1280);
    if (n < 2328) return PC_MLQ + (n - 1304);
    if (n < 2840) return PC_MLV + (n - 2328);
    if (n < 2848) return PC_MLIF + (n - 2840);
    if (n < 3360) return PC_MLO + (n - 2848);
    return PC_MGA + (n - 3360); } };
struct DMapW1 { __device__ __forceinline__ int operator()(int n) const { return n < 1024 ? ((n >> 7) << 8) + (n & 127) : (((n - 1024) >> 7) << 8) + 128 + (n & 127); } };

__device__ __forceinline__ void p0_prologue(Ctx& F) {
    LAS float* scr = (LAS float*)(F.lds + F.wave * 16384);
    const int gw = F.vcu * NWAVES + F.wave, NGW = F.G * NWAVES;
    constexpr int I_IN = (DM / 64) * (INW / 32), I_UP = (512 / 64) * (DM / 32), I_OUT = (DM / 64) * (DM / 32), I_C1 = (2048 / 64) * (128 / 32), I_C2 = (128 / 64) * (64 / 32);
    constexpr int I_E1 = (DM / 64) * (2048 / 32), I_E2 = (DE / 64) * (DM / 32);
    constexpr int NITEMS = I_IN + 2 * I_UP + I_OUT + 2 * I_C1 + 2 * I_C2 + NEXP * (I_E1 + I_E2);
    for (int it = gw; it < NITEMS; it += NGW) {
        int r = it;
        if (r < I_IN) { p0_transpose_item(F.in[I_WIN], DM, INW, (bf16*)(F.ws + WS_WIN), DMapWin(), scr, r, F.lane); continue; } r -= I_IN;
        if (r < I_UP) { p0_transpose_item(F.in[I_WUPA], 512, DM, (bf16*)(F.ws + WS_WUPA), DMapId(), scr, r, F.lane); continue; } r -= I_UP;
        if (r < I_UP) { p0_transpose_item(F.in[I_WUPB], 512, DM, (bf16*)(F.ws + WS_WUPB), DMapId(), scr, r, F.lane); continue; } r -= I_UP;
        if (r < I_OUT) { p0_transpose_item(F.in[I_WOUT], DM, DM, (bf16*)(F.ws + WS_WOUT), DMapId(), scr, r, F.lane); continue; } r -= I_OUT;
        if (r < I_C1) { p0_transpose_item(F.in[I_CW1K], 2048, 128, (bf16*)(F.ws + WS_CW1K), DMapId(), scr, r, F.lane); continue; } r -= I_C1;
        if (r < I_C1) { p0_transpose_item(F.in[I_CW1V], 2048, 128, (bf16*)(F.ws + WS_CW1V), DMapId(), scr, r, F.lane); continue; } r -= I_C1;
        if (r < I_C2) { p0_transpose_item(F.in[I_CW2K], 128, 64, (bf16*)(F.ws + WS_CW2K), DMapId(), scr, r, F.lane); continue; } r -= I_C2;
        if (r < I_C2) { p0_transpose_item(F.in[I_CW2V], 128, 64, (bf16*)(F.ws + WS_CW2V), DMapId(), scr, r, F.lane); continue; } r -= I_C2;
        if (r < NEXP * I_E1) { const int e = r / I_E1; p0_transpose_item(F.in[I_EW1] + (size_t)e * DM * 2048, DM, 2048, (bf16*)(F.ws + WS_W1T) + (size_t)e * 2048 * DM, DMapW1(), scr, r % I_E1, F.lane); continue; } r -= NEXP * I_E1;
        { const int e = r / I_E2; p0_transpose_item(F.in[I_EW2] + (size_t)e * DE * DM, DE, DM, (bf16*)(F.ws + WS_W2T) + (size_t)e * DM * DE, DMapId(), scr, r % I_E2, F.lane); }
    }
    {
        const int gt = F.vcu * NTHREADS + F.tid, NGT = F.G * NTHREADS;
        const float* c = F.in[I_C]; const float* aw = F.in[I_ADAW]; float* modp = (float*)(F.ws + WS_MODP);
        for (int w = gt; w < ADA_SLICES * 6144; w += NGT) {
            const int s = w / 6144, j = w % 6144; float a0 = 0.f, a1 = 0.f, a2 = 0.f, a3 = 0.f;
#pragma unroll 8
            for (int kk = 0; kk < 64; ++kk) { const int k = s * 64 + kk; const float wv = aw[(size_t)k * 6144 + j];
                const float c0 = c[k], c1 = c[DM + k], c2 = c[2 * DM + k], c3 = c[3 * DM + k];
                a0 += c0 * sigmoidf_(c0) * wv; a1 += c1 * sigmoidf_(c1) * wv; a2 += c2 * sigmoidf_(c2) * wv; a3 += c3 * sigmoidf_(c3) * wv; }
            modp[(size_t)(s * 4 + 0) * 6144 + j] = a0; modp[(size_t)(s * 4 + 1) * 6144 + j] = a1; modp[(size_t)(s * 4 + 2) * 6144 + j] = a2; modp[(size_t)(s * 4 + 3) * 6144 + j] = a3;
        }
        { const float* rw = F.in[I_RW]; bf16* rwhi = (bf16*)(F.ws + WS_RWHI); bf16* rwlo = (bf16*)(F.ws + WS_RWLO);
          for (int w = gt; w < DM * NEXP; w += NGT) { const int e = w >> 10, k = w & 1023; const float x = rw[k * NEXP + e]; const unsigned h = f2bf(x); rwhi[w] = (bf16)h; rwlo[w] = (bf16)f2bf(x - bf2f((unsigned short)h)); } }
        float* pbp = (float*)(F.ws + WS_PBP);
        for (int w = gt; w < PB_SLICES * 2 * 128; w += NGT) {
            const int s = w / 256, kv = (w >> 7) & 1, j = w & 127; const float* pe = F.in[kv ? I_PEV : I_PEK]; const float* w1 = F.in[kv ? I_CW1V : I_CW1K]; float a = 0.f;
#pragma unroll 8
            for (int ii = 0; ii < 128; ++ii) { const int i = s * 128 + ii; a += pe[i] * w1[(size_t)i * 128 + j]; }
            pbp[w] = a;
        }
    }
}

template <bool WITH_MOE>
__device__ __forceinline__ void p_final(Ctx& F, const float* H, const float* modf) {
    const int gw = F.vcu * NWAVES + F.wave, NGW = F.G * NWAVES;
    const bf16* Y = (const bf16*)(F.ws + WS_YR); const int* dest = (const int*)(F.ws + WS_DEST);
    const float* fg = F.in[I_FG];
    f32x4 g[4];
#pragma unroll
    for (int j = 0; j < 4; ++j) g[j] = *(const f32x4*)(fg + 4 * F.lane + 256 * j);
    for (int t = gw; t < T; t += NGW) {
        const int b = t / SEQ; f32x4 v[4]; float ss = 0.f;
#pragma unroll
        for (int j = 0; j < 4; ++j) v[j] = *(const f32x4*)(H + (size_t)t * DM + 4 * F.lane + 256 * j);
        if (WITH_MOE) {
            f32x4 m[4];
#pragma unroll
            for (int j = 0; j < 4; ++j) m[j] = (f32x4){0.f, 0.f, 0.f, 0.f};
#pragma unroll
            for (int k = 0; k < TOPK; ++k) { const int r = dest[t * 4 + k];
#pragma unroll
                for (int j = 0; j < 4; ++j) { const v2u w = *(const v2u*)(Y + (size_t)r * DM + 4 * F.lane + 256 * j);
                    m[j][0] += bflo(w.x); m[j][1] += bfhi(w.x); m[j][2] += bflo(w.y); m[j][3] += bfhi(w.y); } }
            const float* gt = modf + (size_t)b * 6 * DM + 5 * DM;
#pragma unroll
            for (int j = 0; j < 4; ++j) { const f32x4 gg = *(const f32x4*)(gt + 4 * F.lane + 256 * j) + 1.0f; v[j] = v[j] + gg * m[j]; }
        }
#pragma unroll
        for (int j = 0; j < 4; ++j) ss += (v[j][0] * v[j][0] + v[j][1] * v[j][1]) + (v[j][2] * v[j][2] + v[j][3] * v[j][3]);
        const float rs = rsqrtf(wave_sum(ss) * (1.0f / DM) + NORM_EPS);
#pragma unroll
        for (int j = 0; j < 4; ++j) *(f32x4*)(F.out + (size_t)t * DM + 4 * F.lane + 256 * j) = v[j] * rs * g[j];
    }
}

__device__ __forceinline__ f32x4 mfma16(bf16x8 a, bf16x8 b, f32x4 c) { return __builtin_amdgcn_mfma_f32_16x16x32_bf16(a, b, c, 0, 0, 0); }
typedef short v4i16_t __attribute__((ext_vector_type(4)));
__device__ __forceinline__ s16x4 lds_tr4(const LAS unsigned char* p) { return __builtin_bit_cast(s16x4, __builtin_amdgcn_ds_read_tr16_b64_v4i16((LAS v4i16_t*)p)); }
__device__ __forceinline__ bf16x8 tr_frag(const LAS unsigned char* img, int sb, int r0, int r1, int n0, int lane) {
    const int q = (lane & 15) >> 2, p = lane & 3;
    const s16x4 lo = lds_tr4(img + (r0 + q) * sb + (n0 + 4 * p) * 2), hi = lds_tr4(img + (r1 + q) * sb + (n0 + 4 * p) * 2);
    return (bf16x8){lo[0], lo[1], lo[2], lo[3], hi[0], hi[1], hi[2], hi[3]};
}
__device__ __forceinline__ bf16x8 lds_row8(const LAS unsigned char* img, int sb, int row, int col) { return *(const LAS bf16x8*)(img + row * sb + col * 2); }
__device__ __forceinline__ bf16x8 pack8(const f32x4 a, const f32x4 b) {
    v4u w; w.x = pg8::cvt_pk_bf16(a[0], a[1]); w.y = pg8::cvt_pk_bf16(a[2], a[3]); w.z = pg8::cvt_pk_bf16(b[0], b[1]); w.w = pg8::cvt_pk_bf16(b[2], b[3]);
    return __builtin_bit_cast(bf16x8, w);
}
__device__ __forceinline__ float grp_max(float v) { v = fmaxf(v, __shfl_xor(v, 16)); return fmaxf(v, __shfl_xor(v, 32)); }
__device__ __forceinline__ float grp_sum(float v) { v += __shfl_xor(v, 16); return v + __shfl_xor(v, 32); }
constexpr float NEG_BIG = -1.0e30f;
constexpr float LOG2E = 1.4426950408889634f;
constexpr int KV_SB = 144;
constexpr int W128_SB = 272;

template <int MODE>
__device__ __forceinline__ void nsa_pass(Ctx& F, const bf16* proj, int b, int g, int qb, int kcol, int vcol, const bf16x8 (&qf)[2][2], const unsigned long long (&selm)[2],
                                         f32x4 (&ot)[2][4], float (&lsum)[2]) {
    LAS unsigned char* Kt = F.lds; LAS unsigned char* Vt = F.lds + 2 * 64 * KV_SB;
    const int lane = F.lane, gq = lane >> 4, th = F.wave >> 2;
    const int ntile = MODE == 0 ? qb + 1 : (qb < 8 ? qb + 1 : 9);
    const int lrow = F.tid >> 3, lch = F.tid & 7;
    const size_t rbase = (size_t)b * SEQ;
    float mrun[2] = {NEG_BIG, NEG_BIG};
#pragma unroll
    for (int qi = 0; qi < 2; ++qi) { lsum[qi] = 0.f;
#pragma unroll
        for (int db = 0; db < 4; ++db) ot[qi][db] = (f32x4){0.f, 0.f, 0.f, 0.f}; }
    auto tile_of = [&](int it) { return MODE == 0 ? it : qb - it; };
    v4u kreg, vreg;
    { const int j = tile_of(0); const bf16* src = proj + (rbase + (size_t)j * 64 + lrow) * PW + lch * 8; kreg = *(const v4u*)(src + kcol); vreg = *(const v4u*)(src + vcol); }
    __syncthreads();
    for (int it = 0; it < ntile; ++it) {
        const int buf = it & 1, j = tile_of(it);
        *(LAS v4u*)(Kt + buf * 64 * KV_SB + lrow * KV_SB + lch * 16) = kreg; *(LAS v4u*)(Vt + buf * 64 * KV_SB + lrow * KV_SB + lch * 16) = vreg;
        __syncthreads();
        if (it + 1 < ntile) { const int jn = tile_of(it + 1); const bf16* src = proj + (rbase + (size_t)jn * 64 + lrow) * PW + lch * 8; kreg = *(const v4u*)(src + kcol); vreg = *(const v4u*)(src + vcol); }
        const LAS unsigned char* Kb = Kt + buf * 64 * KV_SB; const LAS unsigned char* Vb = Vt + buf * 64 * KV_SB;
        f32x4 s[2][4];
#pragma unroll
        for (int kb = 0; kb < 4; ++kb) { const bf16x8 k0 = lds_row8(Kb, KV_SB, 16 * kb + (lane & 15), 8 * gq), k1 = lds_row8(Kb, KV_SB, 16 * kb + (lane & 15), 32 + 8 * gq);
#pragma unroll
            for (int qi = 0; qi < 2; ++qi) { f32x4 a = (f32x4){0.f, 0.f, 0.f, 0.f}; a = mfma16(k0, qf[qi][0], a); a = mfma16(k1, qf[qi][1], a); s[qi][kb] = a; } }
        const bool edge = MODE == 0 ? (j == qb) : (j == qb || j == qb - 8);
#pragma unroll
        for (int qi = 0; qi < 2; ++qi) {
            const int i = th * 32 + qi * 16 + (lane & 15);
            bool rowok = true; if (MODE == 0) rowok = (selm[qi] >> j) & 1ull;
            if (edge) {
#pragma unroll
                for (int kb = 0; kb < 4; ++kb)
#pragma unroll
                    for (int r = 0; r < 4; ++r) { const int kvl = 16 * kb + 4 * gq + r; bool ok;
                        if (MODE == 0) ok = kvl <= i; else { const int rel = (qb - j) * 64 + i - kvl; ok = rel >= 0 && rel < 512; }
                        s[qi][kb][r] = ok ? s[qi][kb][r] : NEG_BIG; } }
            float mx = fmaxf(fmaxf(s[qi][0][0], s[qi][0][1]), fmaxf(s[qi][0][2], s[qi][0][3]));
#pragma unroll
            for (int kb = 1; kb < 4; ++kb) mx = fmaxf(mx, fmaxf(fmaxf(s[qi][kb][0], s[qi][kb][1]), fmaxf(s[qi][kb][2], s[qi][kb][3])));
            mx = rowok ? mx * (0.125f * LOG2E) : NEG_BIG;
            mx = grp_max(mx);
            const float mnew = fmaxf(mrun[qi], mx);
            if (__any(mnew > mrun[qi])) { const float alpha = __builtin_amdgcn_exp2f(mrun[qi] - mnew); lsum[qi] *= alpha;
#pragma unroll
                for (int db = 0; db < 4; ++db) ot[qi][db] *= alpha; }
            mrun[qi] = mnew;
            const float nb = rowok ? -mnew : -INFINITY;
            float ps = 0.f;
#pragma unroll
            for (int kb = 0; kb < 4; ++kb)
#pragma unroll
                for (int r = 0; r < 4; ++r) { const float p = __builtin_amdgcn_exp2f(fmaf(s[qi][kb][r], 0.125f * LOG2E, nb)); s[qi][kb][r] = p; ps += p; }
            lsum[qi] += ps;
        }
#pragma unroll
        for (int st = 0; st < 2; ++st) {
            const bf16x8 p0 = pack8(s[0][2 * st], s[0][2 * st + 1]), p1 = pack8(s[1][2 * st], s[1][2 * st + 1]);
#pragma unroll
            for (int db = 0; db < 4; ++db) { const bf16x8 vf = tr_frag(Vb, KV_SB, 32 * st + 4 * gq, 32 * st + 16 + 4 * gq, 16 * db, lane);
                ot[0][db] = mfma16(vf, p0, ot[0][db]); ot[1][db] = mfma16(vf, p1, ot[1][db]); }
        }
    }
}

__device__ __forceinline__ void nsa_selwin_unit(Ctx& F, int b, int g, int qb) {
    const bf16* proj = (const bf16*)(F.ws + WS_PROJ); const bf16* ocmp = (const bf16*)(F.ws + WS_OCMP); bf16* onsa = (bf16*)(F.ws + WS_ONSA);
    const unsigned long long* selmask = (const unsigned long long*)(F.ws + WS_SELM);
    const int lane = F.lane, gq = lane >> 4, hr = F.wave & 3, th = F.wave >> 2, head = g * 4 + hr;
    bf16x8 qf[2][2]; unsigned long long selm[2]; size_t trow[2];
#pragma unroll
    for (int qi = 0; qi < 2; ++qi) { const int t = qb * 64 + th * 32 + qi * 16 + (lane & 15); trow[qi] = (size_t)b * SEQ + t;
        selm[qi] = selmask[(size_t)(b * 2 + g) * SEQ + t];
#pragma unroll
        for (int st = 0; st < 2; ++st) qf[qi][st] = *(const bf16x8*)(proj + trow[qi] * PW + PC_Q + head * 64 + 32 * st + 8 * gq); }
    f32x4 ot[2][4]; float lsum[2];
    nsa_pass<0>(F, proj, b, g, qb, PC_KV + 2 * 128 + g * 64, PC_KV + 3 * 128 + g * 64, qf, selm, ot, lsum);
#pragma unroll
    for (int qi = 0; qi < 2; ++qi) { const float gate = sigmoidf_(bf2f(proj[trow[qi] * PW + PC_NSAG + 8 + head])) / grp_sum(lsum[qi]);
#pragma unroll
        for (int db = 0; db < 4; ++db) { const size_t o = trow[qi] * 512 + head * 64 + 16 * db + 4 * gq; const v2u c = *(const v2u*)(ocmp + o);
            f32x4 v = ot[qi][db] * gate; v[0] += bflo(c.x); v[1] += bfhi(c.x); v[2] += bflo(c.y); v[3] += bfhi(c.y);
            v2u w; w.x = pg8::cvt_pk_bf16(v[0], v[1]); w.y = pg8::cvt_pk_bf16(v[2], v[3]); *(v2u*)(onsa + o) = w; } }
    nsa_pass<1>(F, proj, b, g, qb, PC_KV + 4 * 128 + g * 64, PC_KV + 5 * 128 + g * 64, qf, selm, ot, lsum);
#pragma unroll
    for (int qi = 0; qi < 2; ++qi) { const float gate = sigmoidf_(bf2f(proj[trow[qi] * PW + PC_NSAG + 16 + head])) / grp_sum(lsum[qi]);
#pragma unroll
        for (int db = 0; db < 4; ++db) { const size_t o = trow[qi] * 512 + head * 64 + 16 * db + 4 * gq; const v2u c = *(const v2u*)(onsa + o);
            f32x4 v = ot[qi][db] * gate; v[0] += bflo(c.x); v[1] += bfhi(c.x); v[2] += bflo(c.y); v[3] += bfhi(c.y);
            v2u w; w.x = pg8::cvt_pk_bf16(v[0], v[1]); w.y = pg8::cvt_pk_bf16(v[2], v[3]); *(v2u*)(onsa + o) = w; } }
}

__device__ __forceinline__ void p1_norm1(Ctx& F) {
    const float* modp = (const float*)(F.ws + WS_MODP); const float* adab = F.in[I_ADAB]; float* modfw = (float*)(F.ws + WS_MODF);
    { const int gt = F.vcu * NTHREADS + F.tid, NGT = F.G * NTHREADS;
      for (int w = gt; w < 4 * 6144; w += NGT) { const int b = w / 6144, j = w % 6144; float a = adab[j];
#pragma unroll
          for (int s = 0; s < ADA_SLICES; ++s) a += modp[(size_t)(s * 4 + b) * 6144 + j];
          modfw[w] = a; } }
    LAS float* shs = (LAS float*)F.lds; LAS float* scs = shs + DM;
    const float* x = F.in[I_X]; const float* g1 = F.in[I_N1G]; bf16* A1 = (bf16*)(F.ws + WS_A1);
    int curb = -1;
    for (int blk = F.vcu; blk < T / 64; blk += F.G) {
        const int b = (blk * 64) / SEQ;
        if (b != curb) { __syncthreads();
            for (int j = F.tid; j < 2 * DM; j += NTHREADS) { float a = adab[j];
#pragma unroll
                for (int s = 0; s < ADA_SLICES; ++s) a += modp[(size_t)(s * 4 + b) * 6144 + j];
                if (j < DM) shs[j] = a; else scs[j - DM] = (1.0f + a) * g1[j - DM]; }
            __syncthreads(); curb = b; }
        for (int tt = F.wave; tt < 64; tt += NWAVES) { const int t = blk * 64 + tt;
            f32x4 v[4]; float ss = 0.f;
#pragma unroll
            for (int j = 0; j < 4; ++j) { v[j] = *(const f32x4*)(x + (size_t)t * DM + 4 * F.lane + 256 * j); ss += (v[j][0] * v[j][0] + v[j][1] * v[j][1]) + (v[j][2] * v[j][2] + v[j][3] * v[j][3]); }
            const float rs = rsqrtf(wave_sum(ss) * (1.0f / DM) + NORM_EPS);
#pragma unroll
            for (int j = 0; j < 4; ++j) { const f32x4 sc = *(const LAS f32x4*)(scs + 4 * F.lane + 256 * j), sh = *(const LAS f32x4*)(shs + 4 * F.lane + 256 * j);
                const f32x4 o = v[j] * rs * sc + sh; v2u w; w.x = pk2(o[0], o[1]); w.y = pk2(o[2], o[3]);
                *(v2u*)(A1 + (size_t)t * DM + 4 * F.lane + 256 * j) = w; }
        }
    }
    __syncthreads();
}

constexpr int RA_SB = 1040;
__device__ __forceinline__ void p8_norm2_router(Ctx& F, const float* H, const float* modf) {
    LAS unsigned char* Ahi = F.lds; LAS unsigned char* Alo = F.lds + 64 * RA_SB; LAS float* lg = (LAS float*)(F.lds + 2 * 64 * RA_SB);
    LAS int* hist = (LAS int*)(lg + 64 * 33);
    const float* rb = F.in[I_RB]; const float* g2 = F.in[I_N2G];
    const bf16* rwhi = (const bf16*)(F.ws + WS_RWHI); const bf16* rwlo = (const bf16*)(F.ws + WS_RWLO);
    bf16* N2 = (bf16*)(F.ws + WS_A1); int* topi = (int*)(F.ws + WS_TOPI); float* gate = (float*)(F.ws + WS_GATE);
    const int lane = F.lane, gq = lane >> 4, w = F.wave;
    if (F.tid < 32) hist[F.tid] = 0;
    f32x4 gv[4];
#pragma unroll
    for (int j = 0; j < 4; ++j) gv[j] = *(const f32x4*)(g2 + 4 * lane + 256 * j);
    for (int blk = F.vcu; blk < T / 64; blk += F.G) {
        const int b = (blk * 64) / SEQ; const float* sh2 = modf + (size_t)b * 6 * DM + 3 * DM; const float* sc2 = sh2 + DM;
        f32x4 scv[4], shv[4];
#pragma unroll
        for (int j = 0; j < 4; ++j) { scv[j] = (*(const f32x4*)(sc2 + 4 * lane + 256 * j) + 1.0f) * gv[j]; shv[j] = *(const f32x4*)(sh2 + 4 * lane + 256 * j); }
        f32x4 v[8][4];
#pragma unroll
        for (int i = 0; i < 8; ++i) { const int t = blk * 64 + w * 8 + i;
#pragma unroll
            for (int j = 0; j < 4; ++j) v[i][j] = *(const f32x4*)(H + (size_t)t * DM + 4 * lane + 256 * j); }
#pragma unroll
        for (int i = 0; i < 8; ++i) { const int t = blk * 64 + w * 8 + i; float ss = 0.f;
#pragma unroll
            for (int j = 0; j < 4; ++j) ss += (v[i][j][0] * v[i][j][0] + v[i][j][1] * v[i][j][1]) + (v[i][j][2] * v[i][j][2] + v[i][j][3] * v[i][j][3]);
            const float rs = rsqrtf(wave_sum(ss) * (1.0f / DM) + NORM_EPS);
#pragma unroll
            for (int j = 0; j < 4; ++j) { v[i][j] = v[i][j] * rs * scv[j] + shv[j]; v2u o; o.x = pk2(v[i][j][0], v[i][j][1]); o.y = pk2(v[i][j][2], v[i][j][3]);
                *(v2u*)(N2 + (size_t)t * DM + 4 * lane + 256 * j) = o; } }
        const int tbk = w & 3, eb = w >> 2; f32x4 acc = (f32x4){0.f, 0.f, 0.f, 0.f};
#pragma unroll
        for (int kh = 0; kh < 2; ++kh) {
            __syncthreads();
#pragma unroll
            for (int i = 0; i < 8; ++i)
#pragma unroll
                for (int jj = 0; jj < 2; ++jj) { const f32x4 x = v[i][2 * kh + jj]; const unsigned h0 = pk2(x[0], x[1]), h1 = pk2(x[2], x[3]);
                    const unsigned l0 = pk2(x[0] - bflo(h0), x[1] - bfhi(h0)), l1 = pk2(x[2] - bflo(h1), x[3] - bfhi(h1));
                    const int off = (w * 8 + i) * RA_SB + (4 * lane + 256 * jj) * 2;
                    *(LAS v2u*)(Ahi + off) = (v2u){h0, h1}; *(LAS v2u*)(Alo + off) = (v2u){l0, l1}; }
            __syncthreads();
#pragma unroll 4
            for (int s = 0; s < 16; ++s) { const size_t bo = (size_t)(16 * eb + (lane & 15)) * DM + 512 * kh + 32 * s + 8 * gq;
                const bf16x8 bh = *(const bf16x8*)(rwhi + bo), bl = *(const bf16x8*)(rwlo + bo);
                const bf16x8 ah = lds_row8(Ahi, RA_SB, 16 * tbk + (lane & 15), 32 * s + 8 * gq), al = lds_row8(Alo, RA_SB, 16 * tbk + (lane & 15), 32 * s + 8 * gq);
                acc = mfma16(ah, bh, acc); acc = mfma16(al, bh, acc); acc = mfma16(ah, bl, acc); }
        }
        { const int e = 16 * eb + (lane & 15); const float rbe = rb[e];
#pragma unroll
          for (int r = 0; r < 4; ++r) lg[(16 * tbk + 4 * gq + r) * 33 + e] = acc[r] + rbe; }
        __syncthreads();
        if (F.tid < 64) { const int t = blk * 64 + F.tid; float lv[32];
#pragma unroll
            for (int e = 0; e < 32; ++e) lv[e] = lg[F.tid * 33 + e];
            int si[4]; float sv[4];
#pragma unroll
            for (int k = 0; k < 4; ++k) { float m = -3.0e38f; int mi = 0;
#pragma unroll
                for (int e = 0; e < 32; ++e) { const bool gt = lv[e] > m; m = gt ? lv[e] : m; mi = gt ? e : mi; }
#pragma unroll
                for (int e = 0; e < 32; ++e) lv[e] = (e == mi) ? -3.0e38f : lv[e];
                si[k] = mi; sv[k] = m; }
            const float e1 = __expf(sv[1] - sv[0]), e2 = __expf(sv[2] - sv[0]), e3 = __expf(sv[3] - sv[0]); const float inv = 1.0f / (1.0f + e1 + e2 + e3);
            *(int4*)(topi + t * 4) = make_int4(si[0], si[1], si[2], si[3]); *(f32x4*)(gate + t * 4) = (f32x4){inv, e1 * inv, e2 * inv, e3 * inv};
#pragma unroll
            for (int k = 0; k < 4; ++k) __hip_atomic_fetch_add(&hist[si[k]], 1, __ATOMIC_RELAXED, __HIP_MEMORY_SCOPE_WORKGROUP); }
    }
    __syncthreads();
    if (F.tid < 32) { const int h = hist[F.tid]; if (h) __hip_atomic_fetch_add(F.ctl + CW_ECNT + 64 * F.tid, (unsigned)h, __ATOMIC_RELAXED, __HIP_MEMORY_SCOPE_AGENT); }
    __syncthreads();
}

__device__ __forceinline__ void p9_permute(Ctx& F) {
    LAS int* sm = (LAS int*)F.lds; LAS int* cnt = sm, *pstart = sm + 32, *lhist = sm + 64, *lbase = sm + 96, *dl = sm + 128;
    if (F.tid < 32) cnt[F.tid] = (int)__hip_atomic_load(F.ctl + CW_ECNT + 64 * F.tid, __ATOMIC_RELAXED, __HIP_MEMORY_SCOPE_AGENT);
    __syncthreads();
    if (F.tid == 0) { int run = 0; unsigned* tab = F.ctl + CW_MOETAB; const bool w0 = (blockIdx.x == 0);
        for (int e = 0; e < NEXP; ++e) { pstart[e] = run; const int nt = (cnt[e] + MOE_ROWS - 1) / MOE_ROWS;
            if (w0) for (int i = 0; i < nt; ++i) tab[64 + run / MOE_ROWS + i] = (unsigned)e;
            run += nt * MOE_ROWS; }
        if (w0) tab[0] = (unsigned)(run / MOE_ROWS); }
    __syncthreads();
    const bf16* N2 = (const bf16*)(F.ws + WS_A1); bf16* XG = (bf16*)(F.ws + WS_XG);
    const int* topi = (const int*)(F.ws + WS_TOPI); const float* gate = (const float*)(F.ws + WS_GATE); int* dest = (int*)(F.ws + WS_DEST); float* rowg = (float*)(F.ws + WS_ROWG);
    for (int blk = F.vcu; blk < T / 64; blk += F.G) {
        if (F.tid < 32) lhist[F.tid] = 0;
        __syncthreads();
        int e = 0, rank = 0; const int a = blk * 256 + F.tid;
        if (F.tid < 256) { e = topi[a]; rank = __hip_atomic_fetch_add(&lhist[e], 1, __ATOMIC_RELAXED, __HIP_MEMORY_SCOPE_WORKGROUP); }
        __syncthreads();
        if (F.tid < 32) { const int h = lhist[F.tid]; lbase[F.tid] = pstart[F.tid] + (h ? (int)__hip_atomic_fetch_add(F.ctl + CW_EFILL + 64 * F.tid, (unsigned)h, __ATOMIC_RELAXED, __HIP_MEMORY_SCOPE_AGENT) : 0); }
        __syncthreads();
        if (F.tid < 256) { const int d = lbase[e] + rank; dest[a] = d; rowg[d] = gate[a]; dl[F.tid] = d; }
        __syncthreads();
        { v4u r0[8], r1[8];
#pragma unroll
          for (int i = 0; i < 8; ++i) { const int t = blk * 64 + F.wave * 8 + i; r0[i] = *(const v4u*)(N2 + (size_t)t * DM + 8 * F.lane); r1[i] = *(const v4u*)(N2 + (size_t)t * DM + 512 + 8 * F.lane); }
#pragma unroll
          for (int i = 0; i < 8; ++i)
#pragma unroll
              for (int k = 0; k < 4; ++k) { const int d = dl[(F.wave * 8 + i) * 4 + k]; *(v4u*)(XG + (size_t)d * DM + 8 * F.lane) = r0[i]; *(v4u*)(XG + (size_t)d * DM + 512 + 8 * F.lane) = r1[i]; } }
        __syncthreads();
    }
}

__device__ __forceinline__ float gelu_tanh(float x) { const float u = 0.7978845608028654f * (x + 0.044715f * x * x * x); const float e = __expf(2.0f * u); const float th = 1.0f - 2.0f / (e + 1.0f); return 0.5f * x * (1.0f + th); }
__device__ __forceinline__ void nsa_compress_unit(Ctx& F, int unit) {
    const int nt = unit & 15, kv = (unit >> 4) & 1, bg = unit >> 5, b = bg >> 1, g = bg & 1, n0 = nt * 16;
    const bf16* proj = (const bf16*)(F.ws + WS_PROJ);
    const bf16* w1t = (const bf16*)(F.ws + (kv ? WS_CW1V : WS_CW1K)); const bf16* w2t = (const bf16*)(F.ws + (kv ? WS_CW2V : WS_CW2K));
    bf16* outp = (bf16*)(F.ws + (kv ? WS_VC : WS_KC)) + (size_t)bg * 256 * 64;
    const float* pbp = (const float*)(F.ws + WS_PBP);
    LAS unsigned char* Hs = F.lds;
    const int lane = F.lane, gq = lane >> 4, w = F.wave;
    const int col = PC_KV + kv * 128 + g * 64;
    int nrow = n0 + (lane & 15); if (nrow > 254) nrow = 254;
    const bf16* arow = proj + ((size_t)b * SEQ + 16 * nrow) * PW + col + 8 * gq;
    const bf16* brow = w1t + (size_t)(16 * w + (lane & 15)) * 2048 + 8 * gq;
    f32x4 acc = (f32x4){0.f, 0.f, 0.f, 0.f};
#pragma unroll 8
    for (int s = 0; s < 64; ++s) {
        const bf16x8 a = *(const bf16x8*)(arow + (size_t)(s >> 1) * PW + (s & 1) * 32);
        const bf16x8 bb = *(const bf16x8*)(brow + 32 * s);
        acc = mfma16(a, bb, acc);
    }
    { const int j = 16 * w + (lane & 15); float pb = 0.f;
#pragma unroll
      for (int s = 0; s < PB_SLICES; ++s) pb += pbp[(s * 2 + kv) * 128 + j];
      __syncthreads();
#pragma unroll
      for (int r = 0; r < 4; ++r) *(LAS unsigned short*)(Hs + (4 * gq + r) * W128_SB + j * 2) = (unsigned short)f2bf(gelu_tanh(acc[r] + pb));
    }
    __syncthreads();
    if (w < 4) {
        f32x4 o = (f32x4){0.f, 0.f, 0.f, 0.f};
#pragma unroll
        for (int s = 0; s < 4; ++s) { const bf16x8 a = lds_row8(Hs, W128_SB, lane & 15, 32 * s + 8 * gq); const bf16x8 bb = *(const bf16x8*)(w2t + (size_t)(16 * w + (lane & 15)) * 128 + 32 * s + 8 * gq); o = mfma16(a, bb, o); }
#pragma unroll
        for (int r = 0; r < 4; ++r) { const int n = n0 + 4 * gq + r; outp[(size_t)n * 64 + 16 * w + (lane & 15)] = (unsigned short)(n < 255 ? f2bf(o[r]) : 0u); }
    }
}

__device__ __forceinline__ void nsa_cmp_unit(Ctx& F, int bg, int tb) {
    const int b = bg >> 1, g = bg & 1;
    const bf16* proj = (const bf16*)(F.ws + WS_PROJ); bf16* ocmp = (bf16*)(F.ws + WS_OCMP);
    const bf16* kc = (const bf16*)(F.ws + WS_KC) + (size_t)bg * 256 * 64; const bf16* vc = (const bf16*)(F.ws + WS_VC) + (size_t)bg * 256 * 64;
    unsigned long long* selmask = (unsigned long long*)(F.ws + WS_SELM);
    LAS unsigned char* Kt = F.lds; LAS unsigned char* Vt = F.lds + 256 * KV_SB; LAS float* IMP = (LAS float*)(F.lds + 2 * 256 * KV_SB);
    const int lane = F.lane, gq = lane >> 4, w = F.wave, tg = w >> 2, hp = w & 3;
    const int nvmax = 4 * tb + 3;
    const int nkb = (nvmax + 15) >> 4;
    __syncthreads();
    for (int i = F.tid; i < 256 * 8; i += NTHREADS) { const int row = i >> 3, ch = i & 7;
        if (row < nkb * 16) { *(LAS v4u*)(Kt + row * KV_SB + ch * 16) = *(const v4u*)(kc + row * 64 + ch * 8); *(LAS v4u*)(Vt + row * KV_SB + ch * 16) = *(const v4u*)(vc + row * 64 + ch * 8); } }
    __syncthreads();
    LAS float* IMPW = IMP + hp * 64 * 64;
#pragma unroll 1
    for (int qi = 0; qi < 2; ++qi) {
        const int tl = tg * 32 + qi * 16 + (lane & 15), t = tb * 64 + tl; const size_t trow = (size_t)b * SEQ + t;
        const int nv = ((t + 1) >> 4) - 1;
        float imp[16], carry[16];
#pragma unroll
        for (int kb = 0; kb < 16; ++kb) { imp[kb] = 0.f; carry[kb] = 0.f; }
        {
            const int head = g * 4 + hp;
            const bf16x8 q0 = *(const bf16x8*)(proj + trow * PW + PC_Q + head * 64 + 8 * gq), q1 = *(const bf16x8*)(proj + trow * PW + PC_Q + head * 64 + 32 + 8 * gq);
            float ml = NEG_BIG, ll = 0.f;
#pragma unroll 2
            for (int kb = 0; kb < nkb; ++kb) { f32x4 a = (f32x4){0.f, 0.f, 0.f, 0.f};
                a = mfma16(lds_row8(Kt, KV_SB, 16 * kb + (lane & 15), 8 * gq), q0, a); a = mfma16(lds_row8(Kt, KV_SB, 16 * kb + (lane & 15), 32 + 8 * gq), q1, a);
                float v[4], tm = NEG_BIG;
#pragma unroll
                for (int r = 0; r < 4; ++r) { const int n = 16 * kb + 4 * gq + r; v[r] = (n < nv) ? a[r] * (0.125f * LOG2E) : NEG_BIG; tm = fmaxf(tm, v[r]); }
                const float mn = fmaxf(ml, tm); float ps = 0.f;
#pragma unroll
                for (int r = 0; r < 4; ++r) { const int n = 16 * kb + 4 * gq + r; ps += (n < nv) ? __builtin_amdgcn_exp2f(v[r] - mn) : 0.f; }
                ll = ll * __builtin_amdgcn_exp2f(ml - mn) + ps; ml = mn; }
            const float mx = grp_max(ml);
            const float ps = grp_sum(ll * __builtin_amdgcn_exp2f(ml - mx));
            const float inv = ps > 0.f ? 1.0f / ps : 0.f;
            f32x4 o[4];
#pragma unroll
            for (int db = 0; db < 4; ++db) o[db] = (f32x4){0.f, 0.f, 0.f, 0.f};
#pragma unroll
            for (int st = 0; st < 8; ++st) if (2 * st < nkb) {
                f32x4 pp[2];
#pragma unroll
                for (int k2 = 0; k2 < 2; ++k2) { const int kb = 2 * st + k2; f32x4 a = (f32x4){0.f, 0.f, 0.f, 0.f};
                    a = mfma16(lds_row8(Kt, KV_SB, 16 * kb + (lane & 15), 8 * gq), q0, a); a = mfma16(lds_row8(Kt, KV_SB, 16 * kb + (lane & 15), 32 + 8 * gq), q1, a);
#pragma unroll
                    for (int r = 0; r < 4; ++r) { const int n = 16 * kb + 4 * gq + r; a[r] = (n < nv) ? __builtin_amdgcn_exp2f(a[r] * (0.125f * LOG2E) - mx) * inv : 0.f; }
                    pp[k2] = a; imp[kb] += (a[0] + a[1]) + (a[2] + 0.5f * a[3]); carry[kb] += 0.5f * a[3]; }
                const bf16x8 pf = pack8(pp[0], pp[1]);
#pragma unroll
                for (int db = 0; db < 4; ++db) o[db] = mfma16(tr_frag(Vt, KV_SB, 32 * st + 4 * gq, 32 * st + 16 + 4 * gq, 16 * db, lane), pf, o[db]);
                asm volatile("" ::: "memory"); }
            const float gate = sigmoidf_(bf2f(proj[trow * PW + PC_NSAG + head]));
#pragma unroll
            for (int db = 0; db < 4; ++db) { const f32x4 v = o[db] * gate; v2u wv; wv.x = pg8::cvt_pk_bf16(v[0], v[1]); wv.y = pg8::cvt_pk_bf16(v[2], v[3]);
                *(v2u*)(ocmp + trow * 512 + head * 64 + 16 * db + 4 * gq) = wv; }
        }
#pragma unroll
        for (int kb = 0; kb < 16; ++kb) { const float c1 = __shfl(carry[kb], (lane + 48) & 63); const float c0 = kb > 0 ? __shfl(carry[kb > 0 ? kb - 1 : 0], (lane + 48) & 63) : 0.f;
            IMPW[tl * 64 + 4 * kb + gq] = imp[kb] + (gq > 0 ? c1 : c0); }
    }
    __syncthreads();
    for (int tl = w; tl < 64; tl += NWAVES) { const int t = tb * 64 + tl, cur = t >> 6;
        float v = (IMP[tl * 64 + lane] + IMP[4096 + tl * 64 + lane]) + (IMP[2 * 4096 + tl * 64 + lane] + IMP[3 * 4096 + tl * 64 + lane]); const bool forced = (lane == 0) || (lane == cur) || (lane == cur - 1);
        v = (lane > cur) ? NEG_BIG : v + (forced ? 1.0e4f : 0.f);
        int rank = 0;
#pragma unroll
        for (int jj = 0; jj < 64; ++jj) { const float o = __builtin_bit_cast(float, __builtin_amdgcn_readlane(__builtin_bit_cast(int, v), jj)); rank += (o > v || (o == v && jj < lane)) ? 1 : 0; }
        const unsigned long long m = __ballot(lane <= cur && rank < 16);
        if (lane == 0) selmask[(size_t)bg * SEQ + t] = m; }
}

constexpr int ML_H = 4, ML_D = 128, ML_L = 64, ML_NCH = SEQ / ML_L, ML_BH = BATCH * ML_H;
__device__ __forceinline__ float log_sigmoid(float x) { return fminf(x, 0.f) - log1pf(__expf(-fabsf(x))); }
__device__ __forceinline__ float siluf_(float x) { return x * sigmoidf_(x); }
__device__ __forceinline__ void ml_stage_a(Ctx& F, int unit) {
    const int c = unit & 63, bh = unit >> 6, b = bh >> 2, h = bh & 3;
    const bf16* proj = (const bf16*)(F.ws + WS_PROJ); bf16* mlq = (bf16*)(F.ws + WS_MLQ); bf16* mlk = (bf16*)(F.ws + WS_MLKK);
    float* mlb = (float*)(F.ws + WS_MLB); float* mlli = (float*)(F.ws + WS_MLLI); float* mlsc = (float*)(F.ws + WS_MLSC);
    float* mlu = (float*)(F.ws + WS_MLU) + (size_t)unit * ML_D * ML_D; float* mlun = (float*)(F.ws + WS_MLUN) + (size_t)unit * ML_D;
    const float* convw = F.in[I_CONVW]; const float* convb = F.in[I_CONVB]; const float* gateb = F.in[I_GATEB];
    LAS unsigned char* KW = F.lds; LAS unsigned char* Vs = F.lds + 64 * W128_SB; LAS float* wts = (LAS float*)(F.lds + 2 * 64 * W128_SB); LAS float* gsc = wts + 64;
    const int t0 = c * ML_L; const size_t row0 = (size_t)b * SEQ + t0;
    __syncthreads();
    if (F.tid < 64) { const int s = F.tid; const float ip = bf2f(proj[(row0 + s) * PW + PC_MLIF + h]) + gateb[h], fp = bf2f(proj[(row0 + s) * PW + PC_MLIF + 4 + h]) + gateb[4 + h];
        gsc[s] = log_sigmoid(fp); gsc[64 + s] = ip; }
    __syncthreads();
    if (F.tid < 64) {
        float v = gsc[F.tid];
#pragma unroll
        for (int o = 1; o < 64; o <<= 1) { const float u = __shfl_up(v, o); if (F.lane >= o) v += u; }
        const float bL = __shfl(v, 63); const float li = gsc[64 + F.tid]; const float a = bL - v + li; const float amax = wave_max(a);
        wts[F.tid] = __expf(a - amax); mlb[(size_t)bh * SEQ + t0 + F.tid] = v; mlli[(size_t)bh * SEQ + t0 + F.tid] = li;
        if (F.tid == 0) { mlsc[unit * 2 + 0] = amax; mlsc[unit * 2 + 1] = bL; } }
    __syncthreads();
    { v4u xin[4][4]; v4u vin[2];
#pragma unroll
      for (int ii = 0; ii < 4; ++ii) { const int it = F.tid + ii * NTHREADS; const int ch8 = it & 15, s = (it >> 4) & 63, which = it >> 10; const int pcol = (which ? PC_MLK : PC_MLQ) + h * 128 + ch8 * 8;
#pragma unroll
          for (int wv = 0; wv < 4; ++wv) { const int tt = t0 + s - 3 + wv; xin[ii][wv] = (tt >= 0) ? *(const v4u*)(proj + ((size_t)b * SEQ + tt) * PW + pcol) : (v4u){0u, 0u, 0u, 0u}; } }
#pragma unroll
      for (int ii = 0; ii < 2; ++ii) { const int it = F.tid + ii * NTHREADS; const int ch8 = it & 15, s = it >> 4; vin[ii] = *(const v4u*)(proj + (row0 + s) * PW + PC_MLV + h * 128 + ch8 * 8); }
#pragma unroll
      for (int ii = 0; ii < 4; ++ii) { const int it = F.tid + ii * NTHREADS; const int ch8 = it & 15, s = (it >> 4) & 63, which = it >> 10;
        const int cch = which * 512 + h * 128 + ch8 * 8;
        float acc[8];
#pragma unroll
        for (int j = 0; j < 8; ++j) acc[j] = convb[cch + j];
#pragma unroll
        for (int wv = 0; wv < 4; ++wv) { const v4u x = xin[ii][wv];
            const f32x4 w0 = *(const f32x4*)(convw + wv * 1024 + cch), w1 = *(const f32x4*)(convw + wv * 1024 + cch + 4);
            acc[0] += bflo(x.x) * w0[0]; acc[1] += bfhi(x.x) * w0[1]; acc[2] += bflo(x.y) * w0[2]; acc[3] += bfhi(x.y) * w0[3];
            acc[4] += bflo(x.z) * w1[0]; acc[5] += bfhi(x.z) * w1[1]; acc[6] += bflo(x.w) * w1[2]; acc[7] += bfhi(x.w) * w1[3]; }
        const float sc = which ? 0.08838834764831845f : 1.0f;
#pragma unroll
        for (int j = 0; j < 8; ++j) acc[j] = siluf_(acc[j]) * sc;
        v4u o; o.x = pk2(acc[0], acc[1]); o.y = pk2(acc[2], acc[3]); o.z = pk2(acc[4], acc[5]); o.w = pk2(acc[6], acc[7]);
        *(v4u*)((which ? mlk : mlq) + (row0 + s) * 512 + h * 128 + ch8 * 8) = o;
        if (which) { const float ws = wts[s]; v4u kw; kw.x = pk2(acc[0] * ws, acc[1] * ws); kw.y = pk2(acc[2] * ws, acc[3] * ws); kw.z = pk2(acc[4] * ws, acc[5] * ws); kw.w = pk2(acc[6] * ws, acc[7] * ws);
            *(LAS v4u*)(KW + s * W128_SB + ch8 * 16) = kw; } }
#pragma unroll
      for (int ii = 0; ii < 2; ++ii) { const int it = F.tid + ii * NTHREADS; const int ch8 = it & 15, s = it >> 4; *(LAS v4u*)(Vs + s * W128_SB + ch8 * 16) = vin[ii]; } }
    __syncthreads();
    { const int lane = F.lane, gq = lane >> 4, w = F.wave;
      const bf16x8 a0 = tr_frag(KW, W128_SB, 8 * gq, 8 * gq + 4, 16 * w, lane), a1 = tr_frag(KW, W128_SB, 32 + 8 * gq, 32 + 8 * gq + 4, 16 * w, lane);
#pragma unroll
      for (int eb = 0; eb < 8; ++eb) { f32x4 acc = (f32x4){0.f, 0.f, 0.f, 0.f};
          acc = mfma16(a0, tr_frag(Vs, W128_SB, 8 * gq, 8 * gq + 4, 16 * eb, lane), acc); acc = mfma16(a1, tr_frag(Vs, W128_SB, 32 + 8 * gq, 32 + 8 * gq + 4, 16 * eb, lane), acc);
          *(f32x4*)(mlu + (size_t)(16 * eb + (lane & 15)) * ML_D + 16 * w + 4 * gq) = acc; } }
    if (F.tid < ML_D) { float a = 0.f;
#pragma unroll 8
        for (int s = 0; s < 64; ++s) a += bf2f(*(const LAS unsigned short*)(KW + s * W128_SB + F.tid * 2));
        mlun[F.tid] = a; }
}
__device__ __forceinline__ void ml_stage_b(Ctx& F, int unit) {
    const int sl = unit & 15, bh = unit >> 4;
    const float* mlsc = (const float*)(F.ws + WS_MLSC); float* mlm = (float*)(F.ws + WS_MLSC) + 4096;
    const float* mlu = (const float*)(F.ws + WS_MLU) + (size_t)bh * 64 * ML_D * ML_D; bf16* mlc = (bf16*)(F.ws + WS_MLC) + (size_t)bh * 64 * ML_D * ML_D;
    const float* mlun = (const float*)(F.ws + WS_MLUN) + (size_t)bh * 64 * ML_D; float* mln = (float*)(F.ws + WS_MLN) + (size_t)bh * 64 * ML_D;
    LAS float* dec = (LAS float*)F.lds; LAS float* scl = dec + 64; LAS float* am = scl + 64; LAS float* bl = am + 64;
    __syncthreads();
    if (F.tid < 64) { const pg8::f32x2 v = *(const pg8::f32x2*)(mlsc + (bh * 64 + F.tid) * 2); am[F.tid] = v.x; bl[F.tid] = v.y; }
    __syncthreads();
    if (F.tid == 0) { float m = 0.f;
        for (int c = 0; c < 64; ++c) { const float amax = am[c], bL = bl[c]; const float mn = fmaxf(bL + m, amax);
            dec[c] = __expf(bL + m - mn); scl[c] = __expf(amax - mn); if (sl == 0) mlm[bh * 64 + c] = m; m = mn; } }
    __syncthreads();
    { const int idx = sl * 1024 + F.tid * 2; float c0 = 0.f, c1 = 0.f;
#pragma unroll 1
      for (int cb = 0; cb < 64; cb += 8) { pg8::f32x2 u[8];
#pragma unroll
          for (int i = 0; i < 8; ++i) u[i] = *(const pg8::f32x2*)(mlu + (size_t)(cb + i) * ML_D * ML_D + idx);
#pragma unroll
          for (int i = 0; i < 8; ++i) { *(unsigned*)(mlc + (size_t)(cb + i) * ML_D * ML_D + idx) = pk2(c0, c1);
              c0 = dec[cb + i] * c0 + scl[cb + i] * u[i].x; c1 = dec[cb + i] * c1 + scl[cb + i] * u[i].y; } } }
    if (sl == 0 && F.tid < ML_D) { float n = 0.f;
#pragma unroll 1
        for (int cb = 0; cb < 64; cb += 8) { float u[8];
#pragma unroll
            for (int i = 0; i < 8; ++i) u[i] = mlun[(cb + i) * ML_D + F.tid];
#pragma unroll
            for (int i = 0; i < 8; ++i) { mln[(cb + i) * ML_D + F.tid] = n; n = dec[cb + i] * n + scl[cb + i] * u[i]; } } }
}
__device__ __forceinline__ void ml_stage_c(Ctx& F, int unit) {
    const int c = unit & 63, bh = unit >> 6, b = bh >> 2, h = bh & 3;
    const bf16* proj = (const bf16*)(F.ws + WS_PROJ); const bf16* mlq = (const bf16*)(F.ws + WS_MLQ); const bf16* mlk = (const bf16*)(F.ws + WS_MLKK);
    const float* mlb = (const float*)(F.ws + WS_MLB); const float* mlli = (const float*)(F.ws + WS_MLLI); const float* mlm = (const float*)(F.ws + WS_MLSC) + 4096;
    const bf16* mlc = (const bf16*)(F.ws + WS_MLC) + (size_t)unit * ML_D * ML_D; const float* mln = (const float*)(F.ws + WS_MLN) + (size_t)unit * ML_D;
    bf16* oml = (bf16*)(F.ws + WS_OML); const float* ng = F.in[I_MLNG];
    LAS unsigned char* Qs = F.lds; LAS unsigned char* Ks = Qs + 64 * W128_SB; LAS unsigned char* Vs = Ks + 64 * W128_SB; LAS unsigned char* Cs = Vs + 64 * W128_SB;
    LAS float* fb = (LAS float*)(Cs + 128 * W128_SB); LAS float* fli = fb + 64; LAS float* fn = fli + 64; LAS float* ssq = fn + 128;
    const int t0 = c * ML_L; const size_t row0 = (size_t)b * SEQ + t0;
    __syncthreads();
    for (int it = F.tid; it < 1024; it += NTHREADS) { const int ch8 = it & 15, s = it >> 4; const size_t go = (row0 + s) * 512 + h * 128 + ch8 * 8;
        *(LAS v4u*)(Qs + s * W128_SB + ch8 * 16) = *(const v4u*)(mlq + go); *(LAS v4u*)(Ks + s * W128_SB + ch8 * 16) = *(const v4u*)(mlk + go);
        *(LAS v4u*)(Vs + s * W128_SB + ch8 * 16) = *(const v4u*)(proj + (row0 + s) * PW + PC_MLV + h * 128 + ch8 * 8); }
    for (int it = F.tid; it < 2048; it += NTHREADS) { const int ch8 = it & 15, e = it >> 4; *(LAS v4u*)(Cs + e * W128_SB + ch8 * 16) = *(const v4u*)(mlc + e * ML_D + ch8 * 8); }
    if (F.tid < 64) { fb[F.tid] = mlb[(size_t)bh * SEQ + t0 + F.tid]; fli[F.tid] = mlli[(size_t)bh * SEQ + t0 + F.tid]; }
    if (F.tid < ML_D) fn[F.tid] = mln[F.tid];
    __syncthreads();
    const int lane = F.lane, gq = lane >> 4, w = F.wave, tb = w & 3, eh = w >> 2;
    const int t = 16 * tb + (lane & 15); const float mc = mlm[unit]; const float bt = fb[t];
    bf16x8 qf[4];
#pragma unroll
    for (int st = 0; st < 4; ++st) qf[st] = lds_row8(Qs, W128_SB, t, 32 * st + 8 * gq);
    f32x4 sT[4]; float dmax = NEG_BIG;
#pragma unroll
    for (int sb = 0; sb < 4; ++sb) { sT[sb] = (f32x4){0.f, 0.f, 0.f, 0.f};
        if (sb <= tb) {
#pragma unroll
            for (int st = 0; st < 4; ++st) sT[sb] = mfma16(lds_row8(Ks, W128_SB, 16 * sb + (lane & 15), 32 * st + 8 * gq), qf[st], sT[sb]);
#pragma unroll
            for (int r = 0; r < 4; ++r) { const int s = 16 * sb + 4 * gq + r; if (s <= t) dmax = fmaxf(dmax, bt - fb[s] + fli[s]); } } }
    dmax = grp_max(dmax);
    const float mt = fmaxf(bt + mc, dmax); const float iw = __expf(bt + mc - mt);
    float dsum = 0.f;
#pragma unroll
    for (int sb = 0; sb < 4; ++sb)
#pragma unroll
        for (int r = 0; r < 4; ++r) { const int s = 16 * sb + 4 * gq + r; const float p = (sb <= tb && s <= t) ? sT[sb][r] * __expf(bt - fb[s] + fli[s] - mt) : 0.f; sT[sb][r] = p; dsum += p; }
    dsum = grp_sum(dsum);
    float qn = 0.f;
#pragma unroll 8
    for (int dd = 0; dd < 32; ++dd) { const int d = gq * 32 + dd; qn += bf2f(*(const LAS unsigned short*)(Qs + t * W128_SB + d * 2)) * fn[d]; }
    qn = grp_sum(qn);
    const float den = dsum + iw * qn; const float rden = 1.0f / fmaxf(fabsf(den), __expf(-mt));
    const bf16x8 p0 = pack8(sT[0], sT[1]), p1 = pack8(sT[2], sT[3]);
    f32x4 hv[4]; float sq = 0.f;
#pragma unroll
    for (int ei = 0; ei < 4; ++ei) { const int eb = eh * 4 + ei;
        f32x4 intra = (f32x4){0.f, 0.f, 0.f, 0.f}, inter = (f32x4){0.f, 0.f, 0.f, 0.f};
        intra = mfma16(tr_frag(Vs, W128_SB, 4 * gq, 16 + 4 * gq, 16 * eb, lane), p0, intra);
        if (tb >= 2) intra = mfma16(tr_frag(Vs, W128_SB, 32 + 4 * gq, 48 + 4 * gq, 16 * eb, lane), p1, intra);
#pragma unroll
        for (int st = 0; st < 4; ++st) inter = mfma16(lds_row8(Cs, W128_SB, 16 * eb + (lane & 15), 32 * st + 8 * gq), qf[st], inter);
        hv[ei] = (intra + inter * iw) * rden; sq += (hv[ei][0] * hv[ei][0] + hv[ei][1] * hv[ei][1]) + (hv[ei][2] * hv[ei][2] + hv[ei][3] * hv[ei][3]); }
    sq = grp_sum(sq);
    if (gq == 0) ssq[eh * 64 + t] = sq;
    __syncthreads();
    const float rn = rsqrtf((ssq[t] + ssq[64 + t]) * (1.0f / ML_D) + NORM_EPS);
#pragma unroll
    for (int ei = 0; ei < 4; ++ei) { const int e0 = 16 * (eh * 4 + ei) + 4 * gq; const f32x4 gg = *(const f32x4*)(ng + h * 128 + e0);
        const v2u ow = *(const v2u*)(proj + (row0 + t) * PW + PC_MLO + h * 128 + e0);
        f32x4 v = hv[ei] * rn * gg; v[0] *= sigmoidf_(bflo(ow.x)); v[1] *= sigmoidf_(bfhi(ow.x)); v[2] *= sigmoidf_(bflo(ow.y)); v[3] *= sigmoidf_(bfhi(ow.y));
        v2u o; o.x = pg8::cvt_pk_bf16(v[0], v[1]); o.y = pg8::cvt_pk_bf16(v[2], v[3]); *(v2u*)(oml + (row0 + t) * 512 + h * 128 + e0) = o; }
}

#ifndef REPEAT_PHASE
#define REPEAT_PHASE -1
#endif
__device__ __forceinline__ void ph2(Ctx& F) {
    pg8::Gemm g{(const bf16*)(F.ws + WS_A1), (const bf16*)(F.ws + WS_WIN), T, PW, DM}; pg8::StaticOrder S; S.init(T, PW, F.G, (int)blockIdx.x);
    EpiStoreBf16 E{(bf16*)(F.ws + WS_PROJ), PW};
    pg8::gemm_phase<EpiStoreBf16, pg8::StaticOrder, true, true>(F.lds, g, S, E);
}
__device__ __forceinline__ void ph3(Ctx& F) {
    for (int u = F.vcu; u < 256; u += F.G) nsa_compress_unit(F, u);
    for (int u = F.vcu; u < ML_BH * ML_NCH; u += F.G) ml_stage_a(F, u);
}
__device__ __forceinline__ void ph4(Ctx& F) {
    for (int p = F.vcu; p < 256; p += F.G) { const int bg = p >> 5, x = p & 31; nsa_cmp_unit(F, bg, 63 - x); nsa_cmp_unit(F, bg, x); }
    for (int u = F.vcu; u < ML_BH * 16; u += F.G) ml_stage_b(F, u);
}
__device__ __forceinline__ void ph5(Ctx& F) {
    for (int p = F.vcu; p < 256; p += F.G) { const int bg = p >> 5, x = p & 31; nsa_selwin_unit(F, bg >> 1, bg & 1, x); nsa_selwin_unit(F, bg >> 1, bg & 1, 63 - x); }
    for (int u = F.vcu; u < ML_BH * ML_NCH; u += F.G) ml_stage_c(F, u);
}
struct UpOrder {
    pg8::StaticOrder so;
    __device__ __forceinline__ bool next(int i, Unit& u) const { if (!so.next(i >> 1, u)) return false; if (i & 1) { u.pm += T / 256; u.pn += DM / 256; } return true; }
    __device__ __forceinline__ void a_ready(const Unit&) const {}
    __device__ __forceinline__ void done(const Unit&) const {}
};
struct EpiUpBoth {
    static constexpr bool PERM = true, AFTER_DRAIN = false;
    bf16* U; const bf16* G;
    __device__ __forceinline__ void operator()(const f32x4 (&acc)[2][2][4][2], const Unit& u, int wr, int wc, int fr, int fq) const {
        if (u.pm < T / 256) { EpiUpGate<false> E{U, G, PC_MGA}; E(acc, u, wr, wc, fr, fq); }
        else { Unit v = u; v.pm -= T / 256; v.pn -= DM / 256; EpiUpGate<true> E{U, G, PC_MGB}; E(acc, v, wr, wc, fr, fq); }
    }
};
static_assert(WS_OML == WS_ONSA + (size_t)T * 512 * 2 && WS_WUPB == WS_WUPA + (size_t)DM * 512 * 2, "stacked operands of the up projection");
__device__ __forceinline__ void ph6(Ctx& F) {
    UpOrder S; S.so.init(T, DM, F.G, (int)blockIdx.x);
    pg8::Gemm g{(const bf16*)(F.ws + WS_ONSA), (const bf16*)(F.ws + WS_WUPA), 2 * T, 2 * DM, 512}; EpiUpBoth E{(bf16*)(F.ws + WS_U), (const bf16*)(F.ws + WS_PROJ)};
    pg8::gemm_phase<EpiUpBoth, UpOrder, true, true>(F.lds, g, S, E);
}
__device__ __forceinline__ void ph7(Ctx& F) {
    pg8::Gemm g{(const bf16*)(F.ws + WS_U), (const bf16*)(F.ws + WS_WOUT), T, DM, DM}; pg8::StaticOrder S; S.init(T, DM, F.G, (int)blockIdx.x);
    EpiOutRes E{F.in[I_X], (float*)(F.ws + WS_H1), (const float*)(F.ws + WS_MODF)};
    pg8::gemm_phase<EpiOutRes, pg8::StaticOrder, true, true>(F.lds, g, S, E);
}
__device__ __forceinline__ void ph10(Ctx& F) {
    pg8::Gemm g{(const bf16*)(F.ws + WS_XG), (const bf16*)(F.ws + WS_W1T), MOE_P, NEXP * 2048, DM};
    MoeOrder S{8, 3, F.G, F.vcu, F.ctl + CW_MOETAB};
    EpiMoe1 E{(bf16*)(F.ws + WS_ACT), F.in[I_EB1]};
    pg8::gemm_phase<EpiMoe1, MoeOrder, true, true>(F.lds, g, S, E);
}
__device__ __forceinline__ void ph11(Ctx& F) {
    pg8::Gemm g{(const bf16*)(F.ws + WS_ACT), (const bf16*)(F.ws + WS_W2T), MOE_P, NEXP * DM, DE};
    MoeOrder S{4, 2, F.G, F.vcu, F.ctl + CW_MOETAB};
    EpiMoe2 E{(bf16*)(F.ws + WS_YR), F.in[I_EB2], (const float*)(F.ws + WS_ROWG)};
    pg8::gemm_phase<EpiMoe2, MoeOrder, true, true>(F.lds, g, S, E);
}
#ifndef TIME_PHASE
#define TIME_PHASE -1
#endif
#define RUN(k, call) do { unsigned long long t0_ = 0; if (TIME_PHASE == (k)) t0_ = __builtin_amdgcn_s_memrealtime(); call; SEAM(); \
    if (TIME_PHASE == (k)) { const unsigned long long n_ = __builtin_amdgcn_s_memrealtime(); const unsigned long long e_ = n_ + 4 * (n_ - t0_); while (__builtin_amdgcn_s_memrealtime() < e_) __builtin_amdgcn_s_sleep(8); SEAM(); } } while (0)
__global__ void __launch_bounds__(NTHREADS, 2) fwd_kernel(Args args) {
    extern __shared__ __attribute__((aligned(16))) unsigned char lds_raw[];
    Ctx F;
    F.lds = (LAS unsigned char*)lds_raw; F.ws = args.ws; F.ctl = (unsigned*)(args.ws + WS_CTL);
    F.tid = threadIdx.x; F.lane = F.tid & 63; F.wave = __builtin_amdgcn_readfirstlane(F.tid >> 6);
    F.G = gridDim.x; { const int bx = blockIdx.x; F.vcu = (F.G % 8 == 0) ? (bx % 8) * (F.G / 8) + bx / 8 : bx; }
    F.in = args.in; F.out = args.out;
    volatile LAS unsigned* MISC = (volatile LAS unsigned*)(F.lds + MISC_OFF);
    for (int u = F.tid; u < (LDS_BYTES - LDSCTL_OFF) / 4; u += NTHREADS) ((LAS unsigned*)(F.lds + LDSCTL_OFF))[u] = 0u;
    __syncthreads();
    XcdBarrier bar = xcd_barrier_post(F.ctl + CW_BAR, MISC + 8);
#define SEAM() xcd_barrier(bar)
    const float* modf = (const float*)(F.ws + WS_MODF);
    const float* H = (const float*)(F.ws + WS_H1);
    RUN(0, p0_prologue(F));
    RUN(1, p1_norm1(F));
    RUN(2, ph2(F));
    RUN(3, ph3(F));
    RUN(4, ph4(F));
    RUN(5, ph5(F));
    RUN(6, ph6(F));
    RUN(7, ph7(F));
    RUN(8, p8_norm2_router(F, H, modf));
    RUN(9, p9_permute(F));
    RUN(10, ph10(F));
    RUN(11, ph11(F));
    p_final<true>(F, H, modf);
#undef SEAM
}

extern "C" void kernel_launch(void* const* d_in, const int* in_sizes, int n_in, void* d_out, int out_size, void* d_ws, size_t ws_size, hipStream_t stream) {
    static int grid = 0;
    if (grid == 0) {
        if (n_in != 27 || in_sizes[0] != T * DM || out_size != T * DM || ws_size < WS_END) { fprintf(stderr, "kernel_launch: unexpected shapes (n_in %d, in0 %d, out %d, ws %zu)\n", n_in, n_in > 0 ? in_sizes[0] : -1, out_size, ws_size); grid = -1; return; }
        int dev = 0, cus = 0, per_cu = 0;
        if (hipGetDevice(&dev) != hipSuccess || hipDeviceGetAttribute(&cus, hipDeviceAttributeMultiprocessorCount, dev) != hipSuccess) { grid = -1; return; }
        if (hipFuncSetAttribute((const void*)fwd_kernel, hipFuncAttributeMaxDynamicSharedMemorySize, LDS_BYTES) != hipSuccess) { fprintf(stderr, "kernel_launch: hipFuncSetAttribute failed\n"); grid = -1; return; }
        if (hipOccupancyMaxActiveBlocksPerMultiprocessor(&per_cu, (const void*)fwd_kernel, NTHREADS, LDS_BYTES) != hipSuccess || per_cu < 1) fprintf(stderr, "kernel_launch: occupancy query reports %d\n", per_cu);
        (void)hipGetLastError();
        grid = cus;
    }
    if (grid < 0) return;
    if (hipMemsetAsync((char*)d_ws + WS_CTL, 0, CTL_ZERO_BYTES, stream) != hipSuccess) return;
    Args a{};
    for (int i = 0; i < 27; ++i) a.in[i] = (const float*)d_in[i];
    a.out = (float*)d_out; a.ws = (unsigned char*)d_ws;
    a.ph_lo = 0; a.ph_hi = 64;
    hipLaunchKernelGGL(fwd_kernel, dim3(grid), dim3(NTHREADS), LDS_BYTES, stream, a);
}
```

```cpp
#include <hip/hip_runtime.h>
#include <cstdio>
#include <cstdint>
namespace pg8 {
#define PG8_LAS __attribute__((address_space(3)))
typedef unsigned short bf16_t;
typedef short bf16x8 __attribute__((ext_vector_type(8)));
typedef float f32x4 __attribute__((ext_vector_type(4)));
typedef unsigned u32x4 __attribute__((ext_vector_type(4)));
constexpr int BM = 256, BK = 64, HALF = 128, HTB = HALF * BK * 2  , STAGE_BYTES = 8 * HTB, NXCD = 8, WGM = 8;

__host__ __device__ __forceinline__ int lds_byte(int r, int c) { const int st = (r >> 4) * 2 + (c >> 5), rr = r & 15, cc = c & 31, ob = rr * 64 + cc * 2; return st * 1024 + (ob ^ (((ob >> 9) & 1) << 5)); }
__host__ __device__ __forceinline__ void stage_rc(int b, int& R, int& C) { const int st = b / 1024, sb = b % 1024, swz = sb ^ (((sb >> 9) & 1) << 5); R = (st >> 1) * 16 + swz / 64; C = (st & 1) * 32 + (swz % 64) / 2; }
__host__ __device__ __forceinline__ int perm32(int rho) { const int n = rho >> 4, i = rho & 15; return 8 * (i >> 2) + 4 * n + (i & 3); }

struct Unit { int pm, pn; };
struct Gemm { const bf16_t* A; const bf16_t* Bt; int M, N, K; };

struct StaticOrder {
    int nM, nN, nwg, G, c;
    __host__ __device__ void init(int M, int N, int G_, int c_) { nM = M / BM; nN = N / BM; nwg = nM * nN; G = G_; c = c_; }
    __host__ __device__ bool next(int i, Unit& u) const {
        const long L = (long)i * G + c; if (L >= nwg) return false;
        int wgid = (int)L; { const int q = nwg / NXCD, r = nwg % NXCD, xcd = wgid % NXCD, off = wgid / NXCD; wgid = (xcd < r ? xcd * (q + 1) : r * (q + 1) + (xcd - r) * q) + off; }
        const int nig = WGM * nN, gid = wgid / nig, fm = gid * WGM, gsz = (nM - fm) < WGM ? (nM - fm) : WGM;
        u.pm = fm + ((wgid % nig) % gsz); u.pn = (wgid % nig) / gsz; return true;
    }
    __device__ __forceinline__ void a_ready(const Unit&) const {}
    __device__ __forceinline__ void done(const Unit&) const {}
};

__device__ __forceinline__ unsigned cvt_pk_bf16(float lo, float hi) { unsigned r; asm volatile("v_cvt_pk_bf16_f32 %0, %1, %2" : "=v"(r) : "v"(lo), "v"(hi)); return r; }
typedef float f32x2 __attribute__((ext_vector_type(2)));
typedef int v8i32 __attribute__((ext_vector_type(8)));
typedef int v4i32 __attribute__((ext_vector_type(4)));
template <bool F8> struct FragT { typedef bf16x8 type; }; template <> struct FragT<true> { typedef v8i32 type; };
constexpr int F8_SCALE_A = 0x7F7F7F7F;
constexpr int F8_SCALE_B = 0x7A7A7A7A;
template <class Epi, class Sched, bool ALIGN_EPI = false, bool SP2 = false, bool F8 = false>
__device__ __forceinline__ void gemm_phase(PG8_LAS unsigned char* lds, const Gemm g, const Sched& S, const Epi& E) {
    const int tid = threadIdx.x, wid = __builtin_amdgcn_readfirstlane(tid >> 6), lane = tid & 63, wr = wid >> 2, wc = wid & 3, fr = lane & 15, fq = lane >> 4;
    const int K = g.K, nt = F8 ? K / (2 * BK) : K / BK; const int RB = F8 ? K : 2 * K;
    unsigned voffA[2], voffB[2];
#pragma unroll
    for (int i = 0; i < 2; ++i) { int R, C; stage_rc(tid * 16 + i * 8192, R, C); const int Rb = Epi::PERM ? ((R & ~31) + perm32(R & 31)) : R;
        voffA[i] = (unsigned)(R * RB + C * 2); voffB[i] = (unsigned)(Rb * RB + C * 2); }
    const size_t kstep = (size_t)(BK * 2);
    const size_t hstep = (size_t)HALF * RB;
    const size_t tstep = 2 * hstep;
    const unsigned ldsw = (unsigned)wid * 1024u;
    const int aoff = lds_byte(wr * 64 + fr, fq * 8), boff = lds_byte(wc * 32 + fr, fq * 8);
#define PG8_SA(b, h) (((b) * 2 + (h)) * HTB)
#define PG8_SB(b, h) ((4 + (b) * 2 + (h)) * HTB)
#define PG8_STAGE(bufoff, gbase, voff) do { _Pragma("unroll") for (int _i = 0; _i < 2; ++_i) \
        __builtin_amdgcn_global_load_lds((const unsigned*)((const char*)(gbase) + (voff)[_i]), (PG8_LAS unsigned*)(lds + (bufoff) + ldsw + _i * 8192), 16, 0, 0); } while (0)
#define PG8_LD16(off) (*(const PG8_LAS v4i32*)(lds + (off)))
#define PG8_LDA(dst, b, h) do { _Pragma("unroll") for (int m = 0; m < 4; ++m) { if constexpr (F8) { const v4i32 lo_ = PG8_LD16(PG8_SA(b, h) + aoff + m * 2048), hi_ = PG8_LD16(PG8_SA(b, h) + aoff + m * 2048 + 1024); dst[m][0] = __builtin_shufflevector(lo_, hi_, 0, 1, 2, 3, 4, 5, 6, 7); } \
        else { _Pragma("unroll") for (int k = 0; k < NK; ++k) dst[m][k] = *(const PG8_LAS frag_t*)(lds + PG8_SA(b, h) + aoff + m * 2048 + k * 1024); } } } while (0)
#define PG8_LDB(dst, b, h) do { _Pragma("unroll") for (int n = 0; n < 2; ++n) { if constexpr (F8) { const v4i32 lo_ = PG8_LD16(PG8_SB(b, h) + boff + n * 2048), hi_ = PG8_LD16(PG8_SB(b, h) + boff + n * 2048 + 1024); dst[n][0] = __builtin_shufflevector(lo_, hi_, 0, 1, 2, 3, 4, 5, 6, 7); } \
        else { _Pragma("unroll") for (int k = 0; k < NK; ++k) dst[n][k] = *(const PG8_LAS frag_t*)(lds + PG8_SB(b, h) + boff + n * 2048 + k * 1024); } } } while (0)
#define PG8_MMA(ai, bj, At, Bt) do { __builtin_amdgcn_s_setprio(1); \
        if constexpr (F8) { _Pragma("unroll") for (int m = 0; m < 4; ++m) _Pragma("unroll") for (int n = 0; n < 2; ++n) \
            asm("v_mfma_scale_f32_16x16x128_f8f6f4 %0, %1, %2, %0, %3, %4 op_sel_hi:[0,0,0]" : "+v"(acc[ai][bj][m][n]) : "v"(Bt[n][0]), "v"(At[m][0]), "v"(f8sb), "v"(f8sa)); } \
        else { _Pragma("unroll") for (int m = 0; m < 4; ++m) _Pragma("unroll") for (int n = 0; n < 2; ++n) _Pragma("unroll") for (int k = 0; k < NK; ++k) \
            acc[ai][bj][m][n] = __builtin_amdgcn_mfma_f32_16x16x32_bf16(Bt[n][k], At[m][k], acc[ai][bj][m][n], 0, 0, 0); } \
        __builtin_amdgcn_s_setprio(0); } while (0)
#define PG8_WAIT_V(n) asm volatile("s_waitcnt vmcnt(" #n ")" ::: "memory")
#define PG8_WAIT_L(n) asm volatile("s_waitcnt lgkmcnt(" #n ")" ::: "memory")
#define PG8_BAR __builtin_amdgcn_s_barrier()
#define PG8_SCHED __builtin_amdgcn_sched_barrier(0)
    Unit cur, nxt; int ui = 0;
    if (!S.next(0, cur)) return;
    f32x4 acc[2][2][4][2];
#pragma unroll
    for (int a = 0; a < 2; ++a)
#pragma unroll
        for (int b = 0; b < 2; ++b)
#pragma unroll
            for (int m = 0; m < 4; ++m)
#pragma unroll
                for (int n = 0; n < 2; ++n) acc[a][b][m][n] = (f32x4){0.f, 0.f, 0.f, 0.f};
    typedef typename FragT<F8>::type frag_t; constexpr int NK = F8 ? 1 : 2;
    int f8sa = F8_SCALE_A, f8sb = F8_SCALE_B; if constexpr (F8) asm volatile("" : "+v"(f8sa), "+v"(f8sb));
    frag_t At[4][NK], B0[2][NK], B1[2][NK];
    const char* cA = (const char*)g.A + (size_t)cur.pm * tstep; const char* cB = (const char*)g.Bt + (size_t)cur.pn * tstep;
    S.a_ready(cur);
    if constexpr (SP2) {
        PG8_STAGE(PG8_SB(0, 0), cB, voffB); PG8_STAGE(PG8_SB(0, 1), cB + hstep, voffB); PG8_STAGE(PG8_SA(0, 0), cA, voffA); PG8_STAGE(PG8_SA(0, 1), cA + hstep, voffA);
        if (wr == 1) PG8_BAR;
        PG8_WAIT_V(2); PG8_BAR;
        PG8_STAGE(PG8_SB(1, 0), cB + kstep, voffB); PG8_STAGE(PG8_SA(1, 0), cA + kstep, voffA); PG8_STAGE(PG8_SB(1, 1), cB + hstep + kstep, voffB);
        PG8_WAIT_V(6); PG8_BAR;
    } else {
        PG8_STAGE(PG8_SB(0, 0), cB, voffB); PG8_STAGE(PG8_SA(0, 0), cA, voffA); PG8_STAGE(PG8_SB(0, 1), cB + hstep, voffB); PG8_STAGE(PG8_SA(0, 1), cA + hstep, voffA);
        if (wr == 1) PG8_BAR;
        PG8_WAIT_V(4); PG8_BAR;
        PG8_STAGE(PG8_SB(1, 0), cB + kstep, voffB); PG8_STAGE(PG8_SA(1, 0), cA + kstep, voffA); PG8_STAGE(PG8_SB(1, 1), cB + hstep + kstep, voffB);
        PG8_WAIT_V(6); PG8_BAR;
    }
    for (;;) {
        const bool has_next = S.next(ui + 1, nxt);
        const char* nA = has_next ? (const char*)g.A + (size_t)nxt.pm * tstep : cA; const char* nB = has_next ? (const char*)g.Bt + (size_t)nxt.pn * tstep : cB;
#pragma unroll 1
        for (int t = 0; t < nt; t += 2) {
            const bool last = (t == nt - 2);
            const char* a1 = cA + (size_t)(t + 1) * kstep;
            const char* a2 = last ? nA : cA + (size_t)(t + 2) * kstep; const char* b2 = last ? nB : cB + (size_t)(t + 2) * kstep;
            const char* a3 = a2 + kstep; const char* b3 = b2 + kstep;
            if (last && has_next) S.a_ready(nxt);
            if constexpr (SP2) {
            PG8_LDB(B0, 0, 0); PG8_LDB(B1, 0, 1); PG8_SCHED; PG8_LDA(At, 0, 0); PG8_STAGE(PG8_SA(1, 1), a1 + hstep, voffA);
            PG8_WAIT_V(8); PG8_WAIT_L(0); PG8_BAR; PG8_MMA(0, 0, At, B0); PG8_MMA(0, 1, At, B1); PG8_BAR; PG8_SCHED;
            PG8_LDA(At, 0, 1); PG8_STAGE(PG8_SB(0, 0), b2, voffB); PG8_STAGE(PG8_SB(0, 1), b2 + hstep, voffB); PG8_STAGE(PG8_SA(0, 0), a2, voffA);
            PG8_WAIT_V(8); PG8_WAIT_L(0); PG8_BAR; PG8_MMA(1, 0, At, B0); PG8_MMA(1, 1, At, B1); PG8_BAR; PG8_SCHED;
            PG8_LDB(B0, 1, 0); PG8_LDB(B1, 1, 1); PG8_SCHED; PG8_LDA(At, 1, 0); PG8_STAGE(PG8_SA(0, 1), a2 + hstep, voffA);
            PG8_WAIT_V(8); PG8_WAIT_L(0); PG8_BAR; PG8_MMA(0, 0, At, B0); PG8_MMA(0, 1, At, B1); PG8_BAR; PG8_SCHED;
            PG8_LDA(At, 1, 1); PG8_STAGE(PG8_SB(1, 0), b3, voffB); PG8_STAGE(PG8_SB(1, 1), b3 + hstep, voffB); PG8_STAGE(PG8_SA(1, 0), a3, voffA);
            PG8_WAIT_V(8); PG8_WAIT_L(0); PG8_BAR; PG8_MMA(1, 0, At, B0); PG8_MMA(1, 1, At, B1); PG8_BAR; PG8_SCHED;
            } else {
            PG8_LDB(B0, 0, 0); PG8_SCHED; PG8_LDA(At, 0, 0); PG8_STAGE(PG8_SA(1, 1), a1 + hstep, voffA);
            PG8_WAIT_L(8); PG8_BAR; PG8_WAIT_L(0); PG8_MMA(0, 0, At, B0); PG8_BAR; PG8_SCHED;
            PG8_LDB(B1, 0, 1); PG8_STAGE(PG8_SB(0, 0), b2, voffB);
            PG8_BAR; PG8_WAIT_L(0); PG8_MMA(0, 1, At, B1); PG8_BAR;
            PG8_LDA(At, 0, 1); PG8_STAGE(PG8_SA(0, 0), a2, voffA);
            PG8_BAR; PG8_WAIT_L(0); PG8_MMA(1, 0, At, B0); PG8_BAR; PG8_SCHED;
            PG8_STAGE(PG8_SB(0, 1), b2 + hstep, voffB);
            PG8_WAIT_V(6); PG8_BAR; PG8_MMA(1, 1, At, B1); PG8_BAR;
            PG8_LDB(B0, 1, 0); PG8_SCHED; PG8_LDA(At, 1, 0); PG8_STAGE(PG8_SA(0, 1), a2 + hstep, voffA);
            PG8_WAIT_L(8); PG8_BAR; PG8_WAIT_L(0); PG8_MMA(0, 0, At, B0); PG8_BAR; PG8_SCHED;
            PG8_LDB(B1, 1, 1); PG8_STAGE(PG8_SB(1, 0), b3, voffB);
            PG8_BAR; PG8_WAIT_L(0); PG8_MMA(0, 1, At, B1); PG8_BAR;
            PG8_LDA(At, 1, 1); PG8_STAGE(PG8_SA(1, 0), a3, voffA);
            PG8_BAR; PG8_WAIT_L(0); PG8_MMA(1, 0, At, B0); PG8_BAR; PG8_SCHED;
            PG8_STAGE(PG8_SB(1, 1), b3 + hstep, voffB);
            PG8_WAIT_V(6); PG8_BAR; PG8_MMA(1, 1, At, B1); PG8_BAR;
            }
        }
        if constexpr (F8) asm volatile("s_nop 15\n\ts_nop 7" ::: "memory");
        if constexpr (ALIGN_EPI) { if (wr == 0) PG8_BAR; }
        if constexpr (!Epi::AFTER_DRAIN) { E(acc, cur, wr, wc, fr, fq); S.done(cur); }
        if (!has_next) break;
#pragma unroll
        for (int a = 0; a < 2; ++a)
#pragma unroll
            for (int b = 0; b < 2; ++b)
#pragma unroll
                for (int m = 0; m < 4; ++m)
#pragma unroll
                    for (int n = 0; n < 2; ++n) acc[a][b][m][n] = (f32x4){0.f, 0.f, 0.f, 0.f};
        cur = nxt; cA = nA; cB = nB; ++ui;
        if constexpr (ALIGN_EPI) { if (wr == 1) PG8_BAR; }
    }
    PG8_WAIT_V(0);
    if constexpr (!ALIGN_EPI) { if (wr == 0) PG8_BAR; }
    PG8_BAR;
    if constexpr (Epi::AFTER_DRAIN) { E.fused(acc, cur, wr, wc, fr, fq, lds, wid, lane); S.done(cur); }
#undef PG8_SA
#undef PG8_SB
#undef PG8_STAGE
#undef PG8_LDA
#undef PG8_LDB
#undef PG8_LD16
#undef PG8_MMA
#undef PG8_WAIT_V
#undef PG8_WAIT_L
#undef PG8_BAR
#undef PG8_SCHED
}
}

constexpr int NWAVES = 8, NTHREADS = 512;
constexpr int BATCH = 4, SEQ = 4096, DM = 1024, T = BATCH * SEQ;
constexpr int INW = 5408, PW = 5632;
constexpr int NEXP = 32, TOPK = 4, DE = 1024, NASSIGN = T * TOPK, MOE_ROWS = 256;
constexpr int MOE_MAXTILES = (NASSIGN + NEXP * (MOE_ROWS - 1) + MOE_ROWS - 1) / MOE_ROWS;
constexpr int MOE_P = MOE_MAXTILES * MOE_ROWS;
constexpr float NORM_EPS = 1e-6f;
constexpr int PC_Q = 0, PC_KV = 512, PC_MLQ = 1280, PC_MLK = 1792, PC_MLV = 2304, PC_MLO = 2816, PC_MGA = 3328, PC_MGB = 4352, PC_NSAG = 5376, PC_MLIF = 5400;
constexpr int ADA_SLICES = 16, PB_SLICES = 16;

constexpr size_t MiB = 1u << 20;
constexpr size_t WS_CTL = 0, CTL_ZERO_BYTES = 1 * MiB;
constexpr size_t WS_MODP = 1 * MiB;
constexpr size_t WS_MODF = 3 * MiB;
constexpr size_t WS_PBP  = 3 * MiB + 512 * 1024;
constexpr size_t WS_WIN  = 4 * MiB;
constexpr size_t WS_WUPA = 16 * MiB, WS_WUPB = 17 * MiB;
constexpr size_t WS_WOUT = 18 * MiB;
constexpr size_t WS_CW1K = 20 * MiB, WS_CW1V = 20 * MiB + 512 * 1024;
constexpr size_t WS_CW2K = 21 * MiB, WS_CW2V = 21 * MiB + 64 * 1024;
constexpr size_t WS_KC = 22 * MiB, WS_VC = 22 * MiB + 512 * 1024;
constexpr size_t WS_SELM = 23 * MiB;
constexpr size_t WS_TOPI = 24 * MiB, WS_GATE = 24 * MiB + 256 * 1024, WS_DEST = 24 * MiB + 512 * 1024;
constexpr size_t WS_ROWG = 25 * MiB;
constexpr size_t WS_MLB = 26 * MiB, WS_MLLI = 26 * MiB + 256 * 1024;
constexpr size_t WS_RWHI = 25 * MiB + 512 * 1024, WS_RWLO = 25 * MiB + 768 * 1024;
constexpr size_t WS_MLSC = 27 * MiB;
constexpr size_t WS_MLUN = 28 * MiB, WS_MLN = 29 * MiB;
constexpr size_t WS_W1T = 32 * MiB;
constexpr size_t WS_W2T = 160 * MiB;
constexpr size_t WS_H1 = 224 * MiB;
constexpr size_t WS_A1 = 288 * MiB;
constexpr size_t WS_PROJ = 320 * MiB;
constexpr size_t WS_XG = 320 * MiB;
constexpr size_t WS_OCMP = 496 * MiB, WS_ONSA = 512 * MiB, WS_OML = 528 * MiB, WS_MLQ = 544 * MiB, WS_MLKK = 560 * MiB;
constexpr size_t WS_MLU = 576 * MiB;
constexpr size_t WS_MLC = 640 * MiB;
constexpr size_t WS_U = 674 * MiB;
constexpr size_t WS_ACT = 496 * MiB;
constexpr size_t WS_YR = 640 * MiB;
constexpr size_t WS_END = 784 * MiB;
constexpr int CW_BAR = 4096;
constexpr int CW_ECNT = 16384;
constexpr int CW_EFILL = 16384 + 64 * 32;
constexpr int CW_MOETAB = 32768;

constexpr int RING_BYTES = 131072;
constexpr int LDSCTL_OFF = 146432, MISC_OFF = LDSCTL_OFF + 320;
constexpr int LDS_BYTES = 147456;

#define GAS __attribute__((address_space(1)))
#define LAS __attribute__((address_space(3)))
typedef unsigned short bf16;
typedef unsigned v4u __attribute__((ext_vector_type(4)));
typedef unsigned v2u __attribute__((ext_vector_type(2)));
typedef float f32x4 __attribute__((ext_vector_type(4)));
typedef short bf16x8 __attribute__((ext_vector_type(8)));
typedef short s16x4 __attribute__((ext_vector_type(4)));
#define LDS_WAIT() asm volatile("s_waitcnt lgkmcnt(0)" ::: "memory")
#define VM_WAIT() asm volatile("s_waitcnt vmcnt(0)" ::: "memory")
__device__ __forceinline__ unsigned f2bf(float f) { unsigned u = __builtin_bit_cast(unsigned, f); return (u + 0x7fffu + ((u >> 16) & 1u)) >> 16; }
__device__ __forceinline__ unsigned pk2(float lo, float hi) { return f2bf(lo) | (f2bf(hi) << 16); }
__device__ __forceinline__ unsigned pk4_fp8(float a, float b, float c, float d) { int w = __builtin_amdgcn_cvt_pk_fp8_f32(a, b, 0, false); w = __builtin_amdgcn_cvt_pk_fp8_f32(c, d, w, true); return (unsigned)w; }
__device__ __forceinline__ float bf2f(unsigned short b) { return __builtin_bit_cast(float, (unsigned)b << 16); }
__device__ __forceinline__ float bflo(unsigned w) { return __builtin_bit_cast(float, w << 16); }
__device__ __forceinline__ float bfhi(unsigned w) { return __builtin_bit_cast(float, w & 0xffff0000u); }
__device__ __forceinline__ float sigmoidf_(float x) { return 1.0f / (1.0f + __expf(-x)); }
__device__ __forceinline__ float wave_sum(float v) {
#pragma unroll
    for (int o = 1; o < 64; o <<= 1) v += __shfl_xor(v, o);
    return v;
}
__device__ __forceinline__ float wave_max(float v) {
#pragma unroll
    for (int o = 1; o < 64; o <<= 1) v = fmaxf(v, __shfl_xor(v, o));
    return v;
}
#define XB_TMO      128
#define XB_XCNT(j)  (256  + 64 * (j))
#define XB_XSUB(j)  (1280 + 64 * (j))
#define XB_XGEN(j)  (2304 + 64 * (j))
#define XB_TOP      3328
#define XB_TOPGEN   3392
#define XCD_BAR_WORDS 3456
#define XB_SPIN_CAP (1u << 18)

__device__ __forceinline__ unsigned xb_ld(unsigned* p)              { return __hip_atomic_load(p, __ATOMIC_RELAXED, __HIP_MEMORY_SCOPE_AGENT); }
__device__ __forceinline__ unsigned xb_add(unsigned* p, unsigned v) { return __hip_atomic_fetch_add(p, v, __ATOMIC_RELAXED, __HIP_MEMORY_SCOPE_AGENT); }
__device__ __forceinline__ unsigned xb_xcc_id() { return (unsigned)__builtin_amdgcn_s_getreg((3 << 11) | 20) & 0xFu; }
#define XB_SPIN(cond, bar) do { unsigned _sp = 0; while (cond) { __builtin_amdgcn_s_sleep(1); \
    if ((++_sp & 255u) == 0u) { if (xb_ld(&(bar)[XB_TMO])) break; if (_sp > XB_SPIN_CAP) { atomicAdd(&(bar)[XB_TMO], 1u); break; } } } } while (0)

struct XcdBarrier {
    unsigned* bar; unsigned x;
    volatile LAS unsigned* st;
};

__device__ __forceinline__ XcdBarrier xcd_barrier_post(unsigned* bar, volatile LAS unsigned* st) {
    XcdBarrier b; b.bar = bar; b.x = xb_xcc_id(); b.st = st;
    if (threadIdx.x == 0) (void)xb_add(&bar[XB_XCNT(b.x)], 1u);
    return b;
}
__device__ __forceinline__ void xcd_barrier_complete(unsigned* bar, unsigned x, unsigned& nloc, unsigned& nx) {
    const unsigned G = gridDim.x * gridDim.y * gridDim.z;
    unsigned sum, cnt, mine, sp = 0u;
    for (;;) {
        sum = 0u; cnt = 0u; mine = 0u;
#pragma unroll
        for (unsigned j = 0; j < 16; ++j) { const unsigned c = xb_ld(&bar[XB_XCNT(j)]); sum += c; cnt += (c > 0u) ? 1u : 0u; mine = (j == x) ? c : mine; }
        if (sum == G) break;
        __builtin_amdgcn_s_sleep(1);
        if ((++sp & 255u) == 0u) { if (xb_ld(&bar[XB_TMO])) break; if (sp > XB_SPIN_CAP) { atomicAdd(&bar[XB_TMO], 1u); break; } }
    }
    nloc = mine > 0u ? mine : 1u; nx = cnt > 0u ? cnt : 1u;
}

__device__ __forceinline__ void xcd_barrier(const XcdBarrier& b) {
    asm volatile("s_waitcnt vmcnt(0)" ::: "memory");
    __syncthreads();
    if (threadIdx.x == 0) {
        unsigned* bar = b.bar;
        __builtin_amdgcn_s_waitcnt(0);
        unsigned nloc = b.st[0], nx = b.st[1];
        if (nloc == 0u) { xcd_barrier_complete(bar, b.x, nloc, nx); b.st[0] = nloc; b.st[1] = nx; }
        const unsigned old = xb_add(&bar[XB_XSUB(b.x)], 1u);
        const unsigned gen = old / nloc;
        if (old + 1u == (gen + 1u) * nloc) {
            __builtin_amdgcn_fence(__ATOMIC_RELEASE, "agent");
            asm volatile("s_waitcnt vmcnt(0)" ::: "memory");
            const unsigned og = xb_add(&bar[XB_TOP], 1u);
            const unsigned tg = og / nx;
            if (og + 1u == (tg + 1u) * nx) xb_add(&bar[XB_TOPGEN], 1u);
            else XB_SPIN(xb_ld(&bar[XB_TOPGEN]) == tg, bar);
            __builtin_amdgcn_fence(__ATOMIC_ACQUIRE, "agent");
            xb_add(&bar[XB_XGEN(b.x)], 1u);
            asm volatile("s_waitcnt vmcnt(0)" ::: "memory");
        } else {
            XB_SPIN(xb_ld(&bar[XB_XGEN(b.x)]) == gen, bar);
            __builtin_amdgcn_fence(__ATOMIC_ACQUIRE, "agent");
            asm volatile("s_waitcnt vmcnt(0)" ::: "memory");
        }
    }
    __syncthreads();
}

using pg8::Unit; using pg8::HALF; using pg8::BM;
struct EpiStoreBf16 {
    static constexpr bool PERM = true, AFTER_DRAIN = false;
    bf16* O; int ldc;
    __device__ __forceinline__ void operator()(const f32x4 (&acc)[2][2][4][2], const Unit& u, int wr, int wc, int fr, int fq) const {
        const int row0 = u.pm * BM + wr * 64 + fr, col0 = u.pn * BM + wc * 32 + 8 * fq;
#pragma unroll
        for (int ai = 0; ai < 2; ++ai)
#pragma unroll
            for (int m = 0; m < 4; ++m) { bf16* rowp = O + (size_t)(row0 + ai * HALF + m * 16) * ldc + col0;
#pragma unroll
                for (int bj = 0; bj < 2; ++bj) { const f32x4 v0 = acc[ai][bj][m][0], v1 = acc[ai][bj][m][1];
                    v4u w; w.x = pg8::cvt_pk_bf16(v0[0], v0[1]); w.y = pg8::cvt_pk_bf16(v0[2], v0[3]); w.z = pg8::cvt_pk_bf16(v1[0], v1[1]); w.w = pg8::cvt_pk_bf16(v1[2], v1[3]);
                    *(v4u*)(rowp + bj * HALF) = w; } }
    }
};
template <bool ADD> struct EpiUpGate {
    static constexpr bool PERM = true, AFTER_DRAIN = false;
    bf16* U; const bf16* G; int goff;
    __device__ __forceinline__ void operator()(const f32x4 (&acc)[2][2][4][2], const Unit& u, int wr, int wc, int fr, int fq) const {
        const int row0 = u.pm * BM + wr * 64 + fr, col0 = u.pn * BM + wc * 32 + 8 * fq;
#pragma unroll
        for (int ai = 0; ai < 2; ++ai)
#pragma unroll
            for (int m = 0; m < 4; ++m) { const size_t row = (size_t)(row0 + ai * HALF + m * 16);
#pragma unroll
                for (int bj = 0; bj < 2; ++bj) { const int col = col0 + bj * HALF;
                    const v4u gw = *(const v4u*)(G + row * PW + goff + col);
                    f32x4 v0 = acc[ai][bj][m][0], v1 = acc[ai][bj][m][1];
                    v0[0] *= sigmoidf_(bflo(gw.x)); v0[1] *= sigmoidf_(bfhi(gw.x)); v0[2] *= sigmoidf_(bflo(gw.y)); v0[3] *= sigmoidf_(bfhi(gw.y));
                    v1[0] *= sigmoidf_(bflo(gw.z)); v1[1] *= sigmoidf_(bfhi(gw.z)); v1[2] *= sigmoidf_(bflo(gw.w)); v1[3] *= sigmoidf_(bfhi(gw.w));
                    if (ADD) { const v4u uw = *(const v4u*)(U + row * DM + col);
                        v0[0] += bflo(uw.x); v0[1] += bfhi(uw.x); v0[2] += bflo(uw.y); v0[3] += bfhi(uw.y); v1[0] += bflo(uw.z); v1[1] += bfhi(uw.z); v1[2] += bflo(uw.w); v1[3] += bfhi(uw.w); }
                    v4u w; w.x = pg8::cvt_pk_bf16(v0[0], v0[1]); w.y = pg8::cvt_pk_bf16(v0[2], v0[3]); w.z = pg8::cvt_pk_bf16(v1[0], v1[1]); w.w = pg8::cvt_pk_bf16(v1[2], v1[3]);
                    *(v4u*)(U + row * DM + col) = w; } }
    }
};
struct EpiOutRes {
    static constexpr bool PERM = false, AFTER_DRAIN = false;
    const float* X; float* H; const float* modf;
    __device__ __forceinline__ void operator()(const f32x4 (&acc)[2][2][4][2], const Unit& u, int wr, int wc, int fr, int fq) const {
        const int row0 = u.pm * BM + wr * 64 + fr, col0 = u.pn * BM + wc * 32 + 4 * fq;
        const int b = (u.pm * BM) / SEQ; const float* gt = modf + (size_t)b * 6 * DM + 2 * DM;
        f32x4 gv[2][2];
#pragma unroll
        for (int bj = 0; bj < 2; ++bj)
#pragma unroll
            for (int n = 0; n < 2; ++n) gv[bj][n] = *(const f32x4*)(gt + col0 + bj * HALF + n * 16) + 1.0f;
#pragma unroll
        for (int ai = 0; ai < 2; ++ai)
#pragma unroll
            for (int m = 0; m < 4; ++m) { const size_t off = (size_t)(row0 + ai * HALF + m * 16) * DM + col0;
#pragma unroll
                for (int bj = 0; bj < 2; ++bj)
#pragma unroll
                    for (int n = 0; n < 2; ++n) { const f32x4 xv = *(const f32x4*)(X + off + bj * HALF + n * 16);
                        *(f32x4*)(H + off + bj * HALF + n * 16) = xv + gv[bj][n] * acc[ai][bj][m][n]; } }
    }
};
struct EpiMoe1 {
    static constexpr bool PERM = true, AFTER_DRAIN = false;
    unsigned char* ACT; const float* b1;
    __device__ __forceinline__ void operator()(const f32x4 (&acc)[2][2][4][2], const Unit& u, int wr, int wc, int fr, int fq) const {
        const int e = u.pn >> 3, pnl = u.pn & 7;
        const int row0 = u.pm * BM + wr * 64 + fr, c0 = pnl * 128 + wc * 32 + 8 * fq;
        const float* bg = b1 + (size_t)e * 2048 + c0; const float* bl = bg + 1024;
        const f32x4 bg0 = *(const f32x4*)bg, bg1 = *(const f32x4*)(bg + 4), bl0 = *(const f32x4*)bl, bl1 = *(const f32x4*)(bl + 4);
#pragma unroll
        for (int ai = 0; ai < 2; ++ai)
#pragma unroll
            for (int m = 0; m < 4; ++m) { unsigned char* rowp = ACT + (size_t)(row0 + ai * HALF + m * 16) * DE + c0;
                float o[8];
#pragma unroll
                for (int n = 0; n < 2; ++n) { const f32x4 g = acc[ai][0][m][n] + (n ? bg1 : bg0), l = acc[ai][1][m][n] + (n ? bl1 : bl0);
#pragma unroll
                    for (int i = 0; i < 4; ++i) { const float gg = fminf(g[i], 7.0f), ll = fminf(fmaxf(l[i], -7.0f), 7.0f);
                        o[n * 4 + i] = gg * sigmoidf_(1.702f * gg) * (ll + 1.0f); } }
                v2u w; w.x = pk4_fp8(o[0], o[1], o[2], o[3]); w.y = pk4_fp8(o[4], o[5], o[6], o[7]);
                *(v2u*)rowp = w; }
    }
};
struct EpiMoe2 {
    static constexpr bool PERM = true, AFTER_DRAIN = false;
    bf16* Y; const float* b2; const float* rg;
    __device__ __forceinline__ void operator()(const f32x4 (&acc)[2][2][4][2], const Unit& u, int wr, int wc, int fr, int fq) const {
        const int e = u.pn >> 2, pnl = u.pn & 3;
        const int row0 = u.pm * BM + wr * 64 + fr, col0 = pnl * BM + wc * 32 + 8 * fq;
        f32x4 bv[2][2];
#pragma unroll
        for (int bj = 0; bj < 2; ++bj)
#pragma unroll
            for (int n = 0; n < 2; ++n) bv[bj][n] = *(const f32x4*)(b2 + (size_t)e * DM + col0 + bj * HALF + 4 * n);
#pragma unroll
        for (int ai = 0; ai < 2; ++ai)
#pragma unroll
            for (int m = 0; m < 4; ++m) { const int row = row0 + ai * HALF + m * 16; const float g = rg[row]; bf16* rowp = Y + (size_t)row * DM + col0;
#pragma unroll
                for (int bj = 0; bj < 2; ++bj) { const f32x4 v0 = (acc[ai][bj][m][0] + bv[bj][0]) * g, v1 = (acc[ai][bj][m][1] + bv[bj][1]) * g;
                    v4u w; w.x = pg8::cvt_pk_bf16(v0[0], v0[1]); w.y = pg8::cvt_pk_bf16(v0[2], v0[3]); w.z = pg8::cvt_pk_bf16(v1[0], v1[1]); w.w = pg8::cvt_pk_bf16(v1[2], v1[3]);
                    *(v4u*)(rowp + bj * HALF) = w; } }
    }
};
struct MoeOrder {
    int nN, sh, G, v; const unsigned* tab;
    __device__ __forceinline__ bool next(int i, Unit& u) const {
        const int ntl = (int)tab[0]; const long L = (long)i * G + v; if (L >= (long)ntl * nN) return false;
        const int pm = (int)(L >> sh), pnl = (int)(L & (nN - 1)); const int e = (int)tab[64 + pm];
        u.pm = pm; u.pn = e * nN + pnl; return true;
    }
    __device__ __forceinline__ void a_ready(const Unit&) const {}
    __device__ __forceinline__ void done(const Unit&) const {}
};

struct Args { const float* in[27]; float* out; unsigned char* ws; int ph_lo, ph_hi; };
struct Ctx {
    LAS unsigned char* lds; unsigned char* ws; unsigned* ctl;
    int tid, lane, wave, vcu, G;
    const float* const* in; float* out;
};
enum { I_X = 0, I_C, I_ADAW, I_ADAB, I_N1G, I_WIN, I_PEK, I_PEV, I_CW1K, I_CW2K, I_CW1V, I_CW2V, I_CONVW, I_CONVB, I_GATEB, I_MLNG, I_WUPA, I_WUPB, I_WOUT, I_N2G, I_RW, I_RB, I_EW1, I_EB1, I_EW2, I_EB2, I_FG };

template <class DMap>
__device__ __forceinline__ void p0_transpose_item(const float* W, int K, int N, bf16* WT, const DMap& dmap, LAS float* scr, int item, int lane) {
    const int nblk = N / 32, kb = item / nblk, nb = item % nblk, k0 = 64 * kb, n0 = 32 * nb;
    float tmp[16];
#pragma unroll
    for (int hh = 0; hh < 2; ++hh) {
#pragma unroll
    for (int i = 0; i < 16; ++i) tmp[i] = W[(size_t)(k0 + 2 * (16 * hh + i) + (lane >> 5)) * N + n0 + (lane & 31)];
#pragma unroll
    for (int i = 0; i < 16; ++i) scr[(2 * (16 * hh + i) + (lane >> 5)) * 33 + (lane & 31)] = tmp[i]; }
    LDS_WAIT(); asm volatile("" ::: "memory");
    const int c = lane & 7;
#pragma unroll
    for (int j = 0; j < 4; ++j) { const int n = (lane >> 3) + 8 * j; const LAS float* s = scr + (8 * c) * 33 + n;
        v4u o; o.x = pk2(s[0 * 33], s[1 * 33]); o.y = pk2(s[2 * 33], s[3 * 33]); o.z = pk2(s[4 * 33], s[5 * 33]); o.w = pk2(s[6 * 33], s[7 * 33]);
        *(GAS v4u*)(WT + (size_t)dmap(n0 + n) * K + k0 + 8 * c) = o; }
    LDS_WAIT(); asm volatile("" ::: "memory");
}
template <class DMap>
__device__ __forceinline__ void p0_transpose_item_f8(const float* W, int K, int N, unsigned char* WT, const DMap& dmap, LAS float* scr, int item, int lane) {
    const int nblk = N / 32, kb = item / nblk, nb = item % nblk, k0 = 128 * kb, n0 = 32 * nb;
    float tmp[16];
#pragma unroll 1
    for (int hh = 0; hh < 4; ++hh) {
#pragma unroll
        for (int i = 0; i < 16; ++i) tmp[i] = W[(size_t)(k0 + 2 * (16 * hh + i) + (lane >> 5)) * N + n0 + (lane & 31)];
#pragma unroll
        for (int i = 0; i < 16; ++i) scr[(2 * (16 * hh + i) + (lane >> 5)) * 33 + (lane & 31)] = tmp[i] * 32.0f; }
    LDS_WAIT(); asm volatile("" ::: "memory");
    const int n = lane >> 1, kh = (lane & 1) * 64; const LAS float* s = scr + kh * 33 + n;
    unsigned char* dst = WT + (size_t)dmap(n0 + n) * K + k0 + kh;
#pragma unroll
    for (int i = 0; i < 4; ++i) { v4u o;
        o.x = pk4_fp8(s[(16 * i + 0) * 33], s[(16 * i + 1) * 33], s[(16 * i + 2) * 33], s[(16 * i + 3) * 33]); o.y = pk4_fp8(s[(16 * i + 4) * 33], s[(16 * i + 5) * 33], s[(16 * i + 6) * 33], s[(16 * i + 7) * 33]);
        o.z = pk4_fp8(s[(16 * i + 8) * 33], s[(16 * i + 9) * 33], s[(16 * i + 10) * 33], s[(16 * i + 11) * 33]); o.w = pk4_fp8(s[(16 * i + 12) * 33], s[(16 * i + 13) * 33], s[(16 * i + 14) * 33], s[(16 * i + 15) * 33]);
        *(GAS v4u*)(dst + 16 * i) = o; }
    LDS_WAIT(); asm volatile("" ::: "memory");
}
struct DMapId { __device__ __forceinline__ int operator()(int n) const { return n; } };
struct DMapWin { __device__ __forceinline__ int operator()(int n) const {
    if (n < 1280) return n;
    if (n < 1304) return PC_NSAG + (n - 1280);
    if (n < 2328) return PC_MLQ + (n - 1304);
    if (n < 2840) return PC_MLV + (n - 2328);
    if (n < 2848) return PC_MLIF + (n - 2840);
    if (n < 3360) return PC_MLO + (n - 2848);
    return PC_MGA + (n - 3360); } };
struct DMapW1 { __device__ __forceinline__ int operator()(int n) const { return n < 1024 ? ((n >> 7) << 8) + (n & 127) : (((n - 1024) >> 7) << 8) + 128 + (n & 127); } };

__device__ __forceinline__ void p0_prologue(Ctx& F) {
    LAS float* scr = (LAS float*)(F.lds + F.wave * 16896);
    const int gw = F.vcu * NWAVES + F.wave, NGW = F.G * NWAVES;
    constexpr int I_IN = (DM / 64) * (INW / 32), I_UP = (512 / 64) * (DM / 32), I_OUT = (DM / 64) * (DM / 32), I_C1 = (2048 / 64) * (128 / 32), I_C2 = (128 / 64) * (64 / 32);
    constexpr int I_E1 = (DM / 128) * (2048 / 32), I_E2 = (DE / 128) * (DM / 32);
    constexpr int NITEMS = I_IN + 2 * I_UP + I_OUT + 2 * I_C1 + 2 * I_C2 + NEXP * (I_E1 + I_E2);
    for (int it = gw; it < NITEMS; it += NGW) {
        int r = it;
        if (r < I_IN) { p0_transpose_item(F.in[I_WIN], DM, INW, (bf16*)(F.ws + WS_WIN), DMapWin(), scr, r, F.lane); continue; } r -= I_IN;
        if (r < I_UP) { p0_transpose_item(F.in[I_WUPA], 512, DM, (bf16*)(F.ws + WS_WUPA), DMapId(), scr, r, F.lane); continue; } r -= I_UP;
        if (r < I_UP) { p0_transpose_item(F.in[I_WUPB], 512, DM, (bf16*)(F.ws + WS_WUPB), DMapId(), scr, r, F.lane); continue; } r -= I_UP;
        if (r < I_OUT) { p0_transpose_item(F.in[I_WOUT], DM, DM, (bf16*)(F.ws + WS_WOUT), DMapId(), scr, r, F.lane); continue; } r -= I_OUT;
        if (r < I_C1) { p0_transpose_item(F.in[I_CW1K], 2048, 128, (bf16*)(F.ws + WS_CW1K), DMapId(), scr, r, F.lane); continue; } r -= I_C1;
        if (r < I_C1) { p0_transpose_item(F.in[I_CW1V], 2048, 128, (bf16*)(F.ws + WS_CW1V), DMapId(), scr, r, F.lane); continue; } r -= I_C1;
        if (r < I_C2) { p0_transpose_item(F.in[I_CW2K], 128, 64, (bf16*)(F.ws + WS_CW2K), DMapId(), scr, r, F.lane); continue; } r -= I_C2;
        if (r < I_C2) { p0_transpose_item(F.in[I_CW2V], 128, 64, (bf16*)(F.ws + WS_CW2V), DMapId(), scr, r, F.lane); continue; } r -= I_C2;
        if (r < NEXP * I_E1) { const int e = r / I_E1; p0_transpose_item_f8(F.in[I_EW1] + (size_t)e * DM * 2048, DM, 2048, F.ws + WS_W1T + (size_t)e * 2048 * DM, DMapW1(), scr, r % I_E1, F.lane); continue; } r -= NEXP * I_E1;
        { const int e = r / I_E2; p0_transpose_item_f8(F.in[I_EW2] + (size_t)e * DE * DM, DE, DM, F.ws + WS_W2T + (size_t)e * DM * DE, DMapId(), scr, r % I_E2, F.lane); }
    }
    {
        const int gt = F.vcu * NTHREADS + F.tid, NGT = F.G * NTHREADS;
        const float* c = F.in[I_C]; const float* aw = F.in[I_ADAW]; float* modp = (float*)(F.ws + WS_MODP);
        for (int w = gt; w < ADA_SLICES * 6144; w += NGT) {
            const int s = w / 6144, j = w % 6144; float a0 = 0.f, a1 = 0.f, a2 = 0.f, a3 = 0.f;
#pragma unroll 8
            for (int kk = 0; kk < 64; ++kk) { const int k = s * 64 + kk; const float wv = aw[(size_t)k * 6144 + j];
                const float c0 = c[k], c1 = c[DM + k], c2 = c[2 * DM + k], c3 = c[3 * DM + k];
                a0 += c0 * sigmoidf_(c0) * wv; a1 += c1 * sigmoidf_(c1) * wv; a2 += c2 * sigmoidf_(c2) * wv; a3 += c3 * sigmoidf_(c3) * wv; }
            modp[(size_t)(s * 4 + 0) * 6144 + j] = a0; modp[(size_t)(s * 4 + 1) * 6144 + j] = a1; modp[(size_t)(s * 4 + 2) * 6144 + j] = a2; modp[(size_t)(s * 4 + 3) * 6144 + j] = a3;
        }
        { const float* rw = F.in[I_RW]; bf16* rwhi = (bf16*)(F.ws + WS_RWHI); bf16* rwlo = (bf16*)(F.ws + WS_RWLO);
          for (int w = gt; w < DM * NEXP; w += NGT) { const int e = w >> 10, k = w & 1023; const float x = rw[k * NEXP + e]; const unsigned h = f2bf(x); rwhi[w] = (bf16)h; rwlo[w] = (bf16)f2bf(x - bf2f((unsigned short)h)); } }
        float* pbp = (float*)(F.ws + WS_PBP);
        for (int w = gt; w < PB_SLICES * 2 * 128; w += NGT) {
            const int s = w / 256, kv = (w >> 7) & 1, j = w & 127; const float* pe = F.in[kv ? I_PEV : I_PEK]; const float* w1 = F.in[kv ? I_CW1V : I_CW1K]; float a = 0.f;
#pragma unroll 8
            for (int ii = 0; ii < 128; ++ii) { const int i = s * 128 + ii; a += pe[i] * w1[(size_t)i * 128 + j]; }
            pbp[w] = a;
        }
    }
}

template <bool WITH_MOE>
__device__ __forceinline__ void p_final(Ctx& F, const float* H, const float* modf) {
    const int gw = F.vcu * NWAVES + F.wave, NGW = F.G * NWAVES;
    const bf16* Y = (const bf16*)(F.ws + WS_YR); const int* dest = (const int*)(F.ws + WS_DEST);
    const float* fg = F.in[I_FG];
    f32x4 g[4];
#pragma unroll
    for (int j = 0; j < 4; ++j) g[j] = *(const f32x4*)(fg + 4 * F.lane + 256 * j);
    for (int t = gw; t < T; t += NGW) {
        const int b = t / SEQ; f32x4 v[4]; float ss = 0.f;
#pragma unroll
        for (int j = 0; j < 4; ++j) v[j] = *(const f32x4*)(H + (size_t)t * DM + 4 * F.lane + 256 * j);
        if (WITH_MOE) {
            f32x4 m[4];
#pragma unroll
            for (int j = 0; j < 4; ++j) m[j] = (f32x4){0.f, 0.f, 0.f, 0.f};
#pragma unroll
            for (int k = 0; k < TOPK; ++k) { const int r = dest[t * 4 + k];
#pragma unroll
                for (int j = 0; j < 4; ++j) { const v2u w = *(const v2u*)(Y + (size_t)r * DM + 4 * F.lane + 256 * j);
                    m[j][0] += bflo(w.x); m[j][1] += bfhi(w.x); m[j][2] += bflo(w.y); m[j][3] += bfhi(w.y); } }
            const float* gt = modf + (size_t)b * 6 * DM + 5 * DM;
#pragma unroll
            for (int j = 0; j < 4; ++j) { const f32x4 gg = *(const f32x4*)(gt + 4 * F.lane + 256 * j) + 1.0f; v[j] = v[j] + gg * m[j]; }
        }
#pragma unroll
        for (int j = 0; j < 4; ++j) ss += (v[j][0] * v[j][0] + v[j][1] * v[j][1]) + (v[j][2] * v[j][2] + v[j][3] * v[j][3]);
        const float rs = rsqrtf(wave_sum(ss) * (1.0f / DM) + NORM_EPS);
#pragma unroll
        for (int j = 0; j < 4; ++j) *(f32x4*)(F.out + (size_t)t * DM + 4 * F.lane + 256 * j) = v[j] * rs * g[j];
    }
}

__device__ __forceinline__ f32x4 mfma16(bf16x8 a, bf16x8 b, f32x4 c) { return __builtin_amdgcn_mfma_f32_16x16x32_bf16(a, b, c, 0, 0, 0); }
typedef short v4i16_t __attribute__((ext_vector_type(4)));
__device__ __forceinline__ s16x4 lds_tr4(const LAS unsigned char* p) { return __builtin_bit_cast(s16x4, __builtin_amdgcn_ds_read_tr16_b64_v4i16((LAS v4i16_t*)p)); }
__device__ __forceinline__ bf16x8 tr_frag(const LAS unsigned char* img, int sb, int r0, int r1, int n0, int lane) {
    const int q = (lane & 15) >> 2, p = lane & 3;
    const s16x4 lo = lds_tr4(img + (r0 + q) * sb + (n0 + 4 * p) * 2), hi = lds_tr4(img + (r1 + q) * sb + (n0 + 4 * p) * 2);
    return (bf16x8){lo[0], lo[1], lo[2], lo[3], hi[0], hi[1], hi[2], hi[3]};
}
__device__ __forceinline__ bf16x8 lds_row8(const LAS unsigned char* img, int sb, int row, int col) { return *(const LAS bf16x8*)(img + row * sb + col * 2); }
__device__ __forceinline__ bf16x8 pack8(const f32x4 a, const f32x4 b) {
    v4u w; w.x = pg8::cvt_pk_bf16(a[0], a[1]); w.y = pg8::cvt_pk_bf16(a[2], a[3]); w.z = pg8::cvt_pk_bf16(b[0], b[1]); w.w = pg8::cvt_pk_bf16(b[2], b[3]);
    return __builtin_bit_cast(bf16x8, w);
}
__device__ __forceinline__ float grp_max(float v) { v = fmaxf(v, __shfl_xor(v, 16)); return fmaxf(v, __shfl_xor(v, 32)); }
__device__ __forceinline__ float grp_sum(float v) { v += __shfl_xor(v, 16); return v + __shfl_xor(v, 32); }
constexpr float NEG_BIG = -1.0e30f;
constexpr float LOG2E = 1.4426950408889634f;
constexpr int KV_SB = 144;
constexpr int W128_SB = 272;

template <int MODE>
__device__ __forceinline__ void nsa_pass(Ctx& F, const bf16* proj, int b, int g, int qb, int kcol, int vcol, const bf16x8 (&qf)[2][2], const unsigned long long (&selm)[2],
                                         f32x4 (&ot)[2][4], float (&lsum)[2]) {
    LAS unsigned char* Kt = F.lds; LAS unsigned char* Vt = F.lds + 2 * 64 * KV_SB;
    const int lane = F.lane, gq = lane >> 4, th = F.wave >> 2;
    const int ntile = MODE == 0 ? qb + 1 : (qb < 8 ? qb + 1 : 9);
    const int lrow = F.tid >> 3, lch = F.tid & 7;
    const size_t rbase = (size_t)b * SEQ;
    float mrun[2] = {NEG_BIG, NEG_BIG};
#pragma unroll
    for (int qi = 0; qi < 2; ++qi) { lsum[qi] = 0.f;
#pragma unroll
        for (int db = 0; db < 4; ++db) ot[qi][db] = (f32x4){0.f, 0.f, 0.f, 0.f}; }
    auto tile_of = [&](int it) { return MODE == 0 ? it : qb - it; };
    v4u kreg, vreg;
    { const int j = tile_of(0); const bf16* src = proj + (rbase + (size_t)j * 64 + lrow) * PW + lch * 8; kreg = *(const v4u*)(src + kcol); vreg = *(const v4u*)(src + vcol); }
    __syncthreads();
    for (int it = 0; it < ntile; ++it) {
        const int buf = it & 1, j = tile_of(it);
        *(LAS v4u*)(Kt + buf * 64 * KV_SB + lrow * KV_SB + lch * 16) = kreg; *(LAS v4u*)(Vt + buf * 64 * KV_SB + lrow * KV_SB + lch * 16) = vreg;
        __syncthreads();
        if (it + 1 < ntile) { const int jn = tile_of(it + 1); const bf16* src = proj + (rbase + (size_t)jn * 64 + lrow) * PW + lch * 8; kreg = *(const v4u*)(src + kcol); vreg = *(const v4u*)(src + vcol); }
        const LAS unsigned char* Kb = Kt + buf * 64 * KV_SB; const LAS unsigned char* Vb = Vt + buf * 64 * KV_SB;
        f32x4 s[2][4];
#pragma unroll
        for (int kb = 0; kb < 4; ++kb) { const bf16x8 k0 = lds_row8(Kb, KV_SB, 16 * kb + (lane & 15), 8 * gq), k1 = lds_row8(Kb, KV_SB, 16 * kb + (lane & 15), 32 + 8 * gq);
#pragma unroll
            for (int qi = 0; qi < 2; ++qi) { f32x4 a = (f32x4){0.f, 0.f, 0.f, 0.f}; a = mfma16(k0, qf[qi][0], a); a = mfma16(k1, qf[qi][1], a); s[qi][kb] = a; } }
        const bool edge = MODE == 0 ? (j == qb) : (j == qb || j == qb - 8);
#pragma unroll
        for (int qi = 0; qi < 2; ++qi) {
            const int i = th * 32 + qi * 16 + (lane & 15);
            bool rowok = true; if (MODE == 0) rowok = (selm[qi] >> j) & 1ull;
            if (edge) {
#pragma unroll
                for (int kb = 0; kb < 4; ++kb)
#pragma unroll
                    for (int r = 0; r < 4; ++r) { const int kvl = 16 * kb + 4 * gq + r; bool ok;
                        if (MODE == 0) ok = kvl <= i; else { const int rel = (qb - j) * 64 + i - kvl; ok = rel >= 0 && rel < 512; }
                        s[qi][kb][r] = ok ? s[qi][kb][r] : NEG_BIG; } }
            float mx = fmaxf(fmaxf(s[qi][0][0], s[qi][0][1]), fmaxf(s[qi][0][2], s[qi][0][3]));
#pragma unroll
            for (int kb = 1; kb < 4; ++kb) mx = fmaxf(mx, fmaxf(fmaxf(s[qi][kb][0], s[qi][kb][1]), fmaxf(s[qi][kb][2], s[qi][kb][3])));
            mx = rowok ? mx * (0.125f * LOG2E) : NEG_BIG;
            mx = grp_max(mx);
            const float mnew = fmaxf(mrun[qi], mx);
            if (__any(mnew > mrun[qi])) { const float alpha = __builtin_amdgcn_exp2f(mrun[qi] - mnew); lsum[qi] *= alpha;
#pragma unroll
                for (int db = 0; db < 4; ++db) ot[qi][db] *= alpha; }
            mrun[qi] = mnew;
            const float nb = rowok ? -mnew : -INFINITY;
            float ps = 0.f;
#pragma unroll
            for (int kb = 0; kb < 4; ++kb)
#pragma unroll
                for (int r = 0; r < 4; ++r) { const float p = __builtin_amdgcn_exp2f(fmaf(s[qi][kb][r], 0.125f * LOG2E, nb)); s[qi][kb][r] = p; ps += p; }
            lsum[qi] += ps;
        }
#pragma unroll
        for (int st = 0; st < 2; ++st) {
            const bf16x8 p0 = pack8(s[0][2 * st], s[0][2 * st + 1]), p1 = pack8(s[1][2 * st], s[1][2 * st + 1]);
#pragma unroll
            for (int db = 0; db < 4; ++db) { const bf16x8 vf = tr_frag(Vb, KV_SB, 32 * st + 4 * gq, 32 * st + 16 + 4 * gq, 16 * db, lane);
                ot[0][db] = mfma16(vf, p0, ot[0][db]); ot[1][db] = mfma16(vf, p1, ot[1][db]); }
        }
    }
}

__device__ __forceinline__ void nsa_selwin_unit(Ctx& F, int b, int g, int qb) {
    const bf16* proj = (const bf16*)(F.ws + WS_PROJ); const bf16* ocmp = (const bf16*)(F.ws + WS_OCMP); bf16* onsa = (bf16*)(F.ws + WS_ONSA);
    const unsigned long long* selmask = (const unsigned long long*)(F.ws + WS_SELM);
    const int lane = F.lane, gq = lane >> 4, hr = F.wave & 3, th = F.wave >> 2, head = g * 4 + hr;
    bf16x8 qf[2][2]; unsigned long long selm[2]; size_t trow[2];
#pragma unroll
    for (int qi = 0; qi < 2; ++qi) { const int t = qb * 64 + th * 32 + qi * 16 + (lane & 15); trow[qi] = (size_t)b * SEQ + t;
        selm[qi] = selmask[(size_t)(b * 2 + g) * SEQ + t];
#pragma unroll
        for (int st = 0; st < 2; ++st) qf[qi][st] = *(const bf16x8*)(proj + trow[qi] * PW + PC_Q + head * 64 + 32 * st + 8 * gq); }
    f32x4 ot[2][4]; float lsum[2];
    nsa_pass<0>(F, proj, b, g, qb, PC_KV + 2 * 128 + g * 64, PC_KV + 3 * 128 + g * 64, qf, selm, ot, lsum);
#pragma unroll
    for (int qi = 0; qi < 2; ++qi) { const float gate = sigmoidf_(bf2f(proj[trow[qi] * PW + PC_NSAG + 8 + head])) / grp_sum(lsum[qi]);
#pragma unroll
        for (int db = 0; db < 4; ++db) { const size_t o = trow[qi] * 512 + head * 64 + 16 * db + 4 * gq; const v2u c = *(const v2u*)(ocmp + o);
            f32x4 v = ot[qi][db] * gate; v[0] += bflo(c.x); v[1] += bfhi(c.x); v[2] += bflo(c.y); v[3] += bfhi(c.y);
            v2u w; w.x = pg8::cvt_pk_bf16(v[0], v[1]); w.y = pg8::cvt_pk_bf16(v[2], v[3]); *(v2u*)(onsa + o) = w; } }
    nsa_pass<1>(F, proj, b, g, qb, PC_KV + 4 * 128 + g * 64, PC_KV + 5 * 128 + g * 64, qf, selm, ot, lsum);
#pragma unroll
    for (int qi = 0; qi < 2; ++qi) { const float gate = sigmoidf_(bf2f(proj[trow[qi] * PW + PC_NSAG + 16 + head])) / grp_sum(lsum[qi]);
#pragma unroll
        for (int db = 0; db < 4; ++db) { const size_t o = trow[qi] * 512 + head * 64 + 16 * db + 4 * gq; const v2u c = *(const v2u*)(onsa + o);
            f32x4 v = ot[qi][db] * gate; v[0] += bflo(c.x); v[1] += bfhi(c.x); v[2] += bflo(c.y); v[3] += bfhi(c.y);
            v2u w; w.x = pg8::cvt_pk_bf16(v[0], v[1]); w.y = pg8::cvt_pk_bf16(v[2], v[3]); *(v2u*)(onsa + o) = w; } }
}

__device__ __forceinline__ void p1_norm1(Ctx& F) {
    const float* modp = (const float*)(F.ws + WS_MODP); const float* adab = F.in[I_ADAB]; float* modfw = (float*)(F.ws + WS_MODF);
    { const int gt = F.vcu * NTHREADS + F.tid, NGT = F.G * NTHREADS;
      for (int w = gt; w < 4 * 6144; w += NGT) { const int b = w / 6144, j = w % 6144; float a = adab[j];
#pragma unroll
          for (int s = 0; s < ADA_SLICES; ++s) a += modp[(size_t)(s * 4 + b) * 6144 + j];
          modfw[w] = a; } }
    LAS float* shs = (LAS float*)F.lds; LAS float* scs = shs + DM;
    const float* x = F.in[I_X]; const float* g1 = F.in[I_N1G]; bf16* A1 = (bf16*)(F.ws + WS_A1);
    int curb = -1;
    for (int blk = F.vcu; blk < T / 64; blk += F.G) {
        const int b = (blk * 64) / SEQ;
        if (b != curb) { __syncthreads();
            for (int j = F.tid; j < 2 * DM; j += NTHREADS) { float a = adab[j];
#pragma unroll
                for (int s = 0; s < ADA_SLICES; ++s) a += modp[(size_t)(s * 4 + b) * 6144 + j];
                if (j < DM) shs[j] = a; else scs[j - DM] = (1.0f + a) * g1[j - DM]; }
            __syncthreads(); curb = b; }
        for (int tt = F.wave; tt < 64; tt += NWAVES) { const int t = blk * 64 + tt;
            f32x4 v[4]; float ss = 0.f;
#pragma unroll
            for (int j = 0; j < 4; ++j) { v[j] = *(const f32x4*)(x + (size_t)t * DM + 4 * F.lane + 256 * j); ss += (v[j][0] * v[j][0] + v[j][1] * v[j][1]) + (v[j][2] * v[j][2] + v[j][3] * v[j][3]); }
            const float rs = rsqrtf(wave_sum(ss) * (1.0f / DM) + NORM_EPS);
#pragma unroll
            for (int j = 0; j < 4; ++j) { const f32x4 sc = *(const LAS f32x4*)(scs + 4 * F.lane + 256 * j), sh = *(const LAS f32x4*)(shs + 4 * F.lane + 256 * j);
                const f32x4 o = v[j] * rs * sc + sh; v2u w; w.x = pk2(o[0], o[1]); w.y = pk2(o[2], o[3]);
                *(v2u*)(A1 + (size_t)t * DM + 4 * F.lane + 256 * j) = w; }
        }
    }
    __syncthreads();
}

constexpr int RA_SB = 1040;
__device__ __forceinline__ void p8_norm2_router(Ctx& F, const float* H, const float* modf) {
    LAS unsigned char* Ahi = F.lds; LAS unsigned char* Alo = F.lds + 64 * RA_SB; LAS float* lg = (LAS float*)(F.lds + 2 * 64 * RA_SB);
    LAS int* hist = (LAS int*)(lg + 64 * 33);
    const float* rb = F.in[I_RB]; const float* g2 = F.in[I_N2G];
    const bf16* rwhi = (const bf16*)(F.ws + WS_RWHI); const bf16* rwlo = (const bf16*)(F.ws + WS_RWLO);
    unsigned char* N2 = F.ws + WS_A1; int* topi = (int*)(F.ws + WS_TOPI); float* gate = (float*)(F.ws + WS_GATE);
    const int lane = F.lane, gq = lane >> 4, w = F.wave;
    if (F.tid < 32) hist[F.tid] = 0;
    f32x4 gv[4];
#pragma unroll
    for (int j = 0; j < 4; ++j) gv[j] = *(const f32x4*)(g2 + 4 * lane + 256 * j);
    for (int blk = F.vcu; blk < T / 64; blk += F.G) {
        const int b = (blk * 64) / SEQ; const float* sh2 = modf + (size_t)b * 6 * DM + 3 * DM; const float* sc2 = sh2 + DM;
        f32x4 scv[4], shv[4];
#pragma unroll
        for (int j = 0; j < 4; ++j) { scv[j] = (*(const f32x4*)(sc2 + 4 * lane + 256 * j) + 1.0f) * gv[j]; shv[j] = *(const f32x4*)(sh2 + 4 * lane + 256 * j); }
        f32x4 v[8][4];
#pragma unroll
        for (int i = 0; i < 8; ++i) { const int t = blk * 64 + w * 8 + i;
#pragma unroll
            for (int j = 0; j < 4; ++j) v[i][j] = *(const f32x4*)(H + (size_t)t * DM + 4 * lane + 256 * j); }
#pragma unroll
        for (int i = 0; i < 8; ++i) { const int t = blk * 64 + w * 8 + i; float ss = 0.f;
#pragma unroll
            for (int j = 0; j < 4; ++j) ss += (v[i][j][0] * v[i][j][0] + v[i][j][1] * v[i][j][1]) + (v[i][j][2] * v[i][j][2] + v[i][j][3] * v[i][j][3]);
            const float rs = rsqrtf(wave_sum(ss) * (1.0f / DM) + NORM_EPS);
#pragma unroll
            for (int j = 0; j < 4; ++j) { v[i][j] = v[i][j] * rs * scv[j] + shv[j];
                *(unsigned*)(N2 + (size_t)t * DM + 4 * lane + 256 * j) = pk4_fp8(v[i][j][0], v[i][j][1], v[i][j][2], v[i][j][3]); } }
        const int tbk = w & 3, eb = w >> 2; f32x4 acc = (f32x4){0.f, 0.f, 0.f, 0.f};
#pragma unroll
        for (int kh = 0; kh < 2; ++kh) {
            __syncthreads();
#pragma unroll
            for (int i = 0; i < 8; ++i)
#pragma unroll
                for (int jj = 0; jj < 2; ++jj) { const f32x4 x = v[i][2 * kh + jj]; const unsigned h0 = pk2(x[0], x[1]), h1 = pk2(x[2], x[3]);
                    const unsigned l0 = pk2(x[0] - bflo(h0), x[1] - bfhi(h0)), l1 = pk2(x[2] - bflo(h1), x[3] - bfhi(h1));
                    const int off = (w * 8 + i) * RA_SB + (4 * lane + 256 * jj) * 2;
                    *(LAS v2u*)(Ahi + off) = (v2u){h0, h1}; *(LAS v2u*)(Alo + off) = (v2u){l0, l1}; }
            __syncthreads();
#pragma unroll 4
            for (int s = 0; s < 16; ++s) { const size_t bo = (size_t)(16 * eb + (lane & 15)) * DM + 512 * kh + 32 * s + 8 * gq;
                const bf16x8 bh = *(const bf16x8*)(rwhi + bo), bl = *(const bf16x8*)(rwlo + bo);
                const bf16x8 ah = lds_row8(Ahi, RA_SB, 16 * tbk + (lane & 15), 32 * s + 8 * gq), al = lds_row8(Alo, RA_SB, 16 * tbk + (lane & 15), 32 * s + 8 * gq);
                acc = mfma16(ah, bh, acc); acc = mfma16(al, bh, acc); acc = mfma16(ah, bl, acc); }
        }
        { const int e = 16 * eb + (lane & 15); const float rbe = rb[e];
#pragma unroll
          for (int r = 0; r < 4; ++r) lg[(16 * tbk + 4 * gq + r) * 33 + e] = acc[r] + rbe; }
        __syncthreads();
        if (F.tid < 64) { const int t = blk * 64 + F.tid; float lv[32];
#pragma unroll
            for (int e = 0; e < 32; ++e) lv[e] = lg[F.tid * 33 + e];
            int si[4]; float sv[4];
#pragma unroll
            for (int k = 0; k < 4; ++k) { float m = -3.0e38f; int mi = 0;
#pragma unroll
                for (int e = 0; e < 32; ++e) { const bool gt = lv[e] > m; m = gt ? lv[e] : m; mi = gt ? e : mi; }
#pragma unroll
                for (int e = 0; e < 32; ++e) lv[e] = (e == mi) ? -3.0e38f : lv[e];
                si[k] = mi; sv[k] = m; }
            const float e1 = __expf(sv[1] - sv[0]), e2 = __expf(sv[2] - sv[0]), e3 = __expf(sv[3] - sv[0]); const float inv = 1.0f / (1.0f + e1 + e2 + e3);
            *(int4*)(topi + t * 4) = make_int4(si[0], si[1], si[2], si[3]); *(f32x4*)(gate + t * 4) = (f32x4){inv, e1 * inv, e2 * inv, e3 * inv};
#pragma unroll
            for (int k = 0; k < 4; ++k) __hip_atomic_fetch_add(&hist[si[k]], 1, __ATOMIC_RELAXED, __HIP_MEMORY_SCOPE_WORKGROUP); }
    }
    __syncthreads();
    if (F.tid < 32) { const int h = hist[F.tid]; if (h) __hip_atomic_fetch_add(F.ctl + CW_ECNT + 64 * F.tid, (unsigned)h, __ATOMIC_RELAXED, __HIP_MEMORY_SCOPE_AGENT); }
    __syncthreads();
}

__device__ __forceinline__ void p9_permute(Ctx& F) {
    LAS int* sm = (LAS int*)F.lds; LAS int* cnt = sm, *pstart = sm + 32, *lhist = sm + 64, *lbase = sm + 96, *dl = sm + 128;
    if (F.tid < 32) cnt[F.tid] = (int)__hip_atomic_load(F.ctl + CW_ECNT + 64 * F.tid, __ATOMIC_RELAXED, __HIP_MEMORY_SCOPE_AGENT);
    __syncthreads();
    if (F.tid == 0) { int run = 0; unsigned* tab = F.ctl + CW_MOETAB; const bool w0 = (blockIdx.x == 0);
        for (int e = 0; e < NEXP; ++e) { pstart[e] = run; const int nt = (cnt[e] + MOE_ROWS - 1) / MOE_ROWS;
            if (w0) for (int i = 0; i < nt; ++i) tab[64 + run / MOE_ROWS + i] = (unsigned)e;
            run += nt * MOE_ROWS; }
        if (w0) tab[0] = (unsigned)(run / MOE_ROWS); }
    __syncthreads();
    const unsigned char* N2 = F.ws + WS_A1; unsigned char* XG = F.ws + WS_XG;
    const int* topi = (const int*)(F.ws + WS_TOPI); const float* gate = (const float*)(F.ws + WS_GATE); int* dest = (int*)(F.ws + WS_DEST); float* rowg = (float*)(F.ws + WS_ROWG);
    for (int blk = F.vcu; blk < T / 64; blk += F.G) {
        if (F.tid < 32) lhist[F.tid] = 0;
        __syncthreads();
        int e = 0, rank = 0; const int a = blk * 256 + F.tid;
        if (F.tid < 256) { e = topi[a]; rank = __hip_atomic_fetch_add(&lhist[e], 1, __ATOMIC_RELAXED, __HIP_MEMORY_SCOPE_WORKGROUP); }
        __syncthreads();
        if (F.tid < 32) { const int h = lhist[F.tid]; lbase[F.tid] = pstart[F.tid] + (h ? (int)__hip_atomic_fetch_add(F.ctl + CW_EFILL + 64 * F.tid, (unsigned)h, __ATOMIC_RELAXED, __HIP_MEMORY_SCOPE_AGENT) : 0); }
        __syncthreads();
        if (F.tid < 256) { const int d = lbase[e] + rank; dest[a] = d; rowg[d] = gate[a]; dl[F.tid] = d; }
        __syncthreads();
        { v4u r0[8];
#pragma unroll
          for (int i = 0; i < 8; ++i) { const int t = blk * 64 + F.wave * 8 + i; r0[i] = *(const v4u*)(N2 + (size_t)t * DM + 16 * F.lane); }
#pragma unroll
          for (int i = 0; i < 8; ++i)
#pragma unroll
              for (int k = 0; k < 4; ++k) { const int d = dl[(F.wave * 8 + i) * 4 + k]; *(v4u*)(XG + (size_t)d * DM + 16 * F.lane) = r0[i]; } }
        __syncthreads();
    }
}

__device__ __forceinline__ float gelu_tanh(float x) { const float u = 0.7978845608028654f * (x + 0.044715f * x * x * x); const float e = __expf(2.0f * u); const float th = 1.0f - 2.0f / (e + 1.0f); return 0.5f * x * (1.0f + th); }
__device__ __forceinline__ void nsa_compress_unit(Ctx& F, int unit) {
    const int nt = unit & 15, kv = (unit >> 4) & 1, bg = unit >> 5, b = bg >> 1, g = bg & 1, n0 = nt * 16;
    const bf16* proj = (const bf16*)(F.ws + WS_PROJ);
    const bf16* w1t = (const bf16*)(F.ws + (kv ? WS_CW1V : WS_CW1K)); const bf16* w2t = (const bf16*)(F.ws + (kv ? WS_CW2V : WS_CW2K));
    bf16* outp = (bf16*)(F.ws + (kv ? WS_VC : WS_KC)) + (size_t)bg * 256 * 64;
    const float* pbp = (const float*)(F.ws + WS_PBP);
    LAS unsigned char* Hs = F.lds;
    const int lane = F.lane, gq = lane >> 4, w = F.wave;
    const int col = PC_KV + kv * 128 + g * 64;
    int nrow = n0 + (lane & 15); if (nrow > 254) nrow = 254;
    const bf16* arow = proj + ((size_t)b * SEQ + 16 * nrow) * PW + col + 8 * gq;
    const bf16* brow = w1t + (size_t)(16 * w + (lane & 15)) * 2048 + 8 * gq;
    f32x4 acc = (f32x4){0.f, 0.f, 0.f, 0.f};
#pragma unroll 8
    for (int s = 0; s < 64; ++s) {
        const bf16x8 a = *(const bf16x8*)(arow + (size_t)(s >> 1) * PW + (s & 1) * 32);
        const bf16x8 bb = *(const bf16x8*)(brow + 32 * s);
        acc = mfma16(a, bb, acc);
    }
    { const int j = 16 * w + (lane & 15); float pb = 0.f;
#pragma unroll
      for (int s = 0; s < PB_SLICES; ++s) pb += pbp[(s * 2 + kv) * 128 + j];
      __syncthreads();
#pragma unroll
      for (int r = 0; r < 4; ++r) *(LAS unsigned short*)(Hs + (4 * gq + r) * W128_SB + j * 2) = (unsigned short)f2bf(gelu_tanh(acc[r] + pb));
    }
    __syncthreads();
    if (w < 4) {
        f32x4 o = (f32x4){0.f, 0.f, 0.f, 0.f};
#pragma unroll
        for (int s = 0; s < 4; ++s) { const bf16x8 a = lds_row8(Hs, W128_SB, lane & 15, 32 * s + 8 * gq); const bf16x8 bb = *(const bf16x8*)(w2t + (size_t)(16 * w + (lane & 15)) * 128 + 32 * s + 8 * gq); o = mfma16(a, bb, o); }
#pragma unroll
        for (int r = 0; r < 4; ++r) { const int n = n0 + 4 * gq + r; outp[(size_t)n * 64 + 16 * w + (lane & 15)] = (unsigned short)(n < 255 ? f2bf(o[r]) : 0u); }
    }
}

__device__ __forceinline__ void nsa_cmp_unit(Ctx& F, int bg, int tb) {
    const int b = bg >> 1, g = bg & 1;
    const bf16* proj = (const bf16*)(F.ws + WS_PROJ); bf16* ocmp = (bf16*)(F.ws + WS_OCMP);
    const bf16* kc = (const bf16*)(F.ws + WS_KC) + (size_t)bg * 256 * 64; const bf16* vc = (const bf16*)(F.ws + WS_VC) + (size_t)bg * 256 * 64;
    unsigned long long* selmask = (unsigned long long*)(F.ws + WS_SELM);
    LAS unsigned char* Kt = F.lds; LAS unsigned char* Vt = F.lds + 256 * KV_SB; LAS float* IMP = (LAS float*)(F.lds + 2 * 256 * KV_SB);
    const int lane = F.lane, gq = lane >> 4, w = F.wave, tg = w >> 2, hp = w & 3;
    const int nvmax = 4 * tb + 3;
    const int nkb = (nvmax + 15) >> 4;
    __syncthreads();
    for (int i = F.tid; i < 256 * 8; i += NTHREADS) { const int row = i >> 3, ch = i & 7;
        if (row < nkb * 16) { *(LAS v4u*)(Kt + row * KV_SB + ch * 16) = *(const v4u*)(kc + row * 64 + ch * 8); *(LAS v4u*)(Vt + row * KV_SB + ch * 16) = *(const v4u*)(vc + row * 64 + ch * 8); } }
    __syncthreads();
    LAS float* IMPW = IMP + hp * 64 * 64;
#pragma unroll 1
    for (int qi = 0; qi < 2; ++qi) {
        const int tl = tg * 32 + qi * 16 + (lane & 15), t = tb * 64 + tl; const size_t trow = (size_t)b * SEQ + t;
        const int nv = ((t + 1) >> 4) - 1;
        float imp[16], carry[16];
#pragma unroll
        for (int kb = 0; kb < 16; ++kb) { imp[kb] = 0.f; carry[kb] = 0.f; }
        {
            const int head = g * 4 + hp;
            const bf16x8 q0 = *(const bf16x8*)(proj + trow * PW + PC_Q + head * 64 + 8 * gq), q1 = *(const bf16x8*)(proj + trow * PW + PC_Q + head * 64 + 32 + 8 * gq);
            float ml = NEG_BIG, ll = 0.f;
#pragma unroll 2
            for (int kb = 0; kb < nkb; ++kb) { f32x4 a = (f32x4){0.f, 0.f, 0.f, 0.f};
                a = mfma16(lds_row8(Kt, KV_SB, 16 * kb + (lane & 15), 8 * gq), q0, a); a = mfma16(lds_row8(Kt, KV_SB, 16 * kb + (lane & 15), 32 + 8 * gq), q1, a);
                float v[4], tm = NEG_BIG;
#pragma unroll
                for (int r = 0; r < 4; ++r) { const int n = 16 * kb + 4 * gq + r; v[r] = (n < nv) ? a[r] * (0.125f * LOG2E) : NEG_BIG; tm = fmaxf(tm, v[r]); }
                const float mn = fmaxf(ml, tm); float ps = 0.f;
#pragma unroll
                for (int r = 0; r < 4; ++r) { const int n = 16 * kb + 4 * gq + r; ps += (n < nv) ? __builtin_amdgcn_exp2f(v[r] - mn) : 0.f; }
                ll = ll * __builtin_amdgcn_exp2f(ml - mn) + ps; ml = mn; }
            const float mx = grp_max(ml);
            const float ps = grp_sum(ll * __builtin_amdgcn_exp2f(ml - mx));
            const float inv = ps > 0.f ? 1.0f / ps : 0.f;
            f32x4 o[4];
#pragma unroll
            for (int db = 0; db < 4; ++db) o[db] = (f32x4){0.f, 0.f, 0.f, 0.f};
#pragma unroll
            for (int st = 0; st < 8; ++st) if (2 * st < nkb) {
                f32x4 pp[2];
#pragma unroll
                for (int k2 = 0; k2 < 2; ++k2) { const int kb = 2 * st + k2; f32x4 a = (f32x4){0.f, 0.f, 0.f, 0.f};
                    a = mfma16(lds_row8(Kt, KV_SB, 16 * kb + (lane & 15), 8 * gq), q0, a); a = mfma16(lds_row8(Kt, KV_SB, 16 * kb + (lane & 15), 32 + 8 * gq), q1, a);
#pragma unroll
                    for (int r = 0; r < 4; ++r) { const int n = 16 * kb + 4 * gq + r; a[r] = (n < nv) ? __builtin_amdgcn_exp2f(a[r] * (0.125f * LOG2E) - mx) * inv : 0.f; }
                    pp[k2] = a; imp[kb] += (a[0] + a[1]) + (a[2] + 0.5f * a[3]); carry[kb] += 0.5f * a[3]; }
                const bf16x8 pf = pack8(pp[0], pp[1]);
#pragma unroll
                for (int db = 0; db < 4; ++db) o[db] = mfma16(tr_frag(Vt, KV_SB, 32 * st + 4 * gq, 32 * st + 16 + 4 * gq, 16 * db, lane), pf, o[db]);
                asm volatile("" ::: "memory"); }
            const float gate = sigmoidf_(bf2f(proj[trow * PW + PC_NSAG + head]));
#pragma unroll
            for (int db = 0; db < 4; ++db) { const f32x4 v = o[db] * gate; v2u wv; wv.x = pg8::cvt_pk_bf16(v[0], v[1]); wv.y = pg8::cvt_pk_bf16(v[2], v[3]);
                *(v2u*)(ocmp + trow * 512 + head * 64 + 16 * db + 4 * gq) = wv; }
        }
#pragma unroll
        for (int kb = 0; kb < 16; ++kb) { const float c1 = __shfl(carry[kb], (lane + 48) & 63); const float c0 = kb > 0 ? __shfl(carry[kb > 0 ? kb - 1 : 0], (lane + 48) & 63) : 0.f;
            IMPW[tl * 64 + 4 * kb + gq] = imp[kb] + (gq > 0 ? c1 : c0); }
    }
    __syncthreads();
    for (int tl = w; tl < 64; tl += NWAVES) { const int t = tb * 64 + tl, cur = t >> 6;
        float v = (IMP[tl * 64 + lane] + IMP[4096 + tl * 64 + lane]) + (IMP[2 * 4096 + tl * 64 + lane] + IMP[3 * 4096 + tl * 64 + lane]); const bool forced = (lane == 0) || (lane == cur) || (lane == cur - 1);
        v = (lane > cur) ? NEG_BIG : v + (forced ? 1.0e4f : 0.f);
        int rank = 0;
#pragma unroll
        for (int jj = 0; jj < 64; ++jj) { const float o = __builtin_bit_cast(float, __builtin_amdgcn_readlane(__builtin_bit_cast(int, v), jj)); rank += (o > v || (o == v && jj < lane)) ? 1 : 0; }
        const unsigned long long m = __ballot(lane <= cur && rank < 16);
        if (lane == 0) selmask[(size_t)bg * SEQ + t] = m; }
}

constexpr int ML_H = 4, ML_D = 128, ML_L = 64, ML_NCH = SEQ / ML_L, ML_BH = BATCH * ML_H;
__device__ __forceinline__ float log_sigmoid(float x) { return fminf(x, 0.f) - log1pf(__expf(-fabsf(x))); }
__device__ __forceinline__ float siluf_(float x) { return x * sigmoidf_(x); }
__device__ __forceinline__ void ml_stage_a(Ctx& F, int unit) {
    const int c = unit & 63, bh = unit >> 6, b = bh >> 2, h = bh & 3;
    const bf16* proj = (const bf16*)(F.ws + WS_PROJ); bf16* mlq = (bf16*)(F.ws + WS_MLQ); bf16* mlk = (bf16*)(F.ws + WS_MLKK);
    float* mlb = (float*)(F.ws + WS_MLB); float* mlli = (float*)(F.ws + WS_MLLI); float* mlsc = (float*)(F.ws + WS_MLSC);
    float* mlu = (float*)(F.ws + WS_MLU) + (size_t)unit * ML_D * ML_D; float* mlun = (float*)(F.ws + WS_MLUN) + (size_t)unit * ML_D;
    const float* convw = F.in[I_CONVW]; const float* convb = F.in[I_CONVB]; const float* gateb = F.in[I_GATEB];
    LAS unsigned char* KW = F.lds; LAS unsigned char* Vs = F.lds + 64 * W128_SB; LAS float* wts = (LAS float*)(F.lds + 2 * 64 * W128_SB); LAS float* gsc = wts + 64;
    const int t0 = c * ML_L; const size_t row0 = (size_t)b * SEQ + t0;
    __syncthreads();
    if (F.tid < 64) { const int s = F.tid; const float ip = bf2f(proj[(row0 + s) * PW + PC_MLIF + h]) + gateb[h], fp = bf2f(proj[(row0 + s) * PW + PC_MLIF + 4 + h]) + gateb[4 + h];
        gsc[s] = log_sigmoid(fp); gsc[64 + s] = ip; }
    __syncthreads();
    if (F.tid < 64) {
        float v = gsc[F.tid];
#pragma unroll
        for (int o = 1; o < 64; o <<= 1) { const float u = __shfl_up(v, o); if (F.lane >= o) v += u; }
        const float bL = __shfl(v, 63); const float li = gsc[64 + F.tid]; const float a = bL - v + li; const float amax = wave_max(a);
        wts[F.tid] = __expf(a - amax); mlb[(size_t)bh * SEQ + t0 + F.tid] = v; mlli[(size_t)bh * SEQ + t0 + F.tid] = li;
        if (F.tid == 0) { mlsc[unit * 2 + 0] = amax; mlsc[unit * 2 + 1] = bL; } }
    __syncthreads();
    { v4u xin[4][4]; v4u vin[2];
#pragma unroll
      for (int ii = 0; ii < 4; ++ii) { const int it = F.tid + ii * NTHREADS; const int ch8 = it & 15, s = (it >> 4) & 63, which = it >> 10; const int pcol = (which ? PC_MLK : PC_MLQ) + h * 128 + ch8 * 8;
#pragma unroll
          for (int wv = 0; wv < 4; ++wv) { const int tt = t0 + s - 3 + wv; xin[ii][wv] = (tt >= 0) ? *(const v4u*)(proj + ((size_t)b * SEQ + tt) * PW + pcol) : (v4u){0u, 0u, 0u, 0u}; } }
#pragma unroll
      for (int ii = 0; ii < 2; ++ii) { const int it = F.tid + ii * NTHREADS; const int ch8 = it & 15, s = it >> 4; vin[ii] = *(const v4u*)(proj + (row0 + s) * PW + PC_MLV + h * 128 + ch8 * 8); }
#pragma unroll
      for (int ii = 0; ii < 4; ++ii) { const int it = F.tid + ii * NTHREADS; const int ch8 = it & 15, s = (it >> 4) & 63, which = it >> 10;
        const int cch = which * 512 + h * 128 + ch8 * 8;
        float acc[8];
#pragma unroll
        for (int j = 0; j < 8; ++j) acc[j] = convb[cch + j];
#pragma unroll
        for (int wv = 0; wv < 4; ++wv) { const v4u x = xin[ii][wv];
            const f32x4 w0 = *(const f32x4*)(convw + wv * 1024 + cch), w1 = *(const f32x4*)(convw + wv * 1024 + cch + 4);
            acc[0] += bflo(x.x) * w0[0]; acc[1] += bfhi(x.x) * w0[1]; acc[2] += bflo(x.y) * w0[2]; acc[3] += bfhi(x.y) * w0[3];
            acc[4] += bflo(x.z) * w1[0]; acc[5] += bfhi(x.z) * w1[1]; acc[6] += bflo(x.w) * w1[2]; acc[7] += bfhi(x.w) * w1[3]; }
        const float sc = which ? 0.08838834764831845f : 1.0f;
#pragma unroll
        for (int j = 0; j < 8; ++j) acc[j] = siluf_(acc[j]) * sc;
        v4u o; o.x = pk2(acc[0], acc[1]); o.y = pk2(acc[2], acc[3]); o.z = pk2(acc[4], acc[5]); o.w = pk2(acc[6], acc[7]);
        *(v4u*)((which ? mlk : mlq) + (row0 + s) * 512 + h * 128 + ch8 * 8) = o;
        if (which) { const float ws = wts[s]; v4u kw; kw.x = pk2(acc[0] * ws, acc[1] * ws); kw.y = pk2(acc[2] * ws, acc[3] * ws); kw.z = pk2(acc[4] * ws, acc[5] * ws); kw.w = pk2(acc[6] * ws, acc[7] * ws);
            *(LAS v4u*)(KW + s * W128_SB + ch8 * 16) = kw; } }
#pragma unroll
      for (int ii = 0; ii < 2; ++ii) { const int it = F.tid + ii * NTHREADS; const int ch8 = it & 15, s = it >> 4; *(LAS v4u*)(Vs + s * W128_SB + ch8 * 16) = vin[ii]; } }
    __syncthreads();
    { const int lane = F.lane, gq = lane >> 4, w = F.wave;
      const bf16x8 a0 = tr_frag(KW, W128_SB, 8 * gq, 8 * gq + 4, 16 * w, lane), a1 = tr_frag(KW, W128_SB, 32 + 8 * gq, 32 + 8 * gq + 4, 16 * w, lane);
#pragma unroll
      for (int eb = 0; eb < 8; ++eb) { f32x4 acc = (f32x4){0.f, 0.f, 0.f, 0.f};
          acc = mfma16(a0, tr_frag(Vs, W128_SB, 8 * gq, 8 * gq + 4, 16 * eb, lane), acc); acc = mfma16(a1, tr_frag(Vs, W128_SB, 32 + 8 * gq, 32 + 8 * gq + 4, 16 * eb, lane), acc);
          *(f32x4*)(mlu + (size_t)(16 * eb + (lane & 15)) * ML_D + 16 * w + 4 * gq) = acc; } }
    if (F.tid < ML_D) { float a = 0.f;
#pragma unroll 8
        for (int s = 0; s < 64; ++s) a += bf2f(*(const LAS unsigned short*)(KW + s * W128_SB + F.tid * 2));
        mlun[F.tid] = a; }
}
__device__ __forceinline__ void ml_stage_b(Ctx& F, int unit) {
    const int sl = unit & 15, bh = unit >> 4;
    const float* mlsc = (const float*)(F.ws + WS_MLSC); float* mlm = (float*)(F.ws + WS_MLSC) + 4096;
    const float* mlu = (const float*)(F.ws + WS_MLU) + (size_t)bh * 64 * ML_D * ML_D; bf16* mlc = (bf16*)(F.ws + WS_MLC) + (size_t)bh * 64 * ML_D * ML_D;
    const float* mlun = (const float*)(F.ws + WS_MLUN) + (size_t)bh * 64 * ML_D; float* mln = (float*)(F.ws + WS_MLN) + (size_t)bh * 64 * ML_D;
    LAS float* dec = (LAS float*)F.lds; LAS float* scl = dec + 64; LAS float* am = scl + 64; LAS float* bl = am + 64;
    __syncthreads();
    if (F.tid < 64) { const pg8::f32x2 v = *(const pg8::f32x2*)(mlsc + (bh * 64 + F.tid) * 2); am[F.tid] = v.x; bl[F.tid] = v.y; }
    __syncthreads();
    if (F.tid == 0) { float m = 0.f;
        for (int c = 0; c < 64; ++c) { const float amax = am[c], bL = bl[c]; const float mn = fmaxf(bL + m, amax);
            dec[c] = __expf(bL + m - mn); scl[c] = __expf(amax - mn); if (sl == 0) mlm[bh * 64 + c] = m; m = mn; } }
    __syncthreads();
    { const int idx = sl * 1024 + F.tid * 2; float c0 = 0.f, c1 = 0.f;
#pragma unroll 1
      for (int cb = 0; cb < 64; cb += 8) { pg8::f32x2 u[8];
#pragma unroll
          for (int i = 0; i < 8; ++i) u[i] = *(const pg8::f32x2*)(mlu + (size_t)(cb + i) * ML_D * ML_D + idx);
#pragma unroll
          for (int i = 0; i < 8; ++i) { *(unsigned*)(mlc + (size_t)(cb + i) * ML_D * ML_D + idx) = pk2(c0, c1);
              c0 = dec[cb + i] * c0 + scl[cb + i] * u[i].x; c1 = dec[cb + i] * c1 + scl[cb + i] * u[i].y; } } }
    if (sl == 0 && F.tid < ML_D) { float n = 0.f;
#pragma unroll 1
        for (int cb = 0; cb < 64; cb += 8) { float u[8];
#pragma unroll
            for (int i = 0; i < 8; ++i) u[i] = mlun[(cb + i) * ML_D + F.tid];
#pragma unroll
            for (int i = 0; i < 8; ++i) { mln[(cb + i) * ML_D + F.tid] = n; n = dec[cb + i] * n + scl[cb + i] * u[i]; } } }
}
__device__ __forceinline__ void ml_stage_c(Ctx& F, int unit) {
    const int c = unit & 63, bh = unit >> 6, b = bh >> 2, h = bh & 3;
    const bf16* proj = (const bf16*)(F.ws + WS_PROJ); const bf16* mlq = (const bf16*)(F.ws + WS_MLQ); const bf16* mlk = (const bf16*)(F.ws + WS_MLKK);
    const float* mlb = (const float*)(F.ws + WS_MLB); const float* mlli = (const float*)(F.ws + WS_MLLI); const float* mlm = (const float*)(F.ws + WS_MLSC) + 4096;
    const bf16* mlc = (const bf16*)(F.ws + WS_MLC) + (size_t)unit * ML_D * ML_D; const float* mln = (const float*)(F.ws + WS_MLN) + (size_t)unit * ML_D;
    bf16* oml = (bf16*)(F.ws + WS_OML); const float* ng = F.in[I_MLNG];
    LAS unsigned char* Qs = F.lds; LAS unsigned char* Ks = Qs + 64 * W128_SB; LAS unsigned char* Vs = Ks + 64 * W128_SB; LAS unsigned char* Cs = Vs + 64 * W128_SB;
    LAS float* fb = (LAS float*)(Cs + 128 * W128_SB); LAS float* fli = fb + 64; LAS float* fn = fli + 64; LAS float* ssq = fn + 128;
    const int t0 = c * ML_L; const size_t row0 = (size_t)b * SEQ + t0;
    __syncthreads();
    for (int it = F.tid; it < 1024; it += NTHREADS) { const int ch8 = it & 15, s = it >> 4; const size_t go = (row0 + s) * 512 + h * 128 + ch8 * 8;
        *(LAS v4u*)(Qs + s * W128_SB + ch8 * 16) = *(const v4u*)(mlq + go); *(LAS v4u*)(Ks + s * W128_SB + ch8 * 16) = *(const v4u*)(mlk + go);
        *(LAS v4u*)(Vs + s * W128_SB + ch8 * 16) = *(const v4u*)(proj + (row0 + s) * PW + PC_MLV + h * 128 + ch8 * 8); }
    for (int it = F.tid; it < 2048; it += NTHREADS) { const int ch8 = it & 15, e = it >> 4; *(LAS v4u*)(Cs + e * W128_SB + ch8 * 16) = *(const v4u*)(mlc + e * ML_D + ch8 * 8); }
    if (F.tid < 64) { fb[F.tid] = mlb[(size_t)bh * SEQ + t0 + F.tid]; fli[F.tid] = mlli[(size_t)bh * SEQ + t0 + F.tid]; }
    if (F.tid < ML_D) fn[F.tid] = mln[F.tid];
    __syncthreads();
    const int lane = F.lane, gq = lane >> 4, w = F.wave, tb = w & 3, eh = w >> 2;
    const int t = 16 * tb + (lane & 15); const float mc = mlm[unit]; const float bt = fb[t];
    bf16x8 qf[4];
#pragma unroll
    for (int st = 0; st < 4; ++st) qf[st] = lds_row8(Qs, W128_SB, t, 32 * st + 8 * gq);
    f32x4 sT[4]; float dmax = NEG_BIG;
#pragma unroll
    for (int sb = 0; sb < 4; ++sb) { sT[sb] = (f32x4){0.f, 0.f, 0.f, 0.f};
        if (sb <= tb) {
#pragma unroll
            for (int st = 0; st < 4; ++st) sT[sb] = mfma16(lds_row8(Ks, W128_SB, 16 * sb + (lane & 15), 32 * st + 8 * gq), qf[st], sT[sb]);
#pragma unroll
            for (int r = 0; r < 4; ++r) { const int s = 16 * sb + 4 * gq + r; if (s <= t) dmax = fmaxf(dmax, bt - fb[s] + fli[s]); } } }
    dmax = grp_max(dmax);
    const float mt = fmaxf(bt + mc, dmax); const float iw = __expf(bt + mc - mt);
    float dsum = 0.f;
#pragma unroll
    for (int sb = 0; sb < 4; ++sb)
#pragma unroll
        for (int r = 0; r < 4; ++r) { const int s = 16 * sb + 4 * gq + r; const float p = (sb <= tb && s <= t) ? sT[sb][r] * __expf(bt - fb[s] + fli[s] - mt) : 0.f; sT[sb][r] = p; dsum += p; }
    dsum = grp_sum(dsum);
    float qn = 0.f;
#pragma unroll 8
    for (int dd = 0; dd < 32; ++dd) { const int d = gq * 32 + dd; qn += bf2f(*(const LAS unsigned short*)(Qs + t * W128_SB + d * 2)) * fn[d]; }
    qn = grp_sum(qn);
    const float den = dsum + iw * qn; const float rden = 1.0f / fmaxf(fabsf(den), __expf(-mt));
    const bf16x8 p0 = pack8(sT[0], sT[1]), p1 = pack8(sT[2], sT[3]);
    f32x4 hv[4]; float sq = 0.f;
#pragma unroll
    for (int ei = 0; ei < 4; ++ei) { const int eb = eh * 4 + ei;
        f32x4 intra = (f32x4){0.f, 0.f, 0.f, 0.f}, inter = (f32x4){0.f, 0.f, 0.f, 0.f};
        intra = mfma16(tr_frag(Vs, W128_SB, 4 * gq, 16 + 4 * gq, 16 * eb, lane), p0, intra);
        if (tb >= 2) intra = mfma16(tr_frag(Vs, W128_SB, 32 + 4 * gq, 48 + 4 * gq, 16 * eb, lane), p1, intra);
#pragma unroll
        for (int st = 0; st < 4; ++st) inter = mfma16(lds_row8(Cs, W128_SB, 16 * eb + (lane & 15), 32 * st + 8 * gq), qf[st], inter);
        hv[ei] = (intra + inter * iw) * rden; sq += (hv[ei][0] * hv[ei][0] + hv[ei][1] * hv[ei][1]) + (hv[ei][2] * hv[ei][2] + hv[ei][3] * hv[ei][3]); }
    sq = grp_sum(sq);
    if (gq == 0) ssq[eh * 64 + t] = sq;
    __syncthreads();
    const float rn = rsqrtf((ssq[t] + ssq[64 + t]) * (1.0f / ML_D) + NORM_EPS);
#pragma unroll
    for (int ei = 0; ei < 4; ++ei) { const int e0 = 16 * (eh * 4 + ei) + 4 * gq; const f32x4 gg = *(const f32x4*)(ng + h * 128 + e0);
        const v2u ow = *(const v2u*)(proj + (row0 + t) * PW + PC_MLO + h * 128 + e0);
        f32x4 v = hv[ei] * rn * gg; v[0] *= sigmoidf_(bflo(ow.x)); v[1] *= sigmoidf_(bfhi(ow.x)); v[2] *= sigmoidf_(bflo(ow.y)); v[3] *= sigmoidf_(bfhi(ow.y));
        v2u o; o.x = pg8::cvt_pk_bf16(v[0], v[1]); o.y = pg8::cvt_pk_bf16(v[2], v[3]); *(v2u*)(oml + (row0 + t) * 512 + h * 128 + e0) = o; }
}

#ifndef REPEAT_PHASE
#define REPEAT_PHASE -1
#endif
__device__ __forceinline__ void ph2(Ctx& F) {
    pg8::Gemm g{(const bf16*)(F.ws + WS_A1), (const bf16*)(F.ws + WS_WIN), T, PW, DM}; pg8::StaticOrder S; S.init(T, PW, F.G, (int)blockIdx.x);
    EpiStoreBf16 E{(bf16*)(F.ws + WS_PROJ), PW};
    pg8::gemm_phase<EpiStoreBf16, pg8::StaticOrder, true, true>(F.lds, g, S, E);
}
__device__ __forceinline__ void ph3(Ctx& F) {
    for (int u = F.vcu; u < 256; u += F.G) nsa_compress_unit(F, u);
    for (int u = F.vcu; u < ML_BH * ML_NCH; u += F.G) ml_stage_a(F, u);
}
__device__ __forceinline__ void ph4(Ctx& F) {
    for (int p = F.vcu; p < 256; p += F.G) { const int bg = p >> 5, x = p & 31; nsa_cmp_unit(F, bg, 63 - x); nsa_cmp_unit(F, bg, x); }
    for (int u = F.vcu; u < ML_BH * 16; u += F.G) ml_stage_b(F, u);
}
__device__ __forceinline__ void ph5(Ctx& F) {
    for (int p = F.vcu; p < 256; p += F.G) { const int bg = p >> 5, x = p & 31; nsa_selwin_unit(F, bg >> 1, bg & 1, x); nsa_selwin_unit(F, bg >> 1, bg & 1, 63 - x); }
    for (int u = F.vcu; u < ML_BH * ML_NCH; u += F.G) ml_stage_c(F, u);
}
struct UpOrder {
    pg8::StaticOrder so;
    __device__ __forceinline__ bool next(int i, Unit& u) const { if (!so.next(i >> 1, u)) return false; if (i & 1) { u.pm += T / 256; u.pn += DM / 256; } return true; }
    __device__ __forceinline__ void a_ready(const Unit&) const {}
    __device__ __forceinline__ void done(const Unit&) const {}
};
struct EpiUpBoth {
    static constexpr bool PERM = true, AFTER_DRAIN = false;
    bf16* U; const bf16* G;
    __device__ __forceinline__ void operator()(const f32x4 (&acc)[2][2][4][2], const Unit& u, int wr, int wc, int fr, int fq) const {
        if (u.pm < T / 256) { EpiUpGate<false> E{U, G, PC_MGA}; E(acc, u, wr, wc, fr, fq); }
        else { Unit v = u; v.pm -= T / 256; v.pn -= DM / 256; EpiUpGate<true> E{U, G, PC_MGB}; E(acc, v, wr, wc, fr, fq); }
    }
};
static_assert(WS_OML == WS_ONSA + (size_t)T * 512 * 2 && WS_WUPB == WS_WUPA + (size_t)DM * 512 * 2, "stacked operands of the up projection");
__device__ __forceinline__ void ph6(Ctx& F) {
    UpOrder S; S.so.init(T, DM, F.G, (int)blockIdx.x);
    pg8::Gemm g{(const bf16*)(F.ws + WS_ONSA), (const bf16*)(F.ws + WS_WUPA), 2 * T, 2 * DM, 512}; EpiUpBoth E{(bf16*)(F.ws + WS_U), (const bf16*)(F.ws + WS_PROJ)};
    pg8::gemm_phase<EpiUpBoth, UpOrder, true, true>(F.lds, g, S, E);
}
__device__ __forceinline__ void ph7(Ctx& F) {
    pg8::Gemm g{(const bf16*)(F.ws + WS_U), (const bf16*)(F.ws + WS_WOUT), T, DM, DM}; pg8::StaticOrder S; S.init(T, DM, F.G, (int)blockIdx.x);
    EpiOutRes E{F.in[I_X], (float*)(F.ws + WS_H1), (const float*)(F.ws + WS_MODF)};
    pg8::gemm_phase<EpiOutRes, pg8::StaticOrder, true, true>(F.lds, g, S, E);
}
__device__ __forceinline__ void ph10(Ctx& F) {
    pg8::Gemm g{(const bf16*)(F.ws + WS_XG), (const bf16*)(F.ws + WS_W1T), MOE_P, NEXP * 2048, DM};
    MoeOrder S{8, 3, F.G, F.vcu, F.ctl + CW_MOETAB};
    EpiMoe1 E{F.ws + WS_ACT, F.in[I_EB1]};
    pg8::gemm_phase<EpiMoe1, MoeOrder, true, true, true>(F.lds, g, S, E);
}
__device__ __forceinline__ void ph11(Ctx& F) {
    pg8::Gemm g{(const bf16*)(F.ws + WS_ACT), (const bf16*)(F.ws + WS_W2T), MOE_P, NEXP * DM, DE};
    MoeOrder S{4, 2, F.G, F.vcu, F.ctl + CW_MOETAB};
    EpiMoe2 E{(bf16*)(F.ws + WS_YR), F.in[I_EB2], (const float*)(F.ws + WS_ROWG)};
    pg8::gemm_phase<EpiMoe2, MoeOrder, true, true, true>(F.lds, g, S, E);
}
#ifndef TIME_PHASE
#define TIME_PHASE -1
#endif
#define RUN(k, call) do { unsigned long long t0_ = 0; if (TIME_PHASE == (k)) t0_ = __builtin_amdgcn_s_memrealtime(); call; SEAM(); \
    if (TIME_PHASE == (k)) { const unsigned long long n_ = __builtin_amdgcn_s_memrealtime(); const unsigned long long e_ = n_ + 4 * (n_ - t0_); while (__builtin_amdgcn_s_memrealtime() < e_) __builtin_amdgcn_s_sleep(8); SEAM(); } } while (0)
__global__ void __launch_bounds__(NTHREADS, 2) fwd_kernel(Args args) {
    extern __shared__ __attribute__((aligned(16))) unsigned char lds_raw[];
    Ctx F;
    F.lds = (LAS unsigned char*)lds_raw; F.ws = args.ws; F.ctl = (unsigned*)(args.ws + WS_CTL);
    F.tid = threadIdx.x; F.lane = F.tid & 63; F.wave = __builtin_amdgcn_readfirstlane(F.tid >> 6);
    F.G = gridDim.x; { const int bx = blockIdx.x; F.vcu = (F.G % 8 == 0) ? (bx % 8) * (F.G / 8) + bx / 8 : bx; }
    F.in = args.in; F.out = args.out;
    volatile LAS unsigned* MISC = (volatile LAS unsigned*)(F.lds + MISC_OFF);
    for (int u = F.tid; u < (LDS_BYTES - LDSCTL_OFF) / 4; u += NTHREADS) ((LAS unsigned*)(F.lds + LDSCTL_OFF))[u] = 0u;
    __syncthreads();
    XcdBarrier bar = xcd_barrier_post(F.ctl + CW_BAR, MISC + 8);
#define SEAM() xcd_barrier(bar)
    const float* modf = (const float*)(F.ws + WS_MODF);
    const float* H = (const float*)(F.ws + WS_H1);
    RUN(0, p0_prologue(F));
    RUN(1, p1_norm1(F));
    RUN(2, ph2(F));
    RUN(3, ph3(F));
    RUN(4, ph4(F));
    RUN(5, ph5(F));
    RUN(6, ph6(F));
    RUN(7, ph7(F));
    RUN(8, p8_norm2_router(F, H, modf));
    RUN(9, p9_permute(F));
    RUN(10, ph10(F));
    RUN(11, ph11(F));
    p_final<true>(F, H, modf);
#undef SEAM
}

extern "C" void kernel_launch(void* const* d_in, const int* in_sizes, int n_in, void* d_out, int out_size, void* d_ws, size_t ws_size, hipStream_t stream) {
    static int grid = 0;
    if (grid == 0) {
        if (n_in != 27 || in_sizes[0] != T * DM || out_size != T * DM || ws_size < WS_END) { fprintf(stderr, "kernel_launch: unexpected shapes (n_in %d, in0 %d, out %d, ws %zu)\n", n_in, n_in > 0 ? in_sizes[0] : -1, out_size, ws_size); grid = -1; return; }
        int dev = 0, cus = 0, per_cu = 0;
        if (hipGetDevice(&dev) != hipSuccess || hipDeviceGetAttribute(&cus, hipDeviceAttributeMultiprocessorCount, dev) != hipSuccess) { grid = -1; return; }
        if (hipFuncSetAttribute((const void*)fwd_kernel, hipFuncAttributeMaxDynamicSharedMemorySize, LDS_BYTES) != hipSuccess) { fprintf(stderr, "kernel_launch: hipFuncSetAttribute failed\n"); grid = -1; return; }
        if (hipOccupancyMaxActiveBlocksPerMultiprocessor(&per_cu, (const void*)fwd_kernel, NTHREADS, LDS_BYTES) != hipSuccess || per_cu < 1) fprintf(stderr, "kernel_launch: occupancy query reports %d\n", per_cu);
        (void)hipGetLastError();
        grid = cus;
    }
    if (grid < 0) return;
    if (hipMemsetAsync((char*)d_ws + WS_CTL, 0, CTL_ZERO_BYTES, stream) != hipSuccess) return;
    Args a{};
    for (int i = 0; i < 27; ++i) a.in[i] = (const float*)d_in[i];
    a.out = (float*)d_out; a.ws = (unsigned char*)d_ws;
    a.ph_lo = 0; a.ph_hi = 64;
    hipLaunchKernelGGL(fwd_kernel, dim3(grid), dim3(NTHREADS), LDS_BYTES, stream, a);
}
```

```cpp
#include <hip/hip_runtime.h>
#include <cstdio>
#include <cstdint>
namespace pg8 {
#define PG8_LAS __attribute__((address_space(3)))
typedef unsigned short bf16_t;
typedef short bf16x8 __attribute__((ext_vector_type(8)));
typedef float f32x4 __attribute__((ext_vector_type(4)));
typedef unsigned u32x4 __attribute__((ext_vector_type(4)));
constexpr int BM = 256, BK = 64, HALF = 128, HTB = HALF * BK * 2  , STAGE_BYTES = 8 * HTB, NXCD = 8, WGM = 8;

__host__ __device__ __forceinline__ int lds_byte(int r, int c) { const int st = (r >> 4) * 2 + (c >> 5), rr = r & 15, cc = c & 31, ob = rr * 64 + cc * 2; return st * 1024 + (ob ^ (((ob >> 9) & 1) << 5)); }
__host__ __device__ __forceinline__ void stage_rc(int b, int& R, int& C) { const int st = b / 1024, sb = b % 1024, swz = sb ^ (((sb >> 9) & 1) << 5); R = (st >> 1) * 16 + swz / 64; C = (st & 1) * 32 + (swz % 64) / 2; }
__host__ __device__ __forceinline__ int perm32(int rho) { const int n = rho >> 4, i = rho & 15; return 8 * (i >> 2) + 4 * n + (i & 3); }

struct Unit { int pm, pn; };
struct Gemm { const bf16_t* A; const bf16_t* Bt; int M, N, K; };

struct StaticOrder {
    int nM, nN, nwg, G, c;
    __host__ __device__ void init(int M, int N, int G_, int c_) { nM = M / BM; nN = N / BM; nwg = nM * nN; G = G_; c = c_; }
    __host__ __device__ bool next(int i, Unit& u) const {
        const long L = (long)i * G + c; if (L >= nwg) return false;
        int wgid = (int)L; { const int q = nwg / NXCD, r = nwg % NXCD, xcd = wgid % NXCD, off = wgid / NXCD; wgid = (xcd < r ? xcd * (q + 1) : r * (q + 1) + (xcd - r) * q) + off; }
        const int nig = WGM * nN, gid = wgid / nig, fm = gid * WGM, gsz = (nM - fm) < WGM ? (nM - fm) : WGM;
        u.pm = fm + ((wgid % nig) % gsz); u.pn = (wgid % nig) / gsz; return true;
    }
    __device__ __forceinline__ void a_ready(const Unit&) const {}
    __device__ __forceinline__ void done(const Unit&) const {}
};

__device__ __forceinline__ unsigned cvt_pk_bf16(float lo, float hi) { unsigned r; asm volatile("v_cvt_pk_bf16_f32 %0, %1, %2" : "=v"(r) : "v"(lo), "v"(hi)); return r; }
typedef float f32x2 __attribute__((ext_vector_type(2)));
typedef int v8i32 __attribute__((ext_vector_type(8)));
typedef int v4i32 __attribute__((ext_vector_type(4)));
template <bool F8> struct FragT { typedef bf16x8 type; }; template <> struct FragT<true> { typedef v8i32 type; };
constexpr int F8_SCALE_A = 0x7F7F7F7F;
constexpr int F8_SCALE_B = 0x7A7A7A7A;
template <class Epi, class Sched, bool ALIGN_EPI = false, bool SP2 = false, bool F8 = false, bool GATHER = false>
__device__ __forceinline__ void gemm_phase(PG8_LAS unsigned char* lds, const Gemm g, const Sched& S, const Epi& E) {
    const int tid = threadIdx.x, wid = __builtin_amdgcn_readfirstlane(tid >> 6), lane = tid & 63, wr = wid >> 2, wc = wid & 3, fr = lane & 15, fq = lane >> 4;
    const int K = g.K, nt = F8 ? K / (2 * BK) : K / BK; const int RB = F8 ? K : 2 * K;
    unsigned voffA[2], voffB[2];
#pragma unroll
    for (int i = 0; i < 2; ++i) { int R, C; stage_rc(tid * 16 + i * 8192, R, C); const int Rb = Epi::PERM ? ((R & ~31) + perm32(R & 31)) : R;
        voffA[i] = (unsigned)(R * RB + C * 2); voffB[i] = (unsigned)(Rb * RB + C * 2); }
    const size_t kstep = (size_t)(BK * 2);
    const size_t hstep = (size_t)HALF * RB;
    const size_t tstep = 2 * hstep;
    const unsigned ldsw = (unsigned)wid * 1024u;
    const int aoff = lds_byte(wr * 64 + fr, fq * 8), boff = lds_byte(wc * 32 + fr, fq * 8);
#define PG8_SA(b, h) (((b) * 2 + (h)) * HTB)
#define PG8_SB(b, h) ((4 + (b) * 2 + (h)) * HTB)
#define PG8_STAGE(bufoff, gbase, voff) do { _Pragma("unroll") for (int _i = 0; _i < 2; ++_i) \
        __builtin_amdgcn_global_load_lds((const unsigned*)((const char*)(gbase) + (voff)[_i]), (PG8_LAS unsigned*)(lds + (bufoff) + ldsw + _i * 8192), 16, 0, 0); } while (0)
#define PG8_GO1(ix, h_, i_) ((unsigned)rt[(ix) * BM + (h_) * HALF + (int)(voffA[i_] / (unsigned)RB)] * (unsigned)RB + voffA[i_] % (unsigned)RB)
#define PG8_STAGE_A(bufoff, gbase, h, nx) do { if constexpr (GATHER) { _Pragma("unroll") for (int _i = 0; _i < 2; ++_i) { const unsigned o_ = PG8_GO1((nx) ? nui : ui, h, _i); \
        __builtin_amdgcn_global_load_lds((const unsigned*)((const char*)(gbase) + o_), (PG8_LAS unsigned*)(lds + (bufoff) + ldsw + _i * 8192), 16, 0, 0); } } \
        else { PG8_STAGE(bufoff, (const char*)(gbase) + (h) * hstep, voffA); } } while (0)
#define PG8_GOFFS(v, ix) do { _Pragma("unroll") for (int h_ = 0; h_ < 2; ++h_) _Pragma("unroll") for (int i_ = 0; i_ < 2; ++i_) v[h_][i_] = PG8_GO1(ix, h_, i_); } while (0)
#define PG8_LD16(off) (*(const PG8_LAS v4i32*)(lds + (off)))
#define PG8_LDA(dst, b, h) do { _Pragma("unroll") for (int m = 0; m < 4; ++m) { if constexpr (F8) { const v4i32 lo_ = PG8_LD16(PG8_SA(b, h) + aoff + m * 2048), hi_ = PG8_LD16(PG8_SA(b, h) + aoff + m * 2048 + 1024); dst[m][0] = __builtin_shufflevector(lo_, hi_, 0, 1, 2, 3, 4, 5, 6, 7); } \
        else { _Pragma("unroll") for (int k = 0; k < NK; ++k) dst[m][k] = *(const PG8_LAS frag_t*)(lds + PG8_SA(b, h) + aoff + m * 2048 + k * 1024); } } } while (0)
#define PG8_LDB(dst, b, h) do { _Pragma("unroll") for (int n = 0; n < 2; ++n) { if constexpr (F8) { const v4i32 lo_ = PG8_LD16(PG8_SB(b, h) + boff + n * 2048), hi_ = PG8_LD16(PG8_SB(b, h) + boff + n * 2048 + 1024); dst[n][0] = __builtin_shufflevector(lo_, hi_, 0, 1, 2, 3, 4, 5, 6, 7); } \
        else { _Pragma("unroll") for (int k = 0; k < NK; ++k) dst[n][k] = *(const PG8_LAS frag_t*)(lds + PG8_SB(b, h) + boff + n * 2048 + k * 1024); } } } while (0)
#define PG8_MMA(ai, bj, At, Bt) do { __builtin_amdgcn_s_setprio(1); \
        if constexpr (F8) { _Pragma("unroll") for (int m = 0; m < 4; ++m) _Pragma("unroll") for (int n = 0; n < 2; ++n) \
            asm("v_mfma_scale_f32_16x16x128_f8f6f4 %0, %1, %2, %0, %3, %4 op_sel_hi:[0,0,0]" : "+v"(acc[ai][bj][m][n]) : "v"(Bt[n][0]), "v"(At[m][0]), "v"(f8sb), "v"(f8sa)); } \
        else { _Pragma("unroll") for (int m = 0; m < 4; ++m) _Pragma("unroll") for (int n = 0; n < 2; ++n) _Pragma("unroll") for (int k = 0; k < NK; ++k) \
            acc[ai][bj][m][n] = __builtin_amdgcn_mfma_f32_16x16x32_bf16(Bt[n][k], At[m][k], acc[ai][bj][m][n], 0, 0, 0); } \
        __builtin_amdgcn_s_setprio(0); } while (0)
#define PG8_WAIT_V(n) asm volatile("s_waitcnt vmcnt(" #n ")" ::: "memory")
#define PG8_WAIT_L(n) asm volatile("s_waitcnt lgkmcnt(" #n ")" ::: "memory")
#define PG8_BAR __builtin_amdgcn_s_barrier()
#define PG8_SCHED __builtin_amdgcn_sched_barrier(0)
    Unit cur, nxt; int ui = 0;
    if (!S.next(0, cur)) return;
    f32x4 acc[2][2][4][2];
#pragma unroll
    for (int a = 0; a < 2; ++a)
#pragma unroll
        for (int b = 0; b < 2; ++b)
#pragma unroll
            for (int m = 0; m < 4; ++m)
#pragma unroll
                for (int n = 0; n < 2; ++n) acc[a][b][m][n] = (f32x4){0.f, 0.f, 0.f, 0.f};
    typedef typename FragT<F8>::type frag_t; constexpr int NK = F8 ? 1 : 2;
    int f8sa = F8_SCALE_A, f8sb = F8_SCALE_B; if constexpr (F8) asm volatile("" : "+v"(f8sa), "+v"(f8sb));
    frag_t At[4][NK], B0[2][NK], B1[2][NK];
    const char* cA = (const char*)g.A + (GATHER ? (size_t)0 : (size_t)cur.pm * tstep); const char* cB = (const char*)g.Bt + (size_t)cur.pn * tstep;
    int nui = 0; PG8_LAS const int* rt = (PG8_LAS const int*)(lds + STAGE_BYTES);
    if constexpr (GATHER) {
        Unit tu; for (int i = 0; S.next(i, tu); ++i) if (tid < BM) ((PG8_LAS int*)(lds + STAGE_BYTES))[i * BM + tid] = S.rowtok[tu.pm * BM + tid];
        __syncthreads();
    }
    S.a_ready(cur);
    if constexpr (SP2) {
        PG8_STAGE(PG8_SB(0, 0), cB, voffB); PG8_STAGE(PG8_SB(0, 1), cB + hstep, voffB); PG8_STAGE_A(PG8_SA(0, 0), cA, 0, false); PG8_STAGE_A(PG8_SA(0, 1), cA, 1, false);
        if (wr == 1) PG8_BAR;
        PG8_WAIT_V(2); PG8_BAR;
        PG8_STAGE(PG8_SB(1, 0), cB + kstep, voffB); PG8_STAGE_A(PG8_SA(1, 0), cA + kstep, 0, false); PG8_STAGE(PG8_SB(1, 1), cB + hstep + kstep, voffB);
        PG8_WAIT_V(6); PG8_BAR;
    } else {
        PG8_STAGE(PG8_SB(0, 0), cB, voffB); PG8_STAGE_A(PG8_SA(0, 0), cA, 0, false); PG8_STAGE(PG8_SB(0, 1), cB + hstep, voffB); PG8_STAGE_A(PG8_SA(0, 1), cA, 1, false);
        if (wr == 1) PG8_BAR;
        PG8_WAIT_V(4); PG8_BAR;
        PG8_STAGE(PG8_SB(1, 0), cB + kstep, voffB); PG8_STAGE_A(PG8_SA(1, 0), cA + kstep, 0, false); PG8_STAGE(PG8_SB(1, 1), cB + hstep + kstep, voffB);
        PG8_WAIT_V(6); PG8_BAR;
    }
    for (;;) {
        const bool has_next = S.next(ui + 1, nxt);
        const char* nA = (has_next && !GATHER) ? (const char*)g.A + (size_t)nxt.pm * tstep : cA; const char* nB = has_next ? (const char*)g.Bt + (size_t)nxt.pn * tstep : cB;
        nui = has_next ? ui + 1 : ui;
#pragma unroll 1
        for (int t = 0; t < nt; t += 2) {
            const bool last = (t == nt - 2);
            const char* a1 = cA + (size_t)(t + 1) * kstep;
            const char* a2 = last ? nA : cA + (size_t)(t + 2) * kstep; const char* b2 = last ? nB : cB + (size_t)(t + 2) * kstep;
            const char* a3 = a2 + kstep; const char* b3 = b2 + kstep;
            if (last && has_next) S.a_ready(nxt);
            if constexpr (SP2) {
            PG8_LDB(B0, 0, 0); PG8_LDB(B1, 0, 1); PG8_SCHED; PG8_LDA(At, 0, 0); PG8_STAGE_A(PG8_SA(1, 1), a1, 1, false);
            PG8_WAIT_V(8); PG8_WAIT_L(0); PG8_BAR; PG8_MMA(0, 0, At, B0); PG8_MMA(0, 1, At, B1); PG8_BAR; PG8_SCHED;
            PG8_LDA(At, 0, 1); PG8_STAGE(PG8_SB(0, 0), b2, voffB); PG8_STAGE(PG8_SB(0, 1), b2 + hstep, voffB); PG8_STAGE_A(PG8_SA(0, 0), a2, 0, last);
            PG8_WAIT_V(8); PG8_WAIT_L(0); PG8_BAR; PG8_MMA(1, 0, At, B0); PG8_MMA(1, 1, At, B1); PG8_BAR; PG8_SCHED;
            PG8_LDB(B0, 1, 0); PG8_LDB(B1, 1, 1); PG8_SCHED; PG8_LDA(At, 1, 0); PG8_STAGE_A(PG8_SA(0, 1), a2, 1, last);
            PG8_WAIT_V(8); PG8_WAIT_L(0); PG8_BAR; PG8_MMA(0, 0, At, B0); PG8_MMA(0, 1, At, B1); PG8_BAR; PG8_SCHED;
            PG8_LDA(At, 1, 1); PG8_STAGE(PG8_SB(1, 0), b3, voffB); PG8_STAGE(PG8_SB(1, 1), b3 + hstep, voffB); PG8_STAGE_A(PG8_SA(1, 0), a3, 0, last);
            PG8_WAIT_V(8); PG8_WAIT_L(0); PG8_BAR; PG8_MMA(1, 0, At, B0); PG8_MMA(1, 1, At, B1); PG8_BAR; PG8_SCHED;
            } else {
            PG8_LDB(B0, 0, 0); PG8_SCHED; PG8_LDA(At, 0, 0); PG8_STAGE_A(PG8_SA(1, 1), a1, 1, false);
            PG8_WAIT_L(8); PG8_BAR; PG8_WAIT_L(0); PG8_MMA(0, 0, At, B0); PG8_BAR; PG8_SCHED;
            PG8_LDB(B1, 0, 1); PG8_STAGE(PG8_SB(0, 0), b2, voffB);
            PG8_BAR; PG8_WAIT_L(0); PG8_MMA(0, 1, At, B1); PG8_BAR;
            PG8_LDA(At, 0, 1); PG8_STAGE_A(PG8_SA(0, 0), a2, 0, last);
            PG8_BAR; PG8_WAIT_L(0); PG8_MMA(1, 0, At, B0); PG8_BAR; PG8_SCHED;
            PG8_STAGE(PG8_SB(0, 1), b2 + hstep, voffB);
            PG8_WAIT_V(6); PG8_BAR; PG8_MMA(1, 1, At, B1); PG8_BAR;
            PG8_LDB(B0, 1, 0); PG8_SCHED; PG8_LDA(At, 1, 0); PG8_STAGE_A(PG8_SA(0, 1), a2, 1, last);
            PG8_WAIT_L(8); PG8_BAR; PG8_WAIT_L(0); PG8_MMA(0, 0, At, B0); PG8_BAR; PG8_SCHED;
            PG8_LDB(B1, 1, 1); PG8_STAGE(PG8_SB(1, 0), b3, voffB);
            PG8_BAR; PG8_WAIT_L(0); PG8_MMA(0, 1, At, B1); PG8_BAR;
            PG8_LDA(At, 1, 1); PG8_STAGE_A(PG8_SA(1, 0), a3, 0, last);
            PG8_BAR; PG8_WAIT_L(0); PG8_MMA(1, 0, At, B0); PG8_BAR; PG8_SCHED;
            PG8_STAGE(PG8_SB(1, 1), b3 + hstep, voffB);
            PG8_WAIT_V(6); PG8_BAR; PG8_MMA(1, 1, At, B1); PG8_BAR;
            }
        }
        if constexpr (F8) asm volatile("s_nop 15\n\ts_nop 7" ::: "memory");
        if constexpr (ALIGN_EPI) { if (wr == 0) PG8_BAR; }
        if constexpr (!Epi::AFTER_DRAIN) { E(acc, cur, wr, wc, fr, fq); S.done(cur); }
        if (!has_next) break;
#pragma unroll
        for (int a = 0; a < 2; ++a)
#pragma unroll
            for (int b = 0; b < 2; ++b)
#pragma unroll
                for (int m = 0; m < 4; ++m)
#pragma unroll
                    for (int n = 0; n < 2; ++n) acc[a][b][m][n] = (f32x4){0.f, 0.f, 0.f, 0.f};
        cur = nxt; cA = nA; cB = nB; ++ui;

        if constexpr (ALIGN_EPI) { if (wr == 1) PG8_BAR; }
    }
    PG8_WAIT_V(0);
    if constexpr (!ALIGN_EPI) { if (wr == 0) PG8_BAR; }
    PG8_BAR;
    if constexpr (Epi::AFTER_DRAIN) { E.fused(acc, cur, wr, wc, fr, fq, lds, wid, lane); S.done(cur); }
#undef PG8_SA
#undef PG8_SB
#undef PG8_STAGE
#undef PG8_LDA
#undef PG8_LDB
#undef PG8_LD16
#undef PG8_STAGE_A
#undef PG8_GOFFS
#undef PG8_GO1
#undef PG8_MMA
#undef PG8_WAIT_V
#undef PG8_WAIT_L
#undef PG8_BAR
#undef PG8_SCHED
}
}

constexpr int NWAVES = 8, NTHREADS = 512;
constexpr int BATCH = 4, SEQ = 4096, DM = 1024, T = BATCH * SEQ;
constexpr int INW = 5408, PW = 5632;
constexpr int NEXP = 32, TOPK = 4, DE = 1024, NASSIGN = T * TOPK, MOE_ROWS = 256;
constexpr int MOE_MAXTILES = (NASSIGN + NEXP * (MOE_ROWS - 1) + MOE_ROWS - 1) / MOE_ROWS;
constexpr int MOE_P = MOE_MAXTILES * MOE_ROWS;
constexpr float NORM_EPS = 1e-6f;
constexpr int PC_Q = 0, PC_KV = 512, PC_MLQ = 1280, PC_MLK = 1792, PC_MLV = 2304, PC_MLO = 2816, PC_MGA = 3328, PC_MGB = 4352, PC_NSAG = 5376, PC_MLIF = 5400;
constexpr int ADA_SLICES = 16, PB_SLICES = 16;

constexpr size_t MiB = 1u << 20;
constexpr size_t WS_CTL = 0, CTL_ZERO_BYTES = 1 * MiB;
constexpr size_t WS_MODP = 1 * MiB;
constexpr size_t WS_MODF = 3 * MiB;
constexpr size_t WS_PBP  = 3 * MiB + 512 * 1024;
constexpr size_t WS_WIN  = 4 * MiB;
constexpr size_t WS_WUPA = 16 * MiB, WS_WUPB = 17 * MiB;
constexpr size_t WS_WOUT = 18 * MiB;
constexpr size_t WS_CW1K = 20 * MiB, WS_CW1V = 20 * MiB + 512 * 1024;
constexpr size_t WS_CW2K = 21 * MiB, WS_CW2V = 21 * MiB + 64 * 1024;
constexpr size_t WS_KC = 22 * MiB, WS_VC = 22 * MiB + 512 * 1024;
constexpr size_t WS_SELM = 23 * MiB;
constexpr size_t WS_TOPI = 24 * MiB, WS_GATE = 24 * MiB + 256 * 1024, WS_DEST = 24 * MiB + 512 * 1024;
constexpr size_t WS_ROWT = 30 * MiB;
constexpr size_t WS_ROWG = 25 * MiB;
constexpr size_t WS_MLB = 26 * MiB, WS_MLLI = 26 * MiB + 256 * 1024;
constexpr size_t WS_RWHI = 25 * MiB + 512 * 1024, WS_RWLO = 25 * MiB + 768 * 1024;
constexpr size_t WS_MLSC = 27 * MiB;
constexpr size_t WS_MLUN = 28 * MiB, WS_MLN = 29 * MiB;
constexpr size_t WS_W1T = 32 * MiB;
constexpr size_t WS_W2T = 160 * MiB;
constexpr size_t WS_H1 = 224 * MiB;
constexpr size_t WS_A1 = 288 * MiB;
constexpr size_t WS_PROJ = 320 * MiB;
constexpr size_t WS_XG = 320 * MiB;
constexpr size_t WS_OCMP = 496 * MiB, WS_ONSA = 512 * MiB, WS_OML = 528 * MiB, WS_MLQ = 544 * MiB, WS_MLKK = 560 * MiB;
constexpr size_t WS_MLU = 576 * MiB;
constexpr size_t WS_MLC = 640 * MiB;
constexpr size_t WS_U = 674 * MiB;
constexpr size_t WS_ACT = 496 * MiB;
constexpr size_t WS_YR = 640 * MiB;
constexpr size_t WS_END = 784 * MiB;
constexpr int CW_BAR = 4096;
constexpr int CW_ECNT = 16384;
constexpr int CW_EFILL = 16384 + 64 * 32;
constexpr int CW_MOETAB = 32768;

constexpr int RING_BYTES = 131072;
constexpr int LDSCTL_OFF = 146432, MISC_OFF = LDSCTL_OFF + 320;
constexpr int LDS_BYTES = 147456;

#define GAS __attribute__((address_space(1)))
#define LAS __attribute__((address_space(3)))
typedef unsigned short bf16;
typedef unsigned v4u __attribute__((ext_vector_type(4)));
typedef unsigned v2u __attribute__((ext_vector_type(2)));
typedef float f32x4 __attribute__((ext_vector_type(4)));
typedef short bf16x8 __attribute__((ext_vector_type(8)));
typedef short s16x4 __attribute__((ext_vector_type(4)));
#define LDS_WAIT() asm volatile("s_waitcnt lgkmcnt(0)" ::: "memory")
#define VM_WAIT() asm volatile("s_waitcnt vmcnt(0)" ::: "memory")
__device__ __forceinline__ unsigned f2bf(float f) { unsigned u = __builtin_bit_cast(unsigned, f); return (u + 0x7fffu + ((u >> 16) & 1u)) >> 16; }
__device__ __forceinline__ unsigned pk2(float lo, float hi) { return f2bf(lo) | (f2bf(hi) << 16); }
__device__ __forceinline__ unsigned pk4_fp8(float a, float b, float c, float d) { int w = __builtin_amdgcn_cvt_pk_fp8_f32(a, b, 0, false); w = __builtin_amdgcn_cvt_pk_fp8_f32(c, d, w, true); return (unsigned)w; }
__device__ __forceinline__ float bf2f(unsigned short b) { return __builtin_bit_cast(float, (unsigned)b << 16); }
__device__ __forceinline__ float bflo(unsigned w) { return __builtin_bit_cast(float, w << 16); }
__device__ __forceinline__ float bfhi(unsigned w) { return __builtin_bit_cast(float, w & 0xffff0000u); }
__device__ __forceinline__ float sigmoidf_(float x) { return 1.0f / (1.0f + __expf(-x)); }
__device__ __forceinline__ float wave_sum(float v) {
#pragma unroll
    for (int o = 1; o < 64; o <<= 1) v += __shfl_xor(v, o);
    return v;
}
__device__ __forceinline__ float wave_max(float v) {
#pragma unroll
    for (int o = 1; o < 64; o <<= 1) v = fmaxf(v, __shfl_xor(v, o));
    return v;
}
#define XB_TMO      128
#define XB_XCNT(j)  (256  + 64 * (j))
#define XB_XSUB(j)  (1280 + 64 * (j))
#define XB_XGEN(j)  (2304 + 64 * (j))
#define XB_TOP      3328
#define XB_TOPGEN   3392
#define XCD_BAR_WORDS 3456
#define XB_SPIN_CAP (1u << 18)

__device__ __forceinline__ unsigned xb_ld(unsigned* p)              { return __hip_atomic_load(p, __ATOMIC_RELAXED, __HIP_MEMORY_SCOPE_AGENT); }
__device__ __forceinline__ unsigned xb_add(unsigned* p, unsigned v) { return __hip_atomic_fetch_add(p, v, __ATOMIC_RELAXED, __HIP_MEMORY_SCOPE_AGENT); }
__device__ __forceinline__ unsigned xb_xcc_id() { return (unsigned)__builtin_amdgcn_s_getreg((3 << 11) | 20) & 0xFu; }
#define XB_SPIN(cond, bar) do { unsigned _sp = 0; while (cond) { __builtin_amdgcn_s_sleep(1); \
    if ((++_sp & 255u) == 0u) { if (xb_ld(&(bar)[XB_TMO])) break; if (_sp > XB_SPIN_CAP) { atomicAdd(&(bar)[XB_TMO], 1u); break; } } } } while (0)

struct XcdBarrier {
    unsigned* bar; unsigned x;
    volatile LAS unsigned* st;
};

__device__ __forceinline__ XcdBarrier xcd_barrier_post(unsigned* bar, volatile LAS unsigned* st) {
    XcdBarrier b; b.bar = bar; b.x = xb_xcc_id(); b.st = st;
    if (threadIdx.x == 0) (void)xb_add(&bar[XB_XCNT(b.x)], 1u);
    return b;
}
__device__ __forceinline__ void xcd_barrier_complete(unsigned* bar, unsigned x, unsigned& nloc, unsigned& nx) {
    const unsigned G = gridDim.x * gridDim.y * gridDim.z;
    unsigned sum, cnt, mine, sp = 0u;
    for (;;) {
        sum = 0u; cnt = 0u; mine = 0u;
#pragma unroll
        for (unsigned j = 0; j < 16; ++j) { const unsigned c = xb_ld(&bar[XB_XCNT(j)]); sum += c; cnt += (c > 0u) ? 1u : 0u; mine = (j == x) ? c : mine; }
        if (sum == G) break;
        __builtin_amdgcn_s_sleep(1);
        if ((++sp & 255u) == 0u) { if (xb_ld(&bar[XB_TMO])) break; if (sp > XB_SPIN_CAP) { atomicAdd(&bar[XB_TMO], 1u); break; } }
    }
    nloc = mine > 0u ? mine : 1u; nx = cnt > 0u ? cnt : 1u;
}

__device__ __forceinline__ void xcd_barrier(const XcdBarrier& b) {
    asm volatile("s_waitcnt vmcnt(0)" ::: "memory");
    __syncthreads();
    if (threadIdx.x == 0) {
        unsigned* bar = b.bar;
        __builtin_amdgcn_s_waitcnt(0);
        unsigned nloc = b.st[0], nx = b.st[1];
        if (nloc == 0u) { xcd_barrier_complete(bar, b.x, nloc, nx); b.st[0] = nloc; b.st[1] = nx; }
        const unsigned old = xb_add(&bar[XB_XSUB(b.x)], 1u);
        const unsigned gen = old / nloc;
        if (old + 1u == (gen + 1u) * nloc) {
            __builtin_amdgcn_fence(__ATOMIC_RELEASE, "agent");
            asm volatile("s_waitcnt vmcnt(0)" ::: "memory");
            const unsigned og = xb_add(&bar[XB_TOP], 1u);
            const unsigned tg = og / nx;
            if (og + 1u == (tg + 1u) * nx) xb_add(&bar[XB_TOPGEN], 1u);
            else XB_SPIN(xb_ld(&bar[XB_TOPGEN]) == tg, bar);
            __builtin_amdgcn_fence(__ATOMIC_ACQUIRE, "agent");
            xb_add(&bar[XB_XGEN(b.x)], 1u);
            asm volatile("s_waitcnt vmcnt(0)" ::: "memory");
        } else {
            XB_SPIN(xb_ld(&bar[XB_XGEN(b.x)]) == gen, bar);
            __builtin_amdgcn_fence(__ATOMIC_ACQUIRE, "agent");
            asm volatile("s_waitcnt vmcnt(0)" ::: "memory");
        }
    }
    __syncthreads();
}

using pg8::Unit; using pg8::HALF; using pg8::BM;
struct EpiStoreBf16 {
    static constexpr bool PERM = true, AFTER_DRAIN = false;
    bf16* O; int ldc;
    __device__ __forceinline__ void operator()(const f32x4 (&acc)[2][2][4][2], const Unit& u, int wr, int wc, int fr, int fq) const {
        const int row0 = u.pm * BM + wr * 64 + fr, col0 = u.pn * BM + wc * 32 + 8 * fq;
#pragma unroll
        for (int ai = 0; ai < 2; ++ai)
#pragma unroll
            for (int m = 0; m < 4; ++m) { bf16* rowp = O + (size_t)(row0 + ai * HALF + m * 16) * ldc + col0;
#pragma unroll
                for (int bj = 0; bj < 2; ++bj) { const f32x4 v0 = acc[ai][bj][m][0], v1 = acc[ai][bj][m][1];
                    v4u w; w.x = pg8::cvt_pk_bf16(v0[0], v0[1]); w.y = pg8::cvt_pk_bf16(v0[2], v0[3]); w.z = pg8::cvt_pk_bf16(v1[0], v1[1]); w.w = pg8::cvt_pk_bf16(v1[2], v1[3]);
                    *(v4u*)(rowp + bj * HALF) = w; } }
    }
};
template <bool ADD> struct EpiUpGate {
    static constexpr bool PERM = true, AFTER_DRAIN = false;
    bf16* U; const bf16* G; int goff;
    __device__ __forceinline__ void operator()(const f32x4 (&acc)[2][2][4][2], const Unit& u, int wr, int wc, int fr, int fq) const {
        const int row0 = u.pm * BM + wr * 64 + fr, col0 = u.pn * BM + wc * 32 + 8 * fq;
#pragma unroll
        for (int ai = 0; ai < 2; ++ai)
#pragma unroll
            for (int m = 0; m < 4; ++m) { const size_t row = (size_t)(row0 + ai * HALF + m * 16);
#pragma unroll
                for (int bj = 0; bj < 2; ++bj) { const int col = col0 + bj * HALF;
                    const v4u gw = *(const v4u*)(G + row * PW + goff + col);
                    f32x4 v0 = acc[ai][bj][m][0], v1 = acc[ai][bj][m][1];
                    v0[0] *= sigmoidf_(bflo(gw.x)); v0[1] *= sigmoidf_(bfhi(gw.x)); v0[2] *= sigmoidf_(bflo(gw.y)); v0[3] *= sigmoidf_(bfhi(gw.y));
                    v1[0] *= sigmoidf_(bflo(gw.z)); v1[1] *= sigmoidf_(bfhi(gw.z)); v1[2] *= sigmoidf_(bflo(gw.w)); v1[3] *= sigmoidf_(bfhi(gw.w));
                    if (ADD) { const v4u uw = *(const v4u*)(U + row * DM + col);
                        v0[0] += bflo(uw.x); v0[1] += bfhi(uw.x); v0[2] += bflo(uw.y); v0[3] += bfhi(uw.y); v1[0] += bflo(uw.z); v1[1] += bfhi(uw.z); v1[2] += bflo(uw.w); v1[3] += bfhi(uw.w); }
                    v4u w; w.x = pg8::cvt_pk_bf16(v0[0], v0[1]); w.y = pg8::cvt_pk_bf16(v0[2], v0[3]); w.z = pg8::cvt_pk_bf16(v1[0], v1[1]); w.w = pg8::cvt_pk_bf16(v1[2], v1[3]);
                    *(v4u*)(U + row * DM + col) = w; } }
    }
};
struct EpiOutRes {
    static constexpr bool PERM = false, AFTER_DRAIN = false;
    const float* X; float* H; const float* modf;
    __device__ __forceinline__ void operator()(const f32x4 (&acc)[2][2][4][2], const Unit& u, int wr, int wc, int fr, int fq) const {
        const int row0 = u.pm * BM + wr * 64 + fr, col0 = u.pn * BM + wc * 32 + 4 * fq;
        const int b = (u.pm * BM) / SEQ; const float* gt = modf + (size_t)b * 6 * DM + 2 * DM;
        f32x4 gv[2][2];
#pragma unroll
        for (int bj = 0; bj < 2; ++bj)
#pragma unroll
            for (int n = 0; n < 2; ++n) gv[bj][n] = *(const f32x4*)(gt + col0 + bj * HALF + n * 16) + 1.0f;
#pragma unroll
        for (int ai = 0; ai < 2; ++ai)
#pragma unroll
            for (int m = 0; m < 4; ++m) { const size_t off = (size_t)(row0 + ai * HALF + m * 16) * DM + col0;
#pragma unroll
                for (int bj = 0; bj < 2; ++bj)
#pragma unroll
                    for (int n = 0; n < 2; ++n) { const f32x4 xv = *(const f32x4*)(X + off + bj * HALF + n * 16);
                        *(f32x4*)(H + off + bj * HALF + n * 16) = xv + gv[bj][n] * acc[ai][bj][m][n]; } }
    }
};
struct EpiMoe1 {
    static constexpr bool PERM = true, AFTER_DRAIN = false;
    unsigned char* ACT; const float* b1;
    __device__ __forceinline__ void operator()(const f32x4 (&acc)[2][2][4][2], const Unit& u, int wr, int wc, int fr, int fq) const {
        const int e = u.pn >> 3, pnl = u.pn & 7;
        const int row0 = u.pm * BM + wr * 64 + fr, c0 = pnl * 128 + wc * 32 + 8 * fq;
        const float* bg = b1 + (size_t)e * 2048 + c0; const float* bl = bg + 1024;
        const f32x4 bg0 = *(const f32x4*)bg, bg1 = *(const f32x4*)(bg + 4), bl0 = *(const f32x4*)bl, bl1 = *(const f32x4*)(bl + 4);
#pragma unroll
        for (int ai = 0; ai < 2; ++ai)
#pragma unroll
            for (int m = 0; m < 4; ++m) { unsigned char* rowp = ACT + (size_t)(row0 + ai * HALF + m * 16) * DE + c0;
                float o[8];
#pragma unroll
                for (int n = 0; n < 2; ++n) { const f32x4 g = acc[ai][0][m][n] + (n ? bg1 : bg0), l = acc[ai][1][m][n] + (n ? bl1 : bl0);
#pragma unroll
                    for (int i = 0; i < 4; ++i) { const float gg = fminf(g[i], 7.0f), ll = fminf(fmaxf(l[i], -7.0f), 7.0f);
                        o[n * 4 + i] = gg * sigmoidf_(1.702f * gg) * (ll + 1.0f); } }
                v2u w; w.x = pk4_fp8(o[0], o[1], o[2], o[3]); w.y = pk4_fp8(o[4], o[5], o[6], o[7]);
                *(v2u*)rowp = w; }
    }
};
struct EpiMoe2 {
    static constexpr bool PERM = true, AFTER_DRAIN = false;
    unsigned char* Y; const float* b2; const float* rg;
    __device__ __forceinline__ void operator()(const f32x4 (&acc)[2][2][4][2], const Unit& u, int wr, int wc, int fr, int fq) const {
        const int e = u.pn >> 2, pnl = u.pn & 3;
        const int row0 = u.pm * BM + wr * 64 + fr, col0 = pnl * BM + wc * 32 + 8 * fq;
        f32x4 bv[2][2];
#pragma unroll
        for (int bj = 0; bj < 2; ++bj)
#pragma unroll
            for (int n = 0; n < 2; ++n) bv[bj][n] = *(const f32x4*)(b2 + (size_t)e * DM + col0 + bj * HALF + 4 * n);
#pragma unroll
        for (int ai = 0; ai < 2; ++ai)
#pragma unroll
            for (int m = 0; m < 4; ++m) { const int row = row0 + ai * HALF + m * 16; const float g = rg[row] * 16.0f; unsigned char* rowp = Y + (size_t)row * DM + col0;
#pragma unroll
                for (int bj = 0; bj < 2; ++bj) { const f32x4 v0 = (acc[ai][bj][m][0] + bv[bj][0]) * g, v1 = (acc[ai][bj][m][1] + bv[bj][1]) * g;
                    v2u w; w.x = pk4_fp8(v0[0], v0[1], v0[2], v0[3]); w.y = pk4_fp8(v1[0], v1[1], v1[2], v1[3]);
                    *(v2u*)(rowp + bj * HALF) = w; } }
    }
};
struct MoeOrder {
    int nN, sh, G, v; const unsigned* tab; const int* rowtok;
    __device__ __forceinline__ bool next(int i, Unit& u) const {
        const int ntl = (int)tab[0]; const long L = (long)i * G + v; if (L >= (long)ntl * nN) return false;
        const int pm = (int)(L >> sh), pnl = (int)(L & (nN - 1)); const int e = (int)tab[64 + pm];
        u.pm = pm; u.pn = e * nN + pnl; return true;
    }
    __device__ __forceinline__ void a_ready(const Unit&) const {}
    __device__ __forceinline__ void done(const Unit&) const {}
};

struct Args { const float* in[27]; float* out; unsigned char* ws; int ph_lo, ph_hi; };
struct Ctx {
    LAS unsigned char* lds; unsigned char* ws; unsigned* ctl;
    int tid, lane, wave, vcu, G;
    const float* const* in; float* out;
};
enum { I_X = 0, I_C, I_ADAW, I_ADAB, I_N1G, I_WIN, I_PEK, I_PEV, I_CW1K, I_CW2K, I_CW1V, I_CW2V, I_CONVW, I_CONVB, I_GATEB, I_MLNG, I_WUPA, I_WUPB, I_WOUT, I_N2G, I_RW, I_RB, I_EW1, I_EB1, I_EW2, I_EB2, I_FG };

template <class DMap>
__device__ __forceinline__ void p0_transpose_item(const float* W, int K, int N, bf16* WT, const DMap& dmap, LAS float* scr, int item, int lane) {
    const int nblk = N / 32, kb = item / nblk, nb = item % nblk, k0 = 64 * kb, n0 = 32 * nb;
    float tmp[16];
#pragma unroll
    for (int hh = 0; hh < 2; ++hh) {
#pragma unroll
    for (int i = 0; i < 16; ++i) tmp[i] = W[(size_t)(k0 + 2 * (16 * hh + i) + (lane >> 5)) * N + n0 + (lane & 31)];
#pragma unroll
    for (int i = 0; i < 16; ++i) scr[(2 * (16 * hh + i) + (lane >> 5)) * 33 + (lane & 31)] = tmp[i]; }
    LDS_WAIT(); asm volatile("" ::: "memory");
    const int c = lane & 7;
#pragma unroll
    for (int j = 0; j < 4; ++j) { const int n = (lane >> 3) + 8 * j; const LAS float* s = scr + (8 * c) * 33 + n;
        v4u o; o.x = pk2(s[0 * 33], s[1 * 33]); o.y = pk2(s[2 * 33], s[3 * 33]); o.z = pk2(s[4 * 33], s[5 * 33]); o.w = pk2(s[6 * 33], s[7 * 33]);
        *(GAS v4u*)(WT + (size_t)dmap(n0 + n) * K + k0 + 8 * c) = o; }
    LDS_WAIT(); asm volatile("" ::: "memory");
}
template <class DMap>
__device__ __forceinline__ void p0_moe_item_f8(const float* W, int K, int N, unsigned char* WT, const DMap& dmap, LAS float* tile, int item, int wave, int lane) {
    const int nblk = N / 256, kb = item / nblk, nb = item % nblk, k0 = 128 * kb, n0 = 256 * nb;
    f32x4 tmp[16];
#pragma unroll
    for (int i = 0; i < 16; ++i) tmp[i] = *(const f32x4*)(W + (size_t)(k0 + 16 * wave + i) * N + n0 + 4 * lane);
    __syncthreads();
#pragma unroll
    for (int i = 0; i < 16; ++i) *(LAS f32x4*)(tile + (16 * wave + i) * 260 + 4 * lane) = tmp[i] * 32.0f;
    __syncthreads();
    const int n = 32 * wave + (lane >> 1), kh = (lane & 1) * 64; const LAS float* s = tile + kh * 260 + n;
    unsigned char* dst = WT + (size_t)dmap(n0 + n) * K + k0 + kh;
#pragma unroll
    for (int i = 0; i < 4; ++i) { v4u o;
        o.x = pk4_fp8(s[(16 * i + 0) * 260], s[(16 * i + 1) * 260], s[(16 * i + 2) * 260], s[(16 * i + 3) * 260]); o.y = pk4_fp8(s[(16 * i + 4) * 260], s[(16 * i + 5) * 260], s[(16 * i + 6) * 260], s[(16 * i + 7) * 260]);
        o.z = pk4_fp8(s[(16 * i + 8) * 260], s[(16 * i + 9) * 260], s[(16 * i + 10) * 260], s[(16 * i + 11) * 260]); o.w = pk4_fp8(s[(16 * i + 12) * 260], s[(16 * i + 13) * 260], s[(16 * i + 14) * 260], s[(16 * i + 15) * 260]);
        *(GAS v4u*)(dst + 16 * i) = o; }
}
struct DMapId { __device__ __forceinline__ int operator()(int n) const { return n; } };
struct DMapWin { __device__ __forceinline__ int operator()(int n) const {
    if (n < 1280) return n;
    if (n < 1304) return PC_NSAG + (n - 1280);
    if (n < 2328) return PC_MLQ + (n - 1304);
    if (n < 2840) return PC_MLV + (n - 2328);
    if (n < 2848) return PC_MLIF + (n - 2840);
    if (n < 3360) return PC_MLO + (n - 2848);
    return PC_MGA + (n - 3360); } };
struct DMapW1 { __device__ __forceinline__ int operator()(int n) const { return n < 1024 ? ((n >> 7) << 8) + (n & 127) : (((n - 1024) >> 7) << 8) + 128 + (n & 127); } };

__device__ __forceinline__ void p0_prologue(Ctx& F) {
    LAS float* scr = (LAS float*)(F.lds + F.wave * 16896);
    const int gw = F.vcu * NWAVES + F.wave, NGW = F.G * NWAVES;
    constexpr int I_IN = (DM / 64) * (INW / 32), I_UP = (512 / 64) * (DM / 32), I_OUT = (DM / 64) * (DM / 32), I_C1 = (2048 / 64) * (128 / 32), I_C2 = (128 / 64) * (64 / 32);
    constexpr int I_E1 = (DM / 128) * (2048 / 256), I_E2 = (DE / 128) * (DM / 256);
    constexpr int NITEMS = I_IN + 2 * I_UP + I_OUT + 2 * I_C1 + 2 * I_C2;
    for (int it = gw; it < NITEMS; it += NGW) {
        int r = it;
        if (r < I_IN) { p0_transpose_item(F.in[I_WIN], DM, INW, (bf16*)(F.ws + WS_WIN), DMapWin(), scr, r, F.lane); continue; } r -= I_IN;
        if (r < I_UP) { p0_transpose_item(F.in[I_WUPA], 512, DM, (bf16*)(F.ws + WS_WUPA), DMapId(), scr, r, F.lane); continue; } r -= I_UP;
        if (r < I_UP) { p0_transpose_item(F.in[I_WUPB], 512, DM, (bf16*)(F.ws + WS_WUPB), DMapId(), scr, r, F.lane); continue; } r -= I_UP;
        if (r < I_OUT) { p0_transpose_item(F.in[I_WOUT], DM, DM, (bf16*)(F.ws + WS_WOUT), DMapId(), scr, r, F.lane); continue; } r -= I_OUT;
        if (r < I_C1) { p0_transpose_item(F.in[I_CW1K], 2048, 128, (bf16*)(F.ws + WS_CW1K), DMapId(), scr, r, F.lane); continue; } r -= I_C1;
        if (r < I_C1) { p0_transpose_item(F.in[I_CW1V], 2048, 128, (bf16*)(F.ws + WS_CW1V), DMapId(), scr, r, F.lane); continue; } r -= I_C1;
        if (r < I_C2) { p0_transpose_item(F.in[I_CW2K], 128, 64, (bf16*)(F.ws + WS_CW2K), DMapId(), scr, r, F.lane); continue; } r -= I_C2;
        { p0_transpose_item(F.in[I_CW2V], 128, 64, (bf16*)(F.ws + WS_CW2V), DMapId(), scr, r, F.lane); }
    }
    __syncthreads();
    for (int it = F.vcu; it < NEXP * (I_E1 + I_E2); it += F.G) {
        if (it < NEXP * I_E1) { const int e = it / I_E1; p0_moe_item_f8(F.in[I_EW1] + (size_t)e * DM * 2048, DM, 2048, F.ws + WS_W1T + (size_t)e * 2048 * DM, DMapW1(), (LAS float*)F.lds, it % I_E1, F.wave, F.lane); }
        else { const int r = it - NEXP * I_E1, e = r / I_E2; p0_moe_item_f8(F.in[I_EW2] + (size_t)e * DE * DM, DE, DM, F.ws + WS_W2T + (size_t)e * DM * DE, DMapId(), (LAS float*)F.lds, r % I_E2, F.wave, F.lane); }
    }
    __syncthreads();
    {
        const int gt = F.vcu * NTHREADS + F.tid, NGT = F.G * NTHREADS;
        const float* c = F.in[I_C]; const float* aw = F.in[I_ADAW]; float* modp = (float*)(F.ws + WS_MODP);
        for (int w = gt; w < ADA_SLICES * 6144; w += NGT) {
            const int s = w / 6144, j = w % 6144; float a0 = 0.f, a1 = 0.f, a2 = 0.f, a3 = 0.f;
#pragma unroll 8
            for (int kk = 0; kk < 64; ++kk) { const int k = s * 64 + kk; const float wv = aw[(size_t)k * 6144 + j];
                const float c0 = c[k], c1 = c[DM + k], c2 = c[2 * DM + k], c3 = c[3 * DM + k];
                a0 += c0 * sigmoidf_(c0) * wv; a1 += c1 * sigmoidf_(c1) * wv; a2 += c2 * sigmoidf_(c2) * wv; a3 += c3 * sigmoidf_(c3) * wv; }
            modp[(size_t)(s * 4 + 0) * 6144 + j] = a0; modp[(size_t)(s * 4 + 1) * 6144 + j] = a1; modp[(size_t)(s * 4 + 2) * 6144 + j] = a2; modp[(size_t)(s * 4 + 3) * 6144 + j] = a3;
        }
        { const float* rw = F.in[I_RW]; bf16* rwhi = (bf16*)(F.ws + WS_RWHI); bf16* rwlo = (bf16*)(F.ws + WS_RWLO);
          for (int w = gt; w < DM * NEXP; w += NGT) { const int e = w >> 10, k = w & 1023; const float x = rw[k * NEXP + e]; const unsigned h = f2bf(x); rwhi[w] = (bf16)h; rwlo[w] = (bf16)f2bf(x - bf2f((unsigned short)h)); } }
        float* pbp = (float*)(F.ws + WS_PBP);
        for (int w = gt; w < PB_SLICES * 2 * 128; w += NGT) {
            const int s = w / 256, kv = (w >> 7) & 1, j = w & 127; const float* pe = F.in[kv ? I_PEV : I_PEK]; const float* w1 = F.in[kv ? I_CW1V : I_CW1K]; float a = 0.f;
#pragma unroll 8
            for (int ii = 0; ii < 128; ++ii) { const int i = s * 128 + ii; a += pe[i] * w1[(size_t)i * 128 + j]; }
            pbp[w] = a;
        }
    }
}

template <bool WITH_MOE>
__device__ __forceinline__ void p_final(Ctx& F, const float* H, const float* modf) {
    const unsigned char* Y = F.ws + WS_YR; const int* dest = (const int*)(F.ws + WS_DEST);
    const float* fg = F.in[I_FG];
    f32x4 g[4];
#pragma unroll
    for (int j = 0; j < 4; ++j) g[j] = *(const f32x4*)(fg + 4 * F.lane + 256 * j);
    for (int blk = F.vcu; blk < T / 64; blk += F.G) {
        const int b = (blk * 64) / SEQ, t0 = blk * 64 + F.wave * 8; const float* gt = modf + (size_t)b * 6 * DM + 5 * DM;
        f32x4 gg[4];
#pragma unroll
        for (int j = 0; j < 4; ++j) gg[j] = *(const f32x4*)(gt + 4 * F.lane + 256 * j) + 1.0f;
        int4 dd[8];
#pragma unroll
        for (int i = 0; i < 8; ++i) dd[i] = WITH_MOE ? *(const int4*)(dest + (t0 + i) * 4) : make_int4(0, 0, 0, 0);
#pragma unroll
        for (int i = 0; i < 8; ++i) {
            f32x4 v[4]; unsigned y[4][4]; const int t = t0 + i;
#pragma unroll
            for (int j = 0; j < 4; ++j) v[j] = *(const f32x4*)(H + (size_t)t * DM + 4 * F.lane + 256 * j);
            if (WITH_MOE) {
#pragma unroll
                for (int j = 0; j < 4; ++j) { y[0][j] = *(const unsigned*)(Y + (size_t)dd[i].x * DM + 4 * F.lane + 256 * j); y[1][j] = *(const unsigned*)(Y + (size_t)dd[i].y * DM + 4 * F.lane + 256 * j);
                    y[2][j] = *(const unsigned*)(Y + (size_t)dd[i].z * DM + 4 * F.lane + 256 * j); y[3][j] = *(const unsigned*)(Y + (size_t)dd[i].w * DM + 4 * F.lane + 256 * j); } }
            float ss = 0.f;
#pragma unroll
            for (int j = 0; j < 4; ++j) { f32x4 m = (f32x4){0.f, 0.f, 0.f, 0.f};
                if (WITH_MOE) {
#pragma unroll
                    for (int k = 0; k < TOPK; ++k) { const pg8::f32x2 lo = __builtin_amdgcn_cvt_pk_f32_fp8((int)y[k][j], false), hi = __builtin_amdgcn_cvt_pk_f32_fp8((int)y[k][j], true); m[0] += lo.x; m[1] += lo.y; m[2] += hi.x; m[3] += hi.y; } }
                v[j] = v[j] + gg[j] * m * 0.0625f;
                ss += (v[j][0] * v[j][0] + v[j][1] * v[j][1]) + (v[j][2] * v[j][2] + v[j][3] * v[j][3]); }
            const float rs = rsqrtf(wave_sum(ss) * (1.0f / DM) + NORM_EPS);
#pragma unroll
            for (int j = 0; j < 4; ++j) *(f32x4*)(F.out + (size_t)t * DM + 4 * F.lane + 256 * j) = v[j] * rs * g[j];
        }
    }
}

__device__ __forceinline__ f32x4 mfma16(bf16x8 a, bf16x8 b, f32x4 c) { return __builtin_amdgcn_mfma_f32_16x16x32_bf16(a, b, c, 0, 0, 0); }
typedef short v4i16_t __attribute__((ext_vector_type(4)));
__device__ __forceinline__ s16x4 lds_tr4(const LAS unsigned char* p) { return __builtin_bit_cast(s16x4, __builtin_amdgcn_ds_read_tr16_b64_v4i16((LAS v4i16_t*)p)); }
__device__ __forceinline__ bf16x8 tr_frag(const LAS unsigned char* img, int sb, int r0, int r1, int n0, int lane) {
    const int q = (lane & 15) >> 2, p = lane & 3;
    const s16x4 lo = lds_tr4(img + (r0 + q) * sb + (n0 + 4 * p) * 2), hi = lds_tr4(img + (r1 + q) * sb + (n0 + 4 * p) * 2);
    return (bf16x8){lo[0], lo[1], lo[2], lo[3], hi[0], hi[1], hi[2], hi[3]};
}
__device__ __forceinline__ bf16x8 lds_row8(const LAS unsigned char* img, int sb, int row, int col) { return *(const LAS bf16x8*)(img + row * sb + col * 2); }
__device__ __forceinline__ bf16x8 pack8(const f32x4 a, const f32x4 b) {
    v4u w; w.x = pg8::cvt_pk_bf16(a[0], a[1]); w.y = pg8::cvt_pk_bf16(a[2], a[3]); w.z = pg8::cvt_pk_bf16(b[0], b[1]); w.w = pg8::cvt_pk_bf16(b[2], b[3]);
    return __builtin_bit_cast(bf16x8, w);
}
__device__ __forceinline__ float grp_max(float v) { v = fmaxf(v, __shfl_xor(v, 16)); return fmaxf(v, __shfl_xor(v, 32)); }
__device__ __forceinline__ float grp_sum(float v) { v += __shfl_xor(v, 16); return v + __shfl_xor(v, 32); }
constexpr float NEG_BIG = -1.0e30f;
constexpr float LOG2E = 1.4426950408889634f;
constexpr int KV_SB = 144;
constexpr int W128_SB = 272;

template <int MODE>
__device__ __forceinline__ void nsa_pass(Ctx& F, const bf16* proj, int b, int g, int qb, int kcol, int vcol, const bf16x8 (&qf)[2][2], const unsigned long long (&selm)[2],
                                         f32x4 (&ot)[2][4], float (&lsum)[2]) {
    LAS unsigned char* Kt = F.lds; LAS unsigned char* Vt = F.lds + 2 * 64 * KV_SB;
    const int lane = F.lane, gq = lane >> 4, th = F.wave >> 2;
    const int ntile = MODE == 0 ? qb + 1 : (qb < 8 ? qb + 1 : 9);
    const int lrow = F.tid >> 3, lch = F.tid & 7;
    const size_t rbase = (size_t)b * SEQ;
    float mrun[2] = {NEG_BIG, NEG_BIG};
#pragma unroll
    for (int qi = 0; qi < 2; ++qi) { lsum[qi] = 0.f;
#pragma unroll
        for (int db = 0; db < 4; ++db) ot[qi][db] = (f32x4){0.f, 0.f, 0.f, 0.f}; }
    auto tile_of = [&](int it) { return MODE == 0 ? it : qb - it; };
    v4u kreg, vreg;
    { const int j = tile_of(0); const bf16* src = proj + (rbase + (size_t)j * 64 + lrow) * PW + lch * 8; kreg = *(const v4u*)(src + kcol); vreg = *(const v4u*)(src + vcol); }
    __syncthreads();
    for (int it = 0; it < ntile; ++it) {
        const int buf = it & 1, j = tile_of(it);
        *(LAS v4u*)(Kt + buf * 64 * KV_SB + lrow * KV_SB + lch * 16) = kreg; *(LAS v4u*)(Vt + buf * 64 * KV_SB + lrow * KV_SB + lch * 16) = vreg;
        __syncthreads();
        if (it + 1 < ntile) { const int jn = tile_of(it + 1); const bf16* src = proj + (rbase + (size_t)jn * 64 + lrow) * PW + lch * 8; kreg = *(const v4u*)(src + kcol); vreg = *(const v4u*)(src + vcol); }
        const LAS unsigned char* Kb = Kt + buf * 64 * KV_SB; const LAS unsigned char* Vb = Vt + buf * 64 * KV_SB;
        f32x4 s[2][4];
#pragma unroll
        for (int kb = 0; kb < 4; ++kb) { const bf16x8 k0 = lds_row8(Kb, KV_SB, 16 * kb + (lane & 15), 8 * gq), k1 = lds_row8(Kb, KV_SB, 16 * kb + (lane & 15), 32 + 8 * gq);
#pragma unroll
            for (int qi = 0; qi < 2; ++qi) { f32x4 a = (f32x4){0.f, 0.f, 0.f, 0.f}; a = mfma16(k0, qf[qi][0], a); a = mfma16(k1, qf[qi][1], a); s[qi][kb] = a; } }
        const bool edge = MODE == 0 ? (j == qb) : (j == qb || j == qb - 8);
#pragma unroll
        for (int qi = 0; qi < 2; ++qi) {
            const int i = th * 32 + qi * 16 + (lane & 15);
            bool rowok = true; if (MODE == 0) rowok = (selm[qi] >> j) & 1ull;
            if (edge) {
#pragma unroll
                for (int kb = 0; kb < 4; ++kb)
#pragma unroll
                    for (int r = 0; r < 4; ++r) { const int kvl = 16 * kb + 4 * gq + r; bool ok;
                        if (MODE == 0) ok = kvl <= i; else { const int rel = (qb - j) * 64 + i - kvl; ok = rel >= 0 && rel < 512; }
                        s[qi][kb][r] = ok ? s[qi][kb][r] : NEG_BIG; } }
            float mx = fmaxf(fmaxf(s[qi][0][0], s[qi][0][1]), fmaxf(s[qi][0][2], s[qi][0][3]));
#pragma unroll
            for (int kb = 1; kb < 4; ++kb) mx = fmaxf(mx, fmaxf(fmaxf(s[qi][kb][0], s[qi][kb][1]), fmaxf(s[qi][kb][2], s[qi][kb][3])));
            mx = rowok ? mx * (0.125f * LOG2E) : NEG_BIG;
            mx = grp_max(mx);
            const float mnew = fmaxf(mrun[qi], mx);
            if (__any(mnew > mrun[qi])) { const float alpha = __builtin_amdgcn_exp2f(mrun[qi] - mnew); lsum[qi] *= alpha;
#pragma unroll
                for (int db = 0; db < 4; ++db) ot[qi][db] *= alpha; }
            mrun[qi] = mnew;
            const float nb = rowok ? -mnew : -INFINITY;
            float ps = 0.f;
#pragma unroll
            for (int kb = 0; kb < 4; ++kb)
#pragma unroll
                for (int r = 0; r < 4; ++r) { const float p = __builtin_amdgcn_exp2f(fmaf(s[qi][kb][r], 0.125f * LOG2E, nb)); s[qi][kb][r] = p; ps += p; }
            lsum[qi] += ps;
        }
#pragma unroll
        for (int st = 0; st < 2; ++st) {
            const bf16x8 p0 = pack8(s[0][2 * st], s[0][2 * st + 1]), p1 = pack8(s[1][2 * st], s[1][2 * st + 1]);
#pragma unroll
            for (int db = 0; db < 4; ++db) { const bf16x8 vf = tr_frag(Vb, KV_SB, 32 * st + 4 * gq, 32 * st + 16 + 4 * gq, 16 * db, lane);
                ot[0][db] = mfma16(vf, p0, ot[0][db]); ot[1][db] = mfma16(vf, p1, ot[1][db]); }
        }
    }
}

__device__ __forceinline__ void nsa_selwin_unit(Ctx& F, int b, int g, int qb) {
    const bf16* proj = (const bf16*)(F.ws + WS_PROJ); const bf16* ocmp = (const bf16*)(F.ws + WS_OCMP); bf16* onsa = (bf16*)(F.ws + WS_ONSA);
    const unsigned long long* selmask = (const unsigned long long*)(F.ws + WS_SELM);
    const int lane = F.lane, gq = lane >> 4, hr = F.wave & 3, th = F.wave >> 2, head = g * 4 + hr;
    bf16x8 qf[2][2]; unsigned long long selm[2]; size_t trow[2];
#pragma unroll
    for (int qi = 0; qi < 2; ++qi) { const int t = qb * 64 + th * 32 + qi * 16 + (lane & 15); trow[qi] = (size_t)b * SEQ + t;
        selm[qi] = selmask[(size_t)(b * 2 + g) * SEQ + t];
#pragma unroll
        for (int st = 0; st < 2; ++st) qf[qi][st] = *(const bf16x8*)(proj + trow[qi] * PW + PC_Q + head * 64 + 32 * st + 8 * gq); }
    f32x4 ot[2][4]; float lsum[2];
    nsa_pass<0>(F, proj, b, g, qb, PC_KV + 2 * 128 + g * 64, PC_KV + 3 * 128 + g * 64, qf, selm, ot, lsum);
#pragma unroll
    for (int qi = 0; qi < 2; ++qi) { const float gate = sigmoidf_(bf2f(proj[trow[qi] * PW + PC_NSAG + 8 + head])) / grp_sum(lsum[qi]);
#pragma unroll
        for (int db = 0; db < 4; ++db) { const size_t o = trow[qi] * 512 + head * 64 + 16 * db + 4 * gq; const v2u c = *(const v2u*)(ocmp + o);
            f32x4 v = ot[qi][db] * gate; v[0] += bflo(c.x); v[1] += bfhi(c.x); v[2] += bflo(c.y); v[3] += bfhi(c.y);
            v2u w; w.x = pg8::cvt_pk_bf16(v[0], v[1]); w.y = pg8::cvt_pk_bf16(v[2], v[3]); *(v2u*)(onsa + o) = w; } }
    nsa_pass<1>(F, proj, b, g, qb, PC_KV + 4 * 128 + g * 64, PC_KV + 5 * 128 + g * 64, qf, selm, ot, lsum);
#pragma unroll
    for (int qi = 0; qi < 2; ++qi) { const float gate = sigmoidf_(bf2f(proj[trow[qi] * PW + PC_NSAG + 16 + head])) / grp_sum(lsum[qi]);
#pragma unroll
        for (int db = 0; db < 4; ++db) { const size_t o = trow[qi] * 512 + head * 64 + 16 * db + 4 * gq; const v2u c = *(const v2u*)(onsa + o);
            f32x4 v = ot[qi][db] * gate; v[0] += bflo(c.x); v[1] += bfhi(c.x); v[2] += bflo(c.y); v[3] += bfhi(c.y);
            v2u w; w.x = pg8::cvt_pk_bf16(v[0], v[1]); w.y = pg8::cvt_pk_bf16(v[2], v[3]); *(v2u*)(onsa + o) = w; } }
}

__device__ __forceinline__ void p1_norm1(Ctx& F) {
    const float* modp = (const float*)(F.ws + WS_MODP); const float* adab = F.in[I_ADAB]; float* modfw = (float*)(F.ws + WS_MODF);
    { const int gt = F.vcu * NTHREADS + F.tid, NGT = F.G * NTHREADS;
      for (int w = gt; w < 4 * 6144; w += NGT) { const int b = w / 6144, j = w % 6144; float a = adab[j];
#pragma unroll
          for (int s = 0; s < ADA_SLICES; ++s) a += modp[(size_t)(s * 4 + b) * 6144 + j];
          modfw[w] = a; } }
    LAS float* shs = (LAS float*)F.lds; LAS float* scs = shs + DM;
    const float* x = F.in[I_X]; const float* g1 = F.in[I_N1G]; bf16* A1 = (bf16*)(F.ws + WS_A1);
    int curb = -1;
    for (int blk = F.vcu; blk < T / 64; blk += F.G) {
        const int b = (blk * 64) / SEQ;
        if (b != curb) { __syncthreads();
            for (int j = F.tid; j < 2 * DM; j += NTHREADS) { float a = adab[j];
#pragma unroll
                for (int s = 0; s < ADA_SLICES; ++s) a += modp[(size_t)(s * 4 + b) * 6144 + j];
                if (j < DM) shs[j] = a; else scs[j - DM] = (1.0f + a) * g1[j - DM]; }
            __syncthreads(); curb = b; }
        { f32x4 v[8][4];
#pragma unroll
          for (int i = 0; i < 8; ++i)
#pragma unroll
              for (int j = 0; j < 4; ++j) v[i][j] = *(const f32x4*)(x + (size_t)(blk * 64 + F.wave * 8 + i) * DM + 4 * F.lane + 256 * j);
#pragma unroll
          for (int i = 0; i < 8; ++i) { const int t = blk * 64 + F.wave * 8 + i; float ss = 0.f;
#pragma unroll
              for (int j = 0; j < 4; ++j) ss += (v[i][j][0] * v[i][j][0] + v[i][j][1] * v[i][j][1]) + (v[i][j][2] * v[i][j][2] + v[i][j][3] * v[i][j][3]);
              const float rs = rsqrtf(wave_sum(ss) * (1.0f / DM) + NORM_EPS);
#pragma unroll
              for (int j = 0; j < 4; ++j) { const f32x4 sc = *(const LAS f32x4*)(scs + 4 * F.lane + 256 * j), sh = *(const LAS f32x4*)(shs + 4 * F.lane + 256 * j);
                  const f32x4 o = v[i][j] * rs * sc + sh; v2u w; w.x = pk2(o[0], o[1]); w.y = pk2(o[2], o[3]);
                  *(v2u*)(A1 + (size_t)t * DM + 4 * F.lane + 256 * j) = w; } } }
    }
    __syncthreads();
}

constexpr int RA_SB = 1040;
__device__ __forceinline__ void p8_norm2_router(Ctx& F, const float* H, const float* modf) {
    LAS unsigned char* Ahi = F.lds; LAS unsigned char* Alo = F.lds + 64 * RA_SB; LAS float* lg = (LAS float*)(F.lds + 2 * 64 * RA_SB);
    LAS int* hist = (LAS int*)(lg + 64 * 33);
    const float* rb = F.in[I_RB]; const float* g2 = F.in[I_N2G];
    const bf16* rwhi = (const bf16*)(F.ws + WS_RWHI); const bf16* rwlo = (const bf16*)(F.ws + WS_RWLO);
    unsigned char* N2 = F.ws + WS_A1; int* topi = (int*)(F.ws + WS_TOPI); float* gate = (float*)(F.ws + WS_GATE);
    const int lane = F.lane, gq = lane >> 4, w = F.wave;
    if (F.tid < 32) hist[F.tid] = 0;
    f32x4 gv[4];
#pragma unroll
    for (int j = 0; j < 4; ++j) gv[j] = *(const f32x4*)(g2 + 4 * lane + 256 * j);
    for (int blk = F.vcu; blk < T / 64; blk += F.G) {
        const int b = (blk * 64) / SEQ; const float* sh2 = modf + (size_t)b * 6 * DM + 3 * DM; const float* sc2 = sh2 + DM;
        f32x4 scv[4], shv[4];
#pragma unroll
        for (int j = 0; j < 4; ++j) { scv[j] = (*(const f32x4*)(sc2 + 4 * lane + 256 * j) + 1.0f) * gv[j]; shv[j] = *(const f32x4*)(sh2 + 4 * lane + 256 * j); }
        f32x4 v[8][4];
#pragma unroll
        for (int i = 0; i < 8; ++i) { const int t = blk * 64 + w * 8 + i;
#pragma unroll
            for (int j = 0; j < 4; ++j) v[i][j] = *(const f32x4*)(H + (size_t)t * DM + 4 * lane + 256 * j); }
#pragma unroll
        for (int i = 0; i < 8; ++i) { const int t = blk * 64 + w * 8 + i; float ss = 0.f;
#pragma unroll
            for (int j = 0; j < 4; ++j) ss += (v[i][j][0] * v[i][j][0] + v[i][j][1] * v[i][j][1]) + (v[i][j][2] * v[i][j][2] + v[i][j][3] * v[i][j][3]);
            const float rs = rsqrtf(wave_sum(ss) * (1.0f / DM) + NORM_EPS);
#pragma unroll
            for (int j = 0; j < 4; ++j) { v[i][j] = v[i][j] * rs * scv[j] + shv[j];
                *(unsigned*)(N2 + (size_t)t * DM + 4 * lane + 256 * j) = pk4_fp8(v[i][j][0], v[i][j][1], v[i][j][2], v[i][j][3]); } }
        const int tbk = w & 3, eb = w >> 2; f32x4 acc = (f32x4){0.f, 0.f, 0.f, 0.f};
#pragma unroll
        for (int kh = 0; kh < 2; ++kh) {
            __syncthreads();
#pragma unroll
            for (int i = 0; i < 8; ++i)
#pragma unroll
                for (int jj = 0; jj < 2; ++jj) { const f32x4 x = v[i][2 * kh + jj]; const unsigned h0 = pk2(x[0], x[1]), h1 = pk2(x[2], x[3]);
                    const unsigned l0 = pk2(x[0] - bflo(h0), x[1] - bfhi(h0)), l1 = pk2(x[2] - bflo(h1), x[3] - bfhi(h1));
                    const int off = (w * 8 + i) * RA_SB + (4 * lane + 256 * jj) * 2;
                    *(LAS v2u*)(Ahi + off) = (v2u){h0, h1}; *(LAS v2u*)(Alo + off) = (v2u){l0, l1}; }
            __syncthreads();
#pragma unroll 4
            for (int s = 0; s < 16; ++s) { const size_t bo = (size_t)(16 * eb + (lane & 15)) * DM + 512 * kh + 32 * s + 8 * gq;
                const bf16x8 bh = *(const bf16x8*)(rwhi + bo), bl = *(const bf16x8*)(rwlo + bo);
                const bf16x8 ah = lds_row8(Ahi, RA_SB, 16 * tbk + (lane & 15), 32 * s + 8 * gq), al = lds_row8(Alo, RA_SB, 16 * tbk + (lane & 15), 32 * s + 8 * gq);
                acc = mfma16(ah, bh, acc); acc = mfma16(al, bh, acc); acc = mfma16(ah, bl, acc); }
        }
        { const int e = 16 * eb + (lane & 15); const float rbe = rb[e];
#pragma unroll
          for (int r = 0; r < 4; ++r) lg[(16 * tbk + 4 * gq + r) * 33 + e] = acc[r] + rbe; }
        __syncthreads();
        if (F.tid < 64) { const int t = blk * 64 + F.tid; float lv[32];
#pragma unroll
            for (int e = 0; e < 32; ++e) lv[e] = lg[F.tid * 33 + e];
            int si[4]; float sv[4];
#pragma unroll
            for (int k = 0; k < 4; ++k) { float m = -3.0e38f; int mi = 0;
#pragma unroll
                for (int e = 0; e < 32; ++e) { const bool gt = lv[e] > m; m = gt ? lv[e] : m; mi = gt ? e : mi; }
#pragma unroll
                for (int e = 0; e < 32; ++e) lv[e] = (e == mi) ? -3.0e38f : lv[e];
                si[k] = mi; sv[k] = m; }
            const float e1 = __expf(sv[1] - sv[0]), e2 = __expf(sv[2] - sv[0]), e3 = __expf(sv[3] - sv[0]); const float inv = 1.0f / (1.0f + e1 + e2 + e3);
            *(int4*)(topi + t * 4) = make_int4(si[0], si[1], si[2], si[3]); *(f32x4*)(gate + t * 4) = (f32x4){inv, e1 * inv, e2 * inv, e3 * inv};
#pragma unroll
            for (int k = 0; k < 4; ++k) __hip_atomic_fetch_add(&hist[si[k]], 1, __ATOMIC_RELAXED, __HIP_MEMORY_SCOPE_WORKGROUP); }
    }
    __syncthreads();
    if (F.tid < 32) { const int h = hist[F.tid]; if (h) __hip_atomic_fetch_add(F.ctl + CW_ECNT + 64 * F.tid, (unsigned)h, __ATOMIC_RELAXED, __HIP_MEMORY_SCOPE_AGENT); }
    __syncthreads();
}

__device__ __forceinline__ void p9_permute(Ctx& F) {
    LAS int* sm = (LAS int*)F.lds; LAS int* cnt = sm, *pstart = sm + 32, *lhist = sm + 64, *lbase = sm + 96, *dl = sm + 128;
    if (F.tid < 32) cnt[F.tid] = (int)__hip_atomic_load(F.ctl + CW_ECNT + 64 * F.tid, __ATOMIC_RELAXED, __HIP_MEMORY_SCOPE_AGENT);
    __syncthreads();
    if (F.tid == 0) { int run = 0; unsigned* tab = F.ctl + CW_MOETAB; const bool w0 = (blockIdx.x == 0);
        for (int e = 0; e < NEXP; ++e) { pstart[e] = run; const int nt = (cnt[e] + MOE_ROWS - 1) / MOE_ROWS;
            if (w0) for (int i = 0; i < nt; ++i) tab[64 + run / MOE_ROWS + i] = (unsigned)e;
            run += nt * MOE_ROWS; }
        if (w0) tab[0] = (unsigned)(run / MOE_ROWS); }
    __syncthreads();
    int* rowt = (int*)(F.ws + WS_ROWT);
    for (int e = F.vcu; e < NEXP; e += F.G) { const int c = cnt[e], pe = (c + MOE_ROWS - 1) / MOE_ROWS * MOE_ROWS; for (int r = c + F.tid; r < pe; r += NTHREADS) rowt[pstart[e] + r] = 0; }
    const int* topi = (const int*)(F.ws + WS_TOPI); const float* gate = (const float*)(F.ws + WS_GATE); int* dest = (int*)(F.ws + WS_DEST); float* rowg = (float*)(F.ws + WS_ROWG);
    for (int blk = F.vcu; blk < T / 64; blk += F.G) {
        if (F.tid < 32) lhist[F.tid] = 0;
        __syncthreads();
        int e = 0, rank = 0; const int a = blk * 256 + F.tid;
        if (F.tid < 256) { e = topi[a]; rank = __hip_atomic_fetch_add(&lhist[e], 1, __ATOMIC_RELAXED, __HIP_MEMORY_SCOPE_WORKGROUP); }
        __syncthreads();
        if (F.tid < 32) { const int h = lhist[F.tid]; lbase[F.tid] = pstart[F.tid] + (h ? (int)__hip_atomic_fetch_add(F.ctl + CW_EFILL + 64 * F.tid, (unsigned)h, __ATOMIC_RELAXED, __HIP_MEMORY_SCOPE_AGENT) : 0); }
        __syncthreads();
        if (F.tid < 256) { const int d = lbase[e] + rank; dest[a] = d; rowg[d] = gate[a]; rowt[d] = a >> 2; }
        __syncthreads();
        __syncthreads();
    }
}

__device__ __forceinline__ float gelu_tanh(float x) { const float u = 0.7978845608028654f * (x + 0.044715f * x * x * x); const float e = __expf(2.0f * u); const float th = 1.0f - 2.0f / (e + 1.0f); return 0.5f * x * (1.0f + th); }
__device__ __forceinline__ void nsa_compress_unit(Ctx& F, int unit) {
    const int nt = unit & 15, kv = (unit >> 4) & 1, bg = unit >> 5, b = bg >> 1, g = bg & 1, n0 = nt * 16;
    const bf16* proj = (const bf16*)(F.ws + WS_PROJ);
    const bf16* w1t = (const bf16*)(F.ws + (kv ? WS_CW1V : WS_CW1K)); const bf16* w2t = (const bf16*)(F.ws + (kv ? WS_CW2V : WS_CW2K));
    bf16* outp = (bf16*)(F.ws + (kv ? WS_VC : WS_KC)) + (size_t)bg * 256 * 64;
    const float* pbp = (const float*)(F.ws + WS_PBP);
    LAS unsigned char* Hs = F.lds;
    const int lane = F.lane, gq = lane >> 4, w = F.wave;
    const int col = PC_KV + kv * 128 + g * 64;
    int nrow = n0 + (lane & 15); if (nrow > 254) nrow = 254;
    const bf16* arow = proj + ((size_t)b * SEQ + 16 * nrow) * PW + col + 8 * gq;
    const bf16* brow = w1t + (size_t)(16 * w + (lane & 15)) * 2048 + 8 * gq;
    f32x4 acc = (f32x4){0.f, 0.f, 0.f, 0.f};
#pragma unroll 8
    for (int s = 0; s < 64; ++s) {
        const bf16x8 a = *(const bf16x8*)(arow + (size_t)(s >> 1) * PW + (s & 1) * 32);
        const bf16x8 bb = *(const bf16x8*)(brow + 32 * s);
        acc = mfma16(a, bb, acc);
    }
    { const int j = 16 * w + (lane & 15); float pb = 0.f;
#pragma unroll
      for (int s = 0; s < PB_SLICES; ++s) pb += pbp[(s * 2 + kv) * 128 + j];
      __syncthreads();
#pragma unroll
      for (int r = 0; r < 4; ++r) *(LAS unsigned short*)(Hs + (4 * gq + r) * W128_SB + j * 2) = (unsigned short)f2bf(gelu_tanh(acc[r] + pb));
    }
    __syncthreads();
    if (w < 4) {
        f32x4 o = (f32x4){0.f, 0.f, 0.f, 0.f};
#pragma unroll
        for (int s = 0; s < 4; ++s) { const bf16x8 a = lds_row8(Hs, W128_SB, lane & 15, 32 * s + 8 * gq); const bf16x8 bb = *(const bf16x8*)(w2t + (size_t)(16 * w + (lane & 15)) * 128 + 32 * s + 8 * gq); o = mfma16(a, bb, o); }
#pragma unroll
        for (int r = 0; r < 4; ++r) { const int n = n0 + 4 * gq + r; outp[(size_t)n * 64 + 16 * w + (lane & 15)] = (unsigned short)(n < 255 ? f2bf(o[r]) : 0u); }
    }
}

__device__ __forceinline__ void nsa_cmp_unit(Ctx& F, int bg, int tb) {
    const int b = bg >> 1, g = bg & 1;
    const bf16* proj = (const bf16*)(F.ws + WS_PROJ); bf16* ocmp = (bf16*)(F.ws + WS_OCMP);
    const bf16* kc = (const bf16*)(F.ws + WS_KC) + (size_t)bg * 256 * 64; const bf16* vc = (const bf16*)(F.ws + WS_VC) + (size_t)bg * 256 * 64;
    unsigned long long* selmask = (unsigned long long*)(F.ws + WS_SELM);
    LAS unsigned char* Kt = F.lds; LAS unsigned char* Vt = F.lds + 256 * KV_SB; LAS float* IMP = (LAS float*)(F.lds + 2 * 256 * KV_SB);
    const int lane = F.lane, gq = lane >> 4, w = F.wave, tg = w >> 2, hp = w & 3;
    const int nvmax = 4 * tb + 3;
    const int nkb = (nvmax + 15) >> 4;
    __syncthreads();
    for (int i = F.tid; i < 256 * 8; i += NTHREADS) { const int row = i >> 3, ch = i & 7;
        if (row < nkb * 16) { *(LAS v4u*)(Kt + row * KV_SB + ch * 16) = *(const v4u*)(kc + row * 64 + ch * 8); *(LAS v4u*)(Vt + row * KV_SB + ch * 16) = *(const v4u*)(vc + row * 64 + ch * 8); } }
    __syncthreads();
    LAS float* IMPW = IMP + hp * 64 * 64;
#pragma unroll 1
    for (int qi = 0; qi < 2; ++qi) {
        const int tl = tg * 32 + qi * 16 + (lane & 15), t = tb * 64 + tl; const size_t trow = (size_t)b * SEQ + t;
        const int nv = ((t + 1) >> 4) - 1;
        float imp[16], carry[16];
#pragma unroll
        for (int kb = 0; kb < 16; ++kb) { imp[kb] = 0.f; carry[kb] = 0.f; }
        {
            const int head = g * 4 + hp;
            const bf16x8 q0 = *(const bf16x8*)(proj + trow * PW + PC_Q + head * 64 + 8 * gq), q1 = *(const bf16x8*)(proj + trow * PW + PC_Q + head * 64 + 32 + 8 * gq);
            float ml = NEG_BIG, ll = 0.f;
#pragma unroll 2
            for (int kb = 0; kb < nkb; ++kb) { f32x4 a = (f32x4){0.f, 0.f, 0.f, 0.f};
                a = mfma16(lds_row8(Kt, KV_SB, 16 * kb + (lane & 15), 8 * gq), q0, a); a = mfma16(lds_row8(Kt, KV_SB, 16 * kb + (lane & 15), 32 + 8 * gq), q1, a);
                float v[4], tm = NEG_BIG;
#pragma unroll
                for (int r = 0; r < 4; ++r) { const int n = 16 * kb + 4 * gq + r; v[r] = (n < nv) ? a[r] * (0.125f * LOG2E) : NEG_BIG; tm = fmaxf(tm, v[r]); }
                const float mn = fmaxf(ml, tm); float ps = 0.f;
#pragma unroll
                for (int r = 0; r < 4; ++r) { const int n = 16 * kb + 4 * gq + r; ps += (n < nv) ? __builtin_amdgcn_exp2f(v[r] - mn) : 0.f; }
                ll = ll * __builtin_amdgcn_exp2f(ml - mn) + ps; ml = mn; }
            const float mx = grp_max(ml);
            const float ps = grp_sum(ll * __builtin_amdgcn_exp2f(ml - mx));
            const float inv = ps > 0.f ? 1.0f / ps : 0.f;
            f32x4 o[4];
#pragma unroll
            for (int db = 0; db < 4; ++db) o[db] = (f32x4){0.f, 0.f, 0.f, 0.f};
#pragma unroll
            for (int st = 0; st < 8; ++st) if (2 * st < nkb) {
                f32x4 pp[2];
#pragma unroll
                for (int k2 = 0; k2 < 2; ++k2) { const int kb = 2 * st + k2; f32x4 a = (f32x4){0.f, 0.f, 0.f, 0.f};
                    a = mfma16(lds_row8(Kt, KV_SB, 16 * kb + (lane & 15), 8 * gq), q0, a); a = mfma16(lds_row8(Kt, KV_SB, 16 * kb + (lane & 15), 32 + 8 * gq), q1, a);
#pragma unroll
                    for (int r = 0; r < 4; ++r) { const int n = 16 * kb + 4 * gq + r; a[r] = (n < nv) ? __builtin_amdgcn_exp2f(a[r] * (0.125f * LOG2E) - mx) * inv : 0.f; }
                    pp[k2] = a; imp[kb] += (a[0] + a[1]) + (a[2] + 0.5f * a[3]); carry[kb] += 0.5f * a[3]; }
                const bf16x8 pf = pack8(pp[0], pp[1]);
#pragma unroll
                for (int db = 0; db < 4; ++db) o[db] = mfma16(tr_frag(Vt, KV_SB, 32 * st + 4 * gq, 32 * st + 16 + 4 * gq, 16 * db, lane), pf, o[db]);
                asm volatile("" ::: "memory"); }
            const float gate = sigmoidf_(bf2f(proj[trow * PW + PC_NSAG + head]));
#pragma unroll
            for (int db = 0; db < 4; ++db) { const f32x4 v = o[db] * gate; v2u wv; wv.x = pg8::cvt_pk_bf16(v[0], v[1]); wv.y = pg8::cvt_pk_bf16(v[2], v[3]);
                *(v2u*)(ocmp + trow * 512 + head * 64 + 16 * db + 4 * gq) = wv; }
        }
#pragma unroll
        for (int kb = 0; kb < 16; ++kb) { const float c1 = __shfl(carry[kb], (lane + 48) & 63); const float c0 = kb > 0 ? __shfl(carry[kb > 0 ? kb - 1 : 0], (lane + 48) & 63) : 0.f;
            IMPW[tl * 64 + 4 * kb + gq] = imp[kb] + (gq > 0 ? c1 : c0); }
    }
    __syncthreads();
    for (int tl = w; tl < 64; tl += NWAVES) { const int t = tb * 64 + tl, cur = t >> 6;
        float v = (IMP[tl * 64 + lane] + IMP[4096 + tl * 64 + lane]) + (IMP[2 * 4096 + tl * 64 + lane] + IMP[3 * 4096 + tl * 64 + lane]); const bool forced = (lane == 0) || (lane == cur) || (lane == cur - 1);
        v = (lane > cur) ? NEG_BIG : v + (forced ? 1.0e4f : 0.f);
        int rank = 0;
#pragma unroll
        for (int jj = 0; jj < 64; ++jj) { const float o = __builtin_bit_cast(float, __builtin_amdgcn_readlane(__builtin_bit_cast(int, v), jj)); rank += (o > v || (o == v && jj < lane)) ? 1 : 0; }
        const unsigned long long m = __ballot(lane <= cur && rank < 16);
        if (lane == 0) selmask[(size_t)bg * SEQ + t] = m; }
}

constexpr int ML_H = 4, ML_D = 128, ML_L = 64, ML_NCH = SEQ / ML_L, ML_BH = BATCH * ML_H;
__device__ __forceinline__ float log_sigmoid(float x) { return fminf(x, 0.f) - log1pf(__expf(-fabsf(x))); }
__device__ __forceinline__ float siluf_(float x) { return x * sigmoidf_(x); }
__device__ __forceinline__ void ml_stage_a(Ctx& F, int unit) {
    const int c = unit & 63, bh = unit >> 6, b = bh >> 2, h = bh & 3;
    const bf16* proj = (const bf16*)(F.ws + WS_PROJ); bf16* mlq = (bf16*)(F.ws + WS_MLQ); bf16* mlk = (bf16*)(F.ws + WS_MLKK);
    float* mlb = (float*)(F.ws + WS_MLB); float* mlli = (float*)(F.ws + WS_MLLI); float* mlsc = (float*)(F.ws + WS_MLSC);
    bf16* mlu = (bf16*)(F.ws + WS_MLU) + (size_t)unit * ML_D * ML_D; float* mlun = (float*)(F.ws + WS_MLUN) + (size_t)unit * ML_D;
    const float* convw = F.in[I_CONVW]; const float* convb = F.in[I_CONVB]; const float* gateb = F.in[I_GATEB];
    LAS unsigned char* KW = F.lds; LAS unsigned char* Vs = F.lds + 64 * W128_SB; LAS float* wts = (LAS float*)(F.lds + 2 * 64 * W128_SB); LAS float* gsc = wts + 64;
    const int t0 = c * ML_L; const size_t row0 = (size_t)b * SEQ + t0;
    __syncthreads();
    if (F.tid < 64) { const int s = F.tid; const float ip = bf2f(proj[(row0 + s) * PW + PC_MLIF + h]) + gateb[h], fp = bf2f(proj[(row0 + s) * PW + PC_MLIF + 4 + h]) + gateb[4 + h];
        gsc[s] = log_sigmoid(fp); gsc[64 + s] = ip; }
    __syncthreads();
    if (F.tid < 64) {
        float v = gsc[F.tid];
#pragma unroll
        for (int o = 1; o < 64; o <<= 1) { const float u = __shfl_up(v, o); if (F.lane >= o) v += u; }
        const float bL = __shfl(v, 63); const float li = gsc[64 + F.tid]; const float a = bL - v + li; const float amax = wave_max(a);
        wts[F.tid] = __expf(a - amax); mlb[(size_t)bh * SEQ + t0 + F.tid] = v; mlli[(size_t)bh * SEQ + t0 + F.tid] = li;
        if (F.tid == 0) { mlsc[unit * 2 + 0] = amax; mlsc[unit * 2 + 1] = bL; } }
    __syncthreads();
    { v4u xin[4][4]; v4u vin[2];
#pragma unroll
      for (int ii = 0; ii < 4; ++ii) { const int it = F.tid + ii * NTHREADS; const int ch8 = it & 15, s = (it >> 4) & 63, which = it >> 10; const int pcol = (which ? PC_MLK : PC_MLQ) + h * 128 + ch8 * 8;
#pragma unroll
          for (int wv = 0; wv < 4; ++wv) { const int tt = t0 + s - 3 + wv; xin[ii][wv] = (tt >= 0) ? *(const v4u*)(proj + ((size_t)b * SEQ + tt) * PW + pcol) : (v4u){0u, 0u, 0u, 0u}; } }
#pragma unroll
      for (int ii = 0; ii < 2; ++ii) { const int it = F.tid + ii * NTHREADS; const int ch8 = it & 15, s = it >> 4; vin[ii] = *(const v4u*)(proj + (row0 + s) * PW + PC_MLV + h * 128 + ch8 * 8); }
#pragma unroll
      for (int ii = 0; ii < 4; ++ii) { const int it = F.tid + ii * NTHREADS; const int ch8 = it & 15, s = (it >> 4) & 63, which = it >> 10;
        const int cch = which * 512 + h * 128 + ch8 * 8;
        float acc[8];
#pragma unroll
        for (int j = 0; j < 8; ++j) acc[j] = convb[cch + j];
#pragma unroll
        for (int wv = 0; wv < 4; ++wv) { const v4u x = xin[ii][wv];
            const f32x4 w0 = *(const f32x4*)(convw + wv * 1024 + cch), w1 = *(const f32x4*)(convw + wv * 1024 + cch + 4);
            acc[0] += bflo(x.x) * w0[0]; acc[1] += bfhi(x.x) * w0[1]; acc[2] += bflo(x.y) * w0[2]; acc[3] += bfhi(x.y) * w0[3];
            acc[4] += bflo(x.z) * w1[0]; acc[5] += bfhi(x.z) * w1[1]; acc[6] += bflo(x.w) * w1[2]; acc[7] += bfhi(x.w) * w1[3]; }
        const float sc = which ? 0.08838834764831845f : 1.0f;
#pragma unroll
        for (int j = 0; j < 8; ++j) acc[j] = siluf_(acc[j]) * sc;
        v4u o; o.x = pk2(acc[0], acc[1]); o.y = pk2(acc[2], acc[3]); o.z = pk2(acc[4], acc[5]); o.w = pk2(acc[6], acc[7]);
        *(v4u*)((which ? mlk : mlq) + (row0 + s) * 512 + h * 128 + ch8 * 8) = o;
        if (which) { const float ws = wts[s]; v4u kw; kw.x = pk2(acc[0] * ws, acc[1] * ws); kw.y = pk2(acc[2] * ws, acc[3] * ws); kw.z = pk2(acc[4] * ws, acc[5] * ws); kw.w = pk2(acc[6] * ws, acc[7] * ws);
            *(LAS v4u*)(KW + s * W128_SB + ch8 * 16) = kw; } }
#pragma unroll
      for (int ii = 0; ii < 2; ++ii) { const int it = F.tid + ii * NTHREADS; const int ch8 = it & 15, s = it >> 4; *(LAS v4u*)(Vs + s * W128_SB + ch8 * 16) = vin[ii]; } }
    __syncthreads();
    { const int lane = F.lane, gq = lane >> 4, w = F.wave;
      const bf16x8 a0 = tr_frag(KW, W128_SB, 8 * gq, 8 * gq + 4, 16 * w, lane), a1 = tr_frag(KW, W128_SB, 32 + 8 * gq, 32 + 8 * gq + 4, 16 * w, lane);
#pragma unroll
      for (int eb = 0; eb < 8; ++eb) { f32x4 acc = (f32x4){0.f, 0.f, 0.f, 0.f};
          acc = mfma16(a0, tr_frag(Vs, W128_SB, 8 * gq, 8 * gq + 4, 16 * eb, lane), acc); acc = mfma16(a1, tr_frag(Vs, W128_SB, 32 + 8 * gq, 32 + 8 * gq + 4, 16 * eb, lane), acc);
          v2u uw; uw.x = pk2(acc[0], acc[1]); uw.y = pk2(acc[2], acc[3]);        *(v2u*)(mlu + (size_t)(16 * eb + (lane & 15)) * ML_D + 16 * w + 4 * gq) = uw; } }
    if (F.tid < ML_D) { float a = 0.f;
#pragma unroll 8
        for (int s = 0; s < 64; ++s) a += bf2f(*(const LAS unsigned short*)(KW + s * W128_SB + F.tid * 2));
        mlun[F.tid] = a; }
}
__device__ __forceinline__ void ml_stage_b(Ctx& F, int unit) {
    const int sl = unit & 15, bh = unit >> 4;
    const float* mlsc = (const float*)(F.ws + WS_MLSC); float* mlm = (float*)(F.ws + WS_MLSC) + 4096;
    const bf16* mlu = (const bf16*)(F.ws + WS_MLU) + (size_t)bh * 64 * ML_D * ML_D; bf16* mlc = (bf16*)(F.ws + WS_MLC) + (size_t)bh * 64 * ML_D * ML_D;
    const float* mlun = (const float*)(F.ws + WS_MLUN) + (size_t)bh * 64 * ML_D; float* mln = (float*)(F.ws + WS_MLN) + (size_t)bh * 64 * ML_D;
    LAS float* dec = (LAS float*)F.lds; LAS float* scl = dec + 64; LAS float* am = scl + 64; LAS float* bl = am + 64;
    __syncthreads();
    if (F.tid < 64) { const pg8::f32x2 v = *(const pg8::f32x2*)(mlsc + (bh * 64 + F.tid) * 2); am[F.tid] = v.x; bl[F.tid] = v.y; }
    __syncthreads();
    if (F.tid == 0) { float m = 0.f;
        for (int c = 0; c < 64; ++c) { const float amax = am[c], bL = bl[c]; const float mn = fmaxf(bL + m, amax);
            dec[c] = __expf(bL + m - mn); scl[c] = __expf(amax - mn); if (sl == 0) mlm[bh * 64 + c] = m; m = mn; } }
    __syncthreads();
    { const int idx = sl * 1024 + F.tid * 2; float c0 = 0.f, c1 = 0.f;
#pragma unroll 1
      for (int cb = 0; cb < 64; cb += 16) { unsigned u[16];
#pragma unroll
          for (int i = 0; i < 16; ++i) u[i] = *(const unsigned*)(mlu + (size_t)(cb + i) * ML_D * ML_D + idx);
#pragma unroll
          for (int i = 0; i < 16; ++i) { *(unsigned*)(mlc + (size_t)(cb + i) * ML_D * ML_D + idx) = pk2(c0, c1);
              c0 = dec[cb + i] * c0 + scl[cb + i] * bflo(u[i]); c1 = dec[cb + i] * c1 + scl[cb + i] * bfhi(u[i]); } } }
    if (sl == 0 && F.tid < ML_D) { float n = 0.f;
#pragma unroll 1
        for (int cb = 0; cb < 64; cb += 8) { float u[8];
#pragma unroll
            for (int i = 0; i < 8; ++i) u[i] = mlun[(cb + i) * ML_D + F.tid];
#pragma unroll
            for (int i = 0; i < 8; ++i) { mln[(cb + i) * ML_D + F.tid] = n; n = dec[cb + i] * n + scl[cb + i] * u[i]; } } }
}
__device__ __forceinline__ void ml_stage_c(Ctx& F, int unit) {
    const int c = unit & 63, bh = unit >> 6, b = bh >> 2, h = bh & 3;
    const bf16* proj = (const bf16*)(F.ws + WS_PROJ); const bf16* mlq = (const bf16*)(F.ws + WS_MLQ); const bf16* mlk = (const bf16*)(F.ws + WS_MLKK);
    const float* mlb = (const float*)(F.ws + WS_MLB); const float* mlli = (const float*)(F.ws + WS_MLLI); const float* mlm = (const float*)(F.ws + WS_MLSC) + 4096;
    const bf16* mlc = (const bf16*)(F.ws + WS_MLC) + (size_t)unit * ML_D * ML_D; const float* mln = (const float*)(F.ws + WS_MLN) + (size_t)unit * ML_D;
    bf16* oml = (bf16*)(F.ws + WS_OML); const float* ng = F.in[I_MLNG];
    LAS unsigned char* Qs = F.lds; LAS unsigned char* Ks = Qs + 64 * W128_SB; LAS unsigned char* Vs = Ks + 64 * W128_SB; LAS unsigned char* Cs = Vs + 64 * W128_SB;
    LAS float* fb = (LAS float*)(Cs + 128 * W128_SB); LAS float* fli = fb + 64; LAS float* fn = fli + 64; LAS float* ssq = fn + 128;
    const int t0 = c * ML_L; const size_t row0 = (size_t)b * SEQ + t0;
    __syncthreads();
    for (int it = F.tid; it < 1024; it += NTHREADS) { const int ch8 = it & 15, s = it >> 4; const size_t go = (row0 + s) * 512 + h * 128 + ch8 * 8;
        *(LAS v4u*)(Qs + s * W128_SB + ch8 * 16) = *(const v4u*)(mlq + go); *(LAS v4u*)(Ks + s * W128_SB + ch8 * 16) = *(const v4u*)(mlk + go);
        *(LAS v4u*)(Vs + s * W128_SB + ch8 * 16) = *(const v4u*)(proj + (row0 + s) * PW + PC_MLV + h * 128 + ch8 * 8); }
    for (int it = F.tid; it < 2048; it += NTHREADS) { const int ch8 = it & 15, e = it >> 4; *(LAS v4u*)(Cs + e * W128_SB + ch8 * 16) = *(const v4u*)(mlc + e * ML_D + ch8 * 8); }
    if (F.tid < 64) { fb[F.tid] = mlb[(size_t)bh * SEQ + t0 + F.tid]; fli[F.tid] = mlli[(size_t)bh * SEQ + t0 + F.tid]; }
    if (F.tid < ML_D) fn[F.tid] = mln[F.tid];
    __syncthreads();
    const int lane = F.lane, gq = lane >> 4, w = F.wave, tb = w & 3, eh = w >> 2;
    const int t = 16 * tb + (lane & 15); const float mc = mlm[unit]; const float bt = fb[t];
    bf16x8 qf[4];
#pragma unroll
    for (int st = 0; st < 4; ++st) qf[st] = lds_row8(Qs, W128_SB, t, 32 * st + 8 * gq);
    f32x4 sT[4]; float dmax = NEG_BIG;
#pragma unroll
    for (int sb = 0; sb < 4; ++sb) { sT[sb] = (f32x4){0.f, 0.f, 0.f, 0.f};
        if (sb <= tb) {
#pragma unroll
            for (int st = 0; st < 4; ++st) sT[sb] = mfma16(lds_row8(Ks, W128_SB, 16 * sb + (lane & 15), 32 * st + 8 * gq), qf[st], sT[sb]);
#pragma unroll
            for (int r = 0; r < 4; ++r) { const int s = 16 * sb + 4 * gq + r; if (s <= t) dmax = fmaxf(dmax, bt - fb[s] + fli[s]); } } }
    dmax = grp_max(dmax);
    const float mt = fmaxf(bt + mc, dmax); const float iw = __expf(bt + mc - mt);
    float dsum = 0.f;
#pragma unroll
    for (int sb = 0; sb < 4; ++sb)
#pragma unroll
        for (int r = 0; r < 4; ++r) { const int s = 16 * sb + 4 * gq + r; const float p = (sb <= tb && s <= t) ? sT[sb][r] * __expf(bt - fb[s] + fli[s] - mt) : 0.f; sT[sb][r] = p; dsum += p; }
    dsum = grp_sum(dsum);
    float qn = 0.f;
#pragma unroll 8
    for (int dd = 0; dd < 32; ++dd) { const int d = gq * 32 + dd; qn += bf2f(*(const LAS unsigned short*)(Qs + t * W128_SB + d * 2)) * fn[d]; }
    qn = grp_sum(qn);
    const float den = dsum + iw * qn; const float rden = 1.0f / fmaxf(fabsf(den), __expf(-mt));
    const bf16x8 p0 = pack8(sT[0], sT[1]), p1 = pack8(sT[2], sT[3]);
    f32x4 hv[4]; float sq = 0.f;
#pragma unroll
    for (int ei = 0; ei < 4; ++ei) { const int eb = eh * 4 + ei;
        f32x4 intra = (f32x4){0.f, 0.f, 0.f, 0.f}, inter = (f32x4){0.f, 0.f, 0.f, 0.f};
        intra = mfma16(tr_frag(Vs, W128_SB, 4 * gq, 16 + 4 * gq, 16 * eb, lane), p0, intra);
        if (tb >= 2) intra = mfma16(tr_frag(Vs, W128_SB, 32 + 4 * gq, 48 + 4 * gq, 16 * eb, lane), p1, intra);
#pragma unroll
        for (int st = 0; st < 4; ++st) inter = mfma16(lds_row8(Cs, W128_SB, 16 * eb + (lane & 15), 32 * st + 8 * gq), qf[st], inter);
        hv[ei] = (intra + inter * iw) * rden; sq += (hv[ei][0] * hv[ei][0] + hv[ei][1] * hv[ei][1]) + (hv[ei][2] * hv[ei][2] + hv[ei][3] * hv[ei][3]); }
    sq = grp_sum(sq);
    if (gq == 0) ssq[eh * 64 + t] = sq;
    __syncthreads();
    const float rn = rsqrtf((ssq[t] + ssq[64 + t]) * (1.0f / ML_D) + NORM_EPS);
#pragma unroll
    for (int ei = 0; ei < 4; ++ei) { const int e0 = 16 * (eh * 4 + ei) + 4 * gq; const f32x4 gg = *(const f32x4*)(ng + h * 128 + e0);
        const v2u ow = *(const v2u*)(proj + (row0 + t) * PW + PC_MLO + h * 128 + e0);
        f32x4 v = hv[ei] * rn * gg; v[0] *= sigmoidf_(bflo(ow.x)); v[1] *= sigmoidf_(bfhi(ow.x)); v[2] *= sigmoidf_(bflo(ow.y)); v[3] *= sigmoidf_(bfhi(ow.y));
        v2u o; o.x = pg8::cvt_pk_bf16(v[0], v[1]); o.y = pg8::cvt_pk_bf16(v[2], v[3]); *(v2u*)(oml + (row0 + t) * 512 + h * 128 + e0) = o; }
}

#ifndef REPEAT_PHASE
#define REPEAT_PHASE -1
#endif
__device__ __forceinline__ void ph2(Ctx& F) {
    pg8::Gemm g{(const bf16*)(F.ws + WS_A1), (const bf16*)(F.ws + WS_WIN), T, PW, DM}; pg8::StaticOrder S; S.init(T, PW, F.G, (int)blockIdx.x);
    EpiStoreBf16 E{(bf16*)(F.ws + WS_PROJ), PW};
    pg8::gemm_phase<EpiStoreBf16, pg8::StaticOrder, true, true>(F.lds, g, S, E);
}
__device__ __forceinline__ void ph3(Ctx& F) {
    for (int u = F.vcu; u < 256; u += F.G) nsa_compress_unit(F, u);
    for (int u = F.vcu; u < ML_BH * ML_NCH; u += F.G) ml_stage_a(F, u);
}
__device__ __forceinline__ void ph4(Ctx& F) {
    for (int p = F.vcu; p < 256; p += F.G) { const int bg = p >> 5, x = p & 31; nsa_cmp_unit(F, bg, 63 - x); nsa_cmp_unit(F, bg, x); }
    for (int u = F.vcu; u < ML_BH * 16; u += F.G) ml_stage_b(F, u);
}
__device__ __forceinline__ void ph5(Ctx& F) {
    for (int p = F.vcu; p < 256; p += F.G) { const int bg = p >> 5, x = p & 31; nsa_selwin_unit(F, bg >> 1, bg & 1, x); nsa_selwin_unit(F, bg >> 1, bg & 1, 63 - x); }
    for (int u = F.vcu; u < ML_BH * ML_NCH; u += F.G) ml_stage_c(F, u);
}
struct UpOrder {
    pg8::StaticOrder so;
    __device__ __forceinline__ bool next(int i, Unit& u) const { if (!so.next(i >> 1, u)) return false; if (i & 1) { u.pm += T / 256; u.pn += DM / 256; } return true; }
    __device__ __forceinline__ void a_ready(const Unit&) const {}
    __device__ __forceinline__ void done(const Unit&) const {}
};
struct EpiUpBoth {
    static constexpr bool PERM = true, AFTER_DRAIN = false;
    bf16* U; const bf16* G;
    __device__ __forceinline__ void operator()(const f32x4 (&acc)[2][2][4][2], const Unit& u, int wr, int wc, int fr, int fq) const {
        if (u.pm < T / 256) { EpiUpGate<false> E{U, G, PC_MGA}; E(acc, u, wr, wc, fr, fq); }
        else { Unit v = u; v.pm -= T / 256; v.pn -= DM / 256; EpiUpGate<true> E{U, G, PC_MGB}; E(acc, v, wr, wc, fr, fq); }
    }
};
static_assert(WS_OML == WS_ONSA + (size_t)T * 512 * 2 && WS_WUPB == WS_WUPA + (size_t)DM * 512 * 2, "stacked operands of the up projection");
__device__ __forceinline__ void ph6(Ctx& F) {
    UpOrder S; S.so.init(T, DM, F.G, (int)blockIdx.x);
    pg8::Gemm g{(const bf16*)(F.ws + WS_ONSA), (const bf16*)(F.ws + WS_WUPA), 2 * T, 2 * DM, 512}; EpiUpBoth E{(bf16*)(F.ws + WS_U), (const bf16*)(F.ws + WS_PROJ)};
    pg8::gemm_phase<EpiUpBoth, UpOrder, true, true>(F.lds, g, S, E);
}
__device__ __forceinline__ void ph7(Ctx& F) {
    pg8::Gemm g{(const bf16*)(F.ws + WS_U), (const bf16*)(F.ws + WS_WOUT), T, DM, DM}; pg8::StaticOrder S; S.init(T, DM, F.G, (int)blockIdx.x);
    EpiOutRes E{F.in[I_X], (float*)(F.ws + WS_H1), (const float*)(F.ws + WS_MODF)};
    pg8::gemm_phase<EpiOutRes, pg8::StaticOrder, true, true>(F.lds, g, S, E);
}
__device__ __forceinline__ void ph10(Ctx& F) {
    pg8::Gemm g{(const bf16*)(F.ws + WS_A1), (const bf16*)(F.ws + WS_W1T), MOE_P, NEXP * 2048, DM};
    MoeOrder S{8, 3, F.G, F.vcu, F.ctl + CW_MOETAB, (const int*)(F.ws + WS_ROWT)};
    EpiMoe1 E{F.ws + WS_ACT, F.in[I_EB1]};
    pg8::gemm_phase<EpiMoe1, MoeOrder, true, true, true, true>(F.lds, g, S, E);
}
__device__ __forceinline__ void ph11(Ctx& F) {
    pg8::Gemm g{(const bf16*)(F.ws + WS_ACT), (const bf16*)(F.ws + WS_W2T), MOE_P, NEXP * DM, DE};
    MoeOrder S{4, 2, F.G, F.vcu, F.ctl + CW_MOETAB, nullptr};
    EpiMoe2 E{F.ws + WS_YR, F.in[I_EB2], (const float*)(F.ws + WS_ROWG)};
    pg8::gemm_phase<EpiMoe2, MoeOrder, true, true, true>(F.lds, g, S, E);
}
#ifndef TIME_PHASE
#define TIME_PHASE -1
#endif
#define RUN(k, call) do { unsigned long long t0_ = 0; if (TIME_PHASE == (k)) t0_ = __builtin_amdgcn_s_memrealtime(); call; SEAM(); \
    if (TIME_PHASE == (k)) { const unsigned long long n_ = __builtin_amdgcn_s_memrealtime(); const unsigned long long e_ = n_ + 4 * (n_ - t0_); while (__builtin_amdgcn_s_memrealtime() < e_) __builtin_amdgcn_s_sleep(8); SEAM(); } } while (0)
__global__ void __launch_bounds__(NTHREADS, 2) fwd_kernel(Args args) {
    extern __shared__ __attribute__((aligned(16))) unsigned char lds_raw[];
    Ctx F;
    F.lds = (LAS unsigned char*)lds_raw; F.ws = args.ws; F.ctl = (unsigned*)(args.ws + WS_CTL);
    F.tid = threadIdx.x; F.lane = F.tid & 63; F.wave = __builtin_amdgcn_readfirstlane(F.tid >> 6);
    F.G = gridDim.x; { const int bx = blockIdx.x; F.vcu = (F.G % 8 == 0) ? (bx % 8) * (F.G / 8) + bx / 8 : bx; }
    F.in = args.in; F.out = args.out;
    volatile LAS unsigned* MISC = (volatile LAS unsigned*)(F.lds + MISC_OFF);
    for (int u = F.tid; u < (LDS_BYTES - LDSCTL_OFF) / 4; u += NTHREADS) ((LAS unsigned*)(F.lds + LDSCTL_OFF))[u] = 0u;
    __syncthreads();
    XcdBarrier bar = xcd_barrier_post(F.ctl + CW_BAR, MISC + 8);
#define SEAM() xcd_barrier(bar)
    const float* modf = (const float*)(F.ws + WS_MODF);
    const float* H = (const float*)(F.ws + WS_H1);
    RUN(0, p0_prologue(F));
    RUN(1, p1_norm1(F));
    RUN(2, ph2(F));
    RUN(3, ph3(F));
    RUN(4, ph4(F));
    RUN(5, ph5(F));
    RUN(6, ph6(F));
    RUN(7, ph7(F));
    RUN(8, p8_norm2_router(F, H, modf));
    RUN(9, p9_permute(F));
    RUN(10, ph10(F));
    RUN(11, ph11(F));
    p_final<true>(F, H, modf);
#undef SEAM
}

extern "C" void kernel_launch(void* const* d_in, const int* in_sizes, int n_in, void* d_out, int out_size, void* d_ws, size_t ws_size, hipStream_t stream) {
    static int grid = 0;
    if (grid == 0) {
        if (n_in != 27 || in_sizes[0] != T * DM || out_size != T * DM || ws_size < WS_END) { fprintf(stderr, "kernel_launch: unexpected shapes (n_in %d, in0 %d, out %d, ws %zu)\n", n_in, n_in > 0 ? in_sizes[0] : -1, out_size, ws_size); grid = -1; return; }
        int dev = 0, cus = 0, per_cu = 0;
        if (hipGetDevice(&dev) != hipSuccess || hipDeviceGetAttribute(&cus, hipDeviceAttributeMultiprocessorCount, dev) != hipSuccess) { grid = -1; return; }
        if (hipFuncSetAttribute((const void*)fwd_kernel, hipFuncAttributeMaxDynamicSharedMemorySize, LDS_BYTES) != hipSuccess) { fprintf(stderr, "kernel_launch: hipFuncSetAttribute failed\n"); grid = -1; return; }
        if (hipOccupancyMaxActiveBlocksPerMultiprocessor(&per_cu, (const void*)fwd_kernel, NTHREADS, LDS_BYTES) != hipSuccess || per_cu < 1) fprintf(stderr, "kernel_launch: occupancy query reports %d\n", per_cu);
        (void)hipGetLastError();
        grid = cus;
    }
    if (grid < 0) return;
    if (hipMemsetAsync((char*)d_ws + WS_CTL, 0, CTL_ZERO_BYTES, stream) != hipSuccess) return;
    Args a{};
    for (int i = 0; i < 27; ++i) a.in[i] = (const float*)d_in[i];
    a.out = (float*)d_out; a.ws = (unsigned char*)d_ws;
    a.ph_lo = 0; a.ph_hi = 64;
    hipLaunchKernelGGL(fwd_kernel, dim3(grid), dim3(NTHREADS), LDS_BYTES, stream, a);
}
```

```cpp
#include <hip/hip_runtime.h>
#include <cstdio>
#include <cstdint>
namespace pg8 {
#define PG8_LAS __attribute__((address_space(3)))
typedef unsigned short bf16_t;
typedef short bf16x8 __attribute__((ext_vector_type(8)));
typedef float f32x4 __attribute__((ext_vector_type(4)));
typedef unsigned u32x4 __attribute__((ext_vector_type(4)));
constexpr int BM = 256, BK = 64, HALF = 128, HTB = HALF * BK * 2  , STAGE_BYTES = 8 * HTB, NXCD = 8, WGM = 8;

__host__ __device__ __forceinline__ int lds_byte(int r, int c) { const int st = (r >> 4) * 2 + (c >> 5), rr = r & 15, cc = c & 31, ob = rr * 64 + cc * 2; return st * 1024 + (ob ^ (((ob >> 9) & 1) << 5)); }
__host__ __device__ __forceinline__ void stage_rc(int b, int& R, int& C) { const int st = b / 1024, sb = b % 1024, swz = sb ^ (((sb >> 9) & 1) << 5); R = (st >> 1) * 16 + swz / 64; C = (st & 1) * 32 + (swz % 64) / 2; }
__host__ __device__ __forceinline__ int perm32(int rho) { const int n = rho >> 4, i = rho & 15; return 8 * (i >> 2) + 4 * n + (i & 3); }

struct Unit { int pm, pn, ix; };
struct Gemm { const bf16_t* A; const bf16_t* Bt; int M, N, K; };

struct StaticOrder {
    int nM, nN, nwg, G, c;
    __host__ __device__ void init(int M, int N, int G_, int c_) { nM = M / BM; nN = N / BM; nwg = nM * nN; G = G_; c = c_; }
    __host__ __device__ bool next(int i, Unit& u) const {
        const long L = (long)i * G + c; if (L >= nwg) return false;
        int wgid = (int)L; { const int q = nwg / NXCD, r = nwg % NXCD, xcd = wgid % NXCD, off = wgid / NXCD; wgid = (xcd < r ? xcd * (q + 1) : r * (q + 1) + (xcd - r) * q) + off; }
        const int nig = WGM * nN, gid = wgid / nig, fm = gid * WGM, gsz = (nM - fm) < WGM ? (nM - fm) : WGM;
        u.pm = fm + ((wgid % nig) % gsz); u.pn = (wgid % nig) / gsz; return true;
    }
    __device__ __forceinline__ void a_ready(const Unit&) const {}
    __device__ __forceinline__ void done(const Unit&) const {}
};

__device__ __forceinline__ unsigned cvt_pk_bf16(float lo, float hi) { unsigned r; asm volatile("v_cvt_pk_bf16_f32 %0, %1, %2" : "=v"(r) : "v"(lo), "v"(hi)); return r; }
typedef float f32x2 __attribute__((ext_vector_type(2)));
typedef int v8i32 __attribute__((ext_vector_type(8)));
typedef int v4i32 __attribute__((ext_vector_type(4)));
template <bool F8> struct FragT { typedef bf16x8 type; }; template <> struct FragT<true> { typedef v8i32 type; };
constexpr int F8_SCALE_A = 0x7F7F7F7F;
constexpr int F8_SCALE_B = 0x7A7A7A7A;
template <class Epi, class Sched, bool ALIGN_EPI = false, bool SP2 = false, bool F8 = false, bool GATHER = false>
__device__ __forceinline__ void gemm_phase(PG8_LAS unsigned char* lds, const Gemm g, const Sched& S, const Epi& E) {
    int tid_ = threadIdx.x; asm volatile("" : "+v"(tid_));
    const int tid = tid_, wid = __builtin_amdgcn_readfirstlane(tid >> 6), lane = tid & 63, wr = wid >> 2, wc = wid & 3, fr = lane & 15, fq = lane >> 4;
    const int K = g.K, nt = F8 ? K / (2 * BK) : K / BK; const int RB = F8 ? K : 2 * K;
    unsigned voffA[2], voffB[2];
#pragma unroll
    for (int i = 0; i < 2; ++i) { int R, C; stage_rc(tid * 16 + i * 8192, R, C); const int Rb = Epi::PERM ? ((R & ~31) + perm32(R & 31)) : R;
        voffA[i] = (unsigned)(R * RB + C * 2); voffB[i] = (unsigned)(Rb * RB + C * 2); }
    const size_t kstep = (size_t)(BK * 2);
    const size_t hstep = (size_t)HALF * RB;
    const size_t tstep = 2 * hstep;
    const unsigned ldsw = (unsigned)wid * 1024u;
    const int aoff = lds_byte(wr * 64 + fr, fq * 8), boff = lds_byte(wc * 32 + fr, fq * 8);
#define PG8_SA(b, h) (((b) * 2 + (h)) * HTB)
#define PG8_SB(b, h) ((4 + (b) * 2 + (h)) * HTB)
#define PG8_STAGE(bufoff, gbase, voff) do { _Pragma("unroll") for (int _i = 0; _i < 2; ++_i) \
        __builtin_amdgcn_global_load_lds((const unsigned*)((const char*)(gbase) + (voff)[_i]), (PG8_LAS unsigned*)(lds + (bufoff) + ldsw + _i * 8192), 16, 0, 0); } while (0)
#define PG8_GO1(ix, h_, i_) ((unsigned)rt[(ix) * BM + (h_) * HALF + (int)(voffA[i_] / (unsigned)RB)] * (unsigned)RB + voffA[i_] % (unsigned)RB)
#define PG8_STAGE_A(bufoff, gbase, h, nx) do { if constexpr (GATHER) { _Pragma("unroll") for (int _i = 0; _i < 2; ++_i) { const unsigned o_ = PG8_GO1((nx) ? nui : ui, h, _i); \
        __builtin_amdgcn_global_load_lds((const unsigned*)((const char*)(gbase) + o_), (PG8_LAS unsigned*)(lds + (bufoff) + ldsw + _i * 8192), 16, 0, 0); } } \
        else { PG8_STAGE(bufoff, (const char*)(gbase) + (h) * hstep, voffA); } } while (0)
#define PG8_GOFFS(v, ix) do { _Pragma("unroll") for (int h_ = 0; h_ < 2; ++h_) _Pragma("unroll") for (int i_ = 0; i_ < 2; ++i_) v[h_][i_] = PG8_GO1(ix, h_, i_); } while (0)
#define PG8_LD16(off) (*(const PG8_LAS v4i32*)(lds + (off)))
#define PG8_LDA(dst, b, h) do { _Pragma("unroll") for (int m = 0; m < 4; ++m) { if constexpr (F8) { const v4i32 lo_ = PG8_LD16(PG8_SA(b, h) + aoff + m * 2048), hi_ = PG8_LD16(PG8_SA(b, h) + aoff + m * 2048 + 1024); dst[m][0] = __builtin_shufflevector(lo_, hi_, 0, 1, 2, 3, 4, 5, 6, 7); } \
        else { _Pragma("unroll") for (int k = 0; k < NK; ++k) dst[m][k] = *(const PG8_LAS frag_t*)(lds + PG8_SA(b, h) + aoff + m * 2048 + k * 1024); } } } while (0)
#define PG8_LDB(dst, b, h) do { _Pragma("unroll") for (int n = 0; n < 2; ++n) { if constexpr (F8) { const v4i32 lo_ = PG8_LD16(PG8_SB(b, h) + boff + n * 2048), hi_ = PG8_LD16(PG8_SB(b, h) + boff + n * 2048 + 1024); dst[n][0] = __builtin_shufflevector(lo_, hi_, 0, 1, 2, 3, 4, 5, 6, 7); } \
        else { _Pragma("unroll") for (int k = 0; k < NK; ++k) dst[n][k] = *(const PG8_LAS frag_t*)(lds + PG8_SB(b, h) + boff + n * 2048 + k * 1024); } } } while (0)
#define PG8_MMA(ai, bj, At, Bt) do { __builtin_amdgcn_s_setprio(1); \
        if constexpr (F8) { _Pragma("unroll") for (int m = 0; m < 4; ++m) _Pragma("unroll") for (int n = 0; n < 2; ++n) \
            asm("v_mfma_scale_f32_16x16x128_f8f6f4 %0, %1, %2, %0, %3, %4 op_sel_hi:[0,0,0]" : "+v"(acc[ai][bj][m][n]) : "v"(Bt[n][0]), "v"(At[m][0]), "v"(f8sb), "v"(f8sa)); } \
        else { _Pragma("unroll") for (int m = 0; m < 4; ++m) _Pragma("unroll") for (int n = 0; n < 2; ++n) _Pragma("unroll") for (int k = 0; k < NK; ++k) \
            acc[ai][bj][m][n] = __builtin_amdgcn_mfma_f32_16x16x32_bf16(Bt[n][k], At[m][k], acc[ai][bj][m][n], 0, 0, 0); } \
        __builtin_amdgcn_s_setprio(0); } while (0)
#define PG8_WAIT_V(n) asm volatile("s_waitcnt vmcnt(" #n ")" ::: "memory")
#define PG8_WAIT_L(n) asm volatile("s_waitcnt lgkmcnt(" #n ")" ::: "memory")
#define PG8_BAR __builtin_amdgcn_s_barrier()
#define PG8_SCHED __builtin_amdgcn_sched_barrier(0)
    Unit cur, nxt; int ui = 0;
    if (!S.next(0, cur)) return;
    f32x4 acc[2][2][4][2];
#pragma unroll
    for (int a = 0; a < 2; ++a)
#pragma unroll
        for (int b = 0; b < 2; ++b)
#pragma unroll
            for (int m = 0; m < 4; ++m)
#pragma unroll
                for (int n = 0; n < 2; ++n) acc[a][b][m][n] = (f32x4){0.f, 0.f, 0.f, 0.f};
    typedef typename FragT<F8>::type frag_t; constexpr int NK = F8 ? 1 : 2;
    int f8sa = F8_SCALE_A, f8sb = F8_SCALE_B; if constexpr (F8) asm volatile("" : "+v"(f8sa), "+v"(f8sb));
    frag_t At[4][NK], B0[2][NK], B1[2][NK];
    const char* cA = (const char*)g.A + (GATHER ? (size_t)0 : (size_t)cur.pm * tstep); const char* cB = (const char*)g.Bt + (size_t)cur.pn * tstep;
    int nui = 0; PG8_LAS const unsigned short* rt = (PG8_LAS const unsigned short*)(lds + STAGE_BYTES);
    if constexpr (GATHER) {
        Unit tu; for (int i = 0; S.next(i, tu); ++i) if (tid < BM) ((PG8_LAS unsigned short*)(lds + STAGE_BYTES))[i * BM + tid] = (unsigned short)S.rowtok[tu.pm * BM + tid];
        __syncthreads();
    }
    S.a_ready(cur);
    if constexpr (SP2) {
        PG8_STAGE(PG8_SB(0, 0), cB, voffB); PG8_STAGE(PG8_SB(0, 1), cB + hstep, voffB); PG8_STAGE_A(PG8_SA(0, 0), cA, 0, false); PG8_STAGE_A(PG8_SA(0, 1), cA, 1, false);
        if (wr == 1) PG8_BAR;
        PG8_WAIT_V(2); PG8_BAR;
        PG8_STAGE(PG8_SB(1, 0), cB + kstep, voffB); PG8_STAGE_A(PG8_SA(1, 0), cA + kstep, 0, false); PG8_STAGE(PG8_SB(1, 1), cB + hstep + kstep, voffB);
        PG8_WAIT_V(6); PG8_BAR;
    } else {
        PG8_STAGE(PG8_SB(0, 0), cB, voffB); PG8_STAGE_A(PG8_SA(0, 0), cA, 0, false); PG8_STAGE(PG8_SB(0, 1), cB + hstep, voffB); PG8_STAGE_A(PG8_SA(0, 1), cA, 1, false);
        if (wr == 1) PG8_BAR;
        PG8_WAIT_V(4); PG8_BAR;
        PG8_STAGE(PG8_SB(1, 0), cB + kstep, voffB); PG8_STAGE_A(PG8_SA(1, 0), cA + kstep, 0, false); PG8_STAGE(PG8_SB(1, 1), cB + hstep + kstep, voffB);
        PG8_WAIT_V(6); PG8_BAR;
    }
    for (;;) {
        const bool has_next = S.next(ui + 1, nxt);
        const char* nA = (has_next && !GATHER) ? (const char*)g.A + (size_t)nxt.pm * tstep : cA; const char* nB = has_next ? (const char*)g.Bt + (size_t)nxt.pn * tstep : cB;
        nui = has_next ? ui + 1 : ui;
#pragma unroll 1
        for (int t = 0; t < nt; t += 2) {
            const bool last = (t == nt - 2);
            const char* a1 = cA + (size_t)(t + 1) * kstep;
            const char* a2 = last ? nA : cA + (size_t)(t + 2) * kstep; const char* b2 = last ? nB : cB + (size_t)(t + 2) * kstep;
            const char* a3 = a2 + kstep; const char* b3 = b2 + kstep;
            if (last && has_next) S.a_ready(nxt);
            if constexpr (SP2) {
            PG8_LDB(B0, 0, 0); PG8_LDB(B1, 0, 1); PG8_SCHED; PG8_LDA(At, 0, 0); PG8_STAGE_A(PG8_SA(1, 1), a1, 1, false);
            PG8_WAIT_V(8); PG8_WAIT_L(0); PG8_BAR; PG8_MMA(0, 0, At, B0); PG8_MMA(0, 1, At, B1); PG8_BAR; PG8_SCHED;
            PG8_LDA(At, 0, 1); PG8_STAGE(PG8_SB(0, 0), b2, voffB); PG8_STAGE(PG8_SB(0, 1), b2 + hstep, voffB); PG8_STAGE_A(PG8_SA(0, 0), a2, 0, last);
            PG8_WAIT_V(8); PG8_WAIT_L(0); PG8_BAR; PG8_MMA(1, 0, At, B0); PG8_MMA(1, 1, At, B1); PG8_BAR; PG8_SCHED;
            PG8_LDB(B0, 1, 0); PG8_LDB(B1, 1, 1); PG8_SCHED; PG8_LDA(At, 1, 0); PG8_STAGE_A(PG8_SA(0, 1), a2, 1, last);
            PG8_WAIT_V(8); PG8_WAIT_L(0); PG8_BAR; PG8_MMA(0, 0, At, B0); PG8_MMA(0, 1, At, B1); PG8_BAR; PG8_SCHED;
            PG8_LDA(At, 1, 1); PG8_STAGE(PG8_SB(1, 0), b3, voffB); PG8_STAGE(PG8_SB(1, 1), b3 + hstep, voffB); PG8_STAGE_A(PG8_SA(1, 0), a3, 0, last);
            PG8_WAIT_V(8); PG8_WAIT_L(0); PG8_BAR; PG8_MMA(1, 0, At, B0); PG8_MMA(1, 1, At, B1); PG8_BAR; PG8_SCHED;
            } else {
            PG8_LDB(B0, 0, 0); PG8_SCHED; PG8_LDA(At, 0, 0); PG8_STAGE_A(PG8_SA(1, 1), a1, 1, false);
            PG8_WAIT_L(8); PG8_BAR; PG8_WAIT_L(0); PG8_MMA(0, 0, At, B0); PG8_BAR; PG8_SCHED;
            PG8_LDB(B1, 0, 1); PG8_STAGE(PG8_SB(0, 0), b2, voffB);
            PG8_BAR; PG8_WAIT_L(0); PG8_MMA(0, 1, At, B1); PG8_BAR;
            PG8_LDA(At, 0, 1); PG8_STAGE_A(PG8_SA(0, 0), a2, 0, last);
            PG8_BAR; PG8_WAIT_L(0); PG8_MMA(1, 0, At, B0); PG8_BAR; PG8_SCHED;
            PG8_STAGE(PG8_SB(0, 1), b2 + hstep, voffB);
            PG8_WAIT_V(6); PG8_BAR; PG8_MMA(1, 1, At, B1); PG8_BAR;
            PG8_LDB(B0, 1, 0); PG8_SCHED; PG8_LDA(At, 1, 0); PG8_STAGE_A(PG8_SA(0, 1), a2, 1, last);
            PG8_WAIT_L(8); PG8_BAR; PG8_WAIT_L(0); PG8_MMA(0, 0, At, B0); PG8_BAR; PG8_SCHED;
            PG8_LDB(B1, 1, 1); PG8_STAGE(PG8_SB(1, 0), b3, voffB);
            PG8_BAR; PG8_WAIT_L(0); PG8_MMA(0, 1, At, B1); PG8_BAR;
            PG8_LDA(At, 1, 1); PG8_STAGE_A(PG8_SA(1, 0), a3, 0, last);
            PG8_BAR; PG8_WAIT_L(0); PG8_MMA(1, 0, At, B0); PG8_BAR; PG8_SCHED;
            PG8_STAGE(PG8_SB(1, 1), b3 + hstep, voffB);
            PG8_WAIT_V(6); PG8_BAR; PG8_MMA(1, 1, At, B1); PG8_BAR;
            }
        }
        if constexpr (F8) asm volatile("s_nop 15\n\ts_nop 7" ::: "memory");
        if constexpr (ALIGN_EPI) { if (wr == 0) PG8_BAR; }
        if constexpr (!Epi::AFTER_DRAIN) { E(acc, cur, wr, wc, fr, fq); S.done(cur); }
        if (!has_next) break;
#pragma unroll
        for (int a = 0; a < 2; ++a)
#pragma unroll
            for (int b = 0; b < 2; ++b)
#pragma unroll
                for (int m = 0; m < 4; ++m)
#pragma unroll
                    for (int n = 0; n < 2; ++n) acc[a][b][m][n] = (f32x4){0.f, 0.f, 0.f, 0.f};
        cur = nxt; cA = nA; cB = nB; ++ui;

        if constexpr (ALIGN_EPI) { if (wr == 1) PG8_BAR; }
    }
    PG8_WAIT_V(0);
    if constexpr (!ALIGN_EPI) { if (wr == 0) PG8_BAR; }
    PG8_BAR;
    if constexpr (Epi::AFTER_DRAIN) { E.fused(acc, cur, wr, wc, fr, fq, lds, wid, lane); S.done(cur); }
#undef PG8_SA
#undef PG8_SB
#undef PG8_STAGE
#undef PG8_LDA
#undef PG8_LDB
#undef PG8_LD16
#undef PG8_STAGE_A
#undef PG8_GOFFS
#undef PG8_GO1
#undef PG8_MMA
#undef PG8_WAIT_V
#undef PG8_WAIT_L
#undef PG8_BAR
#undef PG8_SCHED
}
}

constexpr int NWAVES = 8, NTHREADS = 512;
constexpr int BATCH = 4, SEQ = 4096, DM = 1024, T = BATCH * SEQ;
constexpr int INW = 5408, PW = 5632;
constexpr int NEXP = 32, TOPK = 4, DE = 1024, NASSIGN = T * TOPK, MOE_ROWS = 256;
constexpr int MOE_MAXTILES = (NASSIGN + NEXP * (MOE_ROWS - 1) + MOE_ROWS - 1) / MOE_ROWS;
constexpr int MOE_P = MOE_MAXTILES * MOE_ROWS;
constexpr float NORM_EPS = 1e-6f;
constexpr int PC_Q = 0, PC_KV = 512, PC_MLQ = 1280, PC_MLK = 1792, PC_MLV = 2304, PC_MLO = 2816, PC_MGA = 3328, PC_MGB = 4352, PC_NSAG = 5376, PC_MLIF = 5400;
constexpr int ADA_SLICES = 16, PB_SLICES = 16;

constexpr size_t MiB = 1u << 20;
constexpr size_t WS_CTL = 0, CTL_ZERO_BYTES = 1 * MiB;
constexpr size_t WS_MODP = 1 * MiB;
constexpr size_t WS_MODF = 3 * MiB;
constexpr size_t WS_PBP  = 3 * MiB + 512 * 1024;
constexpr size_t WS_WIN  = 4 * MiB;
constexpr size_t WS_WUPA = 16 * MiB, WS_WUPB = 17 * MiB;
constexpr size_t WS_WOUT = 18 * MiB;
constexpr size_t WS_CW1K = 20 * MiB, WS_CW1V = 20 * MiB + 512 * 1024;
constexpr size_t WS_CW2K = 21 * MiB, WS_CW2V = 21 * MiB + 64 * 1024;
constexpr size_t WS_KC = 22 * MiB, WS_VC = 22 * MiB + 512 * 1024;
constexpr size_t WS_SELM = 23 * MiB;
constexpr size_t WS_TOPI = 24 * MiB, WS_GATE = 24 * MiB + 256 * 1024, WS_DEST = 24 * MiB + 512 * 1024;
constexpr size_t WS_ROWT = 30 * MiB;
constexpr size_t WS_ROWG = 25 * MiB;
constexpr size_t WS_MLB = 26 * MiB, WS_MLLI = 26 * MiB + 256 * 1024;
constexpr size_t WS_RWHI = 25 * MiB + 512 * 1024, WS_RWLO = 25 * MiB + 768 * 1024;
constexpr size_t WS_MLSC = 27 * MiB;
constexpr size_t WS_MLUN = 28 * MiB, WS_MLN = 29 * MiB;
constexpr size_t WS_W1T = 32 * MiB;
constexpr size_t WS_WIN8 = 96 * MiB;
constexpr size_t WS_A1F8 = 674 * MiB;
constexpr size_t WS_W2T = 160 * MiB;
constexpr size_t WS_H1 = 224 * MiB;
constexpr size_t WS_A1 = 288 * MiB;
constexpr size_t WS_PROJ = 320 * MiB;
constexpr size_t WS_XG = 320 * MiB;
constexpr size_t WS_OCMP = 496 * MiB, WS_ONSA = 512 * MiB, WS_OML = 528 * MiB, WS_MLQ = 544 * MiB, WS_MLKK = 560 * MiB;
constexpr size_t WS_MLU = 576 * MiB;
constexpr size_t WS_MLC = 640 * MiB;
constexpr size_t WS_U = 674 * MiB;
constexpr size_t WS_ACT = 496 * MiB;
constexpr size_t WS_YR = 640 * MiB;
constexpr size_t WS_END = 784 * MiB;
constexpr int CW_BAR = 4096;
constexpr int CW_ECNT = 16384;
constexpr int CW_EFILL = 16384 + 64 * 32;
constexpr int CW_MOETAB = 32768;

constexpr int RING_BYTES = 131072;
constexpr int LDSCTL_OFF = 146432, MISC_OFF = LDSCTL_OFF + 320;
constexpr int LDS_BYTES = 147456;

#define GAS __attribute__((address_space(1)))
#define LAS __attribute__((address_space(3)))
typedef unsigned short bf16;
typedef unsigned v4u __attribute__((ext_vector_type(4)));
typedef unsigned v2u __attribute__((ext_vector_type(2)));
typedef float f32x4 __attribute__((ext_vector_type(4)));
typedef short bf16x8 __attribute__((ext_vector_type(8)));
typedef short s16x4 __attribute__((ext_vector_type(4)));
#define LDS_WAIT() asm volatile("s_waitcnt lgkmcnt(0)" ::: "memory")
#define VM_WAIT() asm volatile("s_waitcnt vmcnt(0)" ::: "memory")
__device__ __forceinline__ unsigned f2bf(float f) { unsigned u = __builtin_bit_cast(unsigned, f); return (u + 0x7fffu + ((u >> 16) & 1u)) >> 16; }
__device__ __forceinline__ unsigned pk2(float lo, float hi) { return f2bf(lo) | (f2bf(hi) << 16); }
__device__ __forceinline__ unsigned pk4_fp8(float a, float b, float c, float d) { int w = __builtin_amdgcn_cvt_pk_fp8_f32(a, b, 0, false); w = __builtin_amdgcn_cvt_pk_fp8_f32(c, d, w, true); return (unsigned)w; }
__device__ __forceinline__ float bf2f(unsigned short b) { return __builtin_bit_cast(float, (unsigned)b << 16); }
__device__ __forceinline__ float bflo(unsigned w) { return __builtin_bit_cast(float, w << 16); }
__device__ __forceinline__ float bfhi(unsigned w) { return __builtin_bit_cast(float, w & 0xffff0000u); }
__device__ __forceinline__ float sigmoidf_(float x) { return __builtin_amdgcn_rcpf(1.0f + __builtin_amdgcn_exp2f(x * -1.4426950408889634f)); }
__device__ __forceinline__ float wave_sum(float v) {
#pragma unroll
    for (int o = 1; o < 64; o <<= 1) v += __shfl_xor(v, o);
    return v;
}
__device__ __forceinline__ float wave_max(float v) {
#pragma unroll
    for (int o = 1; o < 64; o <<= 1) v = fmaxf(v, __shfl_xor(v, o));
    return v;
}
#define XB_TMO      128
#define XB_XCNT(j)  (256  + 64 * (j))
#define XB_XSUB(j)  (1280 + 64 * (j))
#define XB_XGEN(j)  (2304 + 64 * (j))
#define XB_TOP      3328
#define XB_TOPGEN   3392
#define XCD_BAR_WORDS 3456
#define XB_SPIN_CAP (1u << 18)

__device__ __forceinline__ unsigned xb_ld(unsigned* p)              { return __hip_atomic_load(p, __ATOMIC_RELAXED, __HIP_MEMORY_SCOPE_AGENT); }
__device__ __forceinline__ unsigned xb_add(unsigned* p, unsigned v) { return __hip_atomic_fetch_add(p, v, __ATOMIC_RELAXED, __HIP_MEMORY_SCOPE_AGENT); }
__device__ __forceinline__ unsigned xb_xcc_id() { return (unsigned)__builtin_amdgcn_s_getreg((3 << 11) | 20) & 0xFu; }
#define XB_SPIN(cond, bar) do { unsigned _sp = 0; while (cond) { __builtin_amdgcn_s_sleep(1); \
    if ((++_sp & 255u) == 0u) { if (xb_ld(&(bar)[XB_TMO])) break; if (_sp > XB_SPIN_CAP) { atomicAdd(&(bar)[XB_TMO], 1u); break; } } } } while (0)

struct XcdBarrier {
    unsigned* bar; unsigned x;
    volatile LAS unsigned* st;
};

__device__ __forceinline__ XcdBarrier xcd_barrier_post(unsigned* bar, volatile LAS unsigned* st) {
    XcdBarrier b; b.bar = bar; b.x = xb_xcc_id(); b.st = st;
    if (threadIdx.x == 0) (void)xb_add(&bar[XB_XCNT(b.x)], 1u);
    return b;
}
__device__ __forceinline__ void xcd_barrier_complete(unsigned* bar, unsigned x, unsigned& nloc, unsigned& nx) {
    const unsigned G = gridDim.x * gridDim.y * gridDim.z;
    unsigned sum, cnt, mine, sp = 0u;
    for (;;) {
        sum = 0u; cnt = 0u; mine = 0u;
#pragma unroll
        for (unsigned j = 0; j < 16; ++j) { const unsigned c = xb_ld(&bar[XB_XCNT(j)]); sum += c; cnt += (c > 0u) ? 1u : 0u; mine = (j == x) ? c : mine; }
        if (sum == G) break;
        __builtin_amdgcn_s_sleep(1);
        if ((++sp & 255u) == 0u) { if (xb_ld(&bar[XB_TMO])) break; if (sp > XB_SPIN_CAP) { atomicAdd(&bar[XB_TMO], 1u); break; } }
    }
    nloc = mine > 0u ? mine : 1u; nx = cnt > 0u ? cnt : 1u;
}

__device__ __forceinline__ void xcd_barrier(const XcdBarrier& b) {
    asm volatile("s_waitcnt vmcnt(0)" ::: "memory");
    __syncthreads();
    if (threadIdx.x == 0) {
        unsigned* bar = b.bar;
        __builtin_amdgcn_s_waitcnt(0);
        unsigned nloc = b.st[0], nx = b.st[1];
        if (nloc == 0u) { xcd_barrier_complete(bar, b.x, nloc, nx); b.st[0] = nloc; b.st[1] = nx; }
        const unsigned old = xb_add(&bar[XB_XSUB(b.x)], 1u);
        const unsigned gen = old / nloc;
        if (old + 1u == (gen + 1u) * nloc) {
            __builtin_amdgcn_fence(__ATOMIC_RELEASE, "agent");
            asm volatile("s_waitcnt vmcnt(0)" ::: "memory");
            const unsigned og = xb_add(&bar[XB_TOP], 1u);
            const unsigned tg = og / nx;
            if (og + 1u == (tg + 1u) * nx) xb_add(&bar[XB_TOPGEN], 1u);
            else XB_SPIN(xb_ld(&bar[XB_TOPGEN]) == tg, bar);
            __builtin_amdgcn_fence(__ATOMIC_ACQUIRE, "agent");
            xb_add(&bar[XB_XGEN(b.x)], 1u);
            asm volatile("s_waitcnt vmcnt(0)" ::: "memory");
        } else {
            XB_SPIN(xb_ld(&bar[XB_XGEN(b.x)]) == gen, bar);
            __builtin_amdgcn_fence(__ATOMIC_ACQUIRE, "agent");
            asm volatile("s_waitcnt vmcnt(0)" ::: "memory");
        }
    }
    __syncthreads();
}

using pg8::Unit; using pg8::HALF; using pg8::BM;
struct EpiStoreBf16 {
    static constexpr bool PERM = true, AFTER_DRAIN = false;
    bf16* O; int ldc;
    __device__ __forceinline__ void operator()(const f32x4 (&acc)[2][2][4][2], const Unit& u, int wr, int wc, int fr, int fq) const {
        const int row0 = u.pm * BM + wr * 64 + fr, col0 = u.pn * BM + wc * 32 + 8 * fq;
#pragma unroll
        for (int ai = 0; ai < 2; ++ai)
#pragma unroll
            for (int m = 0; m < 4; ++m) { bf16* rowp = O + (size_t)(row0 + ai * HALF + m * 16) * ldc + col0;
#pragma unroll
                for (int bj = 0; bj < 2; ++bj) { const f32x4 v0 = acc[ai][bj][m][0], v1 = acc[ai][bj][m][1];
                    v4u w; w.x = pg8::cvt_pk_bf16(v0[0], v0[1]); w.y = pg8::cvt_pk_bf16(v0[2], v0[3]); w.z = pg8::cvt_pk_bf16(v1[0], v1[1]); w.w = pg8::cvt_pk_bf16(v1[2], v1[3]);
                    *(v4u*)(rowp + bj * HALF) = w; } }
    }
};
template <bool ADD> struct EpiUpGate {
    static constexpr bool PERM = true, AFTER_DRAIN = false;
    bf16* U; const bf16* G; int goff;
    __device__ __forceinline__ void operator()(const f32x4 (&acc)[2][2][4][2], const Unit& u, int wr, int wc, int fr, int fq) const {
        const int row0 = u.pm * BM + wr * 64 + fr, col0 = u.pn * BM + wc * 32 + 8 * fq;
#pragma unroll
        for (int ai = 0; ai < 2; ++ai)
#pragma unroll
            for (int m = 0; m < 4; ++m) { const size_t row = (size_t)(row0 + ai * HALF + m * 16);
#pragma unroll
                for (int bj = 0; bj < 2; ++bj) { const int col = col0 + bj * HALF;
                    const v4u gw = *(const v4u*)(G + row * PW + goff + col);
                    f32x4 v0 = acc[ai][bj][m][0], v1 = acc[ai][bj][m][1];
                    v0[0] *= sigmoidf_(bflo(gw.x)); v0[1] *= sigmoidf_(bfhi(gw.x)); v0[2] *= sigmoidf_(bflo(gw.y)); v0[3] *= sigmoidf_(bfhi(gw.y));
                    v1[0] *= sigmoidf_(bflo(gw.z)); v1[1] *= sigmoidf_(bfhi(gw.z)); v1[2] *= sigmoidf_(bflo(gw.w)); v1[3] *= sigmoidf_(bfhi(gw.w));
                    if (ADD) { const v4u uw = *(const v4u*)(U + row * DM + col);
                        v0[0] += bflo(uw.x); v0[1] += bfhi(uw.x); v0[2] += bflo(uw.y); v0[3] += bfhi(uw.y); v1[0] += bflo(uw.z); v1[1] += bfhi(uw.z); v1[2] += bflo(uw.w); v1[3] += bfhi(uw.w); }
                    v4u w; w.x = pg8::cvt_pk_bf16(v0[0], v0[1]); w.y = pg8::cvt_pk_bf16(v0[2], v0[3]); w.z = pg8::cvt_pk_bf16(v1[0], v1[1]); w.w = pg8::cvt_pk_bf16(v1[2], v1[3]);
                    *(v4u*)(U + row * DM + col) = w; } }
    }
};
struct EpiOutRes {
    static constexpr bool PERM = true, AFTER_DRAIN = false;
    const float* X; bf16* H; const float* modf;
    __device__ __forceinline__ void operator()(const f32x4 (&acc)[2][2][4][2], const Unit& u, int wr, int wc, int fr, int fq) const {
        const int row0 = u.pm * BM + wr * 64 + fr, col0 = u.pn * BM + wc * 32 + 8 * fq;
        const int b = (u.pm * BM) / SEQ; const float* gt = modf + (size_t)b * 6 * DM + 2 * DM;
        f32x4 gv[2][2];
#pragma unroll
        for (int bj = 0; bj < 2; ++bj)
#pragma unroll
            for (int n = 0; n < 2; ++n) gv[bj][n] = *(const f32x4*)(gt + col0 + bj * HALF + 4 * n) + 1.0f;
#pragma unroll
        for (int ai = 0; ai < 2; ++ai)
#pragma unroll
            for (int m = 0; m < 4; ++m) { const size_t off = (size_t)(row0 + ai * HALF + m * 16) * DM + col0;
#pragma unroll
                for (int bj = 0; bj < 2; ++bj) { const f32x4 x0 = *(const f32x4*)(X + off + bj * HALF), x1 = *(const f32x4*)(X + off + bj * HALF + 4);
                    const f32x4 v0 = x0 + gv[bj][0] * acc[ai][bj][m][0], v1 = x1 + gv[bj][1] * acc[ai][bj][m][1];
                    v4u w; w.x = pk2(v0[0], v0[1]); w.y = pk2(v0[2], v0[3]); w.z = pk2(v1[0], v1[1]); w.w = pk2(v1[2], v1[3]);
                    *(v4u*)(H + off + bj * HALF) = w; } }
    }
};
struct EpiMoe1 {
    static constexpr bool PERM = true, AFTER_DRAIN = false;
    unsigned char* ACT; const LAS float* bt;
    __device__ __forceinline__ void operator()(const f32x4 (&acc)[2][2][4][2], const Unit& u, int wr, int wc, int fr, int fq) const {
        const int e = u.pn >> 3, pnl = u.pn & 7;
        const int row0 = u.pm * BM + wr * 64 + fr, c0 = pnl * 128 + wc * 32 + 8 * fq;
        const LAS float* bg = bt + u.ix * 256 + wc * 32 + 8 * fq; const LAS float* bl = bg + 128; (void)e;
        const f32x4 bg0 = *(const LAS f32x4*)bg, bg1 = *(const LAS f32x4*)(bg + 4), bl0 = *(const LAS f32x4*)bl, bl1 = *(const LAS f32x4*)(bl + 4);
#pragma unroll
        for (int ai = 0; ai < 2; ++ai)
#pragma unroll
            for (int m = 0; m < 4; ++m) { unsigned char* rowp = ACT + (size_t)(row0 + ai * HALF + m * 16) * DE + c0;
                float o[8];
#pragma unroll
                for (int n = 0; n < 2; ++n) { const f32x4 g = acc[ai][0][m][n] + (n ? bg1 : bg0), l = acc[ai][1][m][n] + (n ? bl1 : bl0);
#pragma unroll
                    for (int i = 0; i < 4; ++i) { const float gg = fminf(g[i], 7.0f), ll = fminf(fmaxf(l[i], -7.0f), 7.0f);
                        o[n * 4 + i] = gg * sigmoidf_(1.702f * gg) * (ll + 1.0f); } }
                v2u w; w.x = pk4_fp8(o[0], o[1], o[2], o[3]); w.y = pk4_fp8(o[4], o[5], o[6], o[7]);
                *(v2u*)rowp = w; }
    }
};
struct EpiMoe2 {
    static constexpr bool PERM = true, AFTER_DRAIN = false;
    unsigned char* Y; const LAS float* bt;
    __device__ __forceinline__ void operator()(const f32x4 (&acc)[2][2][4][2], const Unit& u, int wr, int wc, int fr, int fq) const {
        const int pnl = u.pn & 3;
        const int row0 = u.pm * BM + wr * 64 + fr, col0 = pnl * BM + wc * 32 + 8 * fq;
        f32x4 bv[2][2];
#pragma unroll
        for (int bj = 0; bj < 2; ++bj)
#pragma unroll
            for (int n = 0; n < 2; ++n) bv[bj][n] = *(const LAS f32x4*)(bt + u.ix * 512 + wc * 32 + 8 * fq + bj * HALF + 4 * n);
#pragma unroll
        for (int ai = 0; ai < 2; ++ai)
#pragma unroll
            for (int m = 0; m < 4; ++m) { const int row = row0 + ai * HALF + m * 16; const float g = bt[u.ix * 512 + 256 + wr * 64 + fr + ai * HALF + m * 16] * 16.0f; unsigned char* rowp = Y + (size_t)row * DM + col0;
#pragma unroll
                for (int bj = 0; bj < 2; ++bj) { const f32x4 v0 = (acc[ai][bj][m][0] + bv[bj][0]) * g, v1 = (acc[ai][bj][m][1] + bv[bj][1]) * g;
                    v2u w; w.x = pk4_fp8(v0[0], v0[1], v0[2], v0[3]); w.y = pk4_fp8(v1[0], v1[1], v1[2], v1[3]);
                    *(v2u*)(rowp + bj * HALF) = w; } }
    }
};
constexpr int MOE_UL_OFF = 145408;
struct MoeOrder {
    const LAS int* ul; const int* rowtok;
    __device__ __forceinline__ bool next(int i, Unit& u) const { const int pm = ul[2 * i]; if (pm < 0) return false; u.pm = pm; u.pn = ul[2 * i + 1]; u.ix = i; return true; }
    __device__ __forceinline__ void a_ready(const Unit&) const {}
    __device__ __forceinline__ void done(const Unit&) const {}
};
constexpr int MOE_BT1_OFF = 135680, MOE_BT2_OFF = 131072;
template <int WHICH> __device__ __forceinline__ void moe_units_to_lds(LAS unsigned char* lds, const unsigned* tab, int nN, int sh, int G, int v, const float* bias, const float* rg) {
    LAS int* ul = (LAS int*)(lds + MOE_UL_OFF);
    __syncthreads();
    if (threadIdx.x < 16) { const int i = threadIdx.x; const int ntl = (int)tab[0]; const long L = (long)i * G + v; int pm = -1, pn = 0;
        if (L < (long)ntl * nN) { pm = (int)(L >> sh); const int e = (int)tab[64 + pm]; pn = e * nN + (int)(L & (nN - 1)); }
        ul[2 * i] = pm; ul[2 * i + 1] = pn; }
    __syncthreads();
    { float val[9]; const int t = threadIdx.x;
#pragma unroll
      for (int i = 0; i < 9; ++i) { const int pm = ul[2 * i], pn = ul[2 * i + 1]; val[i] = 0.f;
          if (pm >= 0) { if (WHICH == 1) { if (t < 256) { const int e = pn >> 3, pnl = pn & 7; val[i] = bias[(size_t)e * 2048 + (t < 128 ? 128 * pnl + t : 1024 + 128 * pnl + (t - 128))]; } }
                         else { const int e = pn >> 2, pnl = pn & 3; val[i] = t < 256 ? bias[(size_t)e * DM + 256 * pnl + t] : rg[(size_t)pm * 256 + (t - 256)]; } } }
#pragma unroll
      for (int i = 0; i < 9; ++i) { if (WHICH == 1) { if (t < 256) ((LAS float*)(lds + MOE_BT1_OFF))[i * 256 + t] = val[i]; } else if (i < 5) ((LAS float*)(lds + MOE_BT2_OFF))[i * 512 + t] = val[i]; } }
    __syncthreads();
}

struct Args { const float* in[27]; float* out; unsigned char* ws; int ph_lo, ph_hi; };
struct Ctx {
    LAS unsigned char* lds; unsigned char* ws; unsigned* ctl;
    int tid, lane, wave, vcu, G;
    const float* const* in; float* out;
};
enum { I_X = 0, I_C, I_ADAW, I_ADAB, I_N1G, I_WIN, I_PEK, I_PEV, I_CW1K, I_CW2K, I_CW1V, I_CW2V, I_CONVW, I_CONVB, I_GATEB, I_MLNG, I_WUPA, I_WUPB, I_WOUT, I_N2G, I_RW, I_RB, I_EW1, I_EB1, I_EW2, I_EB2, I_FG };

template <class DMap>
__device__ __forceinline__ void p0_transpose_item(const float* W, int K, int N, bf16* WT, const DMap& dmap, LAS float* scr, int item, int lane) {
    const int nblk = N / 32, kb = item / nblk, nb = item % nblk, k0 = 64 * kb, n0 = 32 * nb;
    float tmp[16];
#pragma unroll
    for (int hh = 0; hh < 2; ++hh) {
#pragma unroll
    for (int i = 0; i < 16; ++i) tmp[i] = W[(size_t)(k0 + 2 * (16 * hh + i) + (lane >> 5)) * N + n0 + (lane & 31)];
#pragma unroll
    for (int i = 0; i < 16; ++i) scr[(2 * (16 * hh + i) + (lane >> 5)) * 33 + (lane & 31)] = tmp[i]; }
    LDS_WAIT(); asm volatile("" ::: "memory");
    const int c = lane & 7;
#pragma unroll
    for (int j = 0; j < 4; ++j) { const int n = (lane >> 3) + 8 * j; const LAS float* s = scr + (8 * c) * 33 + n;
        v4u o; o.x = pk2(s[0 * 33], s[1 * 33]); o.y = pk2(s[2 * 33], s[3 * 33]); o.z = pk2(s[4 * 33], s[5 * 33]); o.w = pk2(s[6 * 33], s[7 * 33]);
        *(GAS v4u*)(WT + (size_t)dmap(n0 + n) * K + k0 + 8 * c) = o; }
    LDS_WAIT(); asm volatile("" ::: "memory");
}
struct DMapId { __device__ __forceinline__ int operator()(int n) const { return n; } };
struct DMapWin { __device__ __forceinline__ int operator()(int n) const {
    if (n < 1280) return n;
    if (n < 1304) return PC_NSAG + (n - 1280);
    if (n < 2328) return PC_MLQ + (n - 1304);
    if (n < 2840) return PC_MLV + (n - 2328);
    if (n < 2848) return PC_MLIF + (n - 2840);
    if (n < 3360) return PC_MLO + (n - 2848);
    return PC_MGA + (n - 3360); } };
struct DMapW1 { __device__ __forceinline__ int operator()(int n) const { return n < 1024 ? ((n >> 7) << 8) + (n & 127) : (((n - 1024) >> 7) << 8) + 128 + (n & 127); } };

constexpr int MOE_I1 = (DM / 128) * (2048 / 256), MOE_I2 = (DE / 128) * (DM / 256), MOE_ITEMS = NEXP * (MOE_I1 + MOE_I2);
struct MoeItem { const float* src; unsigned char* dst; int N; bool w1; };
__device__ __forceinline__ MoeItem moe_item(const Ctx& F, int it) {
    MoeItem m;
    if (it < NEXP * MOE_I1) { const int e = it / MOE_I1, l = it % MOE_I1, kb = l >> 3, nb = l & 7; m.w1 = true; m.N = 2048 | (nb << 16);
        m.src = F.in[I_EW1] + (size_t)e * DM * 2048 + (size_t)(128 * kb) * 2048 + 256 * nb; m.dst = F.ws + WS_W1T + (size_t)e * 2048 * DM + 128 * kb; }
    else { const int r = it - NEXP * MOE_I1, e = r / MOE_I2, l = r % MOE_I2, kb = l >> 2, nb = l & 3; m.w1 = false; m.N = DM | (nb << 16);
        m.src = F.in[I_EW2] + (size_t)e * DE * DM + (size_t)(128 * kb) * DM + 256 * nb; m.dst = F.ws + WS_W2T + (size_t)e * DM * DE + 128 * kb; }
    return m;
}
__device__ __forceinline__ void moe_convert(Ctx& F, int first, int stride) {
    LAS float* tile = (LAS float*)F.lds; const int wave = F.wave, lane = F.lane;
    f32x4 cur[16], nxt[16];
    if (first >= MOE_ITEMS) return;
    { const MoeItem m = moe_item(F, first); const int N = m.N & 0xffff;
#pragma unroll
      for (int i = 0; i < 16; ++i) cur[i] = *(const f32x4*)(m.src + (size_t)(16 * wave + i) * N + 4 * lane); }
#pragma unroll 1
    for (int it = first; it < MOE_ITEMS; it += stride) {
        const MoeItem m = moe_item(F, it); const int nb = m.N >> 16;
        const bool has_next = it + stride < MOE_ITEMS;
        if (has_next) { const MoeItem q = moe_item(F, it + stride); const int N = q.N & 0xffff;
#pragma unroll
            for (int i = 0; i < 16; ++i) nxt[i] = *(const f32x4*)(q.src + (size_t)(16 * wave + i) * N + 4 * lane); }
        __syncthreads();
#pragma unroll
        for (int i = 0; i < 16; ++i) *(LAS f32x4*)(tile + (16 * wave + i) * 260 + 4 * lane) = cur[i] * 32.0f;
        __syncthreads();
        const int n = 32 * wave + (lane >> 1), kh = (lane & 1) * 64; const LAS float* s = tile + kh * 260 + n;
        const int ng = 256 * nb + n; const int drow = m.w1 ? DMapW1()(ng) : ng;
        unsigned char* dst = m.dst + (size_t)drow * DM + kh;
#pragma unroll
        for (int i = 0; i < 4; ++i) { v4u o;
            o.x = pk4_fp8(s[(16 * i + 0) * 260], s[(16 * i + 1) * 260], s[(16 * i + 2) * 260], s[(16 * i + 3) * 260]); o.y = pk4_fp8(s[(16 * i + 4) * 260], s[(16 * i + 5) * 260], s[(16 * i + 6) * 260], s[(16 * i + 7) * 260]);
            o.z = pk4_fp8(s[(16 * i + 8) * 260], s[(16 * i + 9) * 260], s[(16 * i + 10) * 260], s[(16 * i + 11) * 260]); o.w = pk4_fp8(s[(16 * i + 12) * 260], s[(16 * i + 13) * 260], s[(16 * i + 14) * 260], s[(16 * i + 15) * 260]);
            *(GAS v4u*)(dst + 16 * i) = o; }
        if (has_next) {
#pragma unroll
            for (int i = 0; i < 16; ++i) cur[i] = nxt[i]; }
    }
    __syncthreads();
}
template <class DMap>
__device__ __forceinline__ void p0_transpose_item_f8(const float* W, int K, int N, unsigned char* WT, const DMap& dmap, LAS float* scr, int item, int lane) {
    const int nblk = N / 32, kb = item / nblk, nb = item % nblk, k0 = 128 * kb, n0 = 32 * nb;
    const int lr = lane >> 3, c4 = lane & 7;
    f32x4 tmp[16];
#pragma unroll
    for (int i = 0; i < 16; ++i) tmp[i] = *(const f32x4*)(W + (size_t)(k0 + 8 * i + lr) * N + n0 + 4 * c4);
    const int n = lane >> 1, kq = (lane & 1) * 32;
    unsigned char* dst = WT + (size_t)dmap(n0 + n) * K + k0 + kq;
#pragma unroll
    for (int hh = 0; hh < 2; ++hh) {
#pragma unroll
        for (int i = 0; i < 8; ++i) *(LAS f32x4*)(scr + (8 * i + lr) * 36 + 4 * c4) = tmp[8 * hh + i] * 32.0f;
        LDS_WAIT(); asm volatile("" ::: "memory");
        const LAS float* s = scr + kq * 36 + n;
#pragma unroll
        for (int i = 0; i < 2; ++i) { v4u o;
            o.x = pk4_fp8(s[(16 * i + 0) * 36], s[(16 * i + 1) * 36], s[(16 * i + 2) * 36], s[(16 * i + 3) * 36]); o.y = pk4_fp8(s[(16 * i + 4) * 36], s[(16 * i + 5) * 36], s[(16 * i + 6) * 36], s[(16 * i + 7) * 36]);
            o.z = pk4_fp8(s[(16 * i + 8) * 36], s[(16 * i + 9) * 36], s[(16 * i + 10) * 36], s[(16 * i + 11) * 36]); o.w = pk4_fp8(s[(16 * i + 12) * 36], s[(16 * i + 13) * 36], s[(16 * i + 14) * 36], s[(16 * i + 15) * 36]);
            *(GAS v4u*)(dst + 64 * hh + 16 * i) = o; }
        LDS_WAIT(); asm volatile("" ::: "memory");
    }
}
__device__ __forceinline__ void p0_prologue(Ctx& F) {
    LAS float* scr = (LAS float*)(F.lds + F.wave * 16896);
    const int gw = F.vcu * NWAVES + F.wave, NGW = F.G * NWAVES;
    constexpr int I_IN = (DM / 64) * (INW / 32), I_UP = (512 / 64) * (DM / 32), I_OUT = (DM / 64) * (DM / 32), I_C1 = (2048 / 64) * (128 / 32), I_C2 = (128 / 64) * (64 / 32);
    constexpr int NITEMS = I_IN + 2 * I_UP + I_OUT + 2 * I_C1 + 2 * I_C2;
    for (int it = gw; it < NITEMS; it += NGW) {
        int r = it;
        if (r < I_IN) { p0_transpose_item(F.in[I_WIN], DM, INW, (bf16*)(F.ws + WS_WIN), DMapWin(), scr, r, F.lane); continue; } r -= I_IN;
        if (r < I_UP) { p0_transpose_item(F.in[I_WUPA], 512, DM, (bf16*)(F.ws + WS_WUPA), DMapId(), scr, r, F.lane); continue; } r -= I_UP;
        if (r < I_UP) { p0_transpose_item(F.in[I_WUPB], 512, DM, (bf16*)(F.ws + WS_WUPB), DMapId(), scr, r, F.lane); continue; } r -= I_UP;
        if (r < I_OUT) { p0_transpose_item(F.in[I_WOUT], DM, DM, (bf16*)(F.ws + WS_WOUT), DMapId(), scr, r, F.lane); continue; } r -= I_OUT;
        if (r < I_C1) { p0_transpose_item(F.in[I_CW1K], 2048, 128, (bf16*)(F.ws + WS_CW1K), DMapId(), scr, r, F.lane); continue; } r -= I_C1;
        if (r < I_C1) { p0_transpose_item(F.in[I_CW1V], 2048, 128, (bf16*)(F.ws + WS_CW1V), DMapId(), scr, r, F.lane); continue; } r -= I_C1;
        if (r < I_C2) { p0_transpose_item(F.in[I_CW2K], 128, 64, (bf16*)(F.ws + WS_CW2K), DMapId(), scr, r, F.lane); continue; } r -= I_C2;
        { p0_transpose_item(F.in[I_CW2V], 128, 64, (bf16*)(F.ws + WS_CW2V), DMapId(), scr, r, F.lane); }
    }
    __syncthreads();
    {
        const int gt = F.vcu * NTHREADS + F.tid, NGT = F.G * NTHREADS;
        const float* c = F.in[I_C]; const float* aw = F.in[I_ADAW]; float* modp = (float*)(F.ws + WS_MODP);
        for (int w = gt; w < ADA_SLICES * 6144; w += NGT) {
            const int s = w / 6144, j = w % 6144; float a0 = 0.f, a1 = 0.f, a2 = 0.f, a3 = 0.f;
#pragma unroll 8
            for (int kk = 0; kk < 64; ++kk) { const int k = s * 64 + kk; const float wv = aw[(size_t)k * 6144 + j];
                const float c0 = c[k], c1 = c[DM + k], c2 = c[2 * DM + k], c3 = c[3 * DM + k];
                a0 += c0 * sigmoidf_(c0) * wv; a1 += c1 * sigmoidf_(c1) * wv; a2 += c2 * sigmoidf_(c2) * wv; a3 += c3 * sigmoidf_(c3) * wv; }
            modp[(size_t)(s * 4 + 0) * 6144 + j] = a0; modp[(size_t)(s * 4 + 1) * 6144 + j] = a1; modp[(size_t)(s * 4 + 2) * 6144 + j] = a2; modp[(size_t)(s * 4 + 3) * 6144 + j] = a3;
        }
        { const float* rw = F.in[I_RW]; bf16* rwhi = (bf16*)(F.ws + WS_RWHI); bf16* rwlo = (bf16*)(F.ws + WS_RWLO);
          for (int w = gt; w < DM * NEXP; w += NGT) { const int e = w >> 10, k = w & 1023; const float x = rw[k * NEXP + e]; const unsigned h = f2bf(x); rwhi[w] = (bf16)h; rwlo[w] = (bf16)f2bf(x - bf2f((unsigned short)h)); } }
        float* pbp = (float*)(F.ws + WS_PBP);
        for (int w = gt; w < PB_SLICES * 2 * 128; w += NGT) {
            const int s = w / 256, kv = (w >> 7) & 1, j = w & 127; const float* pe = F.in[kv ? I_PEV : I_PEK]; const float* w1 = F.in[kv ? I_CW1V : I_CW1K]; float a = 0.f;
#pragma unroll 8
            for (int ii = 0; ii < 128; ++ii) { const int i = s * 128 + ii; a += pe[i] * w1[(size_t)i * 128 + j]; }
            pbp[w] = a;
        }
    }
}

template <bool WITH_MOE>
__device__ __forceinline__ void p_final(Ctx& F, const bf16* H, const float* modf) {
    const unsigned char* Y = F.ws + WS_YR; const int* dest = (const int*)(F.ws + WS_DEST);
    const float* fg = F.in[I_FG];
    f32x4 g[4];
#pragma unroll
    for (int j = 0; j < 4; ++j) g[j] = *(const f32x4*)(fg + 4 * F.lane + 256 * j);
    for (int blk = F.vcu; blk < T / 64; blk += F.G) {
        const int b = (blk * 64) / SEQ, t0 = blk * 64 + F.wave * 8; const float* gt = modf + (size_t)b * 6 * DM + 5 * DM;
        f32x4 gg[4];
#pragma unroll
        for (int j = 0; j < 4; ++j) gg[j] = *(const f32x4*)(gt + 4 * F.lane + 256 * j) + 1.0f;
        int4 dd[8];
#pragma unroll
        for (int i = 0; i < 8; ++i) dd[i] = WITH_MOE ? *(const int4*)(dest + (t0 + i) * 4) : make_int4(0, 0, 0, 0);
#pragma unroll
        for (int i = 0; i < 8; ++i) {
            f32x4 v[4]; unsigned y[4][4]; const int t = t0 + i;
#pragma unroll
            for (int j = 0; j < 4; ++j) { const v2u hw = *(const v2u*)(H + (size_t)t * DM + 4 * F.lane + 256 * j); v[j] = (f32x4){bflo(hw.x), bfhi(hw.x), bflo(hw.y), bfhi(hw.y)}; }
            if (WITH_MOE) {
#pragma unroll
                for (int j = 0; j < 4; ++j) { y[0][j] = *(const unsigned*)(Y + (size_t)dd[i].x * DM + 4 * F.lane + 256 * j); y[1][j] = *(const unsigned*)(Y + (size_t)dd[i].y * DM + 4 * F.lane + 256 * j);
                    y[2][j] = *(const unsigned*)(Y + (size_t)dd[i].z * DM + 4 * F.lane + 256 * j); y[3][j] = *(const unsigned*)(Y + (size_t)dd[i].w * DM + 4 * F.lane + 256 * j); } }
            float ss = 0.f;
#pragma unroll
            for (int j = 0; j < 4; ++j) { f32x4 m = (f32x4){0.f, 0.f, 0.f, 0.f};
                if (WITH_MOE) {
#pragma unroll
                    for (int k = 0; k < TOPK; ++k) { const pg8::f32x2 lo = __builtin_amdgcn_cvt_pk_f32_fp8((int)y[k][j], false), hi = __builtin_amdgcn_cvt_pk_f32_fp8((int)y[k][j], true); m[0] += lo.x; m[1] += lo.y; m[2] += hi.x; m[3] += hi.y; } }
                v[j] = v[j] + gg[j] * m * 0.0625f;
                ss += (v[j][0] * v[j][0] + v[j][1] * v[j][1]) + (v[j][2] * v[j][2] + v[j][3] * v[j][3]); }
            const float rs = rsqrtf(wave_sum(ss) * (1.0f / DM) + NORM_EPS);
#pragma unroll
            for (int j = 0; j < 4; ++j) *(f32x4*)(F.out + (size_t)t * DM + 4 * F.lane + 256 * j) = v[j] * rs * g[j];
        }
    }
}

__device__ __forceinline__ f32x4 mfma16(bf16x8 a, bf16x8 b, f32x4 c) { return __builtin_amdgcn_mfma_f32_16x16x32_bf16(a, b, c, 0, 0, 0); }
typedef short v4i16_t __attribute__((ext_vector_type(4)));
__device__ __forceinline__ s16x4 lds_tr4(const LAS unsigned char* p) { return __builtin_bit_cast(s16x4, __builtin_amdgcn_ds_read_tr16_b64_v4i16((LAS v4i16_t*)p)); }
__device__ __forceinline__ bf16x8 tr_frag(const LAS unsigned char* img, int sb, int r0, int r1, int n0, int lane) {
    const int q = (lane & 15) >> 2, p = lane & 3;
    const s16x4 lo = lds_tr4(img + (r0 + q) * sb + (n0 + 4 * p) * 2), hi = lds_tr4(img + (r1 + q) * sb + (n0 + 4 * p) * 2);
    return (bf16x8){lo[0], lo[1], lo[2], lo[3], hi[0], hi[1], hi[2], hi[3]};
}
__device__ __forceinline__ bf16x8 lds_row8(const LAS unsigned char* img, int sb, int row, int col) { return *(const LAS bf16x8*)(img + row * sb + col * 2); }
__device__ __forceinline__ bf16x8 pack8(const f32x4 a, const f32x4 b) {
    v4u w; w.x = pg8::cvt_pk_bf16(a[0], a[1]); w.y = pg8::cvt_pk_bf16(a[2], a[3]); w.z = pg8::cvt_pk_bf16(b[0], b[1]); w.w = pg8::cvt_pk_bf16(b[2], b[3]);
    return __builtin_bit_cast(bf16x8, w);
}
__device__ __forceinline__ float grp_max(float v) { v = fmaxf(v, __shfl_xor(v, 16)); return fmaxf(v, __shfl_xor(v, 32)); }
__device__ __forceinline__ float grp_sum(float v) { v += __shfl_xor(v, 16); return v + __shfl_xor(v, 32); }
constexpr float NEG_BIG = -1.0e30f;
constexpr float LOG2E = 1.4426950408889634f;
constexpr int KV_SB = 144;
constexpr int W128_SB = 272;

template <int MODE>
__device__ __forceinline__ void nsa_pass(Ctx& F, const bf16* proj, int b, int g, int qb, int kcol, int vcol, const bf16x8 (&qf)[2][2], const unsigned long long (&selm)[2],
                                         f32x4 (&ot)[2][4], float (&lsum)[2]) {
    LAS unsigned char* Kt = F.lds; LAS unsigned char* Vt = F.lds + 2 * 64 * KV_SB;
    const int lane = F.lane, gq = lane >> 4, th = F.wave >> 2;
    const int ntile = MODE == 0 ? qb + 1 : (qb < 8 ? qb + 1 : 9);
    const int lrow = F.tid >> 3, lch = F.tid & 7;
    const size_t rbase = (size_t)b * SEQ;
    float mrun[2] = {NEG_BIG, NEG_BIG};
#pragma unroll
    for (int qi = 0; qi < 2; ++qi) { lsum[qi] = 0.f;
#pragma unroll
        for (int db = 0; db < 4; ++db) ot[qi][db] = (f32x4){0.f, 0.f, 0.f, 0.f}; }
    auto tile_of = [&](int it) { return MODE == 0 ? it : qb - it; };
    v4u kreg, vreg;
    { const int j = tile_of(0); const bf16* src = proj + (rbase + (size_t)j * 64 + lrow) * PW + lch * 8; kreg = *(const v4u*)(src + kcol); vreg = *(const v4u*)(src + vcol); }
    __syncthreads();
    for (int it = 0; it < ntile; ++it) {
        const int buf = it & 1, j = tile_of(it);
        *(LAS v4u*)(Kt + buf * 64 * KV_SB + lrow * KV_SB + lch * 16) = kreg; *(LAS v4u*)(Vt + buf * 64 * KV_SB + lrow * KV_SB + lch * 16) = vreg;
        __syncthreads();
        if (it + 1 < ntile) { const int jn = tile_of(it + 1); const bf16* src = proj + (rbase + (size_t)jn * 64 + lrow) * PW + lch * 8; kreg = *(const v4u*)(src + kcol); vreg = *(const v4u*)(src + vcol); }
        const LAS unsigned char* Kb = Kt + buf * 64 * KV_SB; const LAS unsigned char* Vb = Vt + buf * 64 * KV_SB;
        f32x4 s[2][4];
#pragma unroll
        for (int kb = 0; kb < 4; ++kb) { const bf16x8 k0 = lds_row8(Kb, KV_SB, 16 * kb + (lane & 15), 8 * gq), k1 = lds_row8(Kb, KV_SB, 16 * kb + (lane & 15), 32 + 8 * gq);
#pragma unroll
            for (int qi = 0; qi < 2; ++qi) { f32x4 a = (f32x4){0.f, 0.f, 0.f, 0.f}; a = mfma16(k0, qf[qi][0], a); a = mfma16(k1, qf[qi][1], a); s[qi][kb] = a; } }
        const bool edge = MODE == 0 ? (j == qb) : (j == qb || j == qb - 8);
#pragma unroll
        for (int qi = 0; qi < 2; ++qi) {
            const int i = th * 32 + qi * 16 + (lane & 15);
            bool rowok = true; if (MODE == 0) rowok = (selm[qi] >> j) & 1ull;
            if (edge) { asm volatile("; boundary tile: per-element mask" ::: "memory");
#pragma unroll
                for (int kb = 0; kb < 4; ++kb)
#pragma unroll
                    for (int r = 0; r < 4; ++r) { const int kvl = 16 * kb + 4 * gq + r; bool ok;
                        if (MODE == 0) ok = kvl <= i; else { const int rel = (qb - j) * 64 + i - kvl; ok = rel >= 0 && rel < 512; }
                        s[qi][kb][r] = ok ? s[qi][kb][r] : NEG_BIG; } }
            float mx = fmaxf(fmaxf(s[qi][0][0], s[qi][0][1]), fmaxf(s[qi][0][2], s[qi][0][3]));
#pragma unroll
            for (int kb = 1; kb < 4; ++kb) mx = fmaxf(mx, fmaxf(fmaxf(s[qi][kb][0], s[qi][kb][1]), fmaxf(s[qi][kb][2], s[qi][kb][3])));
            mx = rowok ? mx * (0.125f * LOG2E) : NEG_BIG;
            mx = grp_max(mx);
            const float mnew = fmaxf(mrun[qi], mx);
            if (__any(mnew > mrun[qi])) { const float alpha = __builtin_amdgcn_exp2f(mrun[qi] - mnew); lsum[qi] *= alpha;
#pragma unroll
                for (int db = 0; db < 4; ++db) ot[qi][db] *= alpha; }
            mrun[qi] = mnew;
            const float nb = rowok ? -mnew : -INFINITY;
            float ps = 0.f;
#pragma unroll
            for (int kb = 0; kb < 4; ++kb)
#pragma unroll
                for (int r = 0; r < 4; ++r) { const float p = __builtin_amdgcn_exp2f(fmaf(s[qi][kb][r], 0.125f * LOG2E, nb)); s[qi][kb][r] = p; ps += p; }
            lsum[qi] += ps;
        }
#pragma unroll
        for (int st = 0; st < 2; ++st) {
            const bf16x8 p0 = pack8(s[0][2 * st], s[0][2 * st + 1]), p1 = pack8(s[1][2 * st], s[1][2 * st + 1]);
#pragma unroll
            for (int db = 0; db < 4; ++db) { const bf16x8 vf = tr_frag(Vb, KV_SB, 32 * st + 4 * gq, 32 * st + 16 + 4 * gq, 16 * db, lane);
                ot[0][db] = mfma16(vf, p0, ot[0][db]); ot[1][db] = mfma16(vf, p1, ot[1][db]); }
        }
    }
}

__device__ __forceinline__ void nsa_selwin_unit(Ctx& F, int b, int g, int qb) {
    const bf16* proj = (const bf16*)(F.ws + WS_PROJ); const bf16* ocmp = (const bf16*)(F.ws + WS_OCMP); bf16* onsa = (bf16*)(F.ws + WS_ONSA);
    const unsigned long long* selmask = (const unsigned long long*)(F.ws + WS_SELM);
    const int lane = F.lane, gq = lane >> 4, hr = F.wave & 3, th = F.wave >> 2, head = g * 4 + hr;
    bf16x8 qf[2][2]; unsigned long long selm[2]; size_t trow[2];
#pragma unroll
    for (int qi = 0; qi < 2; ++qi) { const int t = qb * 64 + th * 32 + qi * 16 + (lane & 15); trow[qi] = (size_t)b * SEQ + t;
        selm[qi] = selmask[(size_t)(b * 2 + g) * SEQ + t];
#pragma unroll
        for (int st = 0; st < 2; ++st) qf[qi][st] = *(const bf16x8*)(proj + trow[qi] * PW + PC_Q + head * 64 + 32 * st + 8 * gq); }
    f32x4 ot[2][4]; float lsum[2];
    nsa_pass<0>(F, proj, b, g, qb, PC_KV + 2 * 128 + g * 64, PC_KV + 3 * 128 + g * 64, qf, selm, ot, lsum);
#pragma unroll
    for (int qi = 0; qi < 2; ++qi) { const float gate = sigmoidf_(bf2f(proj[trow[qi] * PW + PC_NSAG + 8 + head])) / grp_sum(lsum[qi]);
#pragma unroll
        for (int db = 0; db < 4; ++db) { const size_t o = trow[qi] * 512 + head * 64 + 16 * db + 4 * gq; const v2u c = *(const v2u*)(ocmp + o);
            f32x4 v = ot[qi][db] * gate; v[0] += bflo(c.x); v[1] += bfhi(c.x); v[2] += bflo(c.y); v[3] += bfhi(c.y);
            v2u w; w.x = pg8::cvt_pk_bf16(v[0], v[1]); w.y = pg8::cvt_pk_bf16(v[2], v[3]); *(v2u*)(onsa + o) = w; } }
    nsa_pass<1>(F, proj, b, g, qb, PC_KV + 4 * 128 + g * 64, PC_KV + 5 * 128 + g * 64, qf, selm, ot, lsum);
#pragma unroll
    for (int qi = 0; qi < 2; ++qi) { const float gate = sigmoidf_(bf2f(proj[trow[qi] * PW + PC_NSAG + 16 + head])) / grp_sum(lsum[qi]);
#pragma unroll
        for (int db = 0; db < 4; ++db) { const size_t o = trow[qi] * 512 + head * 64 + 16 * db + 4 * gq; const v2u c = *(const v2u*)(onsa + o);
            f32x4 v = ot[qi][db] * gate; v[0] += bflo(c.x); v[1] += bfhi(c.x); v[2] += bflo(c.y); v[3] += bfhi(c.y);
            v2u w; w.x = pg8::cvt_pk_bf16(v[0], v[1]); w.y = pg8::cvt_pk_bf16(v[2], v[3]); *(v2u*)(onsa + o) = w; } }
}

__device__ __forceinline__ void p1_norm1(Ctx& F) {
    const float* modp = (const float*)(F.ws + WS_MODP); const float* adab = F.in[I_ADAB]; float* modfw = (float*)(F.ws + WS_MODF);
    { const int gt = F.vcu * NTHREADS + F.tid, NGT = F.G * NTHREADS;
      for (int w = gt; w < 4 * 6144; w += NGT) { const int b = w / 6144, j = w % 6144; float a = adab[j];
#pragma unroll
          for (int s = 0; s < ADA_SLICES; ++s) a += modp[(size_t)(s * 4 + b) * 6144 + j];
          modfw[w] = a; } }
    LAS float* shs = (LAS float*)F.lds; LAS float* scs = shs + DM;
    const float* x = F.in[I_X]; const float* g1 = F.in[I_N1G]; bf16* A1 = (bf16*)(F.ws + WS_A1);
    int curb = -1;
    for (int blk = F.vcu; blk < T / 64; blk += F.G) {
        const int b = (blk * 64) / SEQ;
        if (b != curb) { __syncthreads();
            for (int j = F.tid; j < 2 * DM; j += NTHREADS) { float a = adab[j];
#pragma unroll
                for (int s = 0; s < ADA_SLICES; ++s) a += modp[(size_t)(s * 4 + b) * 6144 + j];
                if (j < DM) shs[j] = a; else scs[j - DM] = (1.0f + a) * g1[j - DM]; }
            __syncthreads(); curb = b; }
        { f32x4 v[8][4];
#pragma unroll
          for (int i = 0; i < 8; ++i)
#pragma unroll
              for (int j = 0; j < 4; ++j) v[i][j] = *(const f32x4*)(x + (size_t)(blk * 64 + F.wave * 8 + i) * DM + 4 * F.lane + 256 * j);
#pragma unroll
          for (int i = 0; i < 8; ++i) { const int t = blk * 64 + F.wave * 8 + i; float ss = 0.f;
#pragma unroll
              for (int j = 0; j < 4; ++j) ss += (v[i][j][0] * v[i][j][0] + v[i][j][1] * v[i][j][1]) + (v[i][j][2] * v[i][j][2] + v[i][j][3] * v[i][j][3]);
              const float rs = rsqrtf(wave_sum(ss) * (1.0f / DM) + NORM_EPS);
#pragma unroll
              for (int j = 0; j < 4; ++j) { const f32x4 sc = *(const LAS f32x4*)(scs + 4 * F.lane + 256 * j), sh = *(const LAS f32x4*)(shs + 4 * F.lane + 256 * j);
                  const f32x4 o = v[i][j] * rs * sc + sh; v2u w; w.x = pk2(o[0], o[1]); w.y = pk2(o[2], o[3]);
                  *(v2u*)(A1 + (size_t)t * DM + 4 * F.lane + 256 * j) = w; } } }
    }
    __syncthreads();
}

constexpr int RA_SB = 1040;
__device__ __forceinline__ void p8_norm2_router(Ctx& F, const bf16* H, const float* modf) {
    LAS unsigned char* Ahi = F.lds; LAS unsigned char* Alo = F.lds + 64 * RA_SB; LAS float* lg = (LAS float*)(F.lds + 2 * 64 * RA_SB);
    LAS int* hist = (LAS int*)(lg + 64 * 33);
    const float* rb = F.in[I_RB]; const float* g2 = F.in[I_N2G];
    const bf16* rwhi = (const bf16*)(F.ws + WS_RWHI); const bf16* rwlo = (const bf16*)(F.ws + WS_RWLO);
    unsigned char* N2 = F.ws + WS_A1; int* topi = (int*)(F.ws + WS_TOPI); float* gate = (float*)(F.ws + WS_GATE);
    const int lane = F.lane, gq = lane >> 4, w = F.wave;
    if (F.tid < 32) hist[F.tid] = 0;
    f32x4 gv[4];
#pragma unroll
    for (int j = 0; j < 4; ++j) gv[j] = *(const f32x4*)(g2 + 4 * lane + 256 * j);
    for (int blk = F.vcu; blk < T / 64; blk += F.G) {
        const int b = (blk * 64) / SEQ; const float* sh2 = modf + (size_t)b * 6 * DM + 3 * DM; const float* sc2 = sh2 + DM;
        f32x4 scv[4], shv[4];
#pragma unroll
        for (int j = 0; j < 4; ++j) { scv[j] = (*(const f32x4*)(sc2 + 4 * lane + 256 * j) + 1.0f) * gv[j]; shv[j] = *(const f32x4*)(sh2 + 4 * lane + 256 * j); }
        f32x4 v[8][4];
#pragma unroll
        for (int i = 0; i < 8; ++i) { const int t = blk * 64 + w * 8 + i;
#pragma unroll
            for (int j = 0; j < 4; ++j) { const v2u hw = *(const v2u*)(H + (size_t)t * DM + 4 * lane + 256 * j); v[i][j] = (f32x4){bflo(hw.x), bfhi(hw.x), bflo(hw.y), bfhi(hw.y)}; } }
#pragma unroll
        for (int i = 0; i < 8; ++i) { const int t = blk * 64 + w * 8 + i; float ss = 0.f;
#pragma unroll
            for (int j = 0; j < 4; ++j) ss += (v[i][j][0] * v[i][j][0] + v[i][j][1] * v[i][j][1]) + (v[i][j][2] * v[i][j][2] + v[i][j][3] * v[i][j][3]);
            const float rs = rsqrtf(wave_sum(ss) * (1.0f / DM) + NORM_EPS);
#pragma unroll
            for (int j = 0; j < 4; ++j) { v[i][j] = v[i][j] * rs * scv[j] + shv[j];
                *(unsigned*)(N2 + (size_t)t * DM + 4 * lane + 256 * j) = pk4_fp8(v[i][j][0], v[i][j][1], v[i][j][2], v[i][j][3]); } }
        const int tbk = w & 3, eb = w >> 2; f32x4 acc = (f32x4){0.f, 0.f, 0.f, 0.f};
#pragma unroll
        for (int kh = 0; kh < 2; ++kh) {
            __syncthreads();
#pragma unroll
            for (int i = 0; i < 8; ++i)
#pragma unroll
                for (int jj = 0; jj < 2; ++jj) { const f32x4 x = v[i][2 * kh + jj]; const unsigned h0 = pk2(x[0], x[1]), h1 = pk2(x[2], x[3]);
                    const unsigned l0 = pk2(x[0] - bflo(h0), x[1] - bfhi(h0)), l1 = pk2(x[2] - bflo(h1), x[3] - bfhi(h1));
                    const int off = (w * 8 + i) * RA_SB + (4 * lane + 256 * jj) * 2;
                    *(LAS v2u*)(Ahi + off) = (v2u){h0, h1}; *(LAS v2u*)(Alo + off) = (v2u){l0, l1}; }
            __syncthreads();
#pragma unroll 4
            for (int s = 0; s < 16; ++s) { const size_t bo = (size_t)(16 * eb + (lane & 15)) * DM + 512 * kh + 32 * s + 8 * gq;
                const bf16x8 bh = *(const bf16x8*)(rwhi + bo), bl = *(const bf16x8*)(rwlo + bo);
                const bf16x8 ah = lds_row8(Ahi, RA_SB, 16 * tbk + (lane & 15), 32 * s + 8 * gq), al = lds_row8(Alo, RA_SB, 16 * tbk + (lane & 15), 32 * s + 8 * gq);
                acc = mfma16(ah, bh, acc); acc = mfma16(al, bh, acc); acc = mfma16(ah, bl, acc); }
        }
        { const int e = 16 * eb + (lane & 15); const float rbe = rb[e];
#pragma unroll
          for (int r = 0; r < 4; ++r) lg[(16 * tbk + 4 * gq + r) * 33 + e] = acc[r] + rbe; }
        __syncthreads();
        if (F.tid < 64) { const int t = blk * 64 + F.tid; float lv[32];
#pragma unroll
            for (int e = 0; e < 32; ++e) lv[e] = lg[F.tid * 33 + e];
            int si[4]; float sv[4];
#pragma unroll
            for (int k = 0; k < 4; ++k) { float m = -3.0e38f; int mi = 0;
#pragma unroll
                for (int e = 0; e < 32; ++e) { const bool gt = lv[e] > m; m = gt ? lv[e] : m; mi = gt ? e : mi; }
#pragma unroll
                for (int e = 0; e < 32; ++e) lv[e] = (e == mi) ? -3.0e38f : lv[e];
                si[k] = mi; sv[k] = m; }
            const float e1 = __expf(sv[1] - sv[0]), e2 = __expf(sv[2] - sv[0]), e3 = __expf(sv[3] - sv[0]); const float inv = 1.0f / (1.0f + e1 + e2 + e3);
            *(int4*)(topi + t * 4) = make_int4(si[0], si[1], si[2], si[3]); *(f32x4*)(gate + t * 4) = (f32x4){inv, e1 * inv, e2 * inv, e3 * inv};
#pragma unroll
            for (int k = 0; k < 4; ++k) __hip_atomic_fetch_add(&hist[si[k]], 1, __ATOMIC_RELAXED, __HIP_MEMORY_SCOPE_WORKGROUP); }
    }
    __syncthreads();
    if (F.tid < 32) { const int h = hist[F.tid]; if (h) __hip_atomic_fetch_add(F.ctl + CW_ECNT + 64 * F.tid, (unsigned)h, __ATOMIC_RELAXED, __HIP_MEMORY_SCOPE_AGENT); }
    __syncthreads();
}

__device__ __forceinline__ void p9_permute(Ctx& F) {
    LAS int* sm = (LAS int*)F.lds; LAS int* cnt = sm, *pstart = sm + 32, *lhist = sm + 64, *lbase = sm + 96, *dl = sm + 128;
    if (F.tid < 32) cnt[F.tid] = (int)__hip_atomic_load(F.ctl + CW_ECNT + 64 * F.tid, __ATOMIC_RELAXED, __HIP_MEMORY_SCOPE_AGENT);
    __syncthreads();
    if (F.tid == 0) { int run = 0; unsigned* tab = F.ctl + CW_MOETAB; const bool w0 = (blockIdx.x == 0);
        for (int e = 0; e < NEXP; ++e) { pstart[e] = run; const int nt = (cnt[e] + MOE_ROWS - 1) / MOE_ROWS;
            if (w0) for (int i = 0; i < nt; ++i) tab[64 + run / MOE_ROWS + i] = (unsigned)e;
            run += nt * MOE_ROWS; }
        if (w0) tab[0] = (unsigned)(run / MOE_ROWS); }
    __syncthreads();
    int* rowt = (int*)(F.ws + WS_ROWT);
    for (int e = F.vcu; e < NEXP; e += F.G) { const int c = cnt[e], pe = (c + MOE_ROWS - 1) / MOE_ROWS * MOE_ROWS; for (int r = c + F.tid; r < pe; r += NTHREADS) rowt[pstart[e] + r] = 0; }
    const int* topi = (const int*)(F.ws + WS_TOPI); const float* gate = (const float*)(F.ws + WS_GATE); int* dest = (int*)(F.ws + WS_DEST); float* rowg = (float*)(F.ws + WS_ROWG);
    for (int blk = F.vcu; blk < T / 64; blk += F.G) {
        if (F.tid < 32) lhist[F.tid] = 0;
        __syncthreads();
        int e = 0, rank = 0; const int a = blk * 256 + F.tid;
        if (F.tid < 256) { e = topi[a]; rank = __hip_atomic_fetch_add(&lhist[e], 1, __ATOMIC_RELAXED, __HIP_MEMORY_SCOPE_WORKGROUP); }
        __syncthreads();
        if (F.tid < 32) { const int h = lhist[F.tid]; lbase[F.tid] = pstart[F.tid] + (h ? (int)__hip_atomic_fetch_add(F.ctl + CW_EFILL + 64 * F.tid, (unsigned)h, __ATOMIC_RELAXED, __HIP_MEMORY_SCOPE_AGENT) : 0); }
        __syncthreads();
        if (F.tid < 256) { const int d = lbase[e] + rank; dest[a] = d; rowg[d] = gate[a]; rowt[d] = a >> 2; }
        __syncthreads();
        __syncthreads();
    }
}

__device__ __forceinline__ float gelu_tanh(float x) { const float u = 0.7978845608028654f * (x + 0.044715f * x * x * x); const float e = __builtin_amdgcn_exp2f(u * 2.8853900817779268f); const float th = 1.0f - 2.0f * __builtin_amdgcn_rcpf(e + 1.0f); return 0.5f * x * (1.0f + th); }
__device__ __forceinline__ void nsa_compress_unit(Ctx& F, int unit) {
    const int nt = unit & 15, kv = (unit >> 4) & 1, bg = unit >> 5, b = bg >> 1, g = bg & 1, n0 = nt * 16;
    const bf16* proj = (const bf16*)(F.ws + WS_PROJ);
    const bf16* w1t = (const bf16*)(F.ws + (kv ? WS_CW1V : WS_CW1K)); const bf16* w2t = (const bf16*)(F.ws + (kv ? WS_CW2V : WS_CW2K));
    bf16* outp = (bf16*)(F.ws + (kv ? WS_VC : WS_KC)) + (size_t)bg * 256 * 64;
    const float* pbp = (const float*)(F.ws + WS_PBP);
    LAS unsigned char* Hs = F.lds;
    const int lane = F.lane, gq = lane >> 4, w = F.wave;
    const int col = PC_KV + kv * 128 + g * 64;
    int nrow = n0 + (lane & 15); if (nrow > 254) nrow = 254;
    const bf16* arow = proj + ((size_t)b * SEQ + 16 * nrow) * PW + col + 8 * gq;
    const bf16* brow = w1t + (size_t)(16 * w + (lane & 15)) * 2048 + 8 * gq;
    f32x4 acc = (f32x4){0.f, 0.f, 0.f, 0.f};
#pragma unroll 8
    for (int s = 0; s < 64; ++s) {
        const bf16x8 a = *(const bf16x8*)(arow + (size_t)(s >> 1) * PW + (s & 1) * 32);
        const bf16x8 bb = *(const bf16x8*)(brow + 32 * s);
        acc = mfma16(a, bb, acc);
    }
    { const int j = 16 * w + (lane & 15); float pb = 0.f;
#pragma unroll
      for (int s = 0; s < PB_SLICES; ++s) pb += pbp[(s * 2 + kv) * 128 + j];
      __syncthreads();
#pragma unroll
      for (int r = 0; r < 4; ++r) *(LAS unsigned short*)(Hs + (4 * gq + r) * W128_SB + j * 2) = (unsigned short)f2bf(gelu_tanh(acc[r] + pb));
    }
    __syncthreads();
    if (w < 4) {
        f32x4 o = (f32x4){0.f, 0.f, 0.f, 0.f};
#pragma unroll
        for (int s = 0; s < 4; ++s) { const bf16x8 a = lds_row8(Hs, W128_SB, lane & 15, 32 * s + 8 * gq); const bf16x8 bb = *(const bf16x8*)(w2t + (size_t)(16 * w + (lane & 15)) * 128 + 32 * s + 8 * gq); o = mfma16(a, bb, o); }
#pragma unroll
        for (int r = 0; r < 4; ++r) { const int n = n0 + 4 * gq + r; outp[(size_t)n * 64 + 16 * w + (lane & 15)] = (unsigned short)(n < 255 ? f2bf(o[r]) : 0u); }
    }
}

__device__ __forceinline__ void nsa_cmp_unit(Ctx& F, int bg, int tb) {
    const int b = bg >> 1, g = bg & 1;
    const bf16* proj = (const bf16*)(F.ws + WS_PROJ); bf16* ocmp = (bf16*)(F.ws + WS_OCMP);
    const bf16* kc = (const bf16*)(F.ws + WS_KC) + (size_t)bg * 256 * 64; const bf16* vc = (const bf16*)(F.ws + WS_VC) + (size_t)bg * 256 * 64;
    unsigned long long* selmask = (unsigned long long*)(F.ws + WS_SELM);
    LAS unsigned char* Kt = F.lds; LAS unsigned char* Vt = F.lds + 256 * KV_SB; LAS float* IMP = (LAS float*)(F.lds + 2 * 256 * KV_SB);
    const int lane = F.lane, gq = lane >> 4, w = F.wave, tg = w >> 2, hp = w & 3;
    const int nvmax = 4 * tb + 3;
    const int nkb = (nvmax + 15) >> 4;
    __syncthreads();
    for (int i = F.tid; i < 256 * 8; i += NTHREADS) { const int row = i >> 3, ch = i & 7;
        if (row < ((nkb + 1) & ~1) * 16) {        *(LAS v4u*)(Kt + row * KV_SB + ch * 16) = *(const v4u*)(kc + row * 64 + ch * 8); *(LAS v4u*)(Vt + row * KV_SB + ch * 16) = *(const v4u*)(vc + row * 64 + ch * 8); } }
    __syncthreads();
    LAS float* IMPW = IMP + hp * 64 * 64;
#pragma unroll 1
    for (int qi = 0; qi < 2; ++qi) {
        const int tl = tg * 32 + qi * 16 + (lane & 15), t = tb * 64 + tl; const size_t trow = (size_t)b * SEQ + t;
        const int nv = ((t + 1) >> 4) - 1;
        float imp[16], carry[16];
#pragma unroll
        for (int kb = 0; kb < 16; ++kb) { imp[kb] = 0.f; carry[kb] = 0.f; }
        {
            const int head = g * 4 + hp;
            const bf16x8 q0 = *(const bf16x8*)(proj + trow * PW + PC_Q + head * 64 + 8 * gq), q1 = *(const bf16x8*)(proj + trow * PW + PC_Q + head * 64 + 32 + 8 * gq);
            float ml = NEG_BIG, ll = 0.f;
#pragma unroll 2
            for (int kb = 0; kb < nkb; ++kb) { f32x4 a = (f32x4){0.f, 0.f, 0.f, 0.f};
                a = mfma16(lds_row8(Kt, KV_SB, 16 * kb + (lane & 15), 8 * gq), q0, a); a = mfma16(lds_row8(Kt, KV_SB, 16 * kb + (lane & 15), 32 + 8 * gq), q1, a);
                float v[4], tm = NEG_BIG;
#pragma unroll
                for (int r = 0; r < 4; ++r) { const int n = 16 * kb + 4 * gq + r; v[r] = (n < nv) ? a[r] * (0.125f * LOG2E) : NEG_BIG; tm = fmaxf(tm, v[r]); }
                const float mn = fmaxf(ml, tm); float ps = 0.f;
#pragma unroll
                for (int r = 0; r < 4; ++r) { const int n = 16 * kb + 4 * gq + r; ps += (n < nv) ? __builtin_amdgcn_exp2f(v[r] - mn) : 0.f; }
                ll = ll * __builtin_amdgcn_exp2f(ml - mn) + ps; ml = mn; }
            const float mx = grp_max(ml);
            const float ps = grp_sum(ll * __builtin_amdgcn_exp2f(ml - mx));
            const float inv = ps > 0.f ? 1.0f / ps : 0.f;
            f32x4 o[4];
#pragma unroll
            for (int db = 0; db < 4; ++db) o[db] = (f32x4){0.f, 0.f, 0.f, 0.f};
#pragma unroll
            for (int st = 0; st < 8; ++st) if (2 * st < nkb) {
                f32x4 pp[2];
#pragma unroll
                for (int k2 = 0; k2 < 2; ++k2) { const int kb = 2 * st + k2; f32x4 a = (f32x4){0.f, 0.f, 0.f, 0.f};
                    a = mfma16(lds_row8(Kt, KV_SB, 16 * kb + (lane & 15), 8 * gq), q0, a); a = mfma16(lds_row8(Kt, KV_SB, 16 * kb + (lane & 15), 32 + 8 * gq), q1, a);
#pragma unroll
                    for (int r = 0; r < 4; ++r) { const int n = 16 * kb + 4 * gq + r; a[r] = (n < nv) ? __builtin_amdgcn_exp2f(a[r] * (0.125f * LOG2E) - mx) * inv : 0.f; }
                    pp[k2] = a; imp[kb] += (a[0] + a[1]) + (a[2] + 0.5f * a[3]); carry[kb] += 0.5f * a[3]; }
                const bf16x8 pf = pack8(pp[0], pp[1]);
#pragma unroll
                for (int db = 0; db < 4; ++db) o[db] = mfma16(tr_frag(Vt, KV_SB, 32 * st + 4 * gq, 32 * st + 16 + 4 * gq, 16 * db, lane), pf, o[db]);
                asm volatile("" ::: "memory"); }
            const float gate = sigmoidf_(bf2f(proj[trow * PW + PC_NSAG + head]));
#pragma unroll
            for (int db = 0; db < 4; ++db) { const f32x4 v = o[db] * gate; v2u wv; wv.x = pg8::cvt_pk_bf16(v[0], v[1]); wv.y = pg8::cvt_pk_bf16(v[2], v[3]);
                *(v2u*)(ocmp + trow * 512 + head * 64 + 16 * db + 4 * gq) = wv; }
        }
#pragma unroll
        for (int kb = 0; kb < 16; ++kb) { const float c1 = __shfl(carry[kb], (lane + 48) & 63); const float c0 = kb > 0 ? __shfl(carry[kb > 0 ? kb - 1 : 0], (lane + 48) & 63) : 0.f;
            IMPW[tl * 64 + 4 * kb + gq] = imp[kb] + (gq > 0 ? c1 : c0); }
    }
    __syncthreads();
    for (int tl = w; tl < 64; tl += NWAVES) { const int t = tb * 64 + tl, cur = t >> 6;
        float v = (IMP[tl * 64 + lane] + IMP[4096 + tl * 64 + lane]) + (IMP[2 * 4096 + tl * 64 + lane] + IMP[3 * 4096 + tl * 64 + lane]); const bool forced = (lane == 0) || (lane == cur) || (lane == cur - 1);
        v = (lane > cur) ? NEG_BIG : v + (forced ? 1.0e4f : 0.f);
        int rank = 0;
#pragma unroll
        for (int jj = 0; jj < 64; ++jj) { const float o = __builtin_bit_cast(float, __builtin_amdgcn_readlane(__builtin_bit_cast(int, v), jj)); rank += (o > v || (o == v && jj < lane)) ? 1 : 0; }
        const unsigned long long m = __ballot(lane <= cur && rank < 16);
        if (lane == 0) selmask[(size_t)bg * SEQ + t] = m; }
}

constexpr int ML_H = 4, ML_D = 128, ML_L = 64, ML_NCH = SEQ / ML_L, ML_BH = BATCH * ML_H;
__device__ __forceinline__ float log_sigmoid(float x) { return fminf(x, 0.f) - log1pf(__expf(-fabsf(x))); }
__device__ __forceinline__ float siluf_(float x) { return x * sigmoidf_(x); }
__device__ __forceinline__ void ml_stage_a(Ctx& F, int unit) {
    const int c = unit & 63, bh = unit >> 6, b = bh >> 2, h = bh & 3;
    const bf16* proj = (const bf16*)(F.ws + WS_PROJ); bf16* mlq = (bf16*)(F.ws + WS_MLQ); bf16* mlk = (bf16*)(F.ws + WS_MLKK);
    float* mlb = (float*)(F.ws + WS_MLB); float* mlli = (float*)(F.ws + WS_MLLI); float* mlsc = (float*)(F.ws + WS_MLSC);
    bf16* mlu = (bf16*)(F.ws + WS_MLU) + (size_t)unit * ML_D * ML_D; float* mlun = (float*)(F.ws + WS_MLUN) + (size_t)unit * ML_D;
    const float* convw = F.in[I_CONVW]; const float* convb = F.in[I_CONVB]; const float* gateb = F.in[I_GATEB];
    LAS unsigned char* KW = F.lds; LAS unsigned char* Vs = F.lds + 64 * W128_SB; LAS float* wts = (LAS float*)(F.lds + 2 * 64 * W128_SB); LAS float* gsc = wts + 64;
    const int t0 = c * ML_L; const size_t row0 = (size_t)b * SEQ + t0;
    __syncthreads();
    if (F.tid < 64) { const int s = F.tid; const float ip = bf2f(proj[(row0 + s) * PW + PC_MLIF + h]) + gateb[h], fp = bf2f(proj[(row0 + s) * PW + PC_MLIF + 4 + h]) + gateb[4 + h];
        gsc[s] = log_sigmoid(fp); gsc[64 + s] = ip; }
    __syncthreads();
    if (F.tid < 64) {
        float v = gsc[F.tid];
#pragma unroll
        for (int o = 1; o < 64; o <<= 1) { const float u = __shfl_up(v, o); if (F.lane >= o) v += u; }
        const float bL = __shfl(v, 63); const float li = gsc[64 + F.tid]; const float a = bL - v + li; const float amax = wave_max(a);
        wts[F.tid] = __expf(a - amax); mlb[(size_t)bh * SEQ + t0 + F.tid] = v; mlli[(size_t)bh * SEQ + t0 + F.tid] = li;
        if (F.tid == 0) { mlsc[unit * 2 + 0] = amax; mlsc[unit * 2 + 1] = bL; } }
    __syncthreads();
    { v4u xin[4][4]; v4u vin[2];
#pragma unroll
      for (int ii = 0; ii < 4; ++ii) { const int it = F.tid + ii * NTHREADS; const int ch8 = it & 15, s = (it >> 4) & 63, which = it >> 10; const int pcol = (which ? PC_MLK : PC_MLQ) + h * 128 + ch8 * 8;
#pragma unroll
          for (int wv = 0; wv < 4; ++wv) { const int tt = t0 + s - 3 + wv; xin[ii][wv] = (tt >= 0) ? *(const v4u*)(proj + ((size_t)b * SEQ + tt) * PW + pcol) : (v4u){0u, 0u, 0u, 0u}; } }
#pragma unroll
      for (int ii = 0; ii < 2; ++ii) { const int it = F.tid + ii * NTHREADS; const int ch8 = it & 15, s = it >> 4; vin[ii] = *(const v4u*)(proj + (row0 + s) * PW + PC_MLV + h * 128 + ch8 * 8); }
#pragma unroll
      for (int ii = 0; ii < 4; ++ii) { const int it = F.tid + ii * NTHREADS; const int ch8 = it & 15, s = (it >> 4) & 63, which = it >> 10;
        const int cch = which * 512 + h * 128 + ch8 * 8;
        float acc[8];
#pragma unroll
        for (int j = 0; j < 8; ++j) acc[j] = convb[cch + j];
#pragma unroll
        for (int wv = 0; wv < 4; ++wv) { const v4u x = xin[ii][wv];
            const f32x4 w0 = *(const f32x4*)(convw + wv * 1024 + cch), w1 = *(const f32x4*)(convw + wv * 1024 + cch + 4);
            acc[0] += bflo(x.x) * w0[0]; acc[1] += bfhi(x.x) * w0[1]; acc[2] += bflo(x.y) * w0[2]; acc[3] += bfhi(x.y) * w0[3];
            acc[4] += bflo(x.z) * w1[0]; acc[5] += bfhi(x.z) * w1[1]; acc[6] += bflo(x.w) * w1[2]; acc[7] += bfhi(x.w) * w1[3]; }
        const float sc = which ? 0.08838834764831845f : 1.0f;
#pragma unroll
        for (int j = 0; j < 8; ++j) acc[j] = siluf_(acc[j]) * sc;
        v4u o; o.x = pk2(acc[0], acc[1]); o.y = pk2(acc[2], acc[3]); o.z = pk2(acc[4], acc[5]); o.w = pk2(acc[6], acc[7]);
        *(v4u*)((which ? mlk : mlq) + (row0 + s) * 512 + h * 128 + ch8 * 8) = o;
        if (which) { const float ws = wts[s]; v4u kw; kw.x = pk2(acc[0] * ws, acc[1] * ws); kw.y = pk2(acc[2] * ws, acc[3] * ws); kw.z = pk2(acc[4] * ws, acc[5] * ws); kw.w = pk2(acc[6] * ws, acc[7] * ws);
            *(LAS v4u*)(KW + s * W128_SB + ch8 * 16) = kw; } }
#pragma unroll
      for (int ii = 0; ii < 2; ++ii) { const int it = F.tid + ii * NTHREADS; const int ch8 = it & 15, s = it >> 4; *(LAS v4u*)(Vs + s * W128_SB + ch8 * 16) = vin[ii]; } }
    __syncthreads();
    { const int lane = F.lane, gq = lane >> 4, w = F.wave;
      const bf16x8 a0 = tr_frag(KW, W128_SB, 8 * gq, 8 * gq + 4, 16 * w, lane), a1 = tr_frag(KW, W128_SB, 32 + 8 * gq, 32 + 8 * gq + 4, 16 * w, lane);
#pragma unroll
      for (int eb = 0; eb < 8; ++eb) { f32x4 acc = (f32x4){0.f, 0.f, 0.f, 0.f};
          acc = mfma16(a0, tr_frag(Vs, W128_SB, 8 * gq, 8 * gq + 4, 16 * eb, lane), acc); acc = mfma16(a1, tr_frag(Vs, W128_SB, 32 + 8 * gq, 32 + 8 * gq + 4, 16 * eb, lane), acc);
          v2u uw; uw.x = pk2(acc[0], acc[1]); uw.y = pk2(acc[2], acc[3]);        *(v2u*)(mlu + (size_t)(16 * eb + (lane & 15)) * ML_D + 16 * w + 4 * gq) = uw; } }
    if (F.tid < ML_D) { float a = 0.f;
#pragma unroll 8
        for (int s = 0; s < 64; ++s) a += bf2f(*(const LAS unsigned short*)(KW + s * W128_SB + F.tid * 2));
        mlun[F.tid] = a; }
}
__device__ __forceinline__ void ml_stage_b(Ctx& F, int unit) {
    const int sl = unit & 15, bh = unit >> 4;
    const float* mlsc = (const float*)(F.ws + WS_MLSC); float* mlm = (float*)(F.ws + WS_MLSC) + 4096;
    const bf16* mlu = (const bf16*)(F.ws + WS_MLU) + (size_t)bh * 64 * ML_D * ML_D; bf16* mlc = (bf16*)(F.ws + WS_MLC) + (size_t)bh * 64 * ML_D * ML_D;
    const float* mlun = (const float*)(F.ws + WS_MLUN) + (size_t)bh * 64 * ML_D; float* mln = (float*)(F.ws + WS_MLN) + (size_t)bh * 64 * ML_D;
    LAS float* dec = (LAS float*)F.lds; LAS float* scl = dec + 64; LAS float* am = scl + 64; LAS float* bl = am + 64;
    __syncthreads();
    if (F.tid < 64) { const pg8::f32x2 v = *(const pg8::f32x2*)(mlsc + (bh * 64 + F.tid) * 2); am[F.tid] = v.x; bl[F.tid] = v.y; }
    __syncthreads();
    if (F.tid == 0) { float m = 0.f;
        for (int c = 0; c < 64; ++c) { const float amax = am[c], bL = bl[c]; const float mn = fmaxf(bL + m, amax);
            dec[c] = __expf(bL + m - mn); scl[c] = __expf(amax - mn); if (sl == 0) mlm[bh * 64 + c] = m; m = mn; } }
    __syncthreads();
    { const int idx = sl * 1024 + F.tid * 2; float c0 = 0.f, c1 = 0.f;
#pragma unroll 1
      for (int cb = 0; cb < 64; cb += 16) { unsigned u[16];
#pragma unroll
          for (int i = 0; i < 16; ++i) u[i] = *(const unsigned*)(mlu + (size_t)(cb + i) * ML_D * ML_D + idx);
#pragma unroll
          for (int i = 0; i < 16; ++i) { *(unsigned*)(mlc + (size_t)(cb + i) * ML_D * ML_D + idx) = pk2(c0, c1);
              c0 = dec[cb + i] * c0 + scl[cb + i] * bflo(u[i]); c1 = dec[cb + i] * c1 + scl[cb + i] * bfhi(u[i]); } } }
    if (sl == 0 && F.tid < ML_D) { float n = 0.f;
#pragma unroll 1
        for (int cb = 0; cb < 64; cb += 8) { float u[8];
#pragma unroll
            for (int i = 0; i < 8; ++i) u[i] = mlun[(cb + i) * ML_D + F.tid];
#pragma unroll
            for (int i = 0; i < 8; ++i) { mln[(cb + i) * ML_D + F.tid] = n; n = dec[cb + i] * n + scl[cb + i] * u[i]; } } }
}
__device__ __forceinline__ void ml_stage_c(Ctx& F, int unit) {
    const int c = unit & 63, bh = unit >> 6, b = bh >> 2, h = bh & 3;
    const bf16* proj = (const bf16*)(F.ws + WS_PROJ); const bf16* mlq = (const bf16*)(F.ws + WS_MLQ); const bf16* mlk = (const bf16*)(F.ws + WS_MLKK);
    const float* mlb = (const float*)(F.ws + WS_MLB); const float* mlli = (const float*)(F.ws + WS_MLLI); const float* mlm = (const float*)(F.ws + WS_MLSC) + 4096;
    const bf16* mlc = (const bf16*)(F.ws + WS_MLC) + (size_t)unit * ML_D * ML_D; const float* mln = (const float*)(F.ws + WS_MLN) + (size_t)unit * ML_D;
    bf16* oml = (bf16*)(F.ws + WS_OML); const float* ng = F.in[I_MLNG];
    LAS unsigned char* Qs = F.lds; LAS unsigned char* Ks = Qs + 64 * W128_SB; LAS unsigned char* Vs = Ks + 64 * W128_SB; LAS unsigned char* Cs = Vs + 64 * W128_SB;
    LAS float* fb = (LAS float*)(Cs + 128 * W128_SB); LAS float* fli = fb + 64; LAS float* fn = fli + 64; LAS float* ssq = fn + 128;
    const int t0 = c * ML_L; const size_t row0 = (size_t)b * SEQ + t0;
    __syncthreads();
    for (int it = F.tid; it < 1024; it += NTHREADS) { const int ch8 = it & 15, s = it >> 4; const size_t go = (row0 + s) * 512 + h * 128 + ch8 * 8;
        *(LAS v4u*)(Qs + s * W128_SB + ch8 * 16) = *(const v4u*)(mlq + go); *(LAS v4u*)(Ks + s * W128_SB + ch8 * 16) = *(const v4u*)(mlk + go);
        *(LAS v4u*)(Vs + s * W128_SB + ch8 * 16) = *(const v4u*)(proj + (row0 + s) * PW + PC_MLV + h * 128 + ch8 * 8); }
    for (int it = F.tid; it < 2048; it += NTHREADS) { const int ch8 = it & 15, e = it >> 4; *(LAS v4u*)(Cs + e * W128_SB + ch8 * 16) = *(const v4u*)(mlc + e * ML_D + ch8 * 8); }
    if (F.tid < 64) { fb[F.tid] = mlb[(size_t)bh * SEQ + t0 + F.tid]; fli[F.tid] = mlli[(size_t)bh * SEQ + t0 + F.tid]; }
    if (F.tid < ML_D) fn[F.tid] = mln[F.tid];
    __syncthreads();
    const int lane = F.lane, gq = lane >> 4, w = F.wave, tb = w & 3, eh = w >> 2;
    const int t = 16 * tb + (lane & 15); const float mc = mlm[unit]; const float bt = fb[t];
    bf16x8 qf[4];
#pragma unroll
    for (int st = 0; st < 4; ++st) qf[st] = lds_row8(Qs, W128_SB, t, 32 * st + 8 * gq);
    f32x4 sT[4]; float dmax = NEG_BIG;
#pragma unroll
    for (int sb = 0; sb < 4; ++sb) { sT[sb] = (f32x4){0.f, 0.f, 0.f, 0.f};
        if (sb <= tb) {
#pragma unroll
            for (int st = 0; st < 4; ++st) sT[sb] = mfma16(lds_row8(Ks, W128_SB, 16 * sb + (lane & 15), 32 * st + 8 * gq), qf[st], sT[sb]);
#pragma unroll
            for (int r = 0; r < 4; ++r) { const int s = 16 * sb + 4 * gq + r; if (s <= t) dmax = fmaxf(dmax, bt - fb[s] + fli[s]); } } }
    dmax = grp_max(dmax);
    const float mt = fmaxf(bt + mc, dmax); const float iw = __expf(bt + mc - mt);
    float dsum = 0.f;
#pragma unroll
    for (int sb = 0; sb < 4; ++sb)
#pragma unroll
        for (int r = 0; r < 4; ++r) { const int s = 16 * sb + 4 * gq + r; const float p = (sb <= tb && s <= t) ? sT[sb][r] * __expf(bt - fb[s] + fli[s] - mt) : 0.f; sT[sb][r] = p; dsum += p; }
    dsum = grp_sum(dsum);
    float qn = 0.f;
#pragma unroll 8
    for (int dd = 0; dd < 32; ++dd) { const int d = gq * 32 + dd; qn += bf2f(*(const LAS unsigned short*)(Qs + t * W128_SB + d * 2)) * fn[d]; }
    qn = grp_sum(qn);
    const float den = dsum + iw * qn; const float rden = 1.0f / fmaxf(fabsf(den), __expf(-mt));
    const bf16x8 p0 = pack8(sT[0], sT[1]), p1 = pack8(sT[2], sT[3]);
    f32x4 hv[4]; float sq = 0.f;
#pragma unroll
    for (int ei = 0; ei < 4; ++ei) { const int eb = eh * 4 + ei;
        f32x4 intra = (f32x4){0.f, 0.f, 0.f, 0.f}, inter = (f32x4){0.f, 0.f, 0.f, 0.f};
        intra = mfma16(tr_frag(Vs, W128_SB, 4 * gq, 16 + 4 * gq, 16 * eb, lane), p0, intra);
        if (tb >= 2) intra = mfma16(tr_frag(Vs, W128_SB, 32 + 4 * gq, 48 + 4 * gq, 16 * eb, lane), p1, intra);
#pragma unroll
        for (int st = 0; st < 4; ++st) inter = mfma16(lds_row8(Cs, W128_SB, 16 * eb + (lane & 15), 32 * st + 8 * gq), qf[st], inter);
        hv[ei] = (intra + inter * iw) * rden; sq += (hv[ei][0] * hv[ei][0] + hv[ei][1] * hv[ei][1]) + (hv[ei][2] * hv[ei][2] + hv[ei][3] * hv[ei][3]); }
    sq = grp_sum(sq);
    if (gq == 0) ssq[eh * 64 + t] = sq;
    __syncthreads();
    const float rn = rsqrtf((ssq[t] + ssq[64 + t]) * (1.0f / ML_D) + NORM_EPS);
#pragma unroll
    for (int ei = 0; ei < 4; ++ei) { const int e0 = 16 * (eh * 4 + ei) + 4 * gq; const f32x4 gg = *(const f32x4*)(ng + h * 128 + e0);
        const v2u ow = *(const v2u*)(proj + (row0 + t) * PW + PC_MLO + h * 128 + e0);
        f32x4 v = hv[ei] * rn * gg; v[0] *= sigmoidf_(bflo(ow.x)); v[1] *= sigmoidf_(bfhi(ow.x)); v[2] *= sigmoidf_(bflo(ow.y)); v[3] *= sigmoidf_(bfhi(ow.y));
        v2u o; o.x = pg8::cvt_pk_bf16(v[0], v[1]); o.y = pg8::cvt_pk_bf16(v[2], v[3]); *(v2u*)(oml + (row0 + t) * 512 + h * 128 + e0) = o; }
}

#ifndef REPEAT_PHASE
#define REPEAT_PHASE -1
#endif
__device__ __forceinline__ void ph2(Ctx& F) {
    const int nconv = (F.G * 96) / 256, GC = F.G - nconv;
    if ((int)blockIdx.x < GC) {
        pg8::Gemm g{(const bf16*)(F.ws + WS_A1), (const bf16*)(F.ws + WS_WIN), T, PW, DM}; pg8::StaticOrder S; S.init(T, PW, GC, (int)blockIdx.x);
        EpiStoreBf16 E{(bf16*)(F.ws + WS_PROJ), PW};
        pg8::gemm_phase<EpiStoreBf16, pg8::StaticOrder, true, true>(F.lds, g, S, E);
    } else moe_convert(F, (int)blockIdx.x - GC, nconv);
}
__device__ __forceinline__ void ph3(Ctx& F) {
    for (int u = F.vcu; u < 256; u += F.G) nsa_compress_unit(F, u);
    for (int u = F.vcu; u < ML_BH * ML_NCH; u += F.G) ml_stage_a(F, u);
}
__device__ __forceinline__ void ph4(Ctx& F) {
    for (int p = F.vcu; p < 256; p += F.G) { const int bg = p >> 5, x = p & 31; nsa_cmp_unit(F, bg, 63 - x); nsa_cmp_unit(F, bg, x); }
    for (int u = F.vcu; u < ML_BH * 16; u += F.G) ml_stage_b(F, u);
}
__device__ __forceinline__ void ph5(Ctx& F) {
    for (int p = F.vcu; p < 256; p += F.G) { const int bg = p >> 5, x = p & 31; nsa_selwin_unit(F, bg >> 1, bg & 1, x); nsa_selwin_unit(F, bg >> 1, bg & 1, 63 - x); }
    for (int u = F.vcu; u < ML_BH * ML_NCH; u += F.G) ml_stage_c(F, u);
}
struct UpOrder {
    pg8::StaticOrder so;
    __device__ __forceinline__ bool next(int i, Unit& u) const { if (!so.next(i >> 1, u)) return false; if (i & 1) { u.pm += T / 256; u.pn += DM / 256; } return true; }
    __device__ __forceinline__ void a_ready(const Unit&) const {}
    __device__ __forceinline__ void done(const Unit&) const {}
};
struct EpiUpBoth {
    static constexpr bool PERM = true, AFTER_DRAIN = false;
    bf16* U; const bf16* G;
    __device__ __forceinline__ void operator()(const f32x4 (&acc)[2][2][4][2], const Unit& u, int wr, int wc, int fr, int fq) const {
        if (u.pm < T / 256) { EpiUpGate<false> E{U, G, PC_MGA}; E(acc, u, wr, wc, fr, fq); }
        else { Unit v = u; v.pm -= T / 256; v.pn -= DM / 256; EpiUpGate<true> E{U, G, PC_MGB}; E(acc, v, wr, wc, fr, fq); }
    }
};
static_assert(WS_OML == WS_ONSA + (size_t)T * 512 * 2 && WS_WUPB == WS_WUPA + (size_t)DM * 512 * 2, "stacked operands of the up projection");
__device__ __forceinline__ void ph6(Ctx& F) {
    UpOrder S; S.so.init(T, DM, F.G, (int)blockIdx.x);
    pg8::Gemm g{(const bf16*)(F.ws + WS_ONSA), (const bf16*)(F.ws + WS_WUPA), 2 * T, 2 * DM, 512}; EpiUpBoth E{(bf16*)(F.ws + WS_U), (const bf16*)(F.ws + WS_PROJ)};
    pg8::gemm_phase<EpiUpBoth, UpOrder, true, true>(F.lds, g, S, E);
}
__device__ __forceinline__ void ph7(Ctx& F) {
    pg8::Gemm g{(const bf16*)(F.ws + WS_U), (const bf16*)(F.ws + WS_WOUT), T, DM, DM}; pg8::StaticOrder S; S.init(T, DM, F.G, (int)blockIdx.x);
    EpiOutRes E{F.in[I_X], (bf16*)(F.ws + WS_H1), (const float*)(F.ws + WS_MODF)};
    pg8::gemm_phase<EpiOutRes, pg8::StaticOrder, true, true>(F.lds, g, S, E);
}
__device__ __forceinline__ void ph10(Ctx& F) {
    pg8::Gemm g{(const bf16*)(F.ws + WS_A1), (const bf16*)(F.ws + WS_W1T), MOE_P, NEXP * 2048, DM};
    moe_units_to_lds<1>(F.lds, F.ctl + CW_MOETAB, 8, 3, F.G, F.vcu, F.in[I_EB1], nullptr);
    MoeOrder S{(const LAS int*)(F.lds + MOE_UL_OFF), (const int*)(F.ws + WS_ROWT)};
    EpiMoe1 E{F.ws + WS_ACT, (const LAS float*)(F.lds + MOE_BT1_OFF)};
    pg8::gemm_phase<EpiMoe1, MoeOrder, true, true, true, true>(F.lds, g, S, E);
}
__device__ __forceinline__ void ph11(Ctx& F) {
    pg8::Gemm g{(const bf16*)(F.ws + WS_ACT), (const bf16*)(F.ws + WS_W2T), MOE_P, NEXP * DM, DE};
    moe_units_to_lds<2>(F.lds, F.ctl + CW_MOETAB, 4, 2, F.G, F.vcu, F.in[I_EB2], (const float*)(F.ws + WS_ROWG));
    MoeOrder S{(const LAS int*)(F.lds + MOE_UL_OFF), nullptr};
    EpiMoe2 E{F.ws + WS_YR, (const LAS float*)(F.lds + MOE_BT2_OFF)};
    pg8::gemm_phase<EpiMoe2, MoeOrder, true, true, true>(F.lds, g, S, E);
}
#ifndef TIME_PHASE
#define TIME_PHASE -1
#endif
#define RUN(k, call) do { unsigned long long t0_ = 0; if (TIME_PHASE == (k)) t0_ = __builtin_amdgcn_s_memrealtime(); F.tid = threadIdx.x; F.lane = F.tid & 63; call; SEAM(); \
    if (TIME_PHASE == (k)) { const unsigned long long n_ = __builtin_amdgcn_s_memrealtime(); const unsigned long long e_ = n_ + 4 * (n_ - t0_); while (__builtin_amdgcn_s_memrealtime() < e_) __builtin_amdgcn_s_sleep(8); SEAM(); } } while (0)
__global__ void __launch_bounds__(NTHREADS, 2) fwd_kernel(Args args) {
    extern __shared__ __attribute__((aligned(16))) unsigned char lds_raw[];
    Ctx F;
    F.lds = (LAS unsigned char*)lds_raw; F.ws = args.ws; F.ctl = (unsigned*)(args.ws + WS_CTL);
    F.tid = threadIdx.x; F.lane = F.tid & 63; F.wave = __builtin_amdgcn_readfirstlane(F.tid >> 6);
    F.G = gridDim.x; { const int bx = blockIdx.x; F.vcu = (F.G % 8 == 0) ? (bx % 8) * (F.G / 8) + bx / 8 : bx; }
    F.in = args.in; F.out = args.out;
    volatile LAS unsigned* MISC = (volatile LAS unsigned*)(F.lds + MISC_OFF);
    for (int u = F.tid; u < (LDS_BYTES - LDSCTL_OFF) / 4; u += NTHREADS) ((LAS unsigned*)(F.lds + LDSCTL_OFF))[u] = 0u;
    __syncthreads();
    XcdBarrier bar = xcd_barrier_post(F.ctl + CW_BAR, MISC + 8);
#define SEAM() xcd_barrier(bar)
    const float* modf = (const float*)(F.ws + WS_MODF);
    const bf16* H = (const bf16*)(F.ws + WS_H1);
    RUN(0, p0_prologue(F));
    RUN(1, p1_norm1(F));
    RUN(2, ph2(F));
    RUN(3, ph3(F));
    RUN(4, ph4(F));
    RUN(5, ph5(F));
    RUN(6, ph6(F));
    RUN(7, ph7(F));
    RUN(8, p8_norm2_router(F, H, modf));
    RUN(9, p9_permute(F));
    RUN(10, ph10(F));
    RUN(11, ph11(F));
    p_final<true>(F, H, modf);
#undef SEAM
}

extern "C" void kernel_launch(void* const* d_in, const int* in_sizes, int n_in, void* d_out, int out_size, void* d_ws, size_t ws_size, hipStream_t stream) {
    static int grid = 0;
    if (grid == 0) {
        if (n_in != 27 || in_sizes[0] != T * DM || out_size != T * DM || ws_size < WS_END) { fprintf(stderr, "kernel_launch: unexpected shapes (n_in %d, in0 %d, out %d, ws %zu)\n", n_in, n_in > 0 ? in_sizes[0] : -1, out_size, ws_size); grid = -1; return; }
        int dev = 0, cus = 0, per_cu = 0;
        if (hipGetDevice(&dev) != hipSuccess || hipDeviceGetAttribute(&cus, hipDeviceAttributeMultiprocessorCount, dev) != hipSuccess) { grid = -1; return; }
        if (hipFuncSetAttribute((const void*)fwd_kernel, hipFuncAttributeMaxDynamicSharedMemorySize, LDS_BYTES) != hipSuccess) { fprintf(stderr, "kernel_launch: hipFuncSetAttribute failed\n"); grid = -1; return; }
        if (hipOccupancyMaxActiveBlocksPerMultiprocessor(&per_cu, (const void*)fwd_kernel, NTHREADS, LDS_BYTES) != hipSuccess || per_cu < 1) fprintf(stderr, "kernel_launch: occupancy query reports %d\n", per_cu);
        (void)hipGetLastError();
        grid = cus;
    }
    if (grid < 0) return;
    if (hipMemsetAsync((char*)d_ws + WS_CTL, 0, CTL_ZERO_BYTES, stream) != hipSuccess) return;
    Args a{};
    for (int i = 0; i < 27; ++i) a.in[i] = (const float*)d_in[i];
    a.out = (float*)d_out; a.ws = (unsigned char*)d_ws;
    a.ph_lo = 0; a.ph_hi = 64;
    hipLaunchKernelGGL(fwd_kernel, dim3(grid), dim3(NTHREADS), LDS_BYTES, stream, a);
}
```

```cpp
#include <hip/hip_runtime.h>
#include <cstdio>
#include <cstdint>
namespace pg8 {
#define PG8_LAS __attribute__((address_space(3)))
typedef unsigned short bf16_t;
typedef short bf16x8 __attribute__((ext_vector_type(8)));
typedef float f32x4 __attribute__((ext_vector_type(4)));
typedef unsigned u32x4 __attribute__((ext_vector_type(4)));
constexpr int BM = 256, BK = 64, HALF = 128, HTB = HALF * BK * 2  , STAGE_BYTES = 8 * HTB, NXCD = 8, WGM = 8;

__host__ __device__ __forceinline__ int lds_byte(int r, int c) { const int st = (r >> 4) * 2 + (c >> 5), rr = r & 15, cc = c & 31, ob = rr * 64 + cc * 2; return st * 1024 + (ob ^ (((ob >> 9) & 1) << 5)); }
__host__ __device__ __forceinline__ void stage_rc(int b, int& R, int& C) { const int st = b / 1024, sb = b % 1024, swz = sb ^ (((sb >> 9) & 1) << 5); R = (st >> 1) * 16 + swz / 64; C = (st & 1) * 32 + (swz % 64) / 2; }
__host__ __device__ __forceinline__ int perm32(int rho) { const int n = rho >> 4, i = rho & 15; return 8 * (i >> 2) + 4 * n + (i & 3); }

struct Unit { int pm, pn, ix; };
struct Gemm { const bf16_t* A; const bf16_t* Bt; int M, N, K; };

struct StaticOrder {
    int nM, nN, nwg, G, c;
    __host__ __device__ void init(int M, int N, int G_, int c_) { nM = M / BM; nN = N / BM; nwg = nM * nN; G = G_; c = c_; }
    __host__ __device__ bool next(int i, Unit& u) const {
        const long L = (long)i * G + c; if (L >= nwg) return false;
        int wgid = (int)L; { const int q = nwg / NXCD, r = nwg % NXCD, xcd = wgid % NXCD, off = wgid / NXCD; wgid = (xcd < r ? xcd * (q + 1) : r * (q + 1) + (xcd - r) * q) + off; }
        const int nig = WGM * nN, gid = wgid / nig, fm = gid * WGM, gsz = (nM - fm) < WGM ? (nM - fm) : WGM;
        u.pm = fm + ((wgid % nig) % gsz); u.pn = (wgid % nig) / gsz; return true;
    }
    __device__ __forceinline__ void a_ready(const Unit&) const {}
    __device__ __forceinline__ void done(const Unit&) const {}
};

__device__ __forceinline__ unsigned cvt_pk_bf16(float lo, float hi) { unsigned r; asm volatile("v_cvt_pk_bf16_f32 %0, %1, %2" : "=v"(r) : "v"(lo), "v"(hi)); return r; }
typedef float f32x2 __attribute__((ext_vector_type(2)));
typedef int v8i32 __attribute__((ext_vector_type(8)));
typedef int v4i32 __attribute__((ext_vector_type(4)));
template <bool F8> struct FragT { typedef bf16x8 type; }; template <> struct FragT<true> { typedef v8i32 type; };
constexpr int F8_SCALE_A = 0x7F7F7F7F;
constexpr int F8_SCALE_B = 0x7A7A7A7A;
template <class Epi, class Sched, bool ALIGN_EPI = false, bool SP2 = false, bool F8 = false, bool GATHER = false, bool I8 = false>
__device__ __forceinline__ void gemm_phase(PG8_LAS unsigned char* lds, const Gemm g, const Sched& S, const Epi& E) {
    int tid_ = threadIdx.x; asm volatile("" : "+v"(tid_));
    const int tid = tid_, wid = __builtin_amdgcn_readfirstlane(tid >> 6), lane = tid & 63, wr = wid >> 2, wc = wid & 3, fr = lane & 15, fq = lane >> 4;
    const int K = g.K, nt = (F8 || I8) ? K / (2 * BK) : K / BK; const int RB = (F8 || I8) ? K : 2 * K;
    unsigned voffA[2], voffB[2];
#pragma unroll
    for (int i = 0; i < 2; ++i) { int R, C; stage_rc(tid * 16 + i * 8192, R, C); const int Rb = Epi::PERM ? ((R & ~31) + perm32(R & 31)) : R;
        voffA[i] = (unsigned)(R * RB + C * 2); voffB[i] = (unsigned)(Rb * RB + C * 2); }
    const size_t kstep = (size_t)(BK * 2);
    const size_t hstep = (size_t)HALF * RB;
    const size_t tstep = 2 * hstep;
    const unsigned ldsw = (unsigned)wid * 1024u;
    const int aoff = lds_byte(wr * 64 + fr, fq * 8), boff = lds_byte(wc * 32 + fr, fq * 8);
#define PG8_SA(b, h) (((b) * 2 + (h)) * HTB)
#define PG8_SB(b, h) ((4 + (b) * 2 + (h)) * HTB)
#define PG8_STAGE(bufoff, gbase, voff) do { _Pragma("unroll") for (int _i = 0; _i < 2; ++_i) \
        __builtin_amdgcn_global_load_lds((const unsigned*)((const char*)(gbase) + (voff)[_i]), (PG8_LAS unsigned*)(lds + (bufoff) + ldsw + _i * 8192), 16, 0, 0); } while (0)
#define PG8_GO1(ix, h_, i_) ((unsigned)rt[(ix) * BM + (h_) * HALF + (int)(voffA[i_] / (unsigned)RB)] * (unsigned)RB + voffA[i_] % (unsigned)RB)
#define PG8_STAGE_A(bufoff, gbase, h, nx) do { if constexpr (GATHER) { _Pragma("unroll") for (int _i = 0; _i < 2; ++_i) { const unsigned o_ = PG8_GO1((nx) ? nui : ui, h, _i); \
        __builtin_amdgcn_global_load_lds((const unsigned*)((const char*)(gbase) + o_), (PG8_LAS unsigned*)(lds + (bufoff) + ldsw + _i * 8192), 16, 0, 0); } } \
        else { PG8_STAGE(bufoff, (const char*)(gbase) + (h) * hstep, voffA); } } while (0)
#define PG8_GOFFS(v, ix) do { _Pragma("unroll") for (int h_ = 0; h_ < 2; ++h_) _Pragma("unroll") for (int i_ = 0; i_ < 2; ++i_) v[h_][i_] = PG8_GO1(ix, h_, i_); } while (0)
#define PG8_LD16(off) (*(const PG8_LAS v4i32*)(lds + (off)))
#define PG8_LDA(dst, b, h) do { _Pragma("unroll") for (int m = 0; m < 4; ++m) { if constexpr (F8) { const v4i32 lo_ = PG8_LD16(PG8_SA(b, h) + aoff + m * 2048), hi_ = PG8_LD16(PG8_SA(b, h) + aoff + m * 2048 + 1024); dst[m][0] = __builtin_shufflevector(lo_, hi_, 0, 1, 2, 3, 4, 5, 6, 7); } \
        else { _Pragma("unroll") for (int k = 0; k < NK; ++k) dst[m][k] = *(const PG8_LAS frag_t*)(lds + PG8_SA(b, h) + aoff + m * 2048 + k * 1024); } } } while (0)
#define PG8_LDB(dst, b, h) do { _Pragma("unroll") for (int n = 0; n < 2; ++n) { if constexpr (F8) { const v4i32 lo_ = PG8_LD16(PG8_SB(b, h) + boff + n * 2048), hi_ = PG8_LD16(PG8_SB(b, h) + boff + n * 2048 + 1024); dst[n][0] = __builtin_shufflevector(lo_, hi_, 0, 1, 2, 3, 4, 5, 6, 7); } \
        else { _Pragma("unroll") for (int k = 0; k < NK; ++k) dst[n][k] = *(const PG8_LAS frag_t*)(lds + PG8_SB(b, h) + boff + n * 2048 + k * 1024); } } } while (0)
#define PG8_MMA(ai, bj, At, Bt) do { __builtin_amdgcn_s_setprio(1); \
        if constexpr (F8) { _Pragma("unroll") for (int m = 0; m < 4; ++m) _Pragma("unroll") for (int n = 0; n < 2; ++n) \
            asm("v_mfma_scale_f32_16x16x128_f8f6f4 %0, %1, %2, %0, %3, %4 op_sel_hi:[0,0,0]" : "+v"(acc[ai][bj][m][n]) : "v"(Bt[n][0]), "v"(At[m][0]), "v"(f8sb), "v"(f8sa)); } \
        else if constexpr (I8) { _Pragma("unroll") for (int m = 0; m < 4; ++m) _Pragma("unroll") for (int n = 0; n < 2; ++n) _Pragma("unroll") for (int k = 0; k < NK; ++k) \
            acc[ai][bj][m][n] = __builtin_bit_cast(f32x4, __builtin_amdgcn_mfma_i32_16x16x64_i8(__builtin_bit_cast(v4i32, Bt[n][k]), __builtin_bit_cast(v4i32, At[m][k]), __builtin_bit_cast(v4i32, acc[ai][bj][m][n]), 0, 0, 0)); } \
        else { _Pragma("unroll") for (int m = 0; m < 4; ++m) _Pragma("unroll") for (int n = 0; n < 2; ++n) _Pragma("unroll") for (int k = 0; k < NK; ++k) \
            acc[ai][bj][m][n] = __builtin_amdgcn_mfma_f32_16x16x32_bf16(Bt[n][k], At[m][k], acc[ai][bj][m][n], 0, 0, 0); } \
        __builtin_amdgcn_s_setprio(0); } while (0)
#define PG8_WAIT_V(n) asm volatile("s_waitcnt vmcnt(" #n ")" ::: "memory")
#define PG8_WAIT_L(n) asm volatile("s_waitcnt lgkmcnt(" #n ")" ::: "memory")
#define PG8_BAR __builtin_amdgcn_s_barrier()
#define PG8_SCHED __builtin_amdgcn_sched_barrier(0)
    Unit cur, nxt; int ui = 0;
    if (!S.next(0, cur)) return;
    f32x4 acc[2][2][4][2];
#pragma unroll
    for (int a = 0; a < 2; ++a)
#pragma unroll
        for (int b = 0; b < 2; ++b)
#pragma unroll
            for (int m = 0; m < 4; ++m)
#pragma unroll
                for (int n = 0; n < 2; ++n) acc[a][b][m][n] = (f32x4){0.f, 0.f, 0.f, 0.f};
    typedef typename FragT<F8>::type frag_t; constexpr int NK = F8 ? 1 : 2;
    int f8sa = F8_SCALE_A, f8sb = F8_SCALE_B; if constexpr (F8) asm volatile("" : "+v"(f8sa), "+v"(f8sb));
    frag_t At[4][NK], B0[2][NK], B1[2][NK];
    const char* cA = (const char*)g.A + (GATHER ? (size_t)0 : (size_t)cur.pm * tstep); const char* cB = (const char*)g.Bt + (size_t)cur.pn * tstep;
    int nui = 0; PG8_LAS const unsigned short* rt = (PG8_LAS const unsigned short*)(lds + STAGE_BYTES);
    if constexpr (GATHER) {
        Unit tu; for (int i = 0; S.next(i, tu); ++i) if (tid < BM) ((PG8_LAS unsigned short*)(lds + STAGE_BYTES))[i * BM + tid] = (unsigned short)S.rowtok[tu.pm * BM + tid];
        __syncthreads();
    }
    S.a_ready(cur);
    if constexpr (SP2) {
        PG8_STAGE(PG8_SB(0, 0), cB, voffB); PG8_STAGE(PG8_SB(0, 1), cB + hstep, voffB); PG8_STAGE_A(PG8_SA(0, 0), cA, 0, false); PG8_STAGE_A(PG8_SA(0, 1), cA, 1, false);
        if (wr == 1) PG8_BAR;
        PG8_WAIT_V(2); PG8_BAR;
        PG8_STAGE(PG8_SB(1, 0), cB + kstep, voffB); PG8_STAGE_A(PG8_SA(1, 0), cA + kstep, 0, false); PG8_STAGE(PG8_SB(1, 1), cB + hstep + kstep, voffB);
        PG8_WAIT_V(6); PG8_BAR;
    } else {
        PG8_STAGE(PG8_SB(0, 0), cB, voffB); PG8_STAGE_A(PG8_SA(0, 0), cA, 0, false); PG8_STAGE(PG8_SB(0, 1), cB + hstep, voffB); PG8_STAGE_A(PG8_SA(0, 1), cA, 1, false);
        if (wr == 1) PG8_BAR;
        PG8_WAIT_V(4); PG8_BAR;
        PG8_STAGE(PG8_SB(1, 0), cB + kstep, voffB); PG8_STAGE_A(PG8_SA(1, 0), cA + kstep, 0, false); PG8_STAGE(PG8_SB(1, 1), cB + hstep + kstep, voffB);
        PG8_WAIT_V(6); PG8_BAR;
    }
    for (;;) {
        const bool has_next = S.next(ui + 1, nxt);
        const char* nA = (has_next && !GATHER) ? (const char*)g.A + (size_t)nxt.pm * tstep : cA; const char* nB = has_next ? (const char*)g.Bt + (size_t)nxt.pn * tstep : cB;
        nui = has_next ? ui + 1 : ui;
#pragma unroll 1
        for (int t = 0; t < nt; t += 2) {
            const bool last = (t == nt - 2);
            const char* a1 = cA + (size_t)(t + 1) * kstep;
            const char* a2 = last ? nA : cA + (size_t)(t + 2) * kstep; const char* b2 = last ? nB : cB + (size_t)(t + 2) * kstep;
            const char* a3 = a2 + kstep; const char* b3 = b2 + kstep;
            if (last && has_next) S.a_ready(nxt);
            if constexpr (SP2) {
            PG8_LDB(B0, 0, 0); PG8_LDB(B1, 0, 1); PG8_SCHED; PG8_LDA(At, 0, 0); PG8_STAGE_A(PG8_SA(1, 1), a1, 1, false);
            PG8_WAIT_V(8); PG8_WAIT_L(0); PG8_BAR; PG8_MMA(0, 0, At, B0); PG8_MMA(0, 1, At, B1); PG8_BAR; PG8_SCHED;
            PG8_LDA(At, 0, 1); PG8_STAGE(PG8_SB(0, 0), b2, voffB); PG8_STAGE(PG8_SB(0, 1), b2 + hstep, voffB); PG8_STAGE_A(PG8_SA(0, 0), a2, 0, last);
            PG8_WAIT_V(8); PG8_WAIT_L(0); PG8_BAR; PG8_MMA(1, 0, At, B0); PG8_MMA(1, 1, At, B1); PG8_BAR; PG8_SCHED;
            PG8_LDB(B0, 1, 0); PG8_LDB(B1, 1, 1); PG8_SCHED; PG8_LDA(At, 1, 0); PG8_STAGE_A(PG8_SA(0, 1), a2, 1, last);
            PG8_WAIT_V(8); PG8_WAIT_L(0); PG8_BAR; PG8_MMA(0, 0, At, B0); PG8_MMA(0, 1, At, B1); PG8_BAR; PG8_SCHED;
            PG8_LDA(At, 1, 1); PG8_STAGE(PG8_SB(1, 0), b3, voffB); PG8_STAGE(PG8_SB(1, 1), b3 + hstep, voffB); PG8_STAGE_A(PG8_SA(1, 0), a3, 0, last);
            PG8_WAIT_V(8); PG8_WAIT_L(0); PG8_BAR; PG8_MMA(1, 0, At, B0); PG8_MMA(1, 1, At, B1); PG8_BAR; PG8_SCHED;
            } else {
            PG8_LDB(B0, 0, 0); PG8_SCHED; PG8_LDA(At, 0, 0); PG8_STAGE_A(PG8_SA(1, 1), a1, 1, false);
            PG8_WAIT_L(8); PG8_BAR; PG8_WAIT_L(0); PG8_MMA(0, 0, At, B0); PG8_BAR; PG8_SCHED;
            PG8_LDB(B1, 0, 1); PG8_STAGE(PG8_SB(0, 0), b2, voffB);
            PG8_BAR; PG8_WAIT_L(0); PG8_MMA(0, 1, At, B1); PG8_BAR;
            PG8_LDA(At, 0, 1); PG8_STAGE_A(PG8_SA(0, 0), a2, 0, last);
            PG8_BAR; PG8_WAIT_L(0); PG8_MMA(1, 0, At, B0); PG8_BAR; PG8_SCHED;
            PG8_STAGE(PG8_SB(0, 1), b2 + hstep, voffB);
            PG8_WAIT_V(6); PG8_BAR; PG8_MMA(1, 1, At, B1); PG8_BAR;
            PG8_LDB(B0, 1, 0); PG8_SCHED; PG8_LDA(At, 1, 0); PG8_STAGE_A(PG8_SA(0, 1), a2, 1, last);
            PG8_WAIT_L(8); PG8_BAR; PG8_WAIT_L(0); PG8_MMA(0, 0, At, B0); PG8_BAR; PG8_SCHED;
            PG8_LDB(B1, 1, 1); PG8_STAGE(PG8_SB(1, 0), b3, voffB);
            PG8_BAR; PG8_WAIT_L(0); PG8_MMA(0, 1, At, B1); PG8_BAR;
            PG8_LDA(At, 1, 1); PG8_STAGE_A(PG8_SA(1, 0), a3, 0, last);
            PG8_BAR; PG8_WAIT_L(0); PG8_MMA(1, 0, At, B0); PG8_BAR; PG8_SCHED;
            PG8_STAGE(PG8_SB(1, 1), b3 + hstep, voffB);
            PG8_WAIT_V(6); PG8_BAR; PG8_MMA(1, 1, At, B1); PG8_BAR;
            }
        }
        if constexpr (F8) asm volatile("s_nop 15\n\ts_nop 7" ::: "memory");
        if constexpr (ALIGN_EPI) { if (wr == 0) PG8_BAR; }
        if constexpr (I8) {
#pragma unroll
            for (int a = 0; a < 2; ++a)
#pragma unroll
                for (int b = 0; b < 2; ++b)
#pragma unroll
                    for (int m = 0; m < 4; ++m)
#pragma unroll
                        for (int n = 0; n < 2; ++n) acc[a][b][m][n] = __builtin_convertvector(__builtin_bit_cast(v4i32, acc[a][b][m][n]), f32x4); }
        if constexpr (!Epi::AFTER_DRAIN) { E(acc, cur, wr, wc, fr, fq); S.done(cur); }
        if (!has_next) break;
#pragma unroll
        for (int a = 0; a < 2; ++a)
#pragma unroll
            for (int b = 0; b < 2; ++b)
#pragma unroll
                for (int m = 0; m < 4; ++m)
#pragma unroll
                    for (int n = 0; n < 2; ++n) acc[a][b][m][n] = (f32x4){0.f, 0.f, 0.f, 0.f};
        cur = nxt; cA = nA; cB = nB; ++ui;

        if constexpr (ALIGN_EPI) { if (wr == 1) PG8_BAR; }
    }
    PG8_WAIT_V(0);
    if constexpr (!ALIGN_EPI) { if (wr == 0) PG8_BAR; }
    PG8_BAR;
    if constexpr (Epi::AFTER_DRAIN) { E.fused(acc, cur, wr, wc, fr, fq, lds, wid, lane); S.done(cur); }
#undef PG8_SA
#undef PG8_SB
#undef PG8_STAGE
#undef PG8_LDA
#undef PG8_LDB
#undef PG8_LD16
#undef PG8_STAGE_A
#undef PG8_GOFFS
#undef PG8_GO1
#undef PG8_MMA
#undef PG8_WAIT_V
#undef PG8_WAIT_L
#undef PG8_BAR
#undef PG8_SCHED
}
}

constexpr int NWAVES = 8, NTHREADS = 512;
constexpr int BATCH = 4, SEQ = 4096, DM = 1024, T = BATCH * SEQ;
constexpr int INW = 5408, PW = 5632;
constexpr int NEXP = 32, TOPK = 4, DE = 1024, NASSIGN = T * TOPK, MOE_ROWS = 256;
constexpr int MOE_MAXTILES = (NASSIGN + NEXP * (MOE_ROWS - 1) + MOE_ROWS - 1) / MOE_ROWS;
constexpr int MOE_P = MOE_MAXTILES * MOE_ROWS;
constexpr float NORM_EPS = 1e-6f;
constexpr int PC_Q = 0, PC_KV = 512, PC_MLQ = 1280, PC_MLK = 1792, PC_MLV = 2304, PC_MLO = 2816, PC_MGA = 3328, PC_MGB = 4352, PC_NSAG = 5376, PC_MLIF = 5400;
constexpr int ADA_SLICES = 16, PB_SLICES = 16;

constexpr size_t MiB = 1u << 20;
constexpr size_t WS_CTL = 0, CTL_ZERO_BYTES = 1 * MiB;
constexpr size_t WS_MODP = 1 * MiB;
constexpr size_t WS_MODF = 3 * MiB;
constexpr size_t WS_PBP  = 3 * MiB + 512 * 1024;
constexpr size_t WS_WIN  = 4 * MiB;
constexpr size_t WS_WUPA = 16 * MiB, WS_WUPB = 17 * MiB;
constexpr size_t WS_WOUT = 18 * MiB;
constexpr size_t WS_CW1K = 20 * MiB, WS_CW1V = 20 * MiB + 512 * 1024;
constexpr size_t WS_CW2K = 21 * MiB, WS_CW2V = 21 * MiB + 64 * 1024;
constexpr size_t WS_KC = 22 * MiB, WS_VC = 22 * MiB + 512 * 1024;
constexpr size_t WS_SELM = 23 * MiB;
constexpr size_t WS_TOPI = 24 * MiB, WS_GATE = 24 * MiB + 256 * 1024, WS_DEST = 24 * MiB + 512 * 1024;
constexpr size_t WS_ROWT = 30 * MiB;
constexpr size_t WS_ROWG = 25 * MiB;
constexpr size_t WS_MLB = 26 * MiB, WS_MLLI = 26 * MiB + 256 * 1024;
constexpr size_t WS_RWHI = 25 * MiB + 512 * 1024, WS_RWLO = 25 * MiB + 768 * 1024;
constexpr size_t WS_MLSC = 27 * MiB;
constexpr size_t WS_MLUN = 28 * MiB, WS_MLN = 29 * MiB;
constexpr size_t WS_W1T = 32 * MiB;
constexpr size_t WS_WIN8 = 96 * MiB;
constexpr size_t WS_A1F8 = 674 * MiB;
constexpr size_t WS_SA = 31 * MiB;
constexpr size_t WS_SW = 31 * MiB + 128 * 1024;
constexpr size_t WS_W2T = 160 * MiB;
constexpr size_t WS_H1 = 224 * MiB;
constexpr size_t WS_A1 = 288 * MiB;
constexpr size_t WS_PROJ = 320 * MiB;
constexpr size_t WS_XG = 320 * MiB;
constexpr size_t WS_OCMP = 496 * MiB, WS_ONSA = 512 * MiB, WS_OML = 528 * MiB, WS_MLQ = 544 * MiB, WS_MLKK = 560 * MiB;
constexpr size_t WS_MLU = 576 * MiB;
constexpr size_t WS_MLC = 640 * MiB;
constexpr size_t WS_U = 674 * MiB;
constexpr size_t WS_ACT = 496 * MiB;
constexpr size_t WS_YR = 640 * MiB;
constexpr size_t WS_END = 784 * MiB;
constexpr int CW_BAR = 4096;
constexpr int CW_ECNT = 16384;
constexpr int CW_EFILL = 16384 + 64 * 32;
constexpr int CW_CMAX = 65536;
constexpr int CW_MOETAB = 32768;

constexpr int RING_BYTES = 131072;
constexpr int LDSCTL_OFF = 146432, MISC_OFF = LDSCTL_OFF + 320;
constexpr int LDS_BYTES = 147456;

#define GAS __attribute__((address_space(1)))
#define LAS __attribute__((address_space(3)))
typedef unsigned short bf16;
typedef unsigned v4u __attribute__((ext_vector_type(4)));
typedef unsigned v2u __attribute__((ext_vector_type(2)));
typedef float f32x4 __attribute__((ext_vector_type(4)));
typedef short bf16x8 __attribute__((ext_vector_type(8)));
typedef short s16x4 __attribute__((ext_vector_type(4)));
#define LDS_WAIT() asm volatile("s_waitcnt lgkmcnt(0)" ::: "memory")
#define VM_WAIT() asm volatile("s_waitcnt vmcnt(0)" ::: "memory")
__device__ __forceinline__ unsigned f2bf(float f) { unsigned u = __builtin_bit_cast(unsigned, f); return (u + 0x7fffu + ((u >> 16) & 1u)) >> 16; }
__device__ __forceinline__ unsigned pk2(float lo, float hi) { return f2bf(lo) | (f2bf(hi) << 16); }
__device__ __forceinline__ unsigned pk4_fp8(float a, float b, float c, float d) { int w = __builtin_amdgcn_cvt_pk_fp8_f32(a, b, 0, false); w = __builtin_amdgcn_cvt_pk_fp8_f32(c, d, w, true); return (unsigned)w; }
__device__ __forceinline__ float bf2f(unsigned short b) { return __builtin_bit_cast(float, (unsigned)b << 16); }
__device__ __forceinline__ float bflo(unsigned w) { return __builtin_bit_cast(float, w << 16); }
__device__ __forceinline__ float bfhi(unsigned w) { return __builtin_bit_cast(float, w & 0xffff0000u); }
__device__ __forceinline__ float sigmoidf_(float x) { return __builtin_amdgcn_rcpf(1.0f + __builtin_amdgcn_exp2f(x * -1.4426950408889634f)); }
__device__ __forceinline__ float wave_sum(float v) {
#pragma unroll
    for (int o = 1; o < 64; o <<= 1) v += __shfl_xor(v, o);
    return v;
}
__device__ __forceinline__ float wave_max(float v) {
#pragma unroll
    for (int o = 1; o < 64; o <<= 1) v = fmaxf(v, __shfl_xor(v, o));
    return v;
}
#define XB_TMO      128
#define XB_XCNT(j)  (256  + 64 * (j))
#define XB_XSUB(j)  (1280 + 64 * (j))
#define XB_XGEN(j)  (2304 + 64 * (j))
#define XB_TOP      3328
#define XB_TOPGEN   3392
#define XCD_BAR_WORDS 3456
#define XB_SPIN_CAP (1u << 18)

__device__ __forceinline__ unsigned xb_ld(unsigned* p)              { return __hip_atomic_load(p, __ATOMIC_RELAXED, __HIP_MEMORY_SCOPE_AGENT); }
__device__ __forceinline__ unsigned xb_add(unsigned* p, unsigned v) { return __hip_atomic_fetch_add(p, v, __ATOMIC_RELAXED, __HIP_MEMORY_SCOPE_AGENT); }
__device__ __forceinline__ unsigned xb_xcc_id() { return (unsigned)__builtin_amdgcn_s_getreg((3 << 11) | 20) & 0xFu; }
#define XB_SPIN(cond, bar) do { unsigned _sp = 0; while (cond) { __builtin_amdgcn_s_sleep(1); \
    if ((++_sp & 255u) == 0u) { if (xb_ld(&(bar)[XB_TMO])) break; if (_sp > XB_SPIN_CAP) { atomicAdd(&(bar)[XB_TMO], 1u); break; } } } } while (0)

struct XcdBarrier {
    unsigned* bar; unsigned x;
    volatile LAS unsigned* st;
};

__device__ __forceinline__ XcdBarrier xcd_barrier_post(unsigned* bar, volatile LAS unsigned* st) {
    XcdBarrier b; b.bar = bar; b.x = xb_xcc_id(); b.st = st;
    if (threadIdx.x == 0) (void)xb_add(&bar[XB_XCNT(b.x)], 1u);
    return b;
}
__device__ __forceinline__ void xcd_barrier_complete(unsigned* bar, unsigned x, unsigned& nloc, unsigned& nx) {
    const unsigned G = gridDim.x * gridDim.y * gridDim.z;
    unsigned sum, cnt, mine, sp = 0u;
    for (;;) {
        sum = 0u; cnt = 0u; mine = 0u;
#pragma unroll
        for (unsigned j = 0; j < 16; ++j) { const unsigned c = xb_ld(&bar[XB_XCNT(j)]); sum += c; cnt += (c > 0u) ? 1u : 0u; mine = (j == x) ? c : mine; }
        if (sum == G) break;
        __builtin_amdgcn_s_sleep(1);
        if ((++sp & 255u) == 0u) { if (xb_ld(&bar[XB_TMO])) break; if (sp > XB_SPIN_CAP) { atomicAdd(&bar[XB_TMO], 1u); break; } }
    }
    nloc = mine > 0u ? mine : 1u; nx = cnt > 0u ? cnt : 1u;
}

__device__ __forceinline__ void xcd_barrier(const XcdBarrier& b) {
    asm volatile("s_waitcnt vmcnt(0)" ::: "memory");
    __syncthreads();
    if (threadIdx.x == 0) {
        unsigned* bar = b.bar;
        __builtin_amdgcn_s_waitcnt(0);
        unsigned nloc = b.st[0], nx = b.st[1];
        if (nloc == 0u) { xcd_barrier_complete(bar, b.x, nloc, nx); b.st[0] = nloc; b.st[1] = nx; }
        const unsigned old = xb_add(&bar[XB_XSUB(b.x)], 1u);
        const unsigned gen = old / nloc;
        if (old + 1u == (gen + 1u) * nloc) {
            __builtin_amdgcn_fence(__ATOMIC_RELEASE, "agent");
            asm volatile("s_waitcnt vmcnt(0)" ::: "memory");
            const unsigned og = xb_add(&bar[XB_TOP], 1u);
            const unsigned tg = og / nx;
            if (og + 1u == (tg + 1u) * nx) xb_add(&bar[XB_TOPGEN], 1u);
            else XB_SPIN(xb_ld(&bar[XB_TOPGEN]) == tg, bar);
            __builtin_amdgcn_fence(__ATOMIC_ACQUIRE, "agent");
            xb_add(&bar[XB_XGEN(b.x)], 1u);
            asm volatile("s_waitcnt vmcnt(0)" ::: "memory");
        } else {
            XB_SPIN(xb_ld(&bar[XB_XGEN(b.x)]) == gen, bar);
            __builtin_amdgcn_fence(__ATOMIC_ACQUIRE, "agent");
            asm volatile("s_waitcnt vmcnt(0)" ::: "memory");
        }
    }
    __syncthreads();
}

using pg8::Unit; using pg8::HALF; using pg8::BM;
struct EpiStoreBf16 {
    static constexpr bool PERM = true, AFTER_DRAIN = false;
    bf16* O; int ldc;
    __device__ __forceinline__ void operator()(const f32x4 (&acc)[2][2][4][2], const Unit& u, int wr, int wc, int fr, int fq) const {
        const int row0 = u.pm * BM + wr * 64 + fr, col0 = u.pn * BM + wc * 32 + 8 * fq;
#pragma unroll
        for (int ai = 0; ai < 2; ++ai)
#pragma unroll
            for (int m = 0; m < 4; ++m) { bf16* rowp = O + (size_t)(row0 + ai * HALF + m * 16) * ldc + col0;
#pragma unroll
                for (int bj = 0; bj < 2; ++bj) { const f32x4 v0 = acc[ai][bj][m][0], v1 = acc[ai][bj][m][1];
                    v4u w; w.x = pg8::cvt_pk_bf16(v0[0], v0[1]); w.y = pg8::cvt_pk_bf16(v0[2], v0[3]); w.z = pg8::cvt_pk_bf16(v1[0], v1[1]); w.w = pg8::cvt_pk_bf16(v1[2], v1[3]);
                    *(v4u*)(rowp + bj * HALF) = w; } }
    }
};
struct EpiStoreScaled {
    static constexpr bool PERM = true, AFTER_DRAIN = false;
    bf16* O; int ldc; const float* sa; const float* sw;
    __device__ __forceinline__ void operator()(const f32x4 (&acc)[2][2][4][2], const Unit& u, int wr, int wc, int fr, int fq) const {
        const int row0 = u.pm * BM + wr * 64 + fr, col0 = u.pn * BM + wc * 32 + 8 * fq;
        f32x4 cs[2][2];
#pragma unroll
        for (int bj = 0; bj < 2; ++bj)
#pragma unroll
            for (int n = 0; n < 2; ++n) cs[bj][n] = *(const f32x4*)(sw + col0 + bj * HALF + 4 * n);
#pragma unroll
        for (int ai = 0; ai < 2; ++ai)
#pragma unroll
            for (int m = 0; m < 4; ++m) { const int row = row0 + ai * HALF + m * 16; const float rsc = sa[row]; bf16* rowp = O + (size_t)row * ldc + col0;
#pragma unroll
                for (int bj = 0; bj < 2; ++bj) { const f32x4 v0 = acc[ai][bj][m][0] * cs[bj][0] * rsc, v1 = acc[ai][bj][m][1] * cs[bj][1] * rsc;
                    v4u w; w.x = pk2(v0[0], v0[1]); w.y = pk2(v0[2], v0[3]); w.z = pk2(v1[0], v1[1]); w.w = pk2(v1[2], v1[3]);
                    *(v4u*)(rowp + bj * HALF) = w; } }
    }
};
template <bool ADD> struct EpiUpGate {
    static constexpr bool PERM = true, AFTER_DRAIN = false;
    bf16* U; const bf16* G; int goff;
    __device__ __forceinline__ void operator()(const f32x4 (&acc)[2][2][4][2], const Unit& u, int wr, int wc, int fr, int fq) const {
        const int row0 = u.pm * BM + wr * 64 + fr, col0 = u.pn * BM + wc * 32 + 8 * fq;
#pragma unroll
        for (int ai = 0; ai < 2; ++ai)
#pragma unroll
            for (int m = 0; m < 4; ++m) { const size_t row = (size_t)(row0 + ai * HALF + m * 16);
#pragma unroll
                for (int bj = 0; bj < 2; ++bj) { const int col = col0 + bj * HALF;
                    const v4u gw = *(const v4u*)(G + row * PW + goff + col);
                    f32x4 v0 = acc[ai][bj][m][0], v1 = acc[ai][bj][m][1];
                    v0[0] *= sigmoidf_(bflo(gw.x)); v0[1] *= sigmoidf_(bfhi(gw.x)); v0[2] *= sigmoidf_(bflo(gw.y)); v0[3] *= sigmoidf_(bfhi(gw.y));
                    v1[0] *= sigmoidf_(bflo(gw.z)); v1[1] *= sigmoidf_(bfhi(gw.z)); v1[2] *= sigmoidf_(bflo(gw.w)); v1[3] *= sigmoidf_(bfhi(gw.w));
                    if (ADD) { const v4u uw = *(const v4u*)(U + row * DM + col);
                        v0[0] += bflo(uw.x); v0[1] += bfhi(uw.x); v0[2] += bflo(uw.y); v0[3] += bfhi(uw.y); v1[0] += bflo(uw.z); v1[1] += bfhi(uw.z); v1[2] += bflo(uw.w); v1[3] += bfhi(uw.w); }
                    v4u w; w.x = pg8::cvt_pk_bf16(v0[0], v0[1]); w.y = pg8::cvt_pk_bf16(v0[2], v0[3]); w.z = pg8::cvt_pk_bf16(v1[0], v1[1]); w.w = pg8::cvt_pk_bf16(v1[2], v1[3]);
                    *(v4u*)(U + row * DM + col) = w; } }
    }
};
struct EpiOutRes {
    static constexpr bool PERM = true, AFTER_DRAIN = false;
    const float* X; bf16* H; const float* modf;
    __device__ __forceinline__ void operator()(const f32x4 (&acc)[2][2][4][2], const Unit& u, int wr, int wc, int fr, int fq) const {
        const int row0 = u.pm * BM + wr * 64 + fr, col0 = u.pn * BM + wc * 32 + 8 * fq;
        const int b = (u.pm * BM) / SEQ; const float* gt = modf + (size_t)b * 6 * DM + 2 * DM;
        f32x4 gv[2][2];
#pragma unroll
        for (int bj = 0; bj < 2; ++bj)
#pragma unroll
            for (int n = 0; n < 2; ++n) gv[bj][n] = *(const f32x4*)(gt + col0 + bj * HALF + 4 * n) + 1.0f;
#pragma unroll
        for (int ai = 0; ai < 2; ++ai)
#pragma unroll
            for (int m = 0; m < 4; ++m) { const size_t off = (size_t)(row0 + ai * HALF + m * 16) * DM + col0;
#pragma unroll
                for (int bj = 0; bj < 2; ++bj) { const f32x4 x0 = *(const f32x4*)(X + off + bj * HALF), x1 = *(const f32x4*)(X + off + bj * HALF + 4);
                    const f32x4 v0 = x0 + gv[bj][0] * acc[ai][bj][m][0], v1 = x1 + gv[bj][1] * acc[ai][bj][m][1];
                    v4u w; w.x = pk2(v0[0], v0[1]); w.y = pk2(v0[2], v0[3]); w.z = pk2(v1[0], v1[1]); w.w = pk2(v1[2], v1[3]);
                    *(v4u*)(H + off + bj * HALF) = w; } }
    }
};
struct EpiMoe1 {
    static constexpr bool PERM = true, AFTER_DRAIN = false;
    unsigned char* ACT; const LAS float* bt;
    __device__ __forceinline__ void operator()(const f32x4 (&acc)[2][2][4][2], const Unit& u, int wr, int wc, int fr, int fq) const {
        const int e = u.pn >> 3, pnl = u.pn & 7;
        const int row0 = u.pm * BM + wr * 64 + fr, c0 = pnl * 128 + wc * 32 + 8 * fq;
        const LAS float* bg = bt + u.ix * 256 + wc * 32 + 8 * fq; const LAS float* bl = bg + 128; (void)e;
        const f32x4 bg0 = *(const LAS f32x4*)bg, bg1 = *(const LAS f32x4*)(bg + 4), bl0 = *(const LAS f32x4*)bl, bl1 = *(const LAS f32x4*)(bl + 4);
#pragma unroll
        for (int ai = 0; ai < 2; ++ai)
#pragma unroll
            for (int m = 0; m < 4; ++m) { unsigned char* rowp = ACT + (size_t)(row0 + ai * HALF + m * 16) * DE + c0;
                float o[8];
#pragma unroll
                for (int n = 0; n < 2; ++n) { const f32x4 g = acc[ai][0][m][n] + (n ? bg1 : bg0), l = acc[ai][1][m][n] + (n ? bl1 : bl0);
#pragma unroll
                    for (int i = 0; i < 4; ++i) { const float gg = fminf(g[i], 7.0f), ll = fminf(fmaxf(l[i], -7.0f), 7.0f);
                        o[n * 4 + i] = gg * sigmoidf_(1.702f * gg) * (ll + 1.0f); } }
                v2u w; w.x = pk4_fp8(o[0], o[1], o[2], o[3]); w.y = pk4_fp8(o[4], o[5], o[6], o[7]);
                *(v2u*)rowp = w; }
    }
};
struct EpiMoe2 {
    static constexpr bool PERM = true, AFTER_DRAIN = false;
    unsigned char* Y; const LAS float* bt;
    __device__ __forceinline__ void operator()(const f32x4 (&acc)[2][2][4][2], const Unit& u, int wr, int wc, int fr, int fq) const {
        const int pnl = u.pn & 3;
        const int row0 = u.pm * BM + wr * 64 + fr, col0 = pnl * BM + wc * 32 + 8 * fq;
        f32x4 bv[2][2];
#pragma unroll
        for (int bj = 0; bj < 2; ++bj)
#pragma unroll
            for (int n = 0; n < 2; ++n) bv[bj][n] = *(const LAS f32x4*)(bt + u.ix * 512 + wc * 32 + 8 * fq + bj * HALF + 4 * n);
#pragma unroll
        for (int ai = 0; ai < 2; ++ai)
#pragma unroll
            for (int m = 0; m < 4; ++m) { const int row = row0 + ai * HALF + m * 16; const float g = bt[u.ix * 512 + 256 + wr * 64 + fr + ai * HALF + m * 16] * 16.0f; unsigned char* rowp = Y + (size_t)row * DM + col0;
#pragma unroll
                for (int bj = 0; bj < 2; ++bj) { const f32x4 v0 = (acc[ai][bj][m][0] + bv[bj][0]) * g, v1 = (acc[ai][bj][m][1] + bv[bj][1]) * g;
                    v2u w; w.x = pk4_fp8(v0[0], v0[1], v0[2], v0[3]); w.y = pk4_fp8(v1[0], v1[1], v1[2], v1[3]);
                    *(v2u*)(rowp + bj * HALF) = w; } }
    }
};
constexpr int MOE_UL_OFF = 145408;
struct MoeOrder {
    const LAS int* ul; const int* rowtok;
    __device__ __forceinline__ bool next(int i, Unit& u) const { const int pm = ul[2 * i]; if (pm < 0) return false; u.pm = pm; u.pn = ul[2 * i + 1]; u.ix = i; return true; }
    __device__ __forceinline__ void a_ready(const Unit&) const {}
    __device__ __forceinline__ void done(const Unit&) const {}
};
constexpr int MOE_BT1_OFF = 135680, MOE_BT2_OFF = 131072;
template <int WHICH> __device__ __forceinline__ void moe_units_to_lds(LAS unsigned char* lds, const unsigned* tab, int nN, int sh, int G, int v, const float* bias, const float* rg) {
    LAS int* ul = (LAS int*)(lds + MOE_UL_OFF);
    __syncthreads();
    if (threadIdx.x < 16) { const int i = threadIdx.x; const int ntl = (int)tab[0]; const long L = (long)i * G + v; int pm = -1, pn = 0;
        if (L < (long)ntl * nN) { pm = (int)(L >> sh); const int e = (int)tab[64 + pm]; pn = e * nN + (int)(L & (nN - 1)); }
        ul[2 * i] = pm; ul[2 * i + 1] = pn; }
    __syncthreads();
    { float val[9]; const int t = threadIdx.x;
#pragma unroll
      for (int i = 0; i < 9; ++i) { const int pm = ul[2 * i], pn = ul[2 * i + 1]; val[i] = 0.f;
          if (pm >= 0) { if (WHICH == 1) { if (t < 256) { const int e = pn >> 3, pnl = pn & 7; val[i] = bias[(size_t)e * 2048 + (t < 128 ? 128 * pnl + t : 1024 + 128 * pnl + (t - 128))]; } }
                         else { const int e = pn >> 2, pnl = pn & 3; val[i] = t < 256 ? bias[(size_t)e * DM + 256 * pnl + t] : rg[(size_t)pm * 256 + (t - 256)]; } } }
#pragma unroll
      for (int i = 0; i < 9; ++i) { if (WHICH == 1) { if (t < 256) ((LAS float*)(lds + MOE_BT1_OFF))[i * 256 + t] = val[i]; } else if (i < 5) ((LAS float*)(lds + MOE_BT2_OFF))[i * 512 + t] = val[i]; } }
    __syncthreads();
}


struct Args { const float* in[27]; float* out; unsigned char* ws; int ph_lo, ph_hi; };
struct Ctx {
    LAS unsigned char* lds; unsigned char* ws; unsigned* ctl;
    int tid, lane, wave, vcu, G;
    const float* const* in; float* out;
};
enum { I_X = 0, I_C, I_ADAW, I_ADAB, I_N1G, I_WIN, I_PEK, I_PEV, I_CW1K, I_CW2K, I_CW1V, I_CW2V, I_CONVW, I_CONVB, I_GATEB, I_MLNG, I_WUPA, I_WUPB, I_WOUT, I_N2G, I_RW, I_RB, I_EW1, I_EB1, I_EW2, I_EB2, I_FG };

template <class DMap>
__device__ __forceinline__ void p0_transpose_item(const float* W, int K, int N, bf16* WT, const DMap& dmap, LAS float* scr, int item, int lane) {
    const int nblk = N / 32, kb = item / nblk, nb = item % nblk, k0 = 64 * kb, n0 = 32 * nb;
    float tmp[16];
#pragma unroll
    for (int hh = 0; hh < 2; ++hh) {
#pragma unroll
    for (int i = 0; i < 16; ++i) tmp[i] = W[(size_t)(k0 + 2 * (16 * hh + i) + (lane >> 5)) * N + n0 + (lane & 31)];
#pragma unroll
    for (int i = 0; i < 16; ++i) scr[(2 * (16 * hh + i) + (lane >> 5)) * 33 + (lane & 31)] = tmp[i]; }
    LDS_WAIT(); asm volatile("" ::: "memory");
    const int c = lane & 7;
#pragma unroll
    for (int j = 0; j < 4; ++j) { const int n = (lane >> 3) + 8 * j; const LAS float* s = scr + (8 * c) * 33 + n;
        v4u o; o.x = pk2(s[0 * 33], s[1 * 33]); o.y = pk2(s[2 * 33], s[3 * 33]); o.z = pk2(s[4 * 33], s[5 * 33]); o.w = pk2(s[6 * 33], s[7 * 33]);
        *(GAS v4u*)(WT + (size_t)dmap(n0 + n) * K + k0 + 8 * c) = o; }
    LDS_WAIT(); asm volatile("" ::: "memory");
}
struct DMapId { __device__ __forceinline__ int operator()(int n) const { return n; } };
struct DMapWin { __device__ __forceinline__ int operator()(int n) const {
    if (n < 1280) return n;
    if (n < 1304) return PC_NSAG + (n - 1280);
    if (n < 2328) return PC_MLQ + (n - 1304);
    if (n < 2840) return PC_MLV + (n - 2328);
    if (n < 2848) return PC_MLIF + (n - 2840);
    if (n < 3360) return PC_MLO + (n - 2848);
    return PC_MGA + (n - 3360); } };
struct DMapW1 { __device__ __forceinline__ int operator()(int n) const { return n < 1024 ? ((n >> 7) << 8) + (n & 127) : (((n - 1024) >> 7) << 8) + 128 + (n & 127); } };

constexpr int MOE_I1 = (DM / 128) * (2048 / 256), MOE_I2 = (DE / 128) * (DM / 256), MOE_ITEMS = NEXP * (MOE_I1 + MOE_I2);
struct MoeItem { const float* src; unsigned char* dst; int N; bool w1; };
__device__ __forceinline__ MoeItem moe_item(const Ctx& F, int it) {
    MoeItem m;
    if (it < NEXP * MOE_I1) { const int e = it / MOE_I1, l = it % MOE_I1, kb = l >> 3, nb = l & 7; m.w1 = true; m.N = 2048 | (nb << 16);
        m.src = F.in[I_EW1] + (size_t)e * DM * 2048 + (size_t)(128 * kb) * 2048 + 256 * nb; m.dst = F.ws + WS_W1T + (size_t)e * 2048 * DM + 128 * kb; }
    else { const int r = it - NEXP * MOE_I1, e = r / MOE_I2, l = r % MOE_I2, kb = l >> 2, nb = l & 3; m.w1 = false; m.N = DM | (nb << 16);
        m.src = F.in[I_EW2] + (size_t)e * DE * DM + (size_t)(128 * kb) * DM + 256 * nb; m.dst = F.ws + WS_W2T + (size_t)e * DM * DE + 128 * kb; }
    return m;
}
__device__ __forceinline__ void moe_load_item(const Ctx& F, int it, f32x4 (&r)[16]) {
    const MoeItem m = moe_item(F, it); const int N = m.N & 0xffff;
#pragma unroll
    for (int i = 0; i < 16; ++i) r[i] = *(const f32x4*)(m.src + (size_t)(16 * F.wave + i) * N + 4 * F.lane);
}
__device__ __forceinline__ void moe_emit_item(Ctx& F, int it, const f32x4 (&r)[16]) {
    LAS float* tile = (LAS float*)F.lds; const int wave = F.wave, lane = F.lane;
    const MoeItem m = moe_item(F, it); const int nb = m.N >> 16;
    __syncthreads();
#pragma unroll
    for (int i = 0; i < 16; ++i) *(LAS f32x4*)(tile + (16 * wave + i) * 260 + 4 * lane) = r[i] * 32.0f;
    __syncthreads();
    const int n = 32 * wave + (lane >> 1), kh = (lane & 1) * 64; const LAS float* s = tile + kh * 260 + n;
    const int ng = 256 * nb + n; const int drow = m.w1 ? DMapW1()(ng) : ng;
    unsigned char* dst = m.dst + (size_t)drow * DM + kh;
#pragma unroll
    for (int i = 0; i < 4; ++i) { v4u o;
        o.x = pk4_fp8(s[(16 * i + 0) * 260], s[(16 * i + 1) * 260], s[(16 * i + 2) * 260], s[(16 * i + 3) * 260]); o.y = pk4_fp8(s[(16 * i + 4) * 260], s[(16 * i + 5) * 260], s[(16 * i + 6) * 260], s[(16 * i + 7) * 260]);
        o.z = pk4_fp8(s[(16 * i + 8) * 260], s[(16 * i + 9) * 260], s[(16 * i + 10) * 260], s[(16 * i + 11) * 260]); o.w = pk4_fp8(s[(16 * i + 12) * 260], s[(16 * i + 13) * 260], s[(16 * i + 14) * 260], s[(16 * i + 15) * 260]);
        *(GAS v4u*)(dst + 16 * i) = o; }
}
__device__ __forceinline__ void moe_convert(Ctx& F, int first, int stride) {
    f32x4 b0[16], b1[16], b2[16];
    if (first >= MOE_ITEMS) return;
    moe_load_item(F, first, b0);
    if (first + stride < MOE_ITEMS) moe_load_item(F, first + stride, b1);
#pragma unroll 1
    for (int it = first; it < MOE_ITEMS; it += 3 * stride) {
        if (it + 2 * stride < MOE_ITEMS) moe_load_item(F, it + 2 * stride, b2);
        moe_emit_item(F, it, b0);
        if (it + stride >= MOE_ITEMS) break;
        if (it + 3 * stride < MOE_ITEMS) moe_load_item(F, it + 3 * stride, b0);
        moe_emit_item(F, it + stride, b1);
        if (it + 2 * stride >= MOE_ITEMS) break;
        if (it + 4 * stride < MOE_ITEMS) moe_load_item(F, it + 4 * stride, b1);
        moe_emit_item(F, it + 2 * stride, b2);
    }
    __syncthreads();
}
template <class DMap>
__device__ __forceinline__ void p0_transpose_item_f8(const float* W, int K, int N, unsigned char* WT, const DMap& dmap, LAS float* scr, int item, int lane) {
    const int nblk = N / 32, kb = item / nblk, nb = item % nblk, k0 = 128 * kb, n0 = 32 * nb;
    const int lr = lane >> 3, c4 = lane & 7;
    f32x4 tmp[16];
#pragma unroll
    for (int i = 0; i < 16; ++i) tmp[i] = *(const f32x4*)(W + (size_t)(k0 + 8 * i + lr) * N + n0 + 4 * c4);
    const int n = lane >> 1, kq = (lane & 1) * 32;
    unsigned char* dst = WT + (size_t)dmap(n0 + n) * K + k0 + kq;
#pragma unroll
    for (int hh = 0; hh < 2; ++hh) {
#pragma unroll
        for (int i = 0; i < 8; ++i) *(LAS f32x4*)(scr + (8 * i + lr) * 36 + 4 * c4) = tmp[8 * hh + i] * 32.0f;
        LDS_WAIT(); asm volatile("" ::: "memory");
        const LAS float* s = scr + kq * 36 + n;
#pragma unroll
        for (int i = 0; i < 2; ++i) { v4u o;
            o.x = pk4_fp8(s[(16 * i + 0) * 36], s[(16 * i + 1) * 36], s[(16 * i + 2) * 36], s[(16 * i + 3) * 36]); o.y = pk4_fp8(s[(16 * i + 4) * 36], s[(16 * i + 5) * 36], s[(16 * i + 6) * 36], s[(16 * i + 7) * 36]);
            o.z = pk4_fp8(s[(16 * i + 8) * 36], s[(16 * i + 9) * 36], s[(16 * i + 10) * 36], s[(16 * i + 11) * 36]); o.w = pk4_fp8(s[(16 * i + 12) * 36], s[(16 * i + 13) * 36], s[(16 * i + 14) * 36], s[(16 * i + 15) * 36]);
            *(GAS v4u*)(dst + 64 * hh + 16 * i) = o; }
        LDS_WAIT(); asm volatile("" ::: "memory");
    }
}
template <class DMap>
__device__ __forceinline__ void p0_colmax_item(const float* W, int N, unsigned* cmax, const DMap& dmap, int item, int lane) {
    const int nblk = N / 32, kb = item / nblk, nb = item % nblk, k0 = 64 * kb, n0 = 32 * nb;
    float tmp[32];
#pragma unroll
    for (int i = 0; i < 32; ++i) tmp[i] = W[(size_t)(k0 + 2 * i + (lane >> 5)) * N + n0 + (lane & 31)];
    float m = 0.f;
#pragma unroll
    for (int i = 0; i < 32; ++i) m = fmaxf(m, fabsf(tmp[i]));
    m = fmaxf(m, __shfl_xor(m, 32));
    if (lane < 32) atomicMax(cmax + dmap(n0 + lane), __float_as_uint(m));
}
__device__ __forceinline__ unsigned pk4_i8(float a, float b, float c, float d) {
    return (unsigned)(__float2int_rn(a) & 0xff) | ((unsigned)(__float2int_rn(b) & 0xff) << 8) | ((unsigned)(__float2int_rn(c) & 0xff) << 16) | ((unsigned)__float2int_rn(d) << 24);
}
template <class DMap>
__device__ __forceinline__ void p1_quant_item_i8(const float* W, int K, int N, unsigned char* WT, float* sw, const unsigned* cmax, const DMap& dmap, LAS float* scr, int item, int lane) {
    const int nblk = N / 32, kb = item / nblk, nb = item % nblk, k0 = 128 * kb, n0 = 32 * nb;
    const int lr = lane >> 3, c4 = lane & 7;
    f32x4 tmp[16];
#pragma unroll
    for (int i = 0; i < 16; ++i) tmp[i] = *(const f32x4*)(W + (size_t)(k0 + 8 * i + lr) * N + n0 + 4 * c4);
    f32x4 inv;
#pragma unroll
    for (int j = 0; j < 4; ++j) { const float cm = __uint_as_float(cmax[dmap(n0 + 4 * c4 + j)]); inv[j] = cm > 0.f ? 127.0f / cm : 0.f; }
    if (kb == 0 && lane < 32) { const int d = dmap(n0 + lane); sw[d] = __uint_as_float(cmax[d]) * (1.0f / 127.0f); }
    const int n = lane >> 1, kq = (lane & 1) * 32;
    unsigned char* dst = WT + (size_t)dmap(n0 + n) * K + k0 + kq;
#pragma unroll
    for (int hh = 0; hh < 2; ++hh) {
#pragma unroll
        for (int i = 0; i < 8; ++i) *(LAS f32x4*)(scr + (8 * i + lr) * 36 + 4 * c4) = tmp[8 * hh + i] * inv;
        LDS_WAIT(); asm volatile("" ::: "memory");
        const LAS float* s = scr + kq * 36 + n;
#pragma unroll
        for (int i = 0; i < 2; ++i) { v4u o;
            o.x = pk4_i8(s[(16 * i + 0) * 36], s[(16 * i + 1) * 36], s[(16 * i + 2) * 36], s[(16 * i + 3) * 36]); o.y = pk4_i8(s[(16 * i + 4) * 36], s[(16 * i + 5) * 36], s[(16 * i + 6) * 36], s[(16 * i + 7) * 36]);
            o.z = pk4_i8(s[(16 * i + 8) * 36], s[(16 * i + 9) * 36], s[(16 * i + 10) * 36], s[(16 * i + 11) * 36]); o.w = pk4_i8(s[(16 * i + 12) * 36], s[(16 * i + 13) * 36], s[(16 * i + 14) * 36], s[(16 * i + 15) * 36]);
            *(GAS v4u*)(dst + 64 * hh + 16 * i) = o; }
        LDS_WAIT(); asm volatile("" ::: "memory");
    }
}
__device__ __forceinline__ void p0_prologue(Ctx& F) {
    LAS float* scr = (LAS float*)(F.lds + F.wave * 16896);
    const int gw = F.vcu * NWAVES + F.wave, NGW = F.G * NWAVES;
    constexpr int I_IN = (DM / 64) * (INW / 32), I_UP = (512 / 64) * (DM / 32), I_OUT = (DM / 64) * (DM / 32), I_C1 = (2048 / 64) * (128 / 32), I_C2 = (128 / 64) * (64 / 32);
    constexpr int NITEMS = I_IN + 2 * I_UP + I_OUT + 2 * I_C1 + 2 * I_C2;
    for (int it = gw; it < NITEMS; it += NGW) {
        int r = it;
        if (r < I_IN) { p0_colmax_item(F.in[I_WIN], INW, F.ctl + CW_CMAX, DMapWin(), r, F.lane); continue; } r -= I_IN;
        if (r < I_UP) { p0_transpose_item(F.in[I_WUPA], 512, DM, (bf16*)(F.ws + WS_WUPA), DMapId(), scr, r, F.lane); continue; } r -= I_UP;
        if (r < I_UP) { p0_transpose_item(F.in[I_WUPB], 512, DM, (bf16*)(F.ws + WS_WUPB), DMapId(), scr, r, F.lane); continue; } r -= I_UP;
        if (r < I_OUT) { p0_transpose_item(F.in[I_WOUT], DM, DM, (bf16*)(F.ws + WS_WOUT), DMapId(), scr, r, F.lane); continue; } r -= I_OUT;
        if (r < I_C1) { p0_transpose_item(F.in[I_CW1K], 2048, 128, (bf16*)(F.ws + WS_CW1K), DMapId(), scr, r, F.lane); continue; } r -= I_C1;
        if (r < I_C1) { p0_transpose_item(F.in[I_CW1V], 2048, 128, (bf16*)(F.ws + WS_CW1V), DMapId(), scr, r, F.lane); continue; } r -= I_C1;
        if (r < I_C2) { p0_transpose_item(F.in[I_CW2K], 128, 64, (bf16*)(F.ws + WS_CW2K), DMapId(), scr, r, F.lane); continue; } r -= I_C2;
        { p0_transpose_item(F.in[I_CW2V], 128, 64, (bf16*)(F.ws + WS_CW2V), DMapId(), scr, r, F.lane); }
    }
    __syncthreads();
    {
        const int gt = F.vcu * NTHREADS + F.tid, NGT = F.G * NTHREADS;
        const float* c = F.in[I_C]; const float* aw = F.in[I_ADAW]; float* modp = (float*)(F.ws + WS_MODP);
        for (int w = gt; w < ADA_SLICES * 6144; w += NGT) {
            const int s = w / 6144, j = w % 6144; float a0 = 0.f, a1 = 0.f, a2 = 0.f, a3 = 0.f;
#pragma unroll 8
            for (int kk = 0; kk < 64; ++kk) { const int k = s * 64 + kk; const float wv = aw[(size_t)k * 6144 + j];
                const float c0 = c[k], c1 = c[DM + k], c2 = c[2 * DM + k], c3 = c[3 * DM + k];
                a0 += c0 * sigmoidf_(c0) * wv; a1 += c1 * sigmoidf_(c1) * wv; a2 += c2 * sigmoidf_(c2) * wv; a3 += c3 * sigmoidf_(c3) * wv; }
            modp[(size_t)(s * 4 + 0) * 6144 + j] = a0; modp[(size_t)(s * 4 + 1) * 6144 + j] = a1; modp[(size_t)(s * 4 + 2) * 6144 + j] = a2; modp[(size_t)(s * 4 + 3) * 6144 + j] = a3;
        }
        { const float* rw = F.in[I_RW]; bf16* rwhi = (bf16*)(F.ws + WS_RWHI); bf16* rwlo = (bf16*)(F.ws + WS_RWLO);
          for (int w = gt; w < DM * NEXP; w += NGT) { const int e = w >> 10, k = w & 1023; const float x = rw[k * NEXP + e]; const unsigned h = f2bf(x); rwhi[w] = (bf16)h; rwlo[w] = (bf16)f2bf(x - bf2f((unsigned short)h)); } }
        float* pbp = (float*)(F.ws + WS_PBP);
        for (int w = gt; w < PB_SLICES * 2 * 128; w += NGT) {
            const int s = w / 256, kv = (w >> 7) & 1, j = w & 127; const float* pe = F.in[kv ? I_PEV : I_PEK]; const float* w1 = F.in[kv ? I_CW1V : I_CW1K]; float a = 0.f;
#pragma unroll 8
            for (int ii = 0; ii < 128; ++ii) { const int i = s * 128 + ii; a += pe[i] * w1[(size_t)i * 128 + j]; }
            pbp[w] = a;
        }
    }
}

template <bool WITH_MOE>
__device__ __forceinline__ void p_final(Ctx& F, const bf16* H, const float* modf) {
    const unsigned char* Y = F.ws + WS_YR; const int* dest = (const int*)(F.ws + WS_DEST);
    const float* fg = F.in[I_FG];
    f32x4 g[4];
#pragma unroll
    for (int j = 0; j < 4; ++j) g[j] = *(const f32x4*)(fg + 4 * F.lane + 256 * j);
    for (int blk = F.vcu; blk < T / 64; blk += F.G) {
        const int b = (blk * 64) / SEQ, t0 = blk * 64 + F.wave * 8; const float* gt = modf + (size_t)b * 6 * DM + 5 * DM;
        f32x4 gg[4];
#pragma unroll
        for (int j = 0; j < 4; ++j) gg[j] = *(const f32x4*)(gt + 4 * F.lane + 256 * j) + 1.0f;
        int4 dd[8];
#pragma unroll
        for (int i = 0; i < 8; ++i) dd[i] = WITH_MOE ? *(const int4*)(dest + (t0 + i) * 4) : make_int4(0, 0, 0, 0);
#pragma unroll
        for (int i = 0; i < 8; ++i) {
            f32x4 v[4]; unsigned y[4][4]; const int t = t0 + i;
#pragma unroll
            for (int j = 0; j < 4; ++j) { const v2u hw = *(const v2u*)(H + (size_t)t * DM + 4 * F.lane + 256 * j); v[j] = (f32x4){bflo(hw.x), bfhi(hw.x), bflo(hw.y), bfhi(hw.y)}; }
            if (WITH_MOE) {
#pragma unroll
                for (int j = 0; j < 4; ++j) { y[0][j] = *(const unsigned*)(Y + (size_t)dd[i].x * DM + 4 * F.lane + 256 * j); y[1][j] = *(const unsigned*)(Y + (size_t)dd[i].y * DM + 4 * F.lane + 256 * j);
                    y[2][j] = *(const unsigned*)(Y + (size_t)dd[i].z * DM + 4 * F.lane + 256 * j); y[3][j] = *(const unsigned*)(Y + (size_t)dd[i].w * DM + 4 * F.lane + 256 * j); } }
            float ss = 0.f;
#pragma unroll
            for (int j = 0; j < 4; ++j) { f32x4 m = (f32x4){0.f, 0.f, 0.f, 0.f};
                if (WITH_MOE) {
#pragma unroll
                    for (int k = 0; k < TOPK; ++k) { const pg8::f32x2 lo = __builtin_amdgcn_cvt_pk_f32_fp8((int)y[k][j], false), hi = __builtin_amdgcn_cvt_pk_f32_fp8((int)y[k][j], true); m[0] += lo.x; m[1] += lo.y; m[2] += hi.x; m[3] += hi.y; } }
                v[j] = v[j] + gg[j] * m * 0.0625f;
                ss += (v[j][0] * v[j][0] + v[j][1] * v[j][1]) + (v[j][2] * v[j][2] + v[j][3] * v[j][3]); }
            const float rs = rsqrtf(wave_sum(ss) * (1.0f / DM) + NORM_EPS);
#pragma unroll
            for (int j = 0; j < 4; ++j) *(f32x4*)(F.out + (size_t)t * DM + 4 * F.lane + 256 * j) = v[j] * rs * g[j];
        }
    }
}

__device__ __forceinline__ f32x4 mfma16(bf16x8 a, bf16x8 b, f32x4 c) { return __builtin_amdgcn_mfma_f32_16x16x32_bf16(a, b, c, 0, 0, 0); }
typedef short v4i16_t __attribute__((ext_vector_type(4)));
__device__ __forceinline__ s16x4 lds_tr4(const LAS unsigned char* p) { return __builtin_bit_cast(s16x4, __builtin_amdgcn_ds_read_tr16_b64_v4i16((LAS v4i16_t*)p)); }
__device__ __forceinline__ bf16x8 tr_frag(const LAS unsigned char* img, int sb, int r0, int r1, int n0, int lane) {
    const int q = (lane & 15) >> 2, p = lane & 3;
    const s16x4 lo = lds_tr4(img + (r0 + q) * sb + (n0 + 4 * p) * 2), hi = lds_tr4(img + (r1 + q) * sb + (n0 + 4 * p) * 2);
    return (bf16x8){lo[0], lo[1], lo[2], lo[3], hi[0], hi[1], hi[2], hi[3]};
}
__device__ __forceinline__ bf16x8 lds_row8(const LAS unsigned char* img, int sb, int row, int col) { return *(const LAS bf16x8*)(img + row * sb + col * 2); }
__device__ __forceinline__ bf16x8 pack8(const f32x4 a, const f32x4 b) {
    v4u w; w.x = pg8::cvt_pk_bf16(a[0], a[1]); w.y = pg8::cvt_pk_bf16(a[2], a[3]); w.z = pg8::cvt_pk_bf16(b[0], b[1]); w.w = pg8::cvt_pk_bf16(b[2], b[3]);
    return __builtin_bit_cast(bf16x8, w);
}
__device__ __forceinline__ float grp_max(float v) { v = fmaxf(v, __shfl_xor(v, 16)); return fmaxf(v, __shfl_xor(v, 32)); }
__device__ __forceinline__ float grp_sum(float v) { v += __shfl_xor(v, 16); return v + __shfl_xor(v, 32); }
constexpr float NEG_BIG = -1.0e30f;
constexpr float LOG2E = 1.4426950408889634f;
constexpr int KV_SB = 144;
constexpr int W128_SB = 272;

template <int MODE>
__device__ __forceinline__ void nsa_pass(Ctx& F, const bf16* proj, int b, int g, int qb, int kcol, int vcol, const bf16x8 (&qf)[2][2], const unsigned long long (&selm)[2],
                                         f32x4 (&ot)[2][4], float (&lsum)[2]) {
    LAS unsigned char* Kt = F.lds; LAS unsigned char* Vt = F.lds + 2 * 64 * KV_SB;
    const int lane = F.lane, gq = lane >> 4, th = F.wave >> 2;
    const int ntile = MODE == 0 ? qb + 1 : (qb < 8 ? qb + 1 : 9);
    const int lrow = F.tid >> 3, lch = F.tid & 7;
    const size_t rbase = (size_t)b * SEQ;
    float mrun[2] = {NEG_BIG, NEG_BIG};
#pragma unroll
    for (int qi = 0; qi < 2; ++qi) { lsum[qi] = 0.f;
#pragma unroll
        for (int db = 0; db < 4; ++db) ot[qi][db] = (f32x4){0.f, 0.f, 0.f, 0.f}; }
    auto tile_of = [&](int it) { return MODE == 0 ? it : qb - it; };
    v4u kreg, vreg;
    { const int j = tile_of(0); const bf16* src = proj + (rbase + (size_t)j * 64 + lrow) * PW + lch * 8; kreg = *(const v4u*)(src + kcol); vreg = *(const v4u*)(src + vcol); }
    __syncthreads();
    for (int it = 0; it < ntile; ++it) {
        const int buf = it & 1, j = tile_of(it);
        *(LAS v4u*)(Kt + buf * 64 * KV_SB + lrow * KV_SB + lch * 16) = kreg; *(LAS v4u*)(Vt + buf * 64 * KV_SB + lrow * KV_SB + lch * 16) = vreg;
        __syncthreads();
        if (it + 1 < ntile) { const int jn = tile_of(it + 1); const bf16* src = proj + (rbase + (size_t)jn * 64 + lrow) * PW + lch * 8; kreg = *(const v4u*)(src + kcol); vreg = *(const v4u*)(src + vcol); }
        const LAS unsigned char* Kb = Kt + buf * 64 * KV_SB; const LAS unsigned char* Vb = Vt + buf * 64 * KV_SB;
        f32x4 s[2][4];
#pragma unroll
        for (int kb = 0; kb < 4; ++kb) { const bf16x8 k0 = lds_row8(Kb, KV_SB, 16 * kb + (lane & 15), 8 * gq), k1 = lds_row8(Kb, KV_SB, 16 * kb + (lane & 15), 32 + 8 * gq);
#pragma unroll
            for (int qi = 0; qi < 2; ++qi) { f32x4 a = (f32x4){0.f, 0.f, 0.f, 0.f}; a = mfma16(k0, qf[qi][0], a); a = mfma16(k1, qf[qi][1], a); s[qi][kb] = a; } }
        const bool edge = MODE == 0 ? (j == qb) : (j == qb || j == qb - 8);
#pragma unroll
        for (int qi = 0; qi < 2; ++qi) {
            const int i = th * 32 + qi * 16 + (lane & 15);
            bool rowok = true; if (MODE == 0) rowok = (selm[qi] >> j) & 1ull;
            if (edge) { asm volatile("; boundary tile: per-element mask" ::: "memory");
#pragma unroll
                for (int kb = 0; kb < 4; ++kb)
#pragma unroll
                    for (int r = 0; r < 4; ++r) { const int kvl = 16 * kb + 4 * gq + r; bool ok;
                        if (MODE == 0) ok = kvl <= i; else { const int rel = (qb - j) * 64 + i - kvl; ok = rel >= 0 && rel < 512; }
                        s[qi][kb][r] = ok ? s[qi][kb][r] : NEG_BIG; } }
            float mx = fmaxf(fmaxf(s[qi][0][0], s[qi][0][1]), fmaxf(s[qi][0][2], s[qi][0][3]));
#pragma unroll
            for (int kb = 1; kb < 4; ++kb) mx = fmaxf(mx, fmaxf(fmaxf(s[qi][kb][0], s[qi][kb][1]), fmaxf(s[qi][kb][2], s[qi][kb][3])));
            mx = rowok ? mx * (0.125f * LOG2E) : NEG_BIG;
            mx = grp_max(mx);
            const float mnew = fmaxf(mrun[qi], mx);
            if (__any(mnew > mrun[qi])) { const float alpha = __builtin_amdgcn_exp2f(mrun[qi] - mnew); lsum[qi] *= alpha;
#pragma unroll
                for (int db = 0; db < 4; ++db) ot[qi][db] *= alpha; }
            mrun[qi] = mnew;
            const float nb = rowok ? -mnew : -INFINITY;
            float ps = 0.f;
#pragma unroll
            for (int kb = 0; kb < 4; ++kb)
#pragma unroll
                for (int r = 0; r < 4; ++r) { const float p = __builtin_amdgcn_exp2f(fmaf(s[qi][kb][r], 0.125f * LOG2E, nb)); s[qi][kb][r] = p; ps += p; }
            lsum[qi] += ps;
        }
#pragma unroll
        for (int st = 0; st < 2; ++st) {
            const bf16x8 p0 = pack8(s[0][2 * st], s[0][2 * st + 1]), p1 = pack8(s[1][2 * st], s[1][2 * st + 1]);
#pragma unroll
            for (int db = 0; db < 4; ++db) { const bf16x8 vf = tr_frag(Vb, KV_SB, 32 * st + 4 * gq, 32 * st + 16 + 4 * gq, 16 * db, lane);
                ot[0][db] = mfma16(vf, p0, ot[0][db]); ot[1][db] = mfma16(vf, p1, ot[1][db]); }
        }
    }
}

__device__ __forceinline__ void nsa_selwin_unit(Ctx& F, int b, int g, int qb) {
    const bf16* proj = (const bf16*)(F.ws + WS_PROJ); const bf16* ocmp = (const bf16*)(F.ws + WS_OCMP); bf16* onsa = (bf16*)(F.ws + WS_ONSA);
    const unsigned long long* selmask = (const unsigned long long*)(F.ws + WS_SELM);
    const int lane = F.lane, gq = lane >> 4, hr = F.wave & 3, th = F.wave >> 2, head = g * 4 + hr;
    bf16x8 qf[2][2]; unsigned long long selm[2]; size_t trow[2];
#pragma unroll
    for (int qi = 0; qi < 2; ++qi) { const int t = qb * 64 + th * 32 + qi * 16 + (lane & 15); trow[qi] = (size_t)b * SEQ + t;
        selm[qi] = selmask[(size_t)(b * 2 + g) * SEQ + t];
#pragma unroll
        for (int st = 0; st < 2; ++st) qf[qi][st] = *(const bf16x8*)(proj + trow[qi] * PW + PC_Q + head * 64 + 32 * st + 8 * gq); }
    f32x4 ot[2][4]; float lsum[2];
    nsa_pass<0>(F, proj, b, g, qb, PC_KV + 2 * 128 + g * 64, PC_KV + 3 * 128 + g * 64, qf, selm, ot, lsum);
#pragma unroll
    for (int qi = 0; qi < 2; ++qi) { const float gate = sigmoidf_(bf2f(proj[trow[qi] * PW + PC_NSAG + 8 + head])) / grp_sum(lsum[qi]);
#pragma unroll
        for (int db = 0; db < 4; ++db) { const size_t o = trow[qi] * 512 + head * 64 + 16 * db + 4 * gq; const v2u c = *(const v2u*)(ocmp + o);
            f32x4 v = ot[qi][db] * gate; v[0] += bflo(c.x); v[1] += bfhi(c.x); v[2] += bflo(c.y); v[3] += bfhi(c.y);
            v2u w; w.x = pg8::cvt_pk_bf16(v[0], v[1]); w.y = pg8::cvt_pk_bf16(v[2], v[3]); *(v2u*)(onsa + o) = w; } }
    nsa_pass<1>(F, proj, b, g, qb, PC_KV + 4 * 128 + g * 64, PC_KV + 5 * 128 + g * 64, qf, selm, ot, lsum);
#pragma unroll
    for (int qi = 0; qi < 2; ++qi) { const float gate = sigmoidf_(bf2f(proj[trow[qi] * PW + PC_NSAG + 16 + head])) / grp_sum(lsum[qi]);
#pragma unroll
        for (int db = 0; db < 4; ++db) { const size_t o = trow[qi] * 512 + head * 64 + 16 * db + 4 * gq; const v2u c = *(const v2u*)(onsa + o);
            f32x4 v = ot[qi][db] * gate; v[0] += bflo(c.x); v[1] += bfhi(c.x); v[2] += bflo(c.y); v[3] += bfhi(c.y);
            v2u w; w.x = pg8::cvt_pk_bf16(v[0], v[1]); w.y = pg8::cvt_pk_bf16(v[2], v[3]); *(v2u*)(onsa + o) = w; } }
}

__device__ __forceinline__ void p1_norm1(Ctx& F) {
    const float* modp = (const float*)(F.ws + WS_MODP); const float* adab = F.in[I_ADAB]; float* modfw = (float*)(F.ws + WS_MODF);
    { const int gt = F.vcu * NTHREADS + F.tid, NGT = F.G * NTHREADS;
      for (int w = gt; w < 4 * 6144; w += NGT) { const int b = w / 6144, j = w % 6144; float a = adab[j];
#pragma unroll
          for (int s = 0; s < ADA_SLICES; ++s) a += modp[(size_t)(s * 4 + b) * 6144 + j];
          modfw[w] = a; } }
    { LAS float* scr = (LAS float*)(F.lds + 16384 + F.wave * 9216); const int gw = F.vcu * NWAVES + F.wave, NGW = F.G * NWAVES;
      for (int it = gw; it < (DM / 128) * (INW / 32); it += NGW) p1_quant_item_i8(F.in[I_WIN], DM, INW, F.ws + WS_WIN, (float*)(F.ws + WS_SW), F.ctl + CW_CMAX, DMapWin(), scr, it, F.lane); }
    LAS float* shs = (LAS float*)F.lds; LAS float* scs = shs + DM;
    const float* x = F.in[I_X]; const float* g1 = F.in[I_N1G]; unsigned char* A1 = F.ws + WS_A1; float* sa = (float*)(F.ws + WS_SA);
    int curb = -1;
    for (int blk = F.vcu; blk < T / 64; blk += F.G) {
        const int b = (blk * 64) / SEQ;
        if (b != curb) { __syncthreads();
            for (int j = F.tid; j < 2 * DM; j += NTHREADS) { float a = adab[j];
#pragma unroll
                for (int s = 0; s < ADA_SLICES; ++s) a += modp[(size_t)(s * 4 + b) * 6144 + j];
                if (j < DM) shs[j] = a; else scs[j - DM] = (1.0f + a) * g1[j - DM]; }
            __syncthreads(); curb = b; }
        { f32x4 v[8][4];
#pragma unroll
          for (int i = 0; i < 8; ++i)
#pragma unroll
              for (int j = 0; j < 4; ++j) v[i][j] = *(const f32x4*)(x + (size_t)(blk * 64 + F.wave * 8 + i) * DM + 4 * F.lane + 256 * j);
#pragma unroll
          for (int i = 0; i < 8; ++i) { const int t = blk * 64 + F.wave * 8 + i; float ss = 0.f;
#pragma unroll
              for (int j = 0; j < 4; ++j) ss += (v[i][j][0] * v[i][j][0] + v[i][j][1] * v[i][j][1]) + (v[i][j][2] * v[i][j][2] + v[i][j][3] * v[i][j][3]);
              const float rs = rsqrtf(wave_sum(ss) * (1.0f / DM) + NORM_EPS);
              float am = 0.f;
#pragma unroll
              for (int j = 0; j < 4; ++j) { const f32x4 sc = *(const LAS f32x4*)(scs + 4 * F.lane + 256 * j), sh = *(const LAS f32x4*)(shs + 4 * F.lane + 256 * j);
                  v[i][j] = v[i][j] * rs * sc + sh; am = fmaxf(am, fmaxf(fmaxf(fabsf(v[i][j][0]), fabsf(v[i][j][1])), fmaxf(fabsf(v[i][j][2]), fabsf(v[i][j][3])))); }
              am = wave_max(am); const float inv = am > 0.f ? 127.0f / am : 0.f;
              if (F.lane == 0) sa[t] = am * (1.0f / 127.0f);
#pragma unroll
              for (int j = 0; j < 4; ++j) *(unsigned*)(A1 + (size_t)t * DM + 4 * F.lane + 256 * j) = pk4_i8(v[i][j][0] * inv, v[i][j][1] * inv, v[i][j][2] * inv, v[i][j][3] * inv); } }
    }
    __syncthreads();
}

constexpr int RA_SB = 1040;
__device__ __forceinline__ void p8_norm2_router(Ctx& F, const bf16* H, const float* modf) {
    LAS unsigned char* Ahi = F.lds; LAS unsigned char* Alo = F.lds + 64 * RA_SB; LAS float* lg = (LAS float*)(F.lds + 2 * 64 * RA_SB);
    LAS int* hist = (LAS int*)(lg + 64 * 33);
    const float* rb = F.in[I_RB]; const float* g2 = F.in[I_N2G];
    const bf16* rwhi = (const bf16*)(F.ws + WS_RWHI); const bf16* rwlo = (const bf16*)(F.ws + WS_RWLO);
    unsigned char* N2 = F.ws + WS_A1; int* topi = (int*)(F.ws + WS_TOPI); float* gate = (float*)(F.ws + WS_GATE);
    const int lane = F.lane, gq = lane >> 4, w = F.wave;
    if (F.tid < 32) hist[F.tid] = 0;
    f32x4 gv[4];
#pragma unroll
    for (int j = 0; j < 4; ++j) gv[j] = *(const f32x4*)(g2 + 4 * lane + 256 * j);
    for (int blk = F.vcu; blk < T / 64; blk += F.G) {
        const int b = (blk * 64) / SEQ; const float* sh2 = modf + (size_t)b * 6 * DM + 3 * DM; const float* sc2 = sh2 + DM;
        f32x4 scv[4], shv[4];
#pragma unroll
        for (int j = 0; j < 4; ++j) { scv[j] = (*(const f32x4*)(sc2 + 4 * lane + 256 * j) + 1.0f) * gv[j]; shv[j] = *(const f32x4*)(sh2 + 4 * lane + 256 * j); }
        f32x4 v[8][4];
#pragma unroll
        for (int i = 0; i < 8; ++i) { const int t = blk * 64 + w * 8 + i;
#pragma unroll
            for (int j = 0; j < 4; ++j) { const v2u hw = *(const v2u*)(H + (size_t)t * DM + 4 * lane + 256 * j); v[i][j] = (f32x4){bflo(hw.x), bfhi(hw.x), bflo(hw.y), bfhi(hw.y)}; } }
#pragma unroll
        for (int i = 0; i < 8; ++i) { const int t = blk * 64 + w * 8 + i; float ss = 0.f;
#pragma unroll
            for (int j = 0; j < 4; ++j) ss += (v[i][j][0] * v[i][j][0] + v[i][j][1] * v[i][j][1]) + (v[i][j][2] * v[i][j][2] + v[i][j][3] * v[i][j][3]);
            const float rs = rsqrtf(wave_sum(ss) * (1.0f / DM) + NORM_EPS);
#pragma unroll
            for (int j = 0; j < 4; ++j) { v[i][j] = v[i][j] * rs * scv[j] + shv[j];
                *(unsigned*)(N2 + (size_t)t * DM + 4 * lane + 256 * j) = pk4_fp8(v[i][j][0], v[i][j][1], v[i][j][2], v[i][j][3]); } }
        const int tbk = w & 3, eb = w >> 2; f32x4 acc = (f32x4){0.f, 0.f, 0.f, 0.f};
#pragma unroll
        for (int kh = 0; kh < 2; ++kh) {
            __syncthreads();
#pragma unroll
            for (int i = 0; i < 8; ++i)
#pragma unroll
                for (int jj = 0; jj < 2; ++jj) { const f32x4 x = v[i][2 * kh + jj]; const unsigned h0 = pk2(x[0], x[1]), h1 = pk2(x[2], x[3]);
                    const unsigned l0 = pk2(x[0] - bflo(h0), x[1] - bfhi(h0)), l1 = pk2(x[2] - bflo(h1), x[3] - bfhi(h1));
                    const int off = (w * 8 + i) * RA_SB + (4 * lane + 256 * jj) * 2;
                    *(LAS v2u*)(Ahi + off) = (v2u){h0, h1}; *(LAS v2u*)(Alo + off) = (v2u){l0, l1}; }
            __syncthreads();
#pragma unroll 4
            for (int s = 0; s < 16; ++s) { const size_t bo = (size_t)(16 * eb + (lane & 15)) * DM + 512 * kh + 32 * s + 8 * gq;
                const bf16x8 bh = *(const bf16x8*)(rwhi + bo), bl = *(const bf16x8*)(rwlo + bo);
                const bf16x8 ah = lds_row8(Ahi, RA_SB, 16 * tbk + (lane & 15), 32 * s + 8 * gq), al = lds_row8(Alo, RA_SB, 16 * tbk + (lane & 15), 32 * s + 8 * gq);
                acc = mfma16(ah, bh, acc); acc = mfma16(al, bh, acc); acc = mfma16(ah, bl, acc); }
        }
        { const int e = 16 * eb + (lane & 15); const float rbe = rb[e];
#pragma unroll
          for (int r = 0; r < 4; ++r) lg[(16 * tbk + 4 * gq + r) * 33 + e] = acc[r] + rbe; }
        __syncthreads();
        if (F.tid < 64) { const int t = blk * 64 + F.tid; float lv[32];
#pragma unroll
            for (int e = 0; e < 32; ++e) lv[e] = lg[F.tid * 33 + e];
            int si[4]; float sv[4];
#pragma unroll
            for (int k = 0; k < 4; ++k) { float m = -3.0e38f; int mi = 0;
#pragma unroll
                for (int e = 0; e < 32; ++e) { const bool gt = lv[e] > m; m = gt ? lv[e] : m; mi = gt ? e : mi; }
#pragma unroll
                for (int e = 0; e < 32; ++e) lv[e] = (e == mi) ? -3.0e38f : lv[e];
                si[k] = mi; sv[k] = m; }
            const float e1 = __expf(sv[1] - sv[0]), e2 = __expf(sv[2] - sv[0]), e3 = __expf(sv[3] - sv[0]); const float inv = 1.0f / (1.0f + e1 + e2 + e3);
            *(int4*)(topi + t * 4) = make_int4(si[0], si[1], si[2], si[3]); *(f32x4*)(gate + t * 4) = (f32x4){inv, e1 * inv, e2 * inv, e3 * inv};
#pragma unroll
            for (int k = 0; k < 4; ++k) __hip_atomic_fetch_add(&hist[si[k]], 1, __ATOMIC_RELAXED, __HIP_MEMORY_SCOPE_WORKGROUP); }
    }
    __syncthreads();
    if (F.tid < 32) { const int h = hist[F.tid]; if (h) __hip_atomic_fetch_add(F.ctl + CW_ECNT + 64 * F.tid, (unsigned)h, __ATOMIC_RELAXED, __HIP_MEMORY_SCOPE_AGENT); }
    __syncthreads();
}

__device__ __forceinline__ void p9_permute(Ctx& F) {
    LAS int* sm = (LAS int*)F.lds; LAS int* cnt = sm, *pstart = sm + 32, *lhist = sm + 64, *lbase = sm + 96, *dl = sm + 128;
    if (F.tid < 32) cnt[F.tid] = (int)__hip_atomic_load(F.ctl + CW_ECNT + 64 * F.tid, __ATOMIC_RELAXED, __HIP_MEMORY_SCOPE_AGENT);
    __syncthreads();
    if (F.tid == 0) { int run = 0; unsigned* tab = F.ctl + CW_MOETAB; const bool w0 = (blockIdx.x == 0);
        for (int e = 0; e < NEXP; ++e) { pstart[e] = run; const int nt = (cnt[e] + MOE_ROWS - 1) / MOE_ROWS;
            if (w0) for (int i = 0; i < nt; ++i) tab[64 + run / MOE_ROWS + i] = (unsigned)e;
            run += nt * MOE_ROWS; }
        if (w0) tab[0] = (unsigned)(run / MOE_ROWS); }
    __syncthreads();
    int* rowt = (int*)(F.ws + WS_ROWT);
    for (int e = F.vcu; e < NEXP; e += F.G) { const int c = cnt[e], pe = (c + MOE_ROWS - 1) / MOE_ROWS * MOE_ROWS; for (int r = c + F.tid; r < pe; r += NTHREADS) rowt[pstart[e] + r] = 0; }
    const int* topi = (const int*)(F.ws + WS_TOPI); const float* gate = (const float*)(F.ws + WS_GATE); int* dest = (int*)(F.ws + WS_DEST); float* rowg = (float*)(F.ws + WS_ROWG);
    for (int blk = F.vcu; blk < T / 64; blk += F.G) {
        if (F.tid < 32) lhist[F.tid] = 0;
        __syncthreads();
        int e = 0, rank = 0; const int a = blk * 256 + F.tid;
        if (F.tid < 256) { e = topi[a]; rank = __hip_atomic_fetch_add(&lhist[e], 1, __ATOMIC_RELAXED, __HIP_MEMORY_SCOPE_WORKGROUP); }
        __syncthreads();
        if (F.tid < 32) { const int h = lhist[F.tid]; lbase[F.tid] = pstart[F.tid] + (h ? (int)__hip_atomic_fetch_add(F.ctl + CW_EFILL + 64 * F.tid, (unsigned)h, __ATOMIC_RELAXED, __HIP_MEMORY_SCOPE_AGENT) : 0); }
        __syncthreads();
        if (F.tid < 256) { const int d = lbase[e] + rank; dest[a] = d; rowg[d] = gate[a]; rowt[d] = a >> 2; }
        __syncthreads();
        __syncthreads();
    }
}

__device__ __forceinline__ float gelu_tanh(float x) { const float u = 0.7978845608028654f * (x + 0.044715f * x * x * x); const float e = __builtin_amdgcn_exp2f(u * 2.8853900817779268f); const float th = 1.0f - 2.0f * __builtin_amdgcn_rcpf(e + 1.0f); return 0.5f * x * (1.0f + th); }
__device__ __forceinline__ void nsa_compress_unit(Ctx& F, int unit) {
    const int nt = unit & 15, kv = (unit >> 4) & 1, bg = unit >> 5, b = bg >> 1, g = bg & 1, n0 = nt * 16;
    const bf16* proj = (const bf16*)(F.ws + WS_PROJ);
    const bf16* w1t = (const bf16*)(F.ws + (kv ? WS_CW1V : WS_CW1K)); const bf16* w2t = (const bf16*)(F.ws + (kv ? WS_CW2V : WS_CW2K));
    bf16* outp = (bf16*)(F.ws + (kv ? WS_VC : WS_KC)) + (size_t)bg * 256 * 64;
    const float* pbp = (const float*)(F.ws + WS_PBP);
    LAS unsigned char* Hs = F.lds;
    const int lane = F.lane, gq = lane >> 4, w = F.wave;
    const int col = PC_KV + kv * 128 + g * 64;
    int nrow = n0 + (lane & 15); if (nrow > 254) nrow = 254;
    const bf16* arow = proj + ((size_t)b * SEQ + 16 * nrow) * PW + col + 8 * gq;
    const bf16* brow = w1t + (size_t)(16 * w + (lane & 15)) * 2048 + 8 * gq;
    f32x4 acc = (f32x4){0.f, 0.f, 0.f, 0.f};
#pragma unroll 8
    for (int s = 0; s < 64; ++s) {
        const bf16x8 a = *(const bf16x8*)(arow + (size_t)(s >> 1) * PW + (s & 1) * 32);
        const bf16x8 bb = *(const bf16x8*)(brow + 32 * s);
        acc = mfma16(a, bb, acc);
    }
    { const int j = 16 * w + (lane & 15); float pb = 0.f;
#pragma unroll
      for (int s = 0; s < PB_SLICES; ++s) pb += pbp[(s * 2 + kv) * 128 + j];
      __syncthreads();
#pragma unroll
      for (int r = 0; r < 4; ++r) *(LAS unsigned short*)(Hs + (4 * gq + r) * W128_SB + j * 2) = (unsigned short)f2bf(gelu_tanh(acc[r] + pb));
    }
    __syncthreads();
    if (w < 4) {
        f32x4 o = (f32x4){0.f, 0.f, 0.f, 0.f};
#pragma unroll
        for (int s = 0; s < 4; ++s) { const bf16x8 a = lds_row8(Hs, W128_SB, lane & 15, 32 * s + 8 * gq); const bf16x8 bb = *(const bf16x8*)(w2t + (size_t)(16 * w + (lane & 15)) * 128 + 32 * s + 8 * gq); o = mfma16(a, bb, o); }
#pragma unroll
        for (int r = 0; r < 4; ++r) { const int n = n0 + 4 * gq + r; outp[(size_t)n * 64 + 16 * w + (lane & 15)] = (unsigned short)(n < 255 ? f2bf(o[r]) : 0u); }
    }
}

__device__ __forceinline__ void nsa_cmp_unit(Ctx& F, int bg, int tb) {
    const int b = bg >> 1, g = bg & 1;
    const bf16* proj = (const bf16*)(F.ws + WS_PROJ); bf16* ocmp = (bf16*)(F.ws + WS_OCMP);
    const bf16* kc = (const bf16*)(F.ws + WS_KC) + (size_t)bg * 256 * 64; const bf16* vc = (const bf16*)(F.ws + WS_VC) + (size_t)bg * 256 * 64;
    unsigned long long* selmask = (unsigned long long*)(F.ws + WS_SELM);
    LAS unsigned char* Kt = F.lds; LAS unsigned char* Vt = F.lds + 256 * KV_SB; LAS float* IMP = (LAS float*)(F.lds + 2 * 256 * KV_SB);
    const int lane = F.lane, gq = lane >> 4, w = F.wave, tg = w >> 2, hp = w & 3;
    const int nvmax = 4 * tb + 3;
    const int nkb = (nvmax + 15) >> 4;
    __syncthreads();
    for (int i = F.tid; i < 256 * 8; i += NTHREADS) { const int row = i >> 3, ch = i & 7;
        if (row < ((nkb + 1) & ~1) * 16) {        *(LAS v4u*)(Kt + row * KV_SB + ch * 16) = *(const v4u*)(kc + row * 64 + ch * 8); *(LAS v4u*)(Vt + row * KV_SB + ch * 16) = *(const v4u*)(vc + row * 64 + ch * 8); } }
    __syncthreads();
    LAS float* IMPW = IMP + hp * 64 * 64;
#pragma unroll 1
    for (int qi = 0; qi < 2; ++qi) {
        const int tl = tg * 32 + qi * 16 + (lane & 15), t = tb * 64 + tl; const size_t trow = (size_t)b * SEQ + t;
        const int nv = ((t + 1) >> 4) - 1;
        float imp[16], carry[16];
#pragma unroll
        for (int kb = 0; kb < 16; ++kb) { imp[kb] = 0.f; carry[kb] = 0.f; }
        {
            const int head = g * 4 + hp;
            const bf16x8 q0 = *(const bf16x8*)(proj + trow * PW + PC_Q + head * 64 + 8 * gq), q1 = *(const bf16x8*)(proj + trow * PW + PC_Q + head * 64 + 32 + 8 * gq);
            float ml = NEG_BIG, ll = 0.f;
#pragma unroll 2
            for (int kb = 0; kb < nkb; ++kb) { f32x4 a = (f32x4){0.f, 0.f, 0.f, 0.f};
                a = mfma16(lds_row8(Kt, KV_SB, 16 * kb + (lane & 15), 8 * gq), q0, a); a = mfma16(lds_row8(Kt, KV_SB, 16 * kb + (lane & 15), 32 + 8 * gq), q1, a);
                float v[4], tm = NEG_BIG;
#pragma unroll
                for (int r = 0; r < 4; ++r) { const int n = 16 * kb + 4 * gq + r; v[r] = (n < nv) ? a[r] * (0.125f * LOG2E) : NEG_BIG; tm = fmaxf(tm, v[r]); }
                const float mn = fmaxf(ml, tm); float ps = 0.f;
#pragma unroll
                for (int r = 0; r < 4; ++r) { const int n = 16 * kb + 4 * gq + r; ps += (n < nv) ? __builtin_amdgcn_exp2f(v[r] - mn) : 0.f; }
                ll = ll * __builtin_amdgcn_exp2f(ml - mn) + ps; ml = mn; }
            const float mx = grp_max(ml);
            const float ps = grp_sum(ll * __builtin_amdgcn_exp2f(ml - mx));
            const float inv = ps > 0.f ? 1.0f / ps : 0.f;
            f32x4 o[4];
#pragma unroll
            for (int db = 0; db < 4; ++db) o[db] = (f32x4){0.f, 0.f, 0.f, 0.f};
#pragma unroll
            for (int st = 0; st < 8; ++st) if (2 * st < nkb) {
                f32x4 pp[2];
#pragma unroll
                for (int k2 = 0; k2 < 2; ++k2) { const int kb = 2 * st + k2; f32x4 a = (f32x4){0.f, 0.f, 0.f, 0.f};
                    a = mfma16(lds_row8(Kt, KV_SB, 16 * kb + (lane & 15), 8 * gq), q0, a); a = mfma16(lds_row8(Kt, KV_SB, 16 * kb + (lane & 15), 32 + 8 * gq), q1, a);
#pragma unroll
                    for (int r = 0; r < 4; ++r) { const int n = 16 * kb + 4 * gq + r; a[r] = (n < nv) ? __builtin_amdgcn_exp2f(a[r] * (0.125f * LOG2E) - mx) * inv : 0.f; }
                    pp[k2] = a; imp[kb] += (a[0] + a[1]) + (a[2] + 0.5f * a[3]); carry[kb] += 0.5f * a[3]; }
                const bf16x8 pf = pack8(pp[0], pp[1]);
#pragma unroll
                for (int db = 0; db < 4; ++db) o[db] = mfma16(tr_frag(Vt, KV_SB, 32 * st + 4 * gq, 32 * st + 16 + 4 * gq, 16 * db, lane), pf, o[db]);
                asm volatile("" ::: "memory"); }
            const float gate = sigmoidf_(bf2f(proj[trow * PW + PC_NSAG + head]));
#pragma unroll
            for (int db = 0; db < 4; ++db) { const f32x4 v = o[db] * gate; v2u wv; wv.x = pg8::cvt_pk_bf16(v[0], v[1]); wv.y = pg8::cvt_pk_bf16(v[2], v[3]);
                *(v2u*)(ocmp + trow * 512 + head * 64 + 16 * db + 4 * gq) = wv; }
        }
#pragma unroll
        for (int kb = 0; kb < 16; ++kb) { const float c1 = __shfl(carry[kb], (lane + 48) & 63); const float c0 = kb > 0 ? __shfl(carry[kb > 0 ? kb - 1 : 0], (lane + 48) & 63) : 0.f;
            IMPW[tl * 64 + 4 * kb + gq] = imp[kb] + (gq > 0 ? c1 : c0); }
    }
    __syncthreads();
    for (int tl = w; tl < 64; tl += NWAVES) { const int t = tb * 64 + tl, cur = t >> 6;
        float v = (IMP[tl * 64 + lane] + IMP[4096 + tl * 64 + lane]) + (IMP[2 * 4096 + tl * 64 + lane] + IMP[3 * 4096 + tl * 64 + lane]); const bool forced = (lane == 0) || (lane == cur) || (lane == cur - 1);
        v = (lane > cur) ? NEG_BIG : v + (forced ? 1.0e4f : 0.f);
        int rank = 0;
#pragma unroll
        for (int jj = 0; jj < 64; ++jj) { const float o = __builtin_bit_cast(float, __builtin_amdgcn_readlane(__builtin_bit_cast(int, v), jj)); rank += (o > v || (o == v && jj < lane)) ? 1 : 0; }
        const unsigned long long m = __ballot(lane <= cur && rank < 16);
        if (lane == 0) selmask[(size_t)bg * SEQ + t] = m; }
}

constexpr int ML_H = 4, ML_D = 128, ML_L = 64, ML_NCH = SEQ / ML_L, ML_BH = BATCH * ML_H;
__device__ __forceinline__ float log_sigmoid(float x) { return fminf(x, 0.f) - log1pf(__expf(-fabsf(x))); }
__device__ __forceinline__ float siluf_(float x) { return x * sigmoidf_(x); }
__device__ __forceinline__ void ml_stage_a(Ctx& F, int unit) {
    const int c = unit & 63, bh = unit >> 6, b = bh >> 2, h = bh & 3;
    const bf16* proj = (const bf16*)(F.ws + WS_PROJ); bf16* mlq = (bf16*)(F.ws + WS_MLQ); bf16* mlk = (bf16*)(F.ws + WS_MLKK);
    float* mlb = (float*)(F.ws + WS_MLB); float* mlli = (float*)(F.ws + WS_MLLI); float* mlsc = (float*)(F.ws + WS_MLSC);
    bf16* mlu = (bf16*)(F.ws + WS_MLU) + (size_t)unit * ML_D * ML_D; float* mlun = (float*)(F.ws + WS_MLUN) + (size_t)unit * ML_D;
    const float* convw = F.in[I_CONVW]; const float* convb = F.in[I_CONVB]; const float* gateb = F.in[I_GATEB];
    LAS unsigned char* KW = F.lds; LAS unsigned char* Vs = F.lds + 64 * W128_SB; LAS float* wts = (LAS float*)(F.lds + 2 * 64 * W128_SB); LAS float* gsc = wts + 64;
    const int t0 = c * ML_L; const size_t row0 = (size_t)b * SEQ + t0;
    __syncthreads();
    if (F.tid < 64) { const int s = F.tid; const float ip = bf2f(proj[(row0 + s) * PW + PC_MLIF + h]) + gateb[h], fp = bf2f(proj[(row0 + s) * PW + PC_MLIF + 4 + h]) + gateb[4 + h];
        gsc[s] = log_sigmoid(fp); gsc[64 + s] = ip; }
    __syncthreads();
    if (F.tid < 64) {
        float v = gsc[F.tid];
#pragma unroll
        for (int o = 1; o < 64; o <<= 1) { const float u = __shfl_up(v, o); if (F.lane >= o) v += u; }
        const float bL = __shfl(v, 63); const float li = gsc[64 + F.tid]; const float a = bL - v + li; const float amax = wave_max(a);
        wts[F.tid] = __expf(a - amax); mlb[(size_t)bh * SEQ + t0 + F.tid] = v; mlli[(size_t)bh * SEQ + t0 + F.tid] = li;
        if (F.tid == 0) { mlsc[unit * 2 + 0] = amax; mlsc[unit * 2 + 1] = bL; } }
    __syncthreads();
    { v4u xin[4][4]; v4u vin[2];
#pragma unroll
      for (int ii = 0; ii < 4; ++ii) { const int it = F.tid + ii * NTHREADS; const int ch8 = it & 15, s = (it >> 4) & 63, which = it >> 10; const int pcol = (which ? PC_MLK : PC_MLQ) + h * 128 + ch8 * 8;
#pragma unroll
          for (int wv = 0; wv < 4; ++wv) { const int tt = t0 + s - 3 + wv; xin[ii][wv] = (tt >= 0) ? *(const v4u*)(proj + ((size_t)b * SEQ + tt) * PW + pcol) : (v4u){0u, 0u, 0u, 0u}; } }
#pragma unroll
      for (int ii = 0; ii < 2; ++ii) { const int it = F.tid + ii * NTHREADS; const int ch8 = it & 15, s = it >> 4; vin[ii] = *(const v4u*)(proj + (row0 + s) * PW + PC_MLV + h * 128 + ch8 * 8); }
#pragma unroll
      for (int ii = 0; ii < 4; ++ii) { const int it = F.tid + ii * NTHREADS; const int ch8 = it & 15, s = (it >> 4) & 63, which = it >> 10;
        const int cch = which * 512 + h * 128 + ch8 * 8;
        float acc[8];
#pragma unroll
        for (int j = 0; j < 8; ++j) acc[j] = convb[cch + j];
#pragma unroll
        for (int wv = 0; wv < 4; ++wv) { const v4u x = xin[ii][wv];
            const f32x4 w0 = *(const f32x4*)(convw + wv * 1024 + cch), w1 = *(const f32x4*)(convw + wv * 1024 + cch + 4);
            acc[0] += bflo(x.x) * w0[0]; acc[1] += bfhi(x.x) * w0[1]; acc[2] += bflo(x.y) * w0[2]; acc[3] += bfhi(x.y) * w0[3];
            acc[4] += bflo(x.z) * w1[0]; acc[5] += bfhi(x.z) * w1[1]; acc[6] += bflo(x.w) * w1[2]; acc[7] += bfhi(x.w) * w1[3]; }
        const float sc = which ? 0.08838834764831845f : 1.0f;
#pragma unroll
        for (int j = 0; j < 8; ++j) acc[j] = siluf_(acc[j]) * sc;
        v4u o; o.x = pk2(acc[0], acc[1]); o.y = pk2(acc[2], acc[3]); o.z = pk2(acc[4], acc[5]); o.w = pk2(acc[6], acc[7]);
        *(v4u*)((which ? mlk : mlq) + (row0 + s) * 512 + h * 128 + ch8 * 8) = o;
        if (which) { const float ws = wts[s]; v4u kw; kw.x = pk2(acc[0] * ws, acc[1] * ws); kw.y = pk2(acc[2] * ws, acc[3] * ws); kw.z = pk2(acc[4] * ws, acc[5] * ws); kw.w = pk2(acc[6] * ws, acc[7] * ws);
            *(LAS v4u*)(KW + s * W128_SB + ch8 * 16) = kw; } }
#pragma unroll
      for (int ii = 0; ii < 2; ++ii) { const int it = F.tid + ii * NTHREADS; const int ch8 = it & 15, s = it >> 4; *(LAS v4u*)(Vs + s * W128_SB + ch8 * 16) = vin[ii]; } }
    __syncthreads();
    { const int lane = F.lane, gq = lane >> 4, w = F.wave;
      const bf16x8 a0 = tr_frag(KW, W128_SB, 8 * gq, 8 * gq + 4, 16 * w, lane), a1 = tr_frag(KW, W128_SB, 32 + 8 * gq, 32 + 8 * gq + 4, 16 * w, lane);
#pragma unroll
      for (int eb = 0; eb < 8; ++eb) { f32x4 acc = (f32x4){0.f, 0.f, 0.f, 0.f};
          acc = mfma16(a0, tr_frag(Vs, W128_SB, 8 * gq, 8 * gq + 4, 16 * eb, lane), acc); acc = mfma16(a1, tr_frag(Vs, W128_SB, 32 + 8 * gq, 32 + 8 * gq + 4, 16 * eb, lane), acc);
          v2u uw; uw.x = pk2(acc[0], acc[1]); uw.y = pk2(acc[2], acc[3]);        *(v2u*)(mlu + (size_t)(16 * eb + (lane & 15)) * ML_D + 16 * w + 4 * gq) = uw; } }
    if (F.tid < ML_D) { float a = 0.f;
#pragma unroll 8
        for (int s = 0; s < 64; ++s) a += bf2f(*(const LAS unsigned short*)(KW + s * W128_SB + F.tid * 2));
        mlun[F.tid] = a; }
}
__device__ __forceinline__ void ml_stage_b(Ctx& F, int unit) {
    const int sl = unit & 15, bh = unit >> 4;
    const float* mlsc = (const float*)(F.ws + WS_MLSC); float* mlm = (float*)(F.ws + WS_MLSC) + 4096;
    const bf16* mlu = (const bf16*)(F.ws + WS_MLU) + (size_t)bh * 64 * ML_D * ML_D; bf16* mlc = (bf16*)(F.ws + WS_MLC) + (size_t)bh * 64 * ML_D * ML_D;
    const float* mlun = (const float*)(F.ws + WS_MLUN) + (size_t)bh * 64 * ML_D; float* mln = (float*)(F.ws + WS_MLN) + (size_t)bh * 64 * ML_D;
    LAS float* dec = (LAS float*)F.lds; LAS float* scl = dec + 64; LAS float* am = scl + 64; LAS float* bl = am + 64;
    __syncthreads();
    if (F.tid < 64) { const pg8::f32x2 v = *(const pg8::f32x2*)(mlsc + (bh * 64 + F.tid) * 2); am[F.tid] = v.x; bl[F.tid] = v.y; }
    __syncthreads();
    if (F.tid == 0) { float m = 0.f;
        for (int c = 0; c < 64; ++c) { const float amax = am[c], bL = bl[c]; const float mn = fmaxf(bL + m, amax);
            dec[c] = __expf(bL + m - mn); scl[c] = __expf(amax - mn); if (sl == 0) mlm[bh * 64 + c] = m; m = mn; } }
    __syncthreads();
    { const int idx = sl * 1024 + F.tid * 2; float c0 = 0.f, c1 = 0.f;
#pragma unroll 1
      for (int cb = 0; cb < 64; cb += 16) { unsigned u[16];
#pragma unroll
          for (int i = 0; i < 16; ++i) u[i] = *(const unsigned*)(mlu + (size_t)(cb + i) * ML_D * ML_D + idx);
#pragma unroll
          for (int i = 0; i < 16; ++i) { *(unsigned*)(mlc + (size_t)(cb + i) * ML_D * ML_D + idx) = pk2(c0, c1);
              c0 = dec[cb + i] * c0 + scl[cb + i] * bflo(u[i]); c1 = dec[cb + i] * c1 + scl[cb + i] * bfhi(u[i]); } } }
    if (sl == 0 && F.tid < ML_D) { float n = 0.f;
#pragma unroll 1
        for (int cb = 0; cb < 64; cb += 8) { float u[8];
#pragma unroll
            for (int i = 0; i < 8; ++i) u[i] = mlun[(cb + i) * ML_D + F.tid];
#pragma unroll
            for (int i = 0; i < 8; ++i) { mln[(cb + i) * ML_D + F.tid] = n; n = dec[cb + i] * n + scl[cb + i] * u[i]; } } }
}
struct MlcIn { v4u q[2], k[2], v[2], c[4]; float fb, fli, fn, mc; };
__device__ __forceinline__ void ml_stage_c_load(Ctx& F, int unit, MlcIn& r) {
    const int c = unit & 63, bh = unit >> 6, b = bh >> 2, h = bh & 3;
    const bf16* proj = (const bf16*)(F.ws + WS_PROJ); const bf16* mlq = (const bf16*)(F.ws + WS_MLQ); const bf16* mlk = (const bf16*)(F.ws + WS_MLKK);
    const float* mlb = (const float*)(F.ws + WS_MLB); const float* mlli = (const float*)(F.ws + WS_MLLI); const float* mlm = (const float*)(F.ws + WS_MLSC) + 4096;
    const bf16* mlc = (const bf16*)(F.ws + WS_MLC) + (size_t)unit * ML_D * ML_D; const float* mln = (const float*)(F.ws + WS_MLN) + (size_t)unit * ML_D;
    const int t0 = c * ML_L; const size_t row0 = (size_t)b * SEQ + t0;
#pragma unroll
    for (int i = 0; i < 2; ++i) { const int it = F.tid + i * NTHREADS, ch8 = it & 15, s = it >> 4; const size_t go = (row0 + s) * 512 + h * 128 + ch8 * 8;
        r.q[i] = *(const v4u*)(mlq + go); r.k[i] = *(const v4u*)(mlk + go); r.v[i] = *(const v4u*)(proj + (row0 + s) * PW + PC_MLV + h * 128 + ch8 * 8); }
#pragma unroll
    for (int i = 0; i < 4; ++i) { const int it = F.tid + i * NTHREADS, ch8 = it & 15, e = it >> 4; r.c[i] = *(const v4u*)(mlc + e * ML_D + ch8 * 8); }
    r.fb = mlb[(size_t)bh * SEQ + t0 + (F.tid & 63)]; r.fli = mlli[(size_t)bh * SEQ + t0 + (F.tid & 63)]; r.fn = mln[F.tid & 127]; r.mc = mlm[unit];
}
__device__ __forceinline__ void ml_stage_c(Ctx& F, int unit, int next_unit, MlcIn& r) {
    const int c = unit & 63, bh = unit >> 6, b = bh >> 2, h = bh & 3;
    const bf16* proj = (const bf16*)(F.ws + WS_PROJ);
    bf16* oml = (bf16*)(F.ws + WS_OML); const float* ng = F.in[I_MLNG];
    LAS unsigned char* Qs = F.lds; LAS unsigned char* Ks = Qs + 64 * W128_SB; LAS unsigned char* Vs = Ks + 64 * W128_SB; LAS unsigned char* Cs = Vs + 64 * W128_SB;
    LAS float* fb = (LAS float*)(Cs + 128 * W128_SB); LAS float* fli = fb + 64; LAS float* fn = fli + 64; LAS float* ssq = fn + 128;
    const int t0 = c * ML_L; const size_t row0 = (size_t)b * SEQ + t0;
    __syncthreads();
#pragma unroll
    for (int i = 0; i < 2; ++i) { const int it = F.tid + i * NTHREADS, ch8 = it & 15, s = it >> 4;
        *(LAS v4u*)(Qs + s * W128_SB + ch8 * 16) = r.q[i]; *(LAS v4u*)(Ks + s * W128_SB + ch8 * 16) = r.k[i]; *(LAS v4u*)(Vs + s * W128_SB + ch8 * 16) = r.v[i]; }
#pragma unroll
    for (int i = 0; i < 4; ++i) { const int it = F.tid + i * NTHREADS, ch8 = it & 15, e = it >> 4; *(LAS v4u*)(Cs + e * W128_SB + ch8 * 16) = r.c[i]; }
    if (F.tid < 64) { fb[F.tid] = r.fb; fli[F.tid] = r.fli; }
    if (F.tid < ML_D) fn[F.tid] = r.fn;
    const float mc = r.mc;
    __syncthreads();
    if (next_unit >= 0) ml_stage_c_load(F, next_unit, r);
    const int lane = F.lane, gq = lane >> 4, w = F.wave, tb = w & 3, eh = w >> 2;
    const int t = 16 * tb + (lane & 15); const float bt = fb[t];
    f32x4 ggv[4]; v2u owv[4];
#pragma unroll
    for (int ei = 0; ei < 4; ++ei) { const int e0 = 16 * (eh * 4 + ei) + 4 * gq; ggv[ei] = *(const f32x4*)(ng + h * 128 + e0); owv[ei] = *(const v2u*)(proj + (row0 + t) * PW + PC_MLO + h * 128 + e0); }
    bf16x8 qf[4];
#pragma unroll
    for (int st = 0; st < 4; ++st) qf[st] = lds_row8(Qs, W128_SB, t, 32 * st + 8 * gq);
    f32x4 sT[4]; float dmax = NEG_BIG;
#pragma unroll
    for (int sb = 0; sb < 4; ++sb) { sT[sb] = (f32x4){0.f, 0.f, 0.f, 0.f};
        if (sb <= tb) {
#pragma unroll
            for (int st = 0; st < 4; ++st) sT[sb] = mfma16(lds_row8(Ks, W128_SB, 16 * sb + (lane & 15), 32 * st + 8 * gq), qf[st], sT[sb]);
#pragma unroll
            for (int r = 0; r < 4; ++r) { const int s = 16 * sb + 4 * gq + r; if (s <= t) dmax = fmaxf(dmax, bt - fb[s] + fli[s]); } } }
    dmax = grp_max(dmax);
    const float mt = fmaxf(bt + mc, dmax); const float iw = __expf(bt + mc - mt);
    float dsum = 0.f;
#pragma unroll
    for (int sb = 0; sb < 4; ++sb)
#pragma unroll
        for (int r = 0; r < 4; ++r) { const int s = 16 * sb + 4 * gq + r; const float p = (sb <= tb && s <= t) ? sT[sb][r] * __expf(bt - fb[s] + fli[s] - mt) : 0.f; sT[sb][r] = p; dsum += p; }
    dsum = grp_sum(dsum);
    float qn = 0.f;
#pragma unroll 8
    for (int dd = 0; dd < 32; ++dd) { const int d = gq * 32 + dd; qn += bf2f(*(const LAS unsigned short*)(Qs + t * W128_SB + d * 2)) * fn[d]; }
    qn = grp_sum(qn);
    const float den = dsum + iw * qn; const float rden = 1.0f / fmaxf(fabsf(den), __expf(-mt));
    const bf16x8 p0 = pack8(sT[0], sT[1]), p1 = pack8(sT[2], sT[3]);
    f32x4 hv[4]; float sq = 0.f;
#pragma unroll
    for (int ei = 0; ei < 4; ++ei) { const int eb = eh * 4 + ei;
        f32x4 intra = (f32x4){0.f, 0.f, 0.f, 0.f}, inter = (f32x4){0.f, 0.f, 0.f, 0.f};
        intra = mfma16(tr_frag(Vs, W128_SB, 4 * gq, 16 + 4 * gq, 16 * eb, lane), p0, intra);
        if (tb >= 2) intra = mfma16(tr_frag(Vs, W128_SB, 32 + 4 * gq, 48 + 4 * gq, 16 * eb, lane), p1, intra);
#pragma unroll
        for (int st = 0; st < 4; ++st) inter = mfma16(lds_row8(Cs, W128_SB, 16 * eb + (lane & 15), 32 * st + 8 * gq), qf[st], inter);
        hv[ei] = (intra + inter * iw) * rden; sq += (hv[ei][0] * hv[ei][0] + hv[ei][1] * hv[ei][1]) + (hv[ei][2] * hv[ei][2] + hv[ei][3] * hv[ei][3]); }
    sq = grp_sum(sq);
    if (gq == 0) ssq[eh * 64 + t] = sq;
    __syncthreads();
    const float rn = rsqrtf((ssq[t] + ssq[64 + t]) * (1.0f / ML_D) + NORM_EPS);
#pragma unroll
    for (int ei = 0; ei < 4; ++ei) { const int e0 = 16 * (eh * 4 + ei) + 4 * gq; const f32x4 gg = ggv[ei];
        const v2u ow = owv[ei];
        f32x4 v = hv[ei] * rn * gg; v[0] *= sigmoidf_(bflo(ow.x)); v[1] *= sigmoidf_(bfhi(ow.x)); v[2] *= sigmoidf_(bflo(ow.y)); v[3] *= sigmoidf_(bfhi(ow.y));
        v2u o; o.x = pg8::cvt_pk_bf16(v[0], v[1]); o.y = pg8::cvt_pk_bf16(v[2], v[3]); *(v2u*)(oml + (row0 + t) * 512 + h * 128 + e0) = o; }
}

#ifndef REPEAT_PHASE
#define REPEAT_PHASE -1
#endif
__device__ __forceinline__ void ph2(Ctx& F) {
    const int nconv = (F.G * 112) / 256, GC = F.G - nconv;
    if ((int)blockIdx.x < GC) {
        pg8::Gemm g{(const bf16*)(F.ws + WS_A1), (const bf16*)(F.ws + WS_WIN), T, PW, DM}; pg8::StaticOrder S; S.init(T, PW, GC, (int)blockIdx.x);
        EpiStoreScaled E{(bf16*)(F.ws + WS_PROJ), PW, (const float*)(F.ws + WS_SA), (const float*)(F.ws + WS_SW)};
        pg8::gemm_phase<EpiStoreScaled, pg8::StaticOrder, true, true, false, false, true>(F.lds, g, S, E);
    } else moe_convert(F, (int)blockIdx.x - GC, nconv);
}
#ifndef TIME_SUB
#define TIME_SUB 0
#endif
#define SUBT_BEGIN(k) unsigned long long ts_ = 0; if (TIME_SUB == (k)) ts_ = __builtin_amdgcn_s_memrealtime();
#define SUBT_END(k) if (TIME_SUB == (k)) { __syncthreads(); const unsigned long long n_ = __builtin_amdgcn_s_memrealtime(); const unsigned long long e_ = n_ + 4 * (n_ - ts_); while (__builtin_amdgcn_s_memrealtime() < e_) __builtin_amdgcn_s_sleep(8); }
__device__ __forceinline__ void ph3(Ctx& F) {
    { SUBT_BEGIN(3) for (int u = F.vcu; u < 256; u += F.G) nsa_compress_unit(F, u); SUBT_END(3) }
    for (int u = F.vcu; u < ML_BH * ML_NCH; u += F.G) ml_stage_a(F, u);
}
__device__ __forceinline__ void ph4(Ctx& F) {
    { SUBT_BEGIN(4) for (int p = F.vcu; p < 256; p += F.G) { const int bg = p >> 5, x = p & 31; nsa_cmp_unit(F, bg, 63 - x); nsa_cmp_unit(F, bg, x); } SUBT_END(4) }
    for (int u = F.vcu; u < ML_BH * 16; u += F.G) ml_stage_b(F, u);
}
__device__ __forceinline__ void ph5(Ctx& F) {
    { SUBT_BEGIN(5) for (int p = F.vcu; p < 256; p += F.G) { const int bg = p >> 5, x = p & 31; nsa_selwin_unit(F, bg >> 1, bg & 1, x); nsa_selwin_unit(F, bg >> 1, bg & 1, 63 - x); } SUBT_END(5) }
    { MlcIn r; int u = F.vcu; if (u < ML_BH * ML_NCH) ml_stage_c_load(F, u, r);
      for (; u < ML_BH * ML_NCH; u += F.G) { const int nu = u + F.G < ML_BH * ML_NCH ? u + F.G : -1; ml_stage_c(F, u, nu, r); } }
}
struct UpOrder {
    pg8::StaticOrder so;
    __device__ __forceinline__ bool next(int i, Unit& u) const { if (!so.next(i >> 1, u)) return false; if (i & 1) { u.pm += T / 256; u.pn += DM / 256; } return true; }
    __device__ __forceinline__ void a_ready(const Unit&) const {}
    __device__ __forceinline__ void done(const Unit&) const {}
};
struct EpiUpBoth {
    static constexpr bool PERM = true, AFTER_DRAIN = false;
    bf16* U; const bf16* G;
    __device__ __forceinline__ void operator()(const f32x4 (&acc)[2][2][4][2], const Unit& u, int wr, int wc, int fr, int fq) const {
        if (u.pm < T / 256) { EpiUpGate<false> E{U, G, PC_MGA}; E(acc, u, wr, wc, fr, fq); }
        else { Unit v = u; v.pm -= T / 256; v.pn -= DM / 256; EpiUpGate<true> E{U, G, PC_MGB}; E(acc, v, wr, wc, fr, fq); }
    }
};
static_assert(WS_OML == WS_ONSA + (size_t)T * 512 * 2 && WS_WUPB == WS_WUPA + (size_t)DM * 512 * 2, "stacked operands of the up projection");
__device__ __forceinline__ void ph6(Ctx& F) {
    UpOrder S; S.so.init(T, DM, F.G, (int)blockIdx.x);
    pg8::Gemm g{(const bf16*)(F.ws + WS_ONSA), (const bf16*)(F.ws + WS_WUPA), 2 * T, 2 * DM, 512}; EpiUpBoth E{(bf16*)(F.ws + WS_U), (const bf16*)(F.ws + WS_PROJ)};
    pg8::gemm_phase<EpiUpBoth, UpOrder, true, true>(F.lds, g, S, E);
}
__device__ __forceinline__ void ph7(Ctx& F) {
    pg8::Gemm g{(const bf16*)(F.ws + WS_U), (const bf16*)(F.ws + WS_WOUT), T, DM, DM}; pg8::StaticOrder S; S.init(T, DM, F.G, (int)blockIdx.x);
    EpiOutRes E{F.in[I_X], (bf16*)(F.ws + WS_H1), (const float*)(F.ws + WS_MODF)};
    pg8::gemm_phase<EpiOutRes, pg8::StaticOrder, true, true>(F.lds, g, S, E);
}
__device__ __forceinline__ void ph10(Ctx& F) {
    pg8::Gemm g{(const bf16*)(F.ws + WS_A1), (const bf16*)(F.ws + WS_W1T), MOE_P, NEXP * 2048, DM};
    moe_units_to_lds<1>(F.lds, F.ctl + CW_MOETAB, 8, 3, F.G, F.vcu, F.in[I_EB1], nullptr);
    MoeOrder S{(const LAS int*)(F.lds + MOE_UL_OFF), (const int*)(F.ws + WS_ROWT)};
    EpiMoe1 E{F.ws + WS_ACT, (const LAS float*)(F.lds + MOE_BT1_OFF)};
    pg8::gemm_phase<EpiMoe1, MoeOrder, true, true, true, true>(F.lds, g, S, E);
}
__device__ __forceinline__ void ph11(Ctx& F) {
    pg8::Gemm g{(const bf16*)(F.ws + WS_ACT), (const bf16*)(F.ws + WS_W2T), MOE_P, NEXP * DM, DE};
    moe_units_to_lds<2>(F.lds, F.ctl + CW_MOETAB, 4, 2, F.G, F.vcu, F.in[I_EB2], (const float*)(F.ws + WS_ROWG));
    MoeOrder S{(const LAS int*)(F.lds + MOE_UL_OFF), nullptr};
    EpiMoe2 E{F.ws + WS_YR, (const LAS float*)(F.lds + MOE_BT2_OFF)};
    pg8::gemm_phase<EpiMoe2, MoeOrder, true, true, true>(F.lds, g, S, E);
}
#ifndef TIME_PHASE
#define TIME_PHASE -1
#endif
#define RUN(k, call) do { unsigned long long t0_ = 0; if (TIME_PHASE == (k)) t0_ = __builtin_amdgcn_s_memrealtime(); F.tid = threadIdx.x; F.lane = F.tid & 63; call; SEAM(); \
    if (TIME_PHASE == (k)) { const unsigned long long n_ = __builtin_amdgcn_s_memrealtime(); const unsigned long long e_ = n_ + 4 * (n_ - t0_); while (__builtin_amdgcn_s_memrealtime() < e_) __builtin_amdgcn_s_sleep(8); SEAM(); } } while (0)
__global__ void __launch_bounds__(NTHREADS, 2) fwd_kernel(Args args) {
    extern __shared__ __attribute__((aligned(16))) unsigned char lds_raw[];
    Ctx F;
    F.lds = (LAS unsigned char*)lds_raw; F.ws = args.ws; F.ctl = (unsigned*)(args.ws + WS_CTL);
    F.tid = threadIdx.x; F.lane = F.tid & 63; F.wave = __builtin_amdgcn_readfirstlane(F.tid >> 6);
    F.G = gridDim.x; { const int bx = blockIdx.x; F.vcu = (F.G % 8 == 0) ? (bx % 8) * (F.G / 8) + bx / 8 : bx; }
    F.in = args.in; F.out = args.out;
    volatile LAS unsigned* MISC = (volatile LAS unsigned*)(F.lds + MISC_OFF);
    for (int u = F.tid; u < (LDS_BYTES - LDSCTL_OFF) / 4; u += NTHREADS) ((LAS unsigned*)(F.lds + LDSCTL_OFF))[u] = 0u;
    __syncthreads();
    XcdBarrier bar = xcd_barrier_post(F.ctl + CW_BAR, MISC + 8);
#define SEAM() xcd_barrier(bar)
    const float* modf = (const float*)(F.ws + WS_MODF);
    const bf16* H = (const bf16*)(F.ws + WS_H1);
    RUN(0, p0_prologue(F));
    RUN(1, p1_norm1(F));
    RUN(2, ph2(F));
    RUN(3, ph3(F));
    RUN(4, ph4(F));
    RUN(5, ph5(F));
    RUN(6, ph6(F));
    RUN(7, ph7(F));
    RUN(8, p8_norm2_router(F, H, modf));
    RUN(9, p9_permute(F));
    RUN(10, ph10(F));
    RUN(11, ph11(F));
    p_final<true>(F, H, modf);
#undef SEAM
}

extern "C" void kernel_launch(void* const* d_in, const int* in_sizes, int n_in, void* d_out, int out_size, void* d_ws, size_t ws_size, hipStream_t stream) {
    static int grid = 0;
    if (grid == 0) {
        if (n_in != 27 || in_sizes[0] != T * DM || out_size != T * DM || ws_size < WS_END) { fprintf(stderr, "kernel_launch: unexpected shapes (n_in %d, in0 %d, out %d, ws %zu)\n", n_in, n_in > 0 ? in_sizes[0] : -1, out_size, ws_size); grid = -1; return; }
        int dev = 0, cus = 0, per_cu = 0;
        if (hipGetDevice(&dev) != hipSuccess || hipDeviceGetAttribute(&cus, hipDeviceAttributeMultiprocessorCount, dev) != hipSuccess) { grid = -1; return; }
        if (hipFuncSetAttribute((const void*)fwd_kernel, hipFuncAttributeMaxDynamicSharedMemorySize, LDS_BYTES) != hipSuccess) { fprintf(stderr, "kernel_launch: hipFuncSetAttribute failed\n"); grid = -1; return; }
        if (hipOccupancyMaxActiveBlocksPerMultiprocessor(&per_cu, (const void*)fwd_kernel, NTHREADS, LDS_BYTES) != hipSuccess || per_cu < 1) fprintf(stderr, "kernel_launch: occupancy query reports %d\n", per_cu);
        (void)hipGetLastError();
        grid = cus;
    }
    if (grid < 0) return;
    if (hipMemsetAsync((char*)d_ws + WS_CTL, 0, CTL_ZERO_BYTES, stream) != hipSuccess) return;
    Args a{};
    for (int i = 0; i < 27; ++i) a.in[i] = (const float*)d_in[i];
    a.out = (float*)d_out; a.ws = (unsigned char*)d_ws;
    a.ph_lo = 0; a.ph_hi = 64;
    hipLaunchKernelGGL(fwd_kernel, dim3(grid), dim3(NTHREADS), LDS_BYTES, stream, a);
}
```

```cpp
#include <hip/hip_runtime.h>
#include <cstdio>
#include <cstdint>
namespace pg8 {
#define PG8_LAS __attribute__((address_space(3)))
typedef unsigned short bf16_t;
typedef short bf16x8 __attribute__((ext_vector_type(8)));
typedef float f32x4 __attribute__((ext_vector_type(4)));
typedef unsigned u32x4 __attribute__((ext_vector_type(4)));
constexpr int BM = 256, BK = 64, HALF = 128, HTB = HALF * BK * 2  , STAGE_BYTES = 8 * HTB, NXCD = 8, WGM = 8;

__host__ __device__ __forceinline__ int lds_byte(int r, int c) { const int st = (r >> 4) * 2 + (c >> 5), rr = r & 15, cc = c & 31, ob = rr * 64 + cc * 2; return st * 1024 + (ob ^ (((ob >> 9) & 1) << 5)); }
__host__ __device__ __forceinline__ void stage_rc(int b, int& R, int& C) { const int st = b / 1024, sb = b % 1024, swz = sb ^ (((sb >> 9) & 1) << 5); R = (st >> 1) * 16 + swz / 64; C = (st & 1) * 32 + (swz % 64) / 2; }
__host__ __device__ __forceinline__ int perm32(int rho) { const int n = rho >> 4, i = rho & 15; return 8 * (i >> 2) + 4 * n + (i & 3); }

struct Unit { int pm, pn, ix; };
struct Gemm { const bf16_t* A; const bf16_t* Bt; int M, N, K; };

struct StaticOrder {
    int nM, nN, nwg, G, c;
    __host__ __device__ void init(int M, int N, int G_, int c_) { nM = M / BM; nN = N / BM; nwg = nM * nN; G = G_; c = c_; }
    __host__ __device__ bool next(int i, Unit& u) const {
        const long L = (long)i * G + c; if (L >= nwg) return false;
        int wgid = (int)L; { const int q = nwg / NXCD, r = nwg % NXCD, xcd = wgid % NXCD, off = wgid / NXCD; wgid = (xcd < r ? xcd * (q + 1) : r * (q + 1) + (xcd - r) * q) + off; }
        const int nig = WGM * nN, gid = wgid / nig, fm = gid * WGM, gsz = (nM - fm) < WGM ? (nM - fm) : WGM;
        u.pm = fm + ((wgid % nig) % gsz); u.pn = (wgid % nig) / gsz; return true;
    }
    __device__ __forceinline__ void a_ready(const Unit&) const {}
    __device__ __forceinline__ void done(const Unit&) const {}
};

__device__ __forceinline__ unsigned cvt_pk_bf16(float lo, float hi) { unsigned r; asm volatile("v_cvt_pk_bf16_f32 %0, %1, %2" : "=v"(r) : "v"(lo), "v"(hi)); return r; }
typedef float f32x2 __attribute__((ext_vector_type(2)));
typedef int v8i32 __attribute__((ext_vector_type(8)));
typedef int v4i32 __attribute__((ext_vector_type(4)));
template <bool F8> struct FragT { typedef bf16x8 type; }; template <> struct FragT<true> { typedef v8i32 type; };
constexpr int F8_SCALE_A = 0x7F7F7F7F;
constexpr int F8_SCALE_B = 0x7A7A7A7A;
template <class Epi, class Sched, bool ALIGN_EPI = false, bool SP2 = false, bool F8 = false, bool GATHER = false, bool I8 = false>
__device__ __forceinline__ void gemm_phase(PG8_LAS unsigned char* lds, const Gemm g, const Sched& S, const Epi& E) {
    int tid_ = threadIdx.x; asm volatile("" : "+v"(tid_));
    const int tid = tid_, wid = __builtin_amdgcn_readfirstlane(tid >> 6), lane = tid & 63, wr = wid >> 2, wc = wid & 3, fr = lane & 15, fq = lane >> 4;
    const int K = g.K, nt = (F8 || I8) ? K / (2 * BK) : K / BK; const int RB = (F8 || I8) ? K : 2 * K;
    unsigned voffA[2], voffB[2];
#pragma unroll
    for (int i = 0; i < 2; ++i) { int R, C; stage_rc(tid * 16 + i * 8192, R, C); const int Rb = Epi::PERM ? ((R & ~31) + perm32(R & 31)) : R;
        voffA[i] = (unsigned)(R * RB + C * 2); voffB[i] = (unsigned)(Rb * RB + C * 2); }
    const size_t kstep = (size_t)(BK * 2);
    const size_t hstep = (size_t)HALF * RB;
    const size_t tstep = 2 * hstep;
    const unsigned ldsw = (unsigned)wid * 1024u;
    const int aoff = lds_byte(wr * 64 + fr, fq * 8), boff = lds_byte(wc * 32 + fr, fq * 8);
#define PG8_SA(b, h) (((b) * 2 + (h)) * HTB)
#define PG8_SB(b, h) ((4 + (b) * 2 + (h)) * HTB)
#define PG8_STAGE(bufoff, gbase, voff) do { _Pragma("unroll") for (int _i = 0; _i < 2; ++_i) \
        __builtin_amdgcn_global_load_lds((const unsigned*)((const char*)(gbase) + (voff)[_i]), (PG8_LAS unsigned*)(lds + (bufoff) + ldsw + _i * 8192), 16, 0, 0); } while (0)
#define PG8_GO1(ix, h_, i_) ((unsigned)rt[(ix) * BM + (h_) * HALF + (int)(voffA[i_] / (unsigned)RB)] * (unsigned)RB + voffA[i_] % (unsigned)RB)
#define PG8_STAGE_A(bufoff, gbase, h, nx) do { if constexpr (GATHER) { _Pragma("unroll") for (int _i = 0; _i < 2; ++_i) { const unsigned o_ = PG8_GO1((nx) ? nui : ui, h, _i); \
        __builtin_amdgcn_global_load_lds((const unsigned*)((const char*)(gbase) + o_), (PG8_LAS unsigned*)(lds + (bufoff) + ldsw + _i * 8192), 16, 0, 0); } } \
        else { PG8_STAGE(bufoff, (const char*)(gbase) + (h) * hstep, voffA); } } while (0)
#define PG8_GOFFS(v, ix) do { _Pragma("unroll") for (int h_ = 0; h_ < 2; ++h_) _Pragma("unroll") for (int i_ = 0; i_ < 2; ++i_) v[h_][i_] = PG8_GO1(ix, h_, i_); } while (0)
#define PG8_LD16(off) (*(const PG8_LAS v4i32*)(lds + (off)))
#define PG8_LDA(dst, b, h) do { _Pragma("unroll") for (int m = 0; m < 4; ++m) { if constexpr (F8) { const v4i32 lo_ = PG8_LD16(PG8_SA(b, h) + aoff + m * 2048), hi_ = PG8_LD16(PG8_SA(b, h) + aoff + m * 2048 + 1024); dst[m][0] = __builtin_shufflevector(lo_, hi_, 0, 1, 2, 3, 4, 5, 6, 7); } \
        else { _Pragma("unroll") for (int k = 0; k < NK; ++k) dst[m][k] = *(const PG8_LAS frag_t*)(lds + PG8_SA(b, h) + aoff + m * 2048 + k * 1024); } } } while (0)
#define PG8_LDB(dst, b, h) do { _Pragma("unroll") for (int n = 0; n < 2; ++n) { if constexpr (F8) { const v4i32 lo_ = PG8_LD16(PG8_SB(b, h) + boff + n * 2048), hi_ = PG8_LD16(PG8_SB(b, h) + boff + n * 2048 + 1024); dst[n][0] = __builtin_shufflevector(lo_, hi_, 0, 1, 2, 3, 4, 5, 6, 7); } \
        else { _Pragma("unroll") for (int k = 0; k < NK; ++k) dst[n][k] = *(const PG8_LAS frag_t*)(lds + PG8_SB(b, h) + boff + n * 2048 + k * 1024); } } } while (0)
#define PG8_MMA(ai, bj, At, Bt) do { __builtin_amdgcn_s_setprio(1); \
        if constexpr (F8) { _Pragma("unroll") for (int m = 0; m < 4; ++m) _Pragma("unroll") for (int n = 0; n < 2; ++n) \
            asm("v_mfma_scale_f32_16x16x128_f8f6f4 %0, %1, %2, %0, %3, %4 op_sel_hi:[0,0,0]" : "+v"(acc[ai][bj][m][n]) : "v"(Bt[n][0]), "v"(At[m][0]), "v"(f8sb), "v"(f8sa)); } \
        else if constexpr (I8) { _Pragma("unroll") for (int m = 0; m < 4; ++m) _Pragma("unroll") for (int n = 0; n < 2; ++n) _Pragma("unroll") for (int k = 0; k < NK; ++k) \
            acc[ai][bj][m][n] = __builtin_bit_cast(f32x4, __builtin_amdgcn_mfma_i32_16x16x64_i8(__builtin_bit_cast(v4i32, Bt[n][k]), __builtin_bit_cast(v4i32, At[m][k]), __builtin_bit_cast(v4i32, acc[ai][bj][m][n]), 0, 0, 0)); } \
        else { _Pragma("unroll") for (int m = 0; m < 4; ++m) _Pragma("unroll") for (int n = 0; n < 2; ++n) _Pragma("unroll") for (int k = 0; k < NK; ++k) \
            acc[ai][bj][m][n] = __builtin_amdgcn_mfma_f32_16x16x32_bf16(Bt[n][k], At[m][k], acc[ai][bj][m][n], 0, 0, 0); } \
        __builtin_amdgcn_s_setprio(0); } while (0)
#define PG8_WAIT_V(n) asm volatile("s_waitcnt vmcnt(" #n ")" ::: "memory")
#define PG8_WAIT_L(n) asm volatile("s_waitcnt lgkmcnt(" #n ")" ::: "memory")
#define PG8_BAR __builtin_amdgcn_s_barrier()
#define PG8_SCHED __builtin_amdgcn_sched_barrier(0)
    Unit cur, nxt; int ui = 0;
    if (!S.next(0, cur)) return;
    f32x4 acc[2][2][4][2];
#pragma unroll
    for (int a = 0; a < 2; ++a)
#pragma unroll
        for (int b = 0; b < 2; ++b)
#pragma unroll
            for (int m = 0; m < 4; ++m)
#pragma unroll
                for (int n = 0; n < 2; ++n) acc[a][b][m][n] = (f32x4){0.f, 0.f, 0.f, 0.f};
    typedef typename FragT<F8>::type frag_t; constexpr int NK = F8 ? 1 : 2;
    int f8sa = F8_SCALE_A, f8sb = F8_SCALE_B; if constexpr (F8) asm volatile("" : "+v"(f8sa), "+v"(f8sb));
    frag_t At[4][NK], B0[2][NK], B1[2][NK];
    const char* cA = (const char*)g.A + (GATHER ? (size_t)0 : (size_t)cur.pm * tstep); const char* cB = (const char*)g.Bt + (size_t)cur.pn * tstep;
    int nui = 0; PG8_LAS const unsigned short* rt = (PG8_LAS const unsigned short*)(lds + STAGE_BYTES);
    if constexpr (GATHER) {
        Unit tu; for (int i = 0; S.next(i, tu); ++i) if (tid < BM) ((PG8_LAS unsigned short*)(lds + STAGE_BYTES))[i * BM + tid] = (unsigned short)S.rowtok[tu.pm * BM + tid];
        __syncthreads();
    }
    S.a_ready(cur);
    if constexpr (SP2) {
        PG8_STAGE(PG8_SB(0, 0), cB, voffB); PG8_STAGE(PG8_SB(0, 1), cB + hstep, voffB); PG8_STAGE_A(PG8_SA(0, 0), cA, 0, false); PG8_STAGE_A(PG8_SA(0, 1), cA, 1, false);
        if (wr == 1) PG8_BAR;
        PG8_WAIT_V(2); PG8_BAR;
        PG8_STAGE(PG8_SB(1, 0), cB + kstep, voffB); PG8_STAGE_A(PG8_SA(1, 0), cA + kstep, 0, false); PG8_STAGE(PG8_SB(1, 1), cB + hstep + kstep, voffB);
        PG8_WAIT_V(6); PG8_BAR;
    } else {
        PG8_STAGE(PG8_SB(0, 0), cB, voffB); PG8_STAGE_A(PG8_SA(0, 0), cA, 0, false); PG8_STAGE(PG8_SB(0, 1), cB + hstep, voffB); PG8_STAGE_A(PG8_SA(0, 1), cA, 1, false);
        if (wr == 1) PG8_BAR;
        PG8_WAIT_V(4); PG8_BAR;
        PG8_STAGE(PG8_SB(1, 0), cB + kstep, voffB); PG8_STAGE_A(PG8_SA(1, 0), cA + kstep, 0, false); PG8_STAGE(PG8_SB(1, 1), cB + hstep + kstep, voffB);
        PG8_WAIT_V(6); PG8_BAR;
    }
    for (;;) {
        const bool has_next = S.next(ui + 1, nxt);
        const char* nA = (has_next && !GATHER) ? (const char*)g.A + (size_t)nxt.pm * tstep : cA; const char* nB = has_next ? (const char*)g.Bt + (size_t)nxt.pn * tstep : cB;
        nui = has_next ? ui + 1 : ui;
#pragma unroll 1
        for (int t = 0; t < nt; t += 2) {
            const bool last = (t == nt - 2);
            const char* a1 = cA + (size_t)(t + 1) * kstep;
            const char* a2 = last ? nA : cA + (size_t)(t + 2) * kstep; const char* b2 = last ? nB : cB + (size_t)(t + 2) * kstep;
            const char* a3 = a2 + kstep; const char* b3 = b2 + kstep;
            if (last && has_next) S.a_ready(nxt);
            if constexpr (SP2) {
            PG8_LDB(B0, 0, 0); PG8_LDB(B1, 0, 1); PG8_SCHED; PG8_LDA(At, 0, 0); PG8_STAGE_A(PG8_SA(1, 1), a1, 1, false);
            PG8_WAIT_V(8); PG8_WAIT_L(0); PG8_BAR; PG8_MMA(0, 0, At, B0); PG8_MMA(0, 1, At, B1); PG8_BAR; PG8_SCHED;
            PG8_LDA(At, 0, 1); PG8_STAGE(PG8_SB(0, 0), b2, voffB); PG8_STAGE(PG8_SB(0, 1), b2 + hstep, voffB); PG8_STAGE_A(PG8_SA(0, 0), a2, 0, last);
            PG8_WAIT_V(8); PG8_WAIT_L(0); PG8_BAR; PG8_MMA(1, 0, At, B0); PG8_MMA(1, 1, At, B1); PG8_BAR; PG8_SCHED;
            PG8_LDB(B0, 1, 0); PG8_LDB(B1, 1, 1); PG8_SCHED; PG8_LDA(At, 1, 0); PG8_STAGE_A(PG8_SA(0, 1), a2, 1, last);
            PG8_WAIT_V(8); PG8_WAIT_L(0); PG8_BAR; PG8_MMA(0, 0, At, B0); PG8_MMA(0, 1, At, B1); PG8_BAR; PG8_SCHED;
            PG8_LDA(At, 1, 1); PG8_STAGE(PG8_SB(1, 0), b3, voffB); PG8_STAGE(PG8_SB(1, 1), b3 + hstep, voffB); PG8_STAGE_A(PG8_SA(1, 0), a3, 0, last);
            PG8_WAIT_V(8); PG8_WAIT_L(0); PG8_BAR; PG8_MMA(1, 0, At, B0); PG8_MMA(1, 1, At, B1); PG8_BAR; PG8_SCHED;
            } else {
            PG8_LDB(B0, 0, 0); PG8_SCHED; PG8_LDA(At, 0, 0); PG8_STAGE_A(PG8_SA(1, 1), a1, 1, false);
            PG8_WAIT_L(8); PG8_BAR; PG8_WAIT_L(0); PG8_MMA(0, 0, At, B0); PG8_BAR; PG8_SCHED;
            PG8_LDB(B1, 0, 1); PG8_STAGE(PG8_SB(0, 0), b2, voffB);
            PG8_BAR; PG8_WAIT_L(0); PG8_MMA(0, 1, At, B1); PG8_BAR;
            PG8_LDA(At, 0, 1); PG8_STAGE_A(PG8_SA(0, 0), a2, 0, last);
            PG8_BAR; PG8_WAIT_L(0); PG8_MMA(1, 0, At, B0); PG8_BAR; PG8_SCHED;
            PG8_STAGE(PG8_SB(0, 1), b2 + hstep, voffB);
            PG8_WAIT_V(6); PG8_BAR; PG8_MMA(1, 1, At, B1); PG8_BAR;
            PG8_LDB(B0, 1, 0); PG8_SCHED; PG8_LDA(At, 1, 0); PG8_STAGE_A(PG8_SA(0, 1), a2, 1, last);
            PG8_WAIT_L(8); PG8_BAR; PG8_WAIT_L(0); PG8_MMA(0, 0, At, B0); PG8_BAR; PG8_SCHED;
            PG8_LDB(B1, 1, 1); PG8_STAGE(PG8_SB(1, 0), b3, voffB);
            PG8_BAR; PG8_WAIT_L(0); PG8_MMA(0, 1, At, B1); PG8_BAR;
            PG8_LDA(At, 1, 1); PG8_STAGE_A(PG8_SA(1, 0), a3, 0, last);
            PG8_BAR; PG8_WAIT_L(0); PG8_MMA(1, 0, At, B0); PG8_BAR; PG8_SCHED;
            PG8_STAGE(PG8_SB(1, 1), b3 + hstep, voffB);
            PG8_WAIT_V(6); PG8_BAR; PG8_MMA(1, 1, At, B1); PG8_BAR;
            }
        }
        if constexpr (F8) asm volatile("s_nop 15\n\ts_nop 7" ::: "memory");
        if constexpr (ALIGN_EPI) { if (wr == 0) PG8_BAR; }
        if constexpr (I8) {
#pragma unroll
            for (int a = 0; a < 2; ++a)
#pragma unroll
                for (int b = 0; b < 2; ++b)
#pragma unroll
                    for (int m = 0; m < 4; ++m)
#pragma unroll
                        for (int n = 0; n < 2; ++n) acc[a][b][m][n] = __builtin_convertvector(__builtin_bit_cast(v4i32, acc[a][b][m][n]), f32x4); }
        if constexpr (!Epi::AFTER_DRAIN) { E(acc, cur, wr, wc, fr, fq); S.done(cur); }
        if (!has_next) break;
#pragma unroll
        for (int a = 0; a < 2; ++a)
#pragma unroll
            for (int b = 0; b < 2; ++b)
#pragma unroll
                for (int m = 0; m < 4; ++m)
#pragma unroll
                    for (int n = 0; n < 2; ++n) acc[a][b][m][n] = (f32x4){0.f, 0.f, 0.f, 0.f};
        cur = nxt; cA = nA; cB = nB; ++ui;

        if constexpr (ALIGN_EPI) { if (wr == 1) PG8_BAR; }
    }
    PG8_WAIT_V(0);
    if constexpr (!ALIGN_EPI) { if (wr == 0) PG8_BAR; }
    PG8_BAR;
    if constexpr (Epi::AFTER_DRAIN) { E.fused(acc, cur, wr, wc, fr, fq, lds, wid, lane); S.done(cur); }
#undef PG8_SA
#undef PG8_SB
#undef PG8_STAGE
#undef PG8_LDA
#undef PG8_LDB
#undef PG8_LD16
#undef PG8_STAGE_A
#undef PG8_GOFFS
#undef PG8_GO1
#undef PG8_MMA
#undef PG8_WAIT_V
#undef PG8_WAIT_L
#undef PG8_BAR
#undef PG8_SCHED
}
}

constexpr int NWAVES = 8, NTHREADS = 512;
constexpr int BATCH = 4, SEQ = 4096, DM = 1024, T = BATCH * SEQ;
constexpr int INW = 5408, PW = 5632;
constexpr int NEXP = 32, TOPK = 4, DE = 1024, NASSIGN = T * TOPK, MOE_ROWS = 256;
constexpr int MOE_MAXTILES = (NASSIGN + NEXP * (MOE_ROWS - 1) + MOE_ROWS - 1) / MOE_ROWS;
constexpr int MOE_P = MOE_MAXTILES * MOE_ROWS;
constexpr float NORM_EPS = 1e-6f;
constexpr int PC_Q = 0, PC_KV = 512, PC_MLQ = 1280, PC_MLK = 1792, PC_MLV = 2304, PC_MLO = 2816, PC_MGA = 3328, PC_MGB = 4352, PC_NSAG = 5376, PC_MLIF = 5400;
constexpr int ADA_SLICES = 16, PB_SLICES = 16;

constexpr size_t MiB = 1u << 20;
constexpr size_t WS_CTL = 0, CTL_ZERO_BYTES = 1 * MiB;
constexpr size_t WS_MODP = 1 * MiB;
constexpr size_t WS_MODF = 3 * MiB;
constexpr size_t WS_PBP  = 3 * MiB + 512 * 1024;
constexpr size_t WS_WIN  = 4 * MiB;
constexpr size_t WS_WUPA = 16 * MiB, WS_WUPB = 17 * MiB;
constexpr size_t WS_WOUT = 18 * MiB;
constexpr size_t WS_CW1K = 20 * MiB, WS_CW1V = 20 * MiB + 512 * 1024;
constexpr size_t WS_CW2K = 21 * MiB, WS_CW2V = 21 * MiB + 64 * 1024;
constexpr size_t WS_KC = 22 * MiB, WS_VC = 22 * MiB + 512 * 1024;
constexpr size_t WS_SELM = 23 * MiB;
constexpr size_t WS_TOPI = 24 * MiB, WS_GATE = 24 * MiB + 256 * 1024, WS_DEST = 24 * MiB + 512 * 1024;
constexpr size_t WS_ROWT = 30 * MiB;
constexpr size_t WS_ROWG = 25 * MiB;
constexpr size_t WS_MLB = 26 * MiB, WS_MLLI = 26 * MiB + 256 * 1024;
constexpr size_t WS_RWHI = 25 * MiB + 512 * 1024, WS_RWLO = 25 * MiB + 768 * 1024;
constexpr size_t WS_MLSC = 27 * MiB;
constexpr size_t WS_MLUN = 28 * MiB, WS_MLN = 29 * MiB;
constexpr size_t WS_W1T = 32 * MiB;
constexpr size_t WS_WIN8 = 96 * MiB;
constexpr size_t WS_A1F8 = 674 * MiB;
constexpr size_t WS_SA = 31 * MiB;
constexpr size_t WS_SW = 31 * MiB + 128 * 1024;
constexpr size_t WS_W2T = 160 * MiB;
constexpr size_t WS_H1 = 224 * MiB;
constexpr size_t WS_A1 = 288 * MiB;
constexpr size_t WS_PROJ = 320 * MiB;
constexpr size_t WS_XG = 320 * MiB;
constexpr size_t WS_OCMP = 496 * MiB, WS_ONSA = 512 * MiB, WS_OML = 528 * MiB, WS_MLQ = 544 * MiB, WS_MLKK = 560 * MiB;
constexpr size_t WS_MLU = 576 * MiB;
constexpr size_t WS_MLC = 640 * MiB;
constexpr size_t WS_U = 674 * MiB;
constexpr size_t WS_ACT = 496 * MiB;
constexpr size_t WS_YR = 640 * MiB;
constexpr size_t WS_END = 784 * MiB;
constexpr int CW_BAR = 4096;
constexpr int CW_ECNT = 16384;
constexpr int CW_EFILL = 16384 + 64 * 32;
constexpr int CW_CMAX = 65536;
constexpr int CW_MOETAB = 32768;

constexpr int RING_BYTES = 131072;
constexpr int LDSCTL_OFF = 146432, MISC_OFF = LDSCTL_OFF + 320;
constexpr int LDS_BYTES = 147456;

#define GAS __attribute__((address_space(1)))
#define LAS __attribute__((address_space(3)))
typedef unsigned short bf16;
typedef unsigned v4u __attribute__((ext_vector_type(4)));
typedef unsigned v2u __attribute__((ext_vector_type(2)));
typedef float f32x4 __attribute__((ext_vector_type(4)));
typedef short bf16x8 __attribute__((ext_vector_type(8)));
typedef short s16x4 __attribute__((ext_vector_type(4)));
#define LDS_WAIT() asm volatile("s_waitcnt lgkmcnt(0)" ::: "memory")
#define VM_WAIT() asm volatile("s_waitcnt vmcnt(0)" ::: "memory")
__device__ __forceinline__ unsigned f2bf(float f) { unsigned u = __builtin_bit_cast(unsigned, f); return (u + 0x7fffu + ((u >> 16) & 1u)) >> 16; }
__device__ __forceinline__ unsigned pk2(float lo, float hi) { return f2bf(lo) | (f2bf(hi) << 16); }
__device__ __forceinline__ unsigned pk4_fp8(float a, float b, float c, float d) { int w = __builtin_amdgcn_cvt_pk_fp8_f32(a, b, 0, false); w = __builtin_amdgcn_cvt_pk_fp8_f32(c, d, w, true); return (unsigned)w; }
__device__ __forceinline__ float bf2f(unsigned short b) { return __builtin_bit_cast(float, (unsigned)b << 16); }
__device__ __forceinline__ float bflo(unsigned w) { return __builtin_bit_cast(float, w << 16); }
__device__ __forceinline__ float bfhi(unsigned w) { return __builtin_bit_cast(float, w & 0xffff0000u); }
__device__ __forceinline__ float sigmoidf_(float x) { return __builtin_amdgcn_rcpf(1.0f + __builtin_amdgcn_exp2f(x * -1.4426950408889634f)); }
__device__ __forceinline__ float wave_sum(float v) {
#pragma unroll
    for (int o = 1; o < 64; o <<= 1) v += __shfl_xor(v, o);
    return v;
}
__device__ __forceinline__ float wave_max(float v) {
#pragma unroll
    for (int o = 1; o < 64; o <<= 1) v = fmaxf(v, __shfl_xor(v, o));
    return v;
}
#define XB_TMO      128
#define XB_XCNT(j)  (256  + 64 * (j))
#define XB_XSUB(j)  (1280 + 64 * (j))
#define XB_XGEN(j)  (2304 + 64 * (j))
#define XB_TOP      3328
#define XB_TOPGEN   3392
#define XCD_BAR_WORDS 3456
#define XB_SPIN_CAP (1u << 18)

__device__ __forceinline__ unsigned xb_ld(unsigned* p)              { return __hip_atomic_load(p, __ATOMIC_RELAXED, __HIP_MEMORY_SCOPE_AGENT); }
__device__ __forceinline__ unsigned xb_add(unsigned* p, unsigned v) { return __hip_atomic_fetch_add(p, v, __ATOMIC_RELAXED, __HIP_MEMORY_SCOPE_AGENT); }
__device__ __forceinline__ unsigned xb_xcc_id() { return (unsigned)__builtin_amdgcn_s_getreg((3 << 11) | 20) & 0xFu; }
#define XB_SPIN(cond, bar) do { unsigned _sp = 0; while (cond) { __builtin_amdgcn_s_sleep(1); \
    if ((++_sp & 255u) == 0u) { if (xb_ld(&(bar)[XB_TMO])) break; if (_sp > XB_SPIN_CAP) { atomicAdd(&(bar)[XB_TMO], 1u); break; } } } } while (0)

struct XcdBarrier {
    unsigned* bar; unsigned x;
    volatile LAS unsigned* st;
};

__device__ __forceinline__ XcdBarrier xcd_barrier_post(unsigned* bar, volatile LAS unsigned* st) {
    XcdBarrier b; b.bar = bar; b.x = xb_xcc_id(); b.st = st;
    if (threadIdx.x == 0) (void)xb_add(&bar[XB_XCNT(b.x)], 1u);
    return b;
}
__device__ __forceinline__ void xcd_barrier_complete(unsigned* bar, unsigned x, unsigned& nloc, unsigned& nx) {
    const unsigned G = gridDim.x * gridDim.y * gridDim.z;
    unsigned sum, cnt, mine, sp = 0u;
    for (;;) {
        sum = 0u; cnt = 0u; mine = 0u;
#pragma unroll
        for (unsigned j = 0; j < 16; ++j) { const unsigned c = xb_ld(&bar[XB_XCNT(j)]); sum += c; cnt += (c > 0u) ? 1u : 0u; mine = (j == x) ? c : mine; }
        if (sum == G) break;
        __builtin_amdgcn_s_sleep(1);
        if ((++sp & 255u) == 0u) { if (xb_ld(&bar[XB_TMO])) break; if (sp > XB_SPIN_CAP) { atomicAdd(&bar[XB_TMO], 1u); break; } }
    }
    nloc = mine > 0u ? mine : 1u; nx = cnt > 0u ? cnt : 1u;
}

__device__ __forceinline__ void xcd_barrier(const XcdBarrier& b) {
    asm volatile("s_waitcnt vmcnt(0)" ::: "memory");
    __syncthreads();
    if (threadIdx.x == 0) {
        unsigned* bar = b.bar;
        __builtin_amdgcn_s_waitcnt(0);
        unsigned nloc = b.st[0], nx = b.st[1];
        if (nloc == 0u) { xcd_barrier_complete(bar, b.x, nloc, nx); b.st[0] = nloc; b.st[1] = nx; }
        const unsigned old = xb_add(&bar[XB_XSUB(b.x)], 1u);
        const unsigned gen = old / nloc;
        if (old + 1u == (gen + 1u) * nloc) {
            __builtin_amdgcn_fence(__ATOMIC_RELEASE, "agent");
            asm volatile("s_waitcnt vmcnt(0)" ::: "memory");
            const unsigned og = xb_add(&bar[XB_TOP], 1u);
            const unsigned tg = og / nx;
            if (og + 1u == (tg + 1u) * nx) xb_add(&bar[XB_TOPGEN], 1u);
            else XB_SPIN(xb_ld(&bar[XB_TOPGEN]) == tg, bar);
            __builtin_amdgcn_fence(__ATOMIC_ACQUIRE, "agent");
            xb_add(&bar[XB_XGEN(b.x)], 1u);
            asm volatile("s_waitcnt vmcnt(0)" ::: "memory");
        } else {
            XB_SPIN(xb_ld(&bar[XB_XGEN(b.x)]) == gen, bar);
            __builtin_amdgcn_fence(__ATOMIC_ACQUIRE, "agent");
            asm volatile("s_waitcnt vmcnt(0)" ::: "memory");
        }
    }
    __syncthreads();
}

using pg8::Unit; using pg8::HALF; using pg8::BM;
struct EpiStoreBf16 {
    static constexpr bool PERM = true, AFTER_DRAIN = false;
    bf16* O; int ldc;
    __device__ __forceinline__ void operator()(const f32x4 (&acc)[2][2][4][2], const Unit& u, int wr, int wc, int fr, int fq) const {
        const int row0 = u.pm * BM + wr * 64 + fr, col0 = u.pn * BM + wc * 32 + 8 * fq;
#pragma unroll
        for (int ai = 0; ai < 2; ++ai)
#pragma unroll
            for (int m = 0; m < 4; ++m) { bf16* rowp = O + (size_t)(row0 + ai * HALF + m * 16) * ldc + col0;
#pragma unroll
                for (int bj = 0; bj < 2; ++bj) { const f32x4 v0 = acc[ai][bj][m][0], v1 = acc[ai][bj][m][1];
                    v4u w; w.x = pg8::cvt_pk_bf16(v0[0], v0[1]); w.y = pg8::cvt_pk_bf16(v0[2], v0[3]); w.z = pg8::cvt_pk_bf16(v1[0], v1[1]); w.w = pg8::cvt_pk_bf16(v1[2], v1[3]);
                    *(v4u*)(rowp + bj * HALF) = w; } }
    }
};
struct EpiStoreScaled {
    static constexpr bool PERM = true, AFTER_DRAIN = false;
    bf16* O; int ldc; const float* sa; const float* sw;
    __device__ __forceinline__ void operator()(const f32x4 (&acc)[2][2][4][2], const Unit& u, int wr, int wc, int fr, int fq) const {
        const int row0 = u.pm * BM + wr * 64 + fr, col0 = u.pn * BM + wc * 32 + 8 * fq;
        f32x4 cs[2][2];
#pragma unroll
        for (int bj = 0; bj < 2; ++bj)
#pragma unroll
            for (int n = 0; n < 2; ++n) cs[bj][n] = *(const f32x4*)(sw + col0 + bj * HALF + 4 * n);
#pragma unroll
        for (int ai = 0; ai < 2; ++ai)
#pragma unroll
            for (int m = 0; m < 4; ++m) { const int row = row0 + ai * HALF + m * 16; const float rsc = sa[row]; bf16* rowp = O + (size_t)row * ldc + col0;
#pragma unroll
                for (int bj = 0; bj < 2; ++bj) { const f32x4 v0 = acc[ai][bj][m][0] * cs[bj][0] * rsc, v1 = acc[ai][bj][m][1] * cs[bj][1] * rsc;
                    v4u w; w.x = pk2(v0[0], v0[1]); w.y = pk2(v0[2], v0[3]); w.z = pk2(v1[0], v1[1]); w.w = pk2(v1[2], v1[3]);
                    *(v4u*)(rowp + bj * HALF) = w; } }
    }
};
template <bool ADD> struct EpiUpGate {
    static constexpr bool PERM = true, AFTER_DRAIN = false;
    bf16* U; const bf16* G; int goff;
    __device__ __forceinline__ void operator()(const f32x4 (&acc)[2][2][4][2], const Unit& u, int wr, int wc, int fr, int fq) const {
        const int row0 = u.pm * BM + wr * 64 + fr, col0 = u.pn * BM + wc * 32 + 8 * fq;
#pragma unroll
        for (int ai = 0; ai < 2; ++ai)
#pragma unroll
            for (int m = 0; m < 4; ++m) { const size_t row = (size_t)(row0 + ai * HALF + m * 16);
#pragma unroll
                for (int bj = 0; bj < 2; ++bj) { const int col = col0 + bj * HALF;
                    const v4u gw = *(const v4u*)(G + row * PW + goff + col);
                    f32x4 v0 = acc[ai][bj][m][0], v1 = acc[ai][bj][m][1];
                    v0[0] *= sigmoidf_(bflo(gw.x)); v0[1] *= sigmoidf_(bfhi(gw.x)); v0[2] *= sigmoidf_(bflo(gw.y)); v0[3] *= sigmoidf_(bfhi(gw.y));
                    v1[0] *= sigmoidf_(bflo(gw.z)); v1[1] *= sigmoidf_(bfhi(gw.z)); v1[2] *= sigmoidf_(bflo(gw.w)); v1[3] *= sigmoidf_(bfhi(gw.w));
                    if (ADD) { const v4u uw = *(const v4u*)(U + row * DM + col);
                        v0[0] += bflo(uw.x); v0[1] += bfhi(uw.x); v0[2] += bflo(uw.y); v0[3] += bfhi(uw.y); v1[0] += bflo(uw.z); v1[1] += bfhi(uw.z); v1[2] += bflo(uw.w); v1[3] += bfhi(uw.w); }
                    v4u w; w.x = pg8::cvt_pk_bf16(v0[0], v0[1]); w.y = pg8::cvt_pk_bf16(v0[2], v0[3]); w.z = pg8::cvt_pk_bf16(v1[0], v1[1]); w.w = pg8::cvt_pk_bf16(v1[2], v1[3]);
                    *(v4u*)(U + row * DM + col) = w; } }
    }
};
struct EpiOutRes {
    static constexpr bool PERM = true, AFTER_DRAIN = false;
    const float* X; bf16* H; const float* modf;
    __device__ __forceinline__ void operator()(const f32x4 (&acc)[2][2][4][2], const Unit& u, int wr, int wc, int fr, int fq) const {
        const int row0 = u.pm * BM + wr * 64 + fr, col0 = u.pn * BM + wc * 32 + 8 * fq;
        const int b = (u.pm * BM) / SEQ; const float* gt = modf + (size_t)b * 6 * DM + 2 * DM;
        f32x4 gv[2][2];
#pragma unroll
        for (int bj = 0; bj < 2; ++bj)
#pragma unroll
            for (int n = 0; n < 2; ++n) gv[bj][n] = *(const f32x4*)(gt + col0 + bj * HALF + 4 * n) + 1.0f;
#pragma unroll
        for (int ai = 0; ai < 2; ++ai)
#pragma unroll
            for (int m = 0; m < 4; ++m) { const size_t off = (size_t)(row0 + ai * HALF + m * 16) * DM + col0;
#pragma unroll
                for (int bj = 0; bj < 2; ++bj) { const f32x4 x0 = *(const f32x4*)(X + off + bj * HALF), x1 = *(const f32x4*)(X + off + bj * HALF + 4);
                    const f32x4 v0 = x0 + gv[bj][0] * acc[ai][bj][m][0], v1 = x1 + gv[bj][1] * acc[ai][bj][m][1];
                    v4u w; w.x = pk2(v0[0], v0[1]); w.y = pk2(v0[2], v0[3]); w.z = pk2(v1[0], v1[1]); w.w = pk2(v1[2], v1[3]);
                    *(v4u*)(H + off + bj * HALF) = w; } }
    }
};
struct EpiMoe1 {
    static constexpr bool PERM = true, AFTER_DRAIN = false;
    unsigned char* ACT; const LAS float* bt;
    __device__ __forceinline__ void operator()(const f32x4 (&acc)[2][2][4][2], const Unit& u, int wr, int wc, int fr, int fq) const {
        const int e = u.pn >> 3, pnl = u.pn & 7;
        const int row0 = u.pm * BM + wr * 64 + fr, c0 = pnl * 128 + wc * 32 + 8 * fq;
        const LAS float* bg = bt + u.ix * 256 + wc * 32 + 8 * fq; const LAS float* bl = bg + 128; (void)e;
        const f32x4 bg0 = *(const LAS f32x4*)bg, bg1 = *(const LAS f32x4*)(bg + 4), bl0 = *(const LAS f32x4*)bl, bl1 = *(const LAS f32x4*)(bl + 4);
#pragma unroll
        for (int ai = 0; ai < 2; ++ai)
#pragma unroll
            for (int m = 0; m < 4; ++m) { unsigned char* rowp = ACT + (size_t)(row0 + ai * HALF + m * 16) * DE + c0;
                float o[8];
#pragma unroll
                for (int n = 0; n < 2; ++n) { const f32x4 g = acc[ai][0][m][n] + (n ? bg1 : bg0), l = acc[ai][1][m][n] + (n ? bl1 : bl0);
#pragma unroll
                    for (int i = 0; i < 4; ++i) { const float gg = fminf(g[i], 7.0f), ll = fminf(fmaxf(l[i], -7.0f), 7.0f);
                        o[n * 4 + i] = gg * sigmoidf_(1.702f * gg) * (ll + 1.0f); } }
                v2u w; w.x = pk4_fp8(o[0], o[1], o[2], o[3]); w.y = pk4_fp8(o[4], o[5], o[6], o[7]);
                *(v2u*)rowp = w; }
    }
};
struct EpiMoe2 {
    static constexpr bool PERM = true, AFTER_DRAIN = false;
    unsigned char* Y; const LAS float* bt;
    __device__ __forceinline__ void operator()(const f32x4 (&acc)[2][2][4][2], const Unit& u, int wr, int wc, int fr, int fq) const {
        const int pnl = u.pn & 3;
        const int row0 = u.pm * BM + wr * 64 + fr, col0 = pnl * BM + wc * 32 + 8 * fq;
        f32x4 bv[2][2];
#pragma unroll
        for (int bj = 0; bj < 2; ++bj)
#pragma unroll
            for (int n = 0; n < 2; ++n) bv[bj][n] = *(const LAS f32x4*)(bt + u.ix * 512 + wc * 32 + 8 * fq + bj * HALF + 4 * n);
#pragma unroll
        for (int ai = 0; ai < 2; ++ai)
#pragma unroll
            for (int m = 0; m < 4; ++m) { const int row = row0 + ai * HALF + m * 16; const float g = bt[u.ix * 512 + 256 + wr * 64 + fr + ai * HALF + m * 16] * 16.0f; unsigned char* rowp = Y + (size_t)row * DM + col0;
#pragma unroll
                for (int bj = 0; bj < 2; ++bj) { const f32x4 v0 = (acc[ai][bj][m][0] + bv[bj][0]) * g, v1 = (acc[ai][bj][m][1] + bv[bj][1]) * g;
                    v2u w; w.x = pk4_fp8(v0[0], v0[1], v0[2], v0[3]); w.y = pk4_fp8(v1[0], v1[1], v1[2], v1[3]);
                    *(v2u*)(rowp + bj * HALF) = w; } }
    }
};
constexpr int MOE_UL_OFF = 145408;
struct MoeOrder {
    const LAS int* ul; const int* rowtok;
    __device__ __forceinline__ bool next(int i, Unit& u) const { const int pm = ul[2 * i]; if (pm < 0) return false; u.pm = pm; u.pn = ul[2 * i + 1]; u.ix = i; return true; }
    __device__ __forceinline__ void a_ready(const Unit&) const {}
    __device__ __forceinline__ void done(const Unit&) const {}
};
constexpr int MOE_BT1_OFF = 135680, MOE_BT2_OFF = 131072;
template <int WHICH> __device__ __forceinline__ void moe_units_to_lds(LAS unsigned char* lds, const unsigned* tab, int nN, int sh, int G, int v, const float* bias, const float* rg) {
    LAS int* ul = (LAS int*)(lds + MOE_UL_OFF);
    __syncthreads();
    if (threadIdx.x < 16) { const int i = threadIdx.x; const int ntl = (int)tab[0]; const long L = (long)i * G + v; int pm = -1, pn = 0;
        if (L < (long)ntl * nN) { pm = (int)(L >> sh); const int e = (int)tab[64 + pm]; pn = e * nN + (int)(L & (nN - 1)); }
        ul[2 * i] = pm; ul[2 * i + 1] = pn; }
    __syncthreads();
    { float val[9]; const int t = threadIdx.x;
#pragma unroll
      for (int i = 0; i < 9; ++i) { const int pm = ul[2 * i], pn = ul[2 * i + 1]; val[i] = 0.f;
          if (pm >= 0) { if (WHICH == 1) { if (t < 256) { const int e = pn >> 3, pnl = pn & 7; val[i] = bias[(size_t)e * 2048 + (t < 128 ? 128 * pnl + t : 1024 + 128 * pnl + (t - 128))]; } }
                         else { const int e = pn >> 2, pnl = pn & 3; val[i] = t < 256 ? bias[(size_t)e * DM + 256 * pnl + t] : rg[(size_t)pm * 256 + (t - 256)]; } } }
#pragma unroll
      for (int i = 0; i < 9; ++i) { if (WHICH == 1) { if (t < 256) ((LAS float*)(lds + MOE_BT1_OFF))[i * 256 + t] = val[i]; } else if (i < 5) ((LAS float*)(lds + MOE_BT2_OFF))[i * 512 + t] = val[i]; } }
    __syncthreads();
}


struct Args { const float* in[27]; float* out; unsigned char* ws; int ph_lo, ph_hi; };
struct Ctx {
    LAS unsigned char* lds; unsigned char* ws; unsigned* ctl;
    int tid, lane, wave, vcu, G;
    const float* const* in; float* out;
};
enum { I_X = 0, I_C, I_ADAW, I_ADAB, I_N1G, I_WIN, I_PEK, I_PEV, I_CW1K, I_CW2K, I_CW1V, I_CW2V, I_CONVW, I_CONVB, I_GATEB, I_MLNG, I_WUPA, I_WUPB, I_WOUT, I_N2G, I_RW, I_RB, I_EW1, I_EB1, I_EW2, I_EB2, I_FG };

template <class DMap>
__device__ __forceinline__ void p0_transpose_item(const float* W, int K, int N, bf16* WT, const DMap& dmap, LAS float* scr, int item, int lane) {
    const int nblk = N / 32, kb = item / nblk, nb = item % nblk, k0 = 64 * kb, n0 = 32 * nb;
    float tmp[16];
#pragma unroll
    for (int hh = 0; hh < 2; ++hh) {
#pragma unroll
    for (int i = 0; i < 16; ++i) tmp[i] = W[(size_t)(k0 + 2 * (16 * hh + i) + (lane >> 5)) * N + n0 + (lane & 31)];
#pragma unroll
    for (int i = 0; i < 16; ++i) scr[(2 * (16 * hh + i) + (lane >> 5)) * 33 + (lane & 31)] = tmp[i]; }
    LDS_WAIT(); asm volatile("" ::: "memory");
    const int c = lane & 7;
#pragma unroll
    for (int j = 0; j < 4; ++j) { const int n = (lane >> 3) + 8 * j; const LAS float* s = scr + (8 * c) * 33 + n;
        v4u o; o.x = pk2(s[0 * 33], s[1 * 33]); o.y = pk2(s[2 * 33], s[3 * 33]); o.z = pk2(s[4 * 33], s[5 * 33]); o.w = pk2(s[6 * 33], s[7 * 33]);
        *(GAS v4u*)(WT + (size_t)dmap(n0 + n) * K + k0 + 8 * c) = o; }
    LDS_WAIT(); asm volatile("" ::: "memory");
}
struct DMapId { __device__ __forceinline__ int operator()(int n) const { return n; } };
struct DMapWin { __device__ __forceinline__ int operator()(int n) const {
    if (n < 1280) return n;
    if (n < 1304) return PC_NSAG + (n - 1280);
    if (n < 2328) return PC_MLQ + (n - 1304);
    if (n < 2840) return PC_MLV + (n - 2328);
    if (n < 2848) return PC_MLIF + (n - 2840);
    if (n < 3360) return PC_MLO + (n - 2848);
    return PC_MGA + (n - 3360); } };
struct DMapW1 { __device__ __forceinline__ int operator()(int n) const { return n < 1024 ? ((n >> 7) << 8) + (n & 127) : (((n - 1024) >> 7) << 8) + 128 + (n & 127); } };

constexpr int MOE_I1 = (DM / 128) * (2048 / 256), MOE_I2 = (DE / 128) * (DM / 256), MOE_ITEMS = NEXP * (MOE_I1 + MOE_I2);
struct MoeItem { const float* src; unsigned char* dst; int N; bool w1; };
__device__ __forceinline__ MoeItem moe_item(const Ctx& F, int it) {
    MoeItem m;
    if (it < NEXP * MOE_I1) { const int e = it / MOE_I1, l = it % MOE_I1, kb = l >> 3, nb = l & 7; m.w1 = true; m.N = 2048 | (nb << 16);
        m.src = F.in[I_EW1] + (size_t)e * DM * 2048 + (size_t)(128 * kb) * 2048 + 256 * nb; m.dst = F.ws + WS_W1T + (size_t)e * 2048 * DM + 128 * kb; }
    else { const int r = it - NEXP * MOE_I1, e = r / MOE_I2, l = r % MOE_I2, kb = l >> 2, nb = l & 3; m.w1 = false; m.N = DM | (nb << 16);
        m.src = F.in[I_EW2] + (size_t)e * DE * DM + (size_t)(128 * kb) * DM + 256 * nb; m.dst = F.ws + WS_W2T + (size_t)e * DM * DE + 128 * kb; }
    return m;
}
__device__ __forceinline__ void moe_load_item(const Ctx& F, int it, f32x4 (&r)[16]) {
    const MoeItem m = moe_item(F, it); const int N = m.N & 0xffff;
#pragma unroll
    for (int i = 0; i < 16; ++i) r[i] = *(const f32x4*)(m.src + (size_t)(16 * F.wave + i) * N + 4 * F.lane);
}
__device__ __forceinline__ void moe_emit_item(Ctx& F, int it, const f32x4 (&r)[16]) {
    LAS float* tile = (LAS float*)F.lds; const int wave = F.wave, lane = F.lane;
    const MoeItem m = moe_item(F, it); const int nb = m.N >> 16;
    __syncthreads();
#pragma unroll
    for (int i = 0; i < 16; ++i) *(LAS f32x4*)(tile + (16 * wave + i) * 260 + 4 * lane) = r[i] * 32.0f;
    __syncthreads();
    const int n = 32 * wave + (lane >> 1), kh = (lane & 1) * 64; const LAS float* s = tile + kh * 260 + n;
    const int ng = 256 * nb + n; const int drow = m.w1 ? DMapW1()(ng) : ng;
    unsigned char* dst = m.dst + (size_t)drow * DM + kh;
#pragma unroll
    for (int i = 0; i < 4; ++i) { v4u o;
        o.x = pk4_fp8(s[(16 * i + 0) * 260], s[(16 * i + 1) * 260], s[(16 * i + 2) * 260], s[(16 * i + 3) * 260]); o.y = pk4_fp8(s[(16 * i + 4) * 260], s[(16 * i + 5) * 260], s[(16 * i + 6) * 260], s[(16 * i + 7) * 260]);
        o.z = pk4_fp8(s[(16 * i + 8) * 260], s[(16 * i + 9) * 260], s[(16 * i + 10) * 260], s[(16 * i + 11) * 260]); o.w = pk4_fp8(s[(16 * i + 12) * 260], s[(16 * i + 13) * 260], s[(16 * i + 14) * 260], s[(16 * i + 15) * 260]);
        *(GAS v4u*)(dst + 16 * i) = o; }
}
__device__ __forceinline__ void moe_convert(Ctx& F, int first, int stride) {
    f32x4 b0[16], b1[16], b2[16];
    if (first >= MOE_ITEMS) return;
    moe_load_item(F, first, b0);
    if (first + stride < MOE_ITEMS) moe_load_item(F, first + stride, b1);
#pragma unroll 1
    for (int it = first; it < MOE_ITEMS; it += 3 * stride) {
        if (it + 2 * stride < MOE_ITEMS) moe_load_item(F, it + 2 * stride, b2);
        moe_emit_item(F, it, b0);
        if (it + stride >= MOE_ITEMS) break;
        if (it + 3 * stride < MOE_ITEMS) moe_load_item(F, it + 3 * stride, b0);
        moe_emit_item(F, it + stride, b1);
        if (it + 2 * stride >= MOE_ITEMS) break;
        if (it + 4 * stride < MOE_ITEMS) moe_load_item(F, it + 4 * stride, b1);
        moe_emit_item(F, it + 2 * stride, b2);
    }
    __syncthreads();
}
template <class DMap>
__device__ __forceinline__ void p0_transpose_item_f8(const float* W, int K, int N, unsigned char* WT, const DMap& dmap, LAS float* scr, int item, int lane) {
    const int nblk = N / 32, kb = item / nblk, nb = item % nblk, k0 = 128 * kb, n0 = 32 * nb;
    const int lr = lane >> 3, c4 = lane & 7;
    f32x4 tmp[16];
#pragma unroll
    for (int i = 0; i < 16; ++i) tmp[i] = *(const f32x4*)(W + (size_t)(k0 + 8 * i + lr) * N + n0 + 4 * c4);
    const int n = lane >> 1, kq = (lane & 1) * 32;
    unsigned char* dst = WT + (size_t)dmap(n0 + n) * K + k0 + kq;
#pragma unroll
    for (int hh = 0; hh < 2; ++hh) {
#pragma unroll
        for (int i = 0; i < 8; ++i) *(LAS f32x4*)(scr + (8 * i + lr) * 36 + 4 * c4) = tmp[8 * hh + i] * 32.0f;
        LDS_WAIT(); asm volatile("" ::: "memory");
        const LAS float* s = scr + kq * 36 + n;
#pragma unroll
        for (int i = 0; i < 2; ++i) { v4u o;
            o.x = pk4_fp8(s[(16 * i + 0) * 36], s[(16 * i + 1) * 36], s[(16 * i + 2) * 36], s[(16 * i + 3) * 36]); o.y = pk4_fp8(s[(16 * i + 4) * 36], s[(16 * i + 5) * 36], s[(16 * i + 6) * 36], s[(16 * i + 7) * 36]);
            o.z = pk4_fp8(s[(16 * i + 8) * 36], s[(16 * i + 9) * 36], s[(16 * i + 10) * 36], s[(16 * i + 11) * 36]); o.w = pk4_fp8(s[(16 * i + 12) * 36], s[(16 * i + 13) * 36], s[(16 * i + 14) * 36], s[(16 * i + 15) * 36]);
            *(GAS v4u*)(dst + 64 * hh + 16 * i) = o; }
        LDS_WAIT(); asm volatile("" ::: "memory");
    }
}
template <class DMap>
__device__ __forceinline__ void p0_colmax_item(const float* W, int N, unsigned* cmax, const DMap& dmap, int item, int lane) {
    const int nblk = N / 32, kb = item / nblk, nb = item % nblk, k0 = 64 * kb, n0 = 32 * nb;
    float tmp[32];
#pragma unroll
    for (int i = 0; i < 32; ++i) tmp[i] = W[(size_t)(k0 + 2 * i + (lane >> 5)) * N + n0 + (lane & 31)];
    float m = 0.f;
#pragma unroll
    for (int i = 0; i < 32; ++i) m = fmaxf(m, fabsf(tmp[i]));
    m = fmaxf(m, __shfl_xor(m, 32));
    if (lane < 32) atomicMax(cmax + dmap(n0 + lane), __float_as_uint(m));
}
__device__ __forceinline__ unsigned pk4_i8(float a, float b, float c, float d) {
    return (unsigned)(__float2int_rn(a) & 0xff) | ((unsigned)(__float2int_rn(b) & 0xff) << 8) | ((unsigned)(__float2int_rn(c) & 0xff) << 16) | ((unsigned)__float2int_rn(d) << 24);
}
template <class DMap>
__device__ __forceinline__ void p1_quant_item_i8(const float* W, int K, int N, unsigned char* WT, float* sw, const unsigned* cmax, const DMap& dmap, LAS float* scr, int item, int lane) {
    const int nblk = N / 32, kb = item / nblk, nb = item % nblk, k0 = 128 * kb, n0 = 32 * nb;
    const int lr = lane >> 3, c4 = lane & 7;
    f32x4 tmp[16];
#pragma unroll
    for (int i = 0; i < 16; ++i) tmp[i] = *(const f32x4*)(W + (size_t)(k0 + 8 * i + lr) * N + n0 + 4 * c4);
    f32x4 inv;
#pragma unroll
    for (int j = 0; j < 4; ++j) { const float cm = __uint_as_float(cmax[dmap(n0 + 4 * c4 + j)]); inv[j] = cm > 0.f ? 127.0f / cm : 0.f; }
    if (kb == 0 && lane < 32) { const int d = dmap(n0 + lane); sw[d] = __uint_as_float(cmax[d]) * (1.0f / 127.0f); }
    const int n = lane >> 1, kq = (lane & 1) * 32;
    unsigned char* dst = WT + (size_t)dmap(n0 + n) * K + k0 + kq;
#pragma unroll
    for (int hh = 0; hh < 2; ++hh) {
#pragma unroll
        for (int i = 0; i < 8; ++i) *(LAS f32x4*)(scr + (8 * i + lr) * 36 + 4 * c4) = tmp[8 * hh + i] * inv;
        LDS_WAIT(); asm volatile("" ::: "memory");
        const LAS float* s = scr + kq * 36 + n;
#pragma unroll
        for (int i = 0; i < 2; ++i) { v4u o;
            o.x = pk4_i8(s[(16 * i + 0) * 36], s[(16 * i + 1) * 36], s[(16 * i + 2) * 36], s[(16 * i + 3) * 36]); o.y = pk4_i8(s[(16 * i + 4) * 36], s[(16 * i + 5) * 36], s[(16 * i + 6) * 36], s[(16 * i + 7) * 36]);
            o.z = pk4_i8(s[(16 * i + 8) * 36], s[(16 * i + 9) * 36], s[(16 * i + 10) * 36], s[(16 * i + 11) * 36]); o.w = pk4_i8(s[(16 * i + 12) * 36], s[(16 * i + 13) * 36], s[(16 * i + 14) * 36], s[(16 * i + 15) * 36]);
            *(GAS v4u*)(dst + 64 * hh + 16 * i) = o; }
        LDS_WAIT(); asm volatile("" ::: "memory");
    }
}
__device__ __forceinline__ void p0_prologue(Ctx& F) {
    LAS float* scr = (LAS float*)(F.lds + F.wave * 16896);
    const int gw = F.vcu * NWAVES + F.wave, NGW = F.G * NWAVES;
    constexpr int I_IN = (DM / 64) * (INW / 32), I_UP = (512 / 64) * (DM / 32), I_OUT = (DM / 64) * (DM / 32), I_C1 = (2048 / 64) * (128 / 32), I_C2 = (128 / 64) * (64 / 32);
    constexpr int NITEMS = I_IN + 2 * I_UP + I_OUT + 2 * I_C1 + 2 * I_C2;
    for (int it = gw; it < NITEMS; it += NGW) {
        int r = it;
        if (r < I_IN) { p0_colmax_item(F.in[I_WIN], INW, F.ctl + CW_CMAX, DMapWin(), r, F.lane); continue; } r -= I_IN;
        if (r < I_UP) { p0_transpose_item(F.in[I_WUPA], 512, DM, (bf16*)(F.ws + WS_WUPA), DMapId(), scr, r, F.lane); continue; } r -= I_UP;
        if (r < I_UP) { p0_transpose_item(F.in[I_WUPB], 512, DM, (bf16*)(F.ws + WS_WUPB), DMapId(), scr, r, F.lane); continue; } r -= I_UP;
        if (r < I_OUT) { p0_transpose_item(F.in[I_WOUT], DM, DM, (bf16*)(F.ws + WS_WOUT), DMapId(), scr, r, F.lane); continue; } r -= I_OUT;
        if (r < I_C1) { p0_transpose_item(F.in[I_CW1K], 2048, 128, (bf16*)(F.ws + WS_CW1K), DMapId(), scr, r, F.lane); continue; } r -= I_C1;
        if (r < I_C1) { p0_transpose_item(F.in[I_CW1V], 2048, 128, (bf16*)(F.ws + WS_CW1V), DMapId(), scr, r, F.lane); continue; } r -= I_C1;
        if (r < I_C2) { p0_transpose_item(F.in[I_CW2K], 128, 64, (bf16*)(F.ws + WS_CW2K), DMapId(), scr, r, F.lane); continue; } r -= I_C2;
        { p0_transpose_item(F.in[I_CW2V], 128, 64, (bf16*)(F.ws + WS_CW2V), DMapId(), scr, r, F.lane); }
    }
    __syncthreads();
    {
        const int gt = F.vcu * NTHREADS + F.tid, NGT = F.G * NTHREADS;
        const float* c = F.in[I_C]; const float* aw = F.in[I_ADAW]; float* modp = (float*)(F.ws + WS_MODP);
        for (int w = gt; w < ADA_SLICES * 6144; w += NGT) {
            const int s = w / 6144, j = w % 6144; float a0 = 0.f, a1 = 0.f, a2 = 0.f, a3 = 0.f;
#pragma unroll 8
            for (int kk = 0; kk < 64; ++kk) { const int k = s * 64 + kk; const float wv = aw[(size_t)k * 6144 + j];
                const float c0 = c[k], c1 = c[DM + k], c2 = c[2 * DM + k], c3 = c[3 * DM + k];
                a0 += c0 * sigmoidf_(c0) * wv; a1 += c1 * sigmoidf_(c1) * wv; a2 += c2 * sigmoidf_(c2) * wv; a3 += c3 * sigmoidf_(c3) * wv; }
            modp[(size_t)(s * 4 + 0) * 6144 + j] = a0; modp[(size_t)(s * 4 + 1) * 6144 + j] = a1; modp[(size_t)(s * 4 + 2) * 6144 + j] = a2; modp[(size_t)(s * 4 + 3) * 6144 + j] = a3;
        }
        { const float* rw = F.in[I_RW]; bf16* rwhi = (bf16*)(F.ws + WS_RWHI); bf16* rwlo = (bf16*)(F.ws + WS_RWLO);
          for (int w = gt; w < DM * NEXP; w += NGT) { const int e = w >> 10, k = w & 1023; const float x = rw[k * NEXP + e]; const unsigned h = f2bf(x); rwhi[w] = (bf16)h; rwlo[w] = (bf16)f2bf(x - bf2f((unsigned short)h)); } }
        float* pbp = (float*)(F.ws + WS_PBP);
        for (int w = gt; w < PB_SLICES * 2 * 128; w += NGT) {
            const int s = w / 256, kv = (w >> 7) & 1, j = w & 127; const float* pe = F.in[kv ? I_PEV : I_PEK]; const float* w1 = F.in[kv ? I_CW1V : I_CW1K]; float a = 0.f;
#pragma unroll 8
            for (int ii = 0; ii < 128; ++ii) { const int i = s * 128 + ii; a += pe[i] * w1[(size_t)i * 128 + j]; }
            pbp[w] = a;
        }
    }
}

template <bool WITH_MOE>
__device__ __forceinline__ void p_final(Ctx& F, const bf16* H, const float* modf) {
    const unsigned char* Y = F.ws + WS_YR; const int* dest = (const int*)(F.ws + WS_DEST);
    const float* fg = F.in[I_FG];
    f32x4 g[4];
#pragma unroll
    for (int j = 0; j < 4; ++j) g[j] = *(const f32x4*)(fg + 4 * F.lane + 256 * j);
    for (int blk = F.vcu; blk < T / 64; blk += F.G) {
        const int b = (blk * 64) / SEQ, t0 = blk * 64 + F.wave * 8; const float* gt = modf + (size_t)b * 6 * DM + 5 * DM;
        f32x4 gg[4];
#pragma unroll
        for (int j = 0; j < 4; ++j) gg[j] = *(const f32x4*)(gt + 4 * F.lane + 256 * j) + 1.0f;
        int4 dd[8];
#pragma unroll
        for (int i = 0; i < 8; ++i) dd[i] = WITH_MOE ? *(const int4*)(dest + (t0 + i) * 4) : make_int4(0, 0, 0, 0);
#pragma unroll
        for (int i = 0; i < 8; ++i) {
            f32x4 v[4]; unsigned y[4][4]; const int t = t0 + i;
#pragma unroll
            for (int j = 0; j < 4; ++j) { const v2u hw = *(const v2u*)(H + (size_t)t * DM + 4 * F.lane + 256 * j); v[j] = (f32x4){bflo(hw.x), bfhi(hw.x), bflo(hw.y), bfhi(hw.y)}; }
            if (WITH_MOE) {
#pragma unroll
                for (int j = 0; j < 4; ++j) { y[0][j] = *(const unsigned*)(Y + (size_t)dd[i].x * DM + 4 * F.lane + 256 * j); y[1][j] = *(const unsigned*)(Y + (size_t)dd[i].y * DM + 4 * F.lane + 256 * j);
                    y[2][j] = *(const unsigned*)(Y + (size_t)dd[i].z * DM + 4 * F.lane + 256 * j); y[3][j] = *(const unsigned*)(Y + (size_t)dd[i].w * DM + 4 * F.lane + 256 * j); } }
            float ss = 0.f;
#pragma unroll
            for (int j = 0; j < 4; ++j) { f32x4 m = (f32x4){0.f, 0.f, 0.f, 0.f};
                if (WITH_MOE) {
#pragma unroll
                    for (int k = 0; k < TOPK; ++k) { const pg8::f32x2 lo = __builtin_amdgcn_cvt_pk_f32_fp8((int)y[k][j], false), hi = __builtin_amdgcn_cvt_pk_f32_fp8((int)y[k][j], true); m[0] += lo.x; m[1] += lo.y; m[2] += hi.x; m[3] += hi.y; } }
                v[j] = v[j] + gg[j] * m * 0.0625f;
                ss += (v[j][0] * v[j][0] + v[j][1] * v[j][1]) + (v[j][2] * v[j][2] + v[j][3] * v[j][3]); }
            const float rs = rsqrtf(wave_sum(ss) * (1.0f / DM) + NORM_EPS);
#pragma unroll
            for (int j = 0; j < 4; ++j) *(f32x4*)(F.out + (size_t)t * DM + 4 * F.lane + 256 * j) = v[j] * rs * g[j];
        }
    }
}

__device__ __forceinline__ f32x4 mfma16(bf16x8 a, bf16x8 b, f32x4 c) { return __builtin_amdgcn_mfma_f32_16x16x32_bf16(a, b, c, 0, 0, 0); }
typedef short v4i16_t __attribute__((ext_vector_type(4)));
__device__ __forceinline__ s16x4 lds_tr4(const LAS unsigned char* p) { return __builtin_bit_cast(s16x4, __builtin_amdgcn_ds_read_tr16_b64_v4i16((LAS v4i16_t*)p)); }
__device__ __forceinline__ bf16x8 tr_frag(const LAS unsigned char* img, int sb, int r0, int r1, int n0, int lane) {
    const int q = (lane & 15) >> 2, p = lane & 3;
    const s16x4 lo = lds_tr4(img + (r0 + q) * sb + (n0 + 4 * p) * 2), hi = lds_tr4(img + (r1 + q) * sb + (n0 + 4 * p) * 2);
    return (bf16x8){lo[0], lo[1], lo[2], lo[3], hi[0], hi[1], hi[2], hi[3]};
}
__device__ __forceinline__ bf16x8 lds_row8(const LAS unsigned char* img, int sb, int row, int col) { return *(const LAS bf16x8*)(img + row * sb + col * 2); }
__device__ __forceinline__ bf16x8 pack8(const f32x4 a, const f32x4 b) {
    v4u w; w.x = pg8::cvt_pk_bf16(a[0], a[1]); w.y = pg8::cvt_pk_bf16(a[2], a[3]); w.z = pg8::cvt_pk_bf16(b[0], b[1]); w.w = pg8::cvt_pk_bf16(b[2], b[3]);
    return __builtin_bit_cast(bf16x8, w);
}
__device__ __forceinline__ float grp_max(float v) { v = fmaxf(v, __shfl_xor(v, 16)); return fmaxf(v, __shfl_xor(v, 32)); }
__device__ __forceinline__ float grp_sum(float v) { v += __shfl_xor(v, 16); return v + __shfl_xor(v, 32); }
constexpr float NEG_BIG = -1.0e30f;
constexpr float LOG2E = 1.4426950408889634f;
constexpr int KV_SB = 144;
constexpr int W128_SB = 272;

__device__ __forceinline__ float max3f(float a, float b, float c) { return __builtin_fmaxf(__builtin_fmaxf(a, b), c); }
template <int MODE, bool EDGE>
__device__ __forceinline__ void nsa_tile(const LAS unsigned char* Kb, const LAS unsigned char* Vb, int j, int qb, int lane, int gq, int th, const bf16x8 (&qf)[2][2], const unsigned long long (&selm)[2],
                                         f32x4 (&ot)[2][4], float (&lsum)[2], float (&mrun)[2]) {
    f32x4 s[2][4];
#pragma unroll
    for (int kb = 0; kb < 4; ++kb) { const bf16x8 k0 = lds_row8(Kb, KV_SB, 16 * kb + (lane & 15), 8 * gq), k1 = lds_row8(Kb, KV_SB, 16 * kb + (lane & 15), 32 + 8 * gq);
#pragma unroll
        for (int qi = 0; qi < 2; ++qi) { f32x4 a = (f32x4){0.f, 0.f, 0.f, 0.f}; a = mfma16(k0, qf[qi][0], a); a = mfma16(k1, qf[qi][1], a); s[qi][kb] = a; } }
#pragma unroll
    for (int qi = 0; qi < 2; ++qi) {
        bool rowok = true; if (MODE == 0) rowok = (selm[qi] >> j) & 1ull;
        if (EDGE) { const int i = th * 32 + qi * 16 + (lane & 15);
#pragma unroll
            for (int kb = 0; kb < 4; ++kb)
#pragma unroll
                for (int r = 0; r < 4; ++r) { const int kvl = 16 * kb + 4 * gq + r; bool ok;
                    if (MODE == 0) ok = kvl <= i; else { const int rel = (qb - j) * 64 + i - kvl; ok = rel >= 0 && rel < 512; }
                    s[qi][kb][r] = ok ? s[qi][kb][r] : NEG_BIG; } }
        float mx = max3f(max3f(s[qi][0][0], s[qi][0][1], s[qi][0][2]), max3f(s[qi][0][3], s[qi][1][0], s[qi][1][1]), max3f(s[qi][1][2], s[qi][1][3], s[qi][2][0]));
        mx = max3f(mx, max3f(s[qi][2][1], s[qi][2][2], s[qi][2][3]), max3f(s[qi][3][0], s[qi][3][1], max3f(s[qi][3][2], s[qi][3][3], mx)));
        mx = rowok ? mx * (0.125f * LOG2E) : NEG_BIG;
        mx = grp_max(mx);
        const float mnew = fmaxf(mrun[qi], mx);
        if (__any(mnew > mrun[qi])) { const float alpha = __builtin_amdgcn_exp2f(mrun[qi] - mnew); lsum[qi] *= alpha;
#pragma unroll
            for (int db = 0; db < 4; ++db) ot[qi][db] *= alpha; }
        mrun[qi] = mnew;
        const float nb = rowok ? -mnew : -INFINITY;
        float ps = 0.f;
#pragma unroll
        for (int kb = 0; kb < 4; ++kb)
#pragma unroll
            for (int r = 0; r < 4; ++r) { const float p = __builtin_amdgcn_exp2f(fmaf(s[qi][kb][r], 0.125f * LOG2E, nb)); s[qi][kb][r] = p; ps += p; }
        lsum[qi] += ps;
    }
#pragma unroll
    for (int st = 0; st < 2; ++st) {
        const bf16x8 p0 = pack8(s[0][2 * st], s[0][2 * st + 1]), p1 = pack8(s[1][2 * st], s[1][2 * st + 1]);
#pragma unroll
        for (int db = 0; db < 4; ++db) { const bf16x8 vf = tr_frag(Vb, KV_SB, 32 * st + 4 * gq, 32 * st + 16 + 4 * gq, 16 * db, lane);
            ot[0][db] = mfma16(vf, p0, ot[0][db]); ot[1][db] = mfma16(vf, p1, ot[1][db]); }
    }
}
template <int MODE>
__device__ __forceinline__ void nsa_pass(Ctx& F, const bf16* proj, int b, int g, int qb, int kcol, int vcol, const bf16x8 (&qf)[2][2], const unsigned long long (&selm)[2],
                                         f32x4 (&ot)[2][4], float (&lsum)[2]) {
    LAS unsigned char* Kt = F.lds; LAS unsigned char* Vt = F.lds + 2 * 64 * KV_SB;
    const int lane = F.lane, gq = lane >> 4, th = F.wave >> 2;
    const int ntile = MODE == 0 ? qb + 1 : (qb < 8 ? qb + 1 : 9);
    const int lrow = F.tid >> 3, lch = F.tid & 7;
    const size_t rbase = (size_t)b * SEQ;
    float mrun[2] = {NEG_BIG, NEG_BIG};
#pragma unroll
    for (int qi = 0; qi < 2; ++qi) { lsum[qi] = 0.f;
#pragma unroll
        for (int db = 0; db < 4; ++db) ot[qi][db] = (f32x4){0.f, 0.f, 0.f, 0.f}; }
    auto tile_of = [&](int it) { return MODE == 0 ? it : qb - it; };
    v4u kreg, vreg;
    { const int j = tile_of(0); const bf16* src = proj + (rbase + (size_t)j * 64 + lrow) * PW + lch * 8; kreg = *(const v4u*)(src + kcol); vreg = *(const v4u*)(src + vcol); }
    __syncthreads();
#pragma unroll 1
    for (int it = 0; it < ntile; ++it) {
        const int buf = it & 1, j = tile_of(it);
        *(LAS v4u*)(Kt + buf * 64 * KV_SB + lrow * KV_SB + lch * 16) = kreg; *(LAS v4u*)(Vt + buf * 64 * KV_SB + lrow * KV_SB + lch * 16) = vreg;
        __syncthreads();
        if (it + 1 < ntile) { const int jn = tile_of(it + 1); const bf16* src = proj + (rbase + (size_t)jn * 64 + lrow) * PW + lch * 8; kreg = *(const v4u*)(src + kcol); vreg = *(const v4u*)(src + vcol); }
        const LAS unsigned char* Kb = Kt + buf * 64 * KV_SB; const LAS unsigned char* Vb = Vt + buf * 64 * KV_SB;
        const bool edge = MODE == 0 ? (j == qb) : (j == qb || j == qb - 8);
        if (edge) nsa_tile<MODE, true>(Kb, Vb, j, qb, lane, gq, th, qf, selm, ot, lsum, mrun);
        else      nsa_tile<MODE, false>(Kb, Vb, j, qb, lane, gq, th, qf, selm, ot, lsum, mrun);
    }
}

__device__ __forceinline__ void nsa_selwin_unit(Ctx& F, int b, int g, int qb) {
    const bf16* proj = (const bf16*)(F.ws + WS_PROJ); const bf16* ocmp = (const bf16*)(F.ws + WS_OCMP); bf16* onsa = (bf16*)(F.ws + WS_ONSA);
    const unsigned long long* selmask = (const unsigned long long*)(F.ws + WS_SELM);
    const int lane = F.lane, gq = lane >> 4, hr = F.wave & 3, th = F.wave >> 2, head = g * 4 + hr;
    bf16x8 qf[2][2]; unsigned long long selm[2]; size_t trow[2];
#pragma unroll
    for (int qi = 0; qi < 2; ++qi) { const int t = qb * 64 + th * 32 + qi * 16 + (lane & 15); trow[qi] = (size_t)b * SEQ + t;
        selm[qi] = selmask[(size_t)(b * 2 + g) * SEQ + t];
#pragma unroll
        for (int st = 0; st < 2; ++st) qf[qi][st] = *(const bf16x8*)(proj + trow[qi] * PW + PC_Q + head * 64 + 32 * st + 8 * gq); }
    f32x4 ot[2][4]; float lsum[2];
    nsa_pass<0>(F, proj, b, g, qb, PC_KV + 2 * 128 + g * 64, PC_KV + 3 * 128 + g * 64, qf, selm, ot, lsum);
#pragma unroll
    for (int qi = 0; qi < 2; ++qi) { const float gate = sigmoidf_(bf2f(proj[trow[qi] * PW + PC_NSAG + 8 + head])) / grp_sum(lsum[qi]);
#pragma unroll
        for (int db = 0; db < 4; ++db) { const size_t o = trow[qi] * 512 + head * 64 + 16 * db + 4 * gq; const v2u c = *(const v2u*)(ocmp + o);
            f32x4 v = ot[qi][db] * gate; v[0] += bflo(c.x); v[1] += bfhi(c.x); v[2] += bflo(c.y); v[3] += bfhi(c.y);
            v2u w; w.x = pg8::cvt_pk_bf16(v[0], v[1]); w.y = pg8::cvt_pk_bf16(v[2], v[3]); *(v2u*)(onsa + o) = w; } }
    nsa_pass<1>(F, proj, b, g, qb, PC_KV + 4 * 128 + g * 64, PC_KV + 5 * 128 + g * 64, qf, selm, ot, lsum);
#pragma unroll
    for (int qi = 0; qi < 2; ++qi) { const float gate = sigmoidf_(bf2f(proj[trow[qi] * PW + PC_NSAG + 16 + head])) / grp_sum(lsum[qi]);
#pragma unroll
        for (int db = 0; db < 4; ++db) { const size_t o = trow[qi] * 512 + head * 64 + 16 * db + 4 * gq; const v2u c = *(const v2u*)(onsa + o);
            f32x4 v = ot[qi][db] * gate; v[0] += bflo(c.x); v[1] += bfhi(c.x); v[2] += bflo(c.y); v[3] += bfhi(c.y);
            v2u w; w.x = pg8::cvt_pk_bf16(v[0], v[1]); w.y = pg8::cvt_pk_bf16(v[2], v[3]); *(v2u*)(onsa + o) = w; } }
}

__device__ __forceinline__ void p1_norm1(Ctx& F) {
    const float* modp = (const float*)(F.ws + WS_MODP); const float* adab = F.in[I_ADAB]; float* modfw = (float*)(F.ws + WS_MODF);
    { const int gt = F.vcu * NTHREADS + F.tid, NGT = F.G * NTHREADS;
      for (int w = gt; w < 4 * 6144; w += NGT) { const int b = w / 6144, j = w % 6144; float a = adab[j];
#pragma unroll
          for (int s = 0; s < ADA_SLICES; ++s) a += modp[(size_t)(s * 4 + b) * 6144 + j];
          modfw[w] = a; } }
    { LAS float* scr = (LAS float*)(F.lds + 16384 + F.wave * 9216); const int gw = F.vcu * NWAVES + F.wave, NGW = F.G * NWAVES;
      for (int it = gw; it < (DM / 128) * (INW / 32); it += NGW) p1_quant_item_i8(F.in[I_WIN], DM, INW, F.ws + WS_WIN, (float*)(F.ws + WS_SW), F.ctl + CW_CMAX, DMapWin(), scr, it, F.lane); }
    LAS float* shs = (LAS float*)F.lds; LAS float* scs = shs + DM;
    const float* x = F.in[I_X]; const float* g1 = F.in[I_N1G]; unsigned char* A1 = F.ws + WS_A1; float* sa = (float*)(F.ws + WS_SA);
    int curb = -1;
    for (int blk = F.vcu; blk < T / 64; blk += F.G) {
        const int b = (blk * 64) / SEQ;
        if (b != curb) { __syncthreads();
            { float pa[4][ADA_SLICES];
#pragma unroll
              for (int q = 0; q < 4; ++q)
#pragma unroll
                  for (int s = 0; s < ADA_SLICES; ++s) pa[q][s] = modp[(size_t)(s * 4 + b) * 6144 + F.tid + q * NTHREADS];
#pragma unroll
              for (int q = 0; q < 4; ++q) { const int j = F.tid + q * NTHREADS; float a = adab[j];
#pragma unroll
                  for (int s = 0; s < ADA_SLICES; ++s) a += pa[q][s];
                  if (j < DM) shs[j] = a; else scs[j - DM] = (1.0f + a) * g1[j - DM]; } }
            __syncthreads(); curb = b; }
        { f32x4 v[8][4];
#pragma unroll
          for (int i = 0; i < 8; ++i)
#pragma unroll
              for (int j = 0; j < 4; ++j) v[i][j] = *(const f32x4*)(x + (size_t)(blk * 64 + F.wave * 8 + i) * DM + 4 * F.lane + 256 * j);
#pragma unroll
          for (int i = 0; i < 8; ++i) { const int t = blk * 64 + F.wave * 8 + i; float ss = 0.f;
#pragma unroll
              for (int j = 0; j < 4; ++j) ss += (v[i][j][0] * v[i][j][0] + v[i][j][1] * v[i][j][1]) + (v[i][j][2] * v[i][j][2] + v[i][j][3] * v[i][j][3]);
              const float rs = rsqrtf(wave_sum(ss) * (1.0f / DM) + NORM_EPS);
              float am = 0.f;
#pragma unroll
              for (int j = 0; j < 4; ++j) { const f32x4 sc = *(const LAS f32x4*)(scs + 4 * F.lane + 256 * j), sh = *(const LAS f32x4*)(shs + 4 * F.lane + 256 * j);
                  v[i][j] = v[i][j] * rs * sc + sh; am = fmaxf(am, fmaxf(fmaxf(fabsf(v[i][j][0]), fabsf(v[i][j][1])), fmaxf(fabsf(v[i][j][2]), fabsf(v[i][j][3])))); }
              am = wave_max(am); const float inv = am > 0.f ? 127.0f / am : 0.f;
              if (F.lane == 0) sa[t] = am * (1.0f / 127.0f);
#pragma unroll
              for (int j = 0; j < 4; ++j) *(unsigned*)(A1 + (size_t)t * DM + 4 * F.lane + 256 * j) = pk4_i8(v[i][j][0] * inv, v[i][j][1] * inv, v[i][j][2] * inv, v[i][j][3] * inv); } }
    }
    __syncthreads();
}

constexpr int RA_SB = 1040;
__device__ __forceinline__ void p8_norm2_router(Ctx& F, const bf16* H, const float* modf) {
    LAS unsigned char* Ahi = F.lds; LAS unsigned char* Alo = F.lds + 64 * RA_SB; LAS float* lg = (LAS float*)(F.lds + 2 * 64 * RA_SB);
    LAS int* hist = (LAS int*)(lg + 64 * 33);
    const float* rb = F.in[I_RB]; const float* g2 = F.in[I_N2G];
    const bf16* rwhi = (const bf16*)(F.ws + WS_RWHI); const bf16* rwlo = (const bf16*)(F.ws + WS_RWLO);
    unsigned char* N2 = F.ws + WS_A1; int* topi = (int*)(F.ws + WS_TOPI); float* gate = (float*)(F.ws + WS_GATE);
    const int lane = F.lane, gq = lane >> 4, w = F.wave;
    if (F.tid < 32) hist[F.tid] = 0;
    f32x4 gv[4];
#pragma unroll
    for (int j = 0; j < 4; ++j) gv[j] = *(const f32x4*)(g2 + 4 * lane + 256 * j);
    for (int blk = F.vcu; blk < T / 64; blk += F.G) {
        const int b = (blk * 64) / SEQ; const float* sh2 = modf + (size_t)b * 6 * DM + 3 * DM; const float* sc2 = sh2 + DM;
        f32x4 scv[4], shv[4];
#pragma unroll
        for (int j = 0; j < 4; ++j) { scv[j] = (*(const f32x4*)(sc2 + 4 * lane + 256 * j) + 1.0f) * gv[j]; shv[j] = *(const f32x4*)(sh2 + 4 * lane + 256 * j); }
        f32x4 v[8][4];
#pragma unroll
        for (int i = 0; i < 8; ++i) { const int t = blk * 64 + w * 8 + i;
#pragma unroll
            for (int j = 0; j < 4; ++j) { const v2u hw = *(const v2u*)(H + (size_t)t * DM + 4 * lane + 256 * j); v[i][j] = (f32x4){bflo(hw.x), bfhi(hw.x), bflo(hw.y), bfhi(hw.y)}; } }
#pragma unroll
        for (int i = 0; i < 8; ++i) { const int t = blk * 64 + w * 8 + i; float ss = 0.f;
#pragma unroll
            for (int j = 0; j < 4; ++j) ss += (v[i][j][0] * v[i][j][0] + v[i][j][1] * v[i][j][1]) + (v[i][j][2] * v[i][j][2] + v[i][j][3] * v[i][j][3]);
            const float rs = rsqrtf(wave_sum(ss) * (1.0f / DM) + NORM_EPS);
#pragma unroll
            for (int j = 0; j < 4; ++j) { v[i][j] = v[i][j] * rs * scv[j] + shv[j];
                *(unsigned*)(N2 + (size_t)t * DM + 4 * lane + 256 * j) = pk4_fp8(v[i][j][0], v[i][j][1], v[i][j][2], v[i][j][3]); } }
        const int tbk = w & 3, eb = w >> 2; f32x4 acc = (f32x4){0.f, 0.f, 0.f, 0.f};
#pragma unroll
        for (int kh = 0; kh < 2; ++kh) {
            __syncthreads();
#pragma unroll
            for (int i = 0; i < 8; ++i)
#pragma unroll
                for (int jj = 0; jj < 2; ++jj) { const f32x4 x = v[i][2 * kh + jj]; const unsigned h0 = pk2(x[0], x[1]), h1 = pk2(x[2], x[3]);
                    const unsigned l0 = pk2(x[0] - bflo(h0), x[1] - bfhi(h0)), l1 = pk2(x[2] - bflo(h1), x[3] - bfhi(h1));
                    const int off = (w * 8 + i) * RA_SB + (4 * lane + 256 * jj) * 2;
                    *(LAS v2u*)(Ahi + off) = (v2u){h0, h1}; *(LAS v2u*)(Alo + off) = (v2u){l0, l1}; }
            __syncthreads();
#pragma unroll 4
            for (int s = 0; s < 16; ++s) { const size_t bo = (size_t)(16 * eb + (lane & 15)) * DM + 512 * kh + 32 * s + 8 * gq;
                const bf16x8 bh = *(const bf16x8*)(rwhi + bo), bl = *(const bf16x8*)(rwlo + bo);
                const bf16x8 ah = lds_row8(Ahi, RA_SB, 16 * tbk + (lane & 15), 32 * s + 8 * gq), al = lds_row8(Alo, RA_SB, 16 * tbk + (lane & 15), 32 * s + 8 * gq);
                acc = mfma16(ah, bh, acc); acc = mfma16(al, bh, acc); acc = mfma16(ah, bl, acc); }
        }
        { const int e = 16 * eb + (lane & 15); const float rbe = rb[e];
#pragma unroll
          for (int r = 0; r < 4; ++r) lg[(16 * tbk + 4 * gq + r) * 33 + e] = acc[r] + rbe; }
        __syncthreads();
        if (F.tid < 64) { const int t = blk * 64 + F.tid; float lv[32];
#pragma unroll
            for (int e = 0; e < 32; ++e) lv[e] = lg[F.tid * 33 + e];
            int si[4]; float sv[4];
#pragma unroll
            for (int k = 0; k < 4; ++k) { float m = -3.0e38f; int mi = 0;
#pragma unroll
                for (int e = 0; e < 32; ++e) { const bool gt = lv[e] > m; m = gt ? lv[e] : m; mi = gt ? e : mi; }
#pragma unroll
                for (int e = 0; e < 32; ++e) lv[e] = (e == mi) ? -3.0e38f : lv[e];
                si[k] = mi; sv[k] = m; }
            const float e1 = __expf(sv[1] - sv[0]), e2 = __expf(sv[2] - sv[0]), e3 = __expf(sv[3] - sv[0]); const float inv = 1.0f / (1.0f + e1 + e2 + e3);
            *(int4*)(topi + t * 4) = make_int4(si[0], si[1], si[2], si[3]); *(f32x4*)(gate + t * 4) = (f32x4){inv, e1 * inv, e2 * inv, e3 * inv};
#pragma unroll
            for (int k = 0; k < 4; ++k) __hip_atomic_fetch_add(&hist[si[k]], 1, __ATOMIC_RELAXED, __HIP_MEMORY_SCOPE_WORKGROUP); }
    }
    __syncthreads();
    if (F.tid < 32) { const int h = hist[F.tid]; if (h) __hip_atomic_fetch_add(F.ctl + CW_ECNT + 64 * F.tid, (unsigned)h, __ATOMIC_RELAXED, __HIP_MEMORY_SCOPE_AGENT); }
    __syncthreads();
}

__device__ __forceinline__ void p9_permute(Ctx& F) {
    LAS int* sm = (LAS int*)F.lds; LAS int* cnt = sm, *pstart = sm + 32, *lhist = sm + 64, *lbase = sm + 96, *dl = sm + 128;
    if (F.tid < 32) cnt[F.tid] = (int)__hip_atomic_load(F.ctl + CW_ECNT + 64 * F.tid, __ATOMIC_RELAXED, __HIP_MEMORY_SCOPE_AGENT);
    __syncthreads();
    if (F.tid == 0) { int run = 0; unsigned* tab = F.ctl + CW_MOETAB; const bool w0 = (blockIdx.x == 0);
        for (int e = 0; e < NEXP; ++e) { pstart[e] = run; const int nt = (cnt[e] + MOE_ROWS - 1) / MOE_ROWS;
            if (w0) for (int i = 0; i < nt; ++i) tab[64 + run / MOE_ROWS + i] = (unsigned)e;
            run += nt * MOE_ROWS; }
        if (w0) tab[0] = (unsigned)(run / MOE_ROWS); }
    __syncthreads();
    int* rowt = (int*)(F.ws + WS_ROWT);
    for (int e = F.vcu; e < NEXP; e += F.G) { const int c = cnt[e], pe = (c + MOE_ROWS - 1) / MOE_ROWS * MOE_ROWS; for (int r = c + F.tid; r < pe; r += NTHREADS) rowt[pstart[e] + r] = 0; }
    const int* topi = (const int*)(F.ws + WS_TOPI); const float* gate = (const float*)(F.ws + WS_GATE); int* dest = (int*)(F.ws + WS_DEST); float* rowg = (float*)(F.ws + WS_ROWG);
    for (int blk = F.vcu; blk < T / 64; blk += F.G) {
        if (F.tid < 32) lhist[F.tid] = 0;
        __syncthreads();
        int e = 0, rank = 0; const int a = blk * 256 + F.tid;
        if (F.tid < 256) { e = topi[a]; rank = __hip_atomic_fetch_add(&lhist[e], 1, __ATOMIC_RELAXED, __HIP_MEMORY_SCOPE_WORKGROUP); }
        __syncthreads();
        if (F.tid < 32) { const int h = lhist[F.tid]; lbase[F.tid] = pstart[F.tid] + (h ? (int)__hip_atomic_fetch_add(F.ctl + CW_EFILL + 64 * F.tid, (unsigned)h, __ATOMIC_RELAXED, __HIP_MEMORY_SCOPE_AGENT) : 0); }
        __syncthreads();
        if (F.tid < 256) { const int d = lbase[e] + rank; dest[a] = d; rowg[d] = gate[a]; rowt[d] = a >> 2; }
        __syncthreads();
        __syncthreads();
    }
}

__device__ __forceinline__ float gelu_tanh(float x) { const float u = 0.7978845608028654f * (x + 0.044715f * x * x * x); const float e = __builtin_amdgcn_exp2f(u * 2.8853900817779268f); const float th = 1.0f - 2.0f * __builtin_amdgcn_rcpf(e + 1.0f); return 0.5f * x * (1.0f + th); }
__device__ __forceinline__ void nsa_compress_unit(Ctx& F, int unit) {
    const int nt = unit & 15, kv = (unit >> 4) & 1, bg = unit >> 5, b = bg >> 1, g = bg & 1, n0 = nt * 16;
    const bf16* proj = (const bf16*)(F.ws + WS_PROJ);
    const bf16* w1t = (const bf16*)(F.ws + (kv ? WS_CW1V : WS_CW1K)); const bf16* w2t = (const bf16*)(F.ws + (kv ? WS_CW2V : WS_CW2K));
    bf16* outp = (bf16*)(F.ws + (kv ? WS_VC : WS_KC)) + (size_t)bg * 256 * 64;
    const float* pbp = (const float*)(F.ws + WS_PBP);
    LAS float* part = (LAS float*)F.lds;
    LAS unsigned char* Hs = F.lds + 65536;
    const int lane = F.lane, gq = lane >> 4, w = F.wave;
    const int col = PC_KV + kv * 128 + g * 64;
    int nrow = n0 + (lane & 15); if (nrow > 254) nrow = 254;
    const bf16* arow = proj + ((size_t)b * SEQ + 16 * nrow + 4 * w) * PW + col + 8 * gq;
    const bf16* brow = w1t + (size_t)(lane & 15) * 2048 + 256 * w + 8 * gq;
    f32x4 acc[8];
#pragma unroll
    for (int cb = 0; cb < 8; ++cb) acc[cb] = (f32x4){0.f, 0.f, 0.f, 0.f};
#pragma unroll
    for (int h2 = 0; h2 < 2; ++h2) {
        bf16x8 af[4], bfr[4][8];
#pragma unroll
        for (int s4 = 0; s4 < 4; ++s4) { const int s = 4 * h2 + s4; af[s4] = *(const bf16x8*)(arow + (size_t)(s >> 1) * PW + (s & 1) * 32);
#pragma unroll
            for (int cb = 0; cb < 8; ++cb) bfr[s4][cb] = *(const bf16x8*)(brow + (size_t)(16 * cb) * 2048 + 32 * s); }
#pragma unroll
        for (int s4 = 0; s4 < 4; ++s4)
#pragma unroll
            for (int cb = 0; cb < 8; ++cb) acc[cb] = mfma16(af[s4], bfr[s4][cb], acc[cb]);
    }
    __syncthreads();
#pragma unroll
    for (int cb = 0; cb < 8; ++cb)
#pragma unroll
        for (int r = 0; r < 4; ++r) part[(w * 16 + 4 * gq + r) * 128 + 16 * cb + (lane & 15)] = acc[cb][r];
    __syncthreads();
    { const int j = F.tid & 127, r0 = F.tid >> 7; float pb = 0.f;
#pragma unroll
      for (int s = 0; s < PB_SLICES; ++s) pb += pbp[(s * 2 + kv) * 128 + j];
#pragma unroll
      for (int q = 0; q < 4; ++q) { const int row = r0 + 4 * q; float a = pb;
#pragma unroll
          for (int ww = 0; ww < 8; ++ww) a += part[(ww * 16 + row) * 128 + j];
          *(LAS unsigned short*)(Hs + row * W128_SB + j * 2) = (unsigned short)f2bf(gelu_tanh(a)); } }
    __syncthreads();
    if (w < 4) {
        f32x4 o = (f32x4){0.f, 0.f, 0.f, 0.f};
#pragma unroll
        for (int s = 0; s < 4; ++s) { const bf16x8 a = lds_row8(Hs, W128_SB, lane & 15, 32 * s + 8 * gq); const bf16x8 bb = *(const bf16x8*)(w2t + (size_t)(16 * w + (lane & 15)) * 128 + 32 * s + 8 * gq); o = mfma16(a, bb, o); }
#pragma unroll
        for (int r = 0; r < 4; ++r) { const int n = n0 + 4 * gq + r; outp[(size_t)n * 64 + 16 * w + (lane & 15)] = (unsigned short)(n < 255 ? f2bf(o[r]) : 0u); }
    }
}

__device__ __forceinline__ void nsa_cmp_unit(Ctx& F, int bg, int tb) {
    const int b = bg >> 1, g = bg & 1;
    const bf16* proj = (const bf16*)(F.ws + WS_PROJ); bf16* ocmp = (bf16*)(F.ws + WS_OCMP);
    const bf16* kc = (const bf16*)(F.ws + WS_KC) + (size_t)bg * 256 * 64; const bf16* vc = (const bf16*)(F.ws + WS_VC) + (size_t)bg * 256 * 64;
    unsigned long long* selmask = (unsigned long long*)(F.ws + WS_SELM);
    LAS unsigned char* Kt = F.lds; LAS unsigned char* Vt = F.lds + 256 * KV_SB; LAS float* IMP = (LAS float*)(F.lds + 2 * 256 * KV_SB);
    const int lane = F.lane, gq = lane >> 4, w = F.wave, tg = w >> 2, hp = w & 3;
    const int nvmax = 4 * tb + 3;
    const int nkb = (nvmax + 15) >> 4;
    __syncthreads();
    for (int i = F.tid; i < 256 * 8; i += NTHREADS) { const int row = i >> 3, ch = i & 7;
        if (row < ((nkb + 1) & ~1) * 16) {        *(LAS v4u*)(Kt + row * KV_SB + ch * 16) = *(const v4u*)(kc + row * 64 + ch * 8); *(LAS v4u*)(Vt + row * KV_SB + ch * 16) = *(const v4u*)(vc + row * 64 + ch * 8); } }
    __syncthreads();
    LAS float* IMPW = IMP + hp * 64 * 64;
#pragma unroll 1
    for (int qi = 0; qi < 2; ++qi) {
        const int tl = tg * 32 + qi * 16 + (lane & 15), t = tb * 64 + tl; const size_t trow = (size_t)b * SEQ + t;
        const int nv = ((t + 1) >> 4) - 1;
        float imp[16], carry[16];
#pragma unroll
        for (int kb = 0; kb < 16; ++kb) { imp[kb] = 0.f; carry[kb] = 0.f; }
        {
            const int head = g * 4 + hp;
            const bf16x8 q0 = *(const bf16x8*)(proj + trow * PW + PC_Q + head * 64 + 8 * gq), q1 = *(const bf16x8*)(proj + trow * PW + PC_Q + head * 64 + 32 + 8 * gq);
            float ml = NEG_BIG, ll = 0.f;
#pragma unroll 2
            for (int kb = 0; kb < nkb; ++kb) { f32x4 a = (f32x4){0.f, 0.f, 0.f, 0.f};
                a = mfma16(lds_row8(Kt, KV_SB, 16 * kb + (lane & 15), 8 * gq), q0, a); a = mfma16(lds_row8(Kt, KV_SB, 16 * kb + (lane & 15), 32 + 8 * gq), q1, a);
                float v[4], tm = NEG_BIG;
#pragma unroll
                for (int r = 0; r < 4; ++r) { const int n = 16 * kb + 4 * gq + r; v[r] = (n < nv) ? a[r] * (0.125f * LOG2E) : NEG_BIG; tm = fmaxf(tm, v[r]); }
                const float mn = fmaxf(ml, tm); float ps = 0.f;
#pragma unroll
                for (int r = 0; r < 4; ++r) { const int n = 16 * kb + 4 * gq + r; ps += (n < nv) ? __builtin_amdgcn_exp2f(v[r] - mn) : 0.f; }
                ll = ll * __builtin_amdgcn_exp2f(ml - mn) + ps; ml = mn; }
            const float mx = grp_max(ml);
            const float ps = grp_sum(ll * __builtin_amdgcn_exp2f(ml - mx));
            const float inv = ps > 0.f ? 1.0f / ps : 0.f;
            f32x4 o[4];
#pragma unroll
            for (int db = 0; db < 4; ++db) o[db] = (f32x4){0.f, 0.f, 0.f, 0.f};
#pragma unroll
            for (int st = 0; st < 8; ++st) if (2 * st < nkb) {
                f32x4 pp[2];
#pragma unroll
                for (int k2 = 0; k2 < 2; ++k2) { const int kb = 2 * st + k2; f32x4 a = (f32x4){0.f, 0.f, 0.f, 0.f};
                    a = mfma16(lds_row8(Kt, KV_SB, 16 * kb + (lane & 15), 8 * gq), q0, a); a = mfma16(lds_row8(Kt, KV_SB, 16 * kb + (lane & 15), 32 + 8 * gq), q1, a);
#pragma unroll
                    for (int r = 0; r < 4; ++r) { const int n = 16 * kb + 4 * gq + r; a[r] = (n < nv) ? __builtin_amdgcn_exp2f(a[r] * (0.125f * LOG2E) - mx) * inv : 0.f; }
                    pp[k2] = a; imp[kb] += (a[0] + a[1]) + (a[2] + 0.5f * a[3]); carry[kb] += 0.5f * a[3]; }
                const bf16x8 pf = pack8(pp[0], pp[1]);
#pragma unroll
                for (int db = 0; db < 4; ++db) o[db] = mfma16(tr_frag(Vt, KV_SB, 32 * st + 4 * gq, 32 * st + 16 + 4 * gq, 16 * db, lane), pf, o[db]);
                asm volatile("" ::: "memory"); }
            const float gate = sigmoidf_(bf2f(proj[trow * PW + PC_NSAG + head]));
#pragma unroll
            for (int db = 0; db < 4; ++db) { const f32x4 v = o[db] * gate; v2u wv; wv.x = pg8::cvt_pk_bf16(v[0], v[1]); wv.y = pg8::cvt_pk_bf16(v[2], v[3]);
                *(v2u*)(ocmp + trow * 512 + head * 64 + 16 * db + 4 * gq) = wv; }
        }
#pragma unroll
        for (int kb = 0; kb < 16; ++kb) { const float c1 = __shfl(carry[kb], (lane + 48) & 63); const float c0 = kb > 0 ? __shfl(carry[kb > 0 ? kb - 1 : 0], (lane + 48) & 63) : 0.f;
            IMPW[tl * 64 + 4 * kb + gq] = imp[kb] + (gq > 0 ? c1 : c0); }
    }
    __syncthreads();
    for (int tl = w; tl < 64; tl += NWAVES) { const int t = tb * 64 + tl, cur = t >> 6;
        float v = (IMP[tl * 64 + lane] + IMP[4096 + tl * 64 + lane]) + (IMP[2 * 4096 + tl * 64 + lane] + IMP[3 * 4096 + tl * 64 + lane]); const bool forced = (lane == 0) || (lane == cur) || (lane == cur - 1);
        v = (lane > cur) ? NEG_BIG : v + (forced ? 1.0e4f : 0.f);
        int rank = 0;
#pragma unroll
        for (int jj = 0; jj < 64; ++jj) { const float o = __builtin_bit_cast(float, __builtin_amdgcn_readlane(__builtin_bit_cast(int, v), jj)); rank += (o > v || (o == v && jj < lane)) ? 1 : 0; }
        const unsigned long long m = __ballot(lane <= cur && rank < 16);
        if (lane == 0) selmask[(size_t)bg * SEQ + t] = m; }
}

constexpr int ML_H = 4, ML_D = 128, ML_L = 64, ML_NCH = SEQ / ML_L, ML_BH = BATCH * ML_H;
__device__ __forceinline__ float log_sigmoid(float x) { return fminf(x, 0.f) - log1pf(__expf(-fabsf(x))); }
__device__ __forceinline__ float siluf_(float x) { return x * sigmoidf_(x); }
__device__ __forceinline__ void ml_stage_a(Ctx& F, int unit) {
    const int c = unit & 63, bh = unit >> 6, b = bh >> 2, h = bh & 3;
    const bf16* proj = (const bf16*)(F.ws + WS_PROJ); bf16* mlq = (bf16*)(F.ws + WS_MLQ); bf16* mlk = (bf16*)(F.ws + WS_MLKK);
    float* mlb = (float*)(F.ws + WS_MLB); float* mlli = (float*)(F.ws + WS_MLLI); float* mlsc = (float*)(F.ws + WS_MLSC);
    bf16* mlu = (bf16*)(F.ws + WS_MLU) + (size_t)unit * ML_D * ML_D; float* mlun = (float*)(F.ws + WS_MLUN) + (size_t)unit * ML_D;
    const float* convw = F.in[I_CONVW]; const float* convb = F.in[I_CONVB]; const float* gateb = F.in[I_GATEB];
    LAS unsigned char* KW = F.lds; LAS unsigned char* Vs = F.lds + 64 * W128_SB; LAS float* wts = (LAS float*)(F.lds + 2 * 64 * W128_SB); LAS float* gsc = wts + 64;
    const int t0 = c * ML_L; const size_t row0 = (size_t)b * SEQ + t0;
    __syncthreads();
    if (F.tid < 64) { const int s = F.tid; const float ip = bf2f(proj[(row0 + s) * PW + PC_MLIF + h]) + gateb[h], fp = bf2f(proj[(row0 + s) * PW + PC_MLIF + 4 + h]) + gateb[4 + h];
        gsc[s] = log_sigmoid(fp); gsc[64 + s] = ip; }
    __syncthreads();
    if (F.tid < 64) {
        float v = gsc[F.tid];
#pragma unroll
        for (int o = 1; o < 64; o <<= 1) { const float u = __shfl_up(v, o); if (F.lane >= o) v += u; }
        const float bL = __shfl(v, 63); const float li = gsc[64 + F.tid]; const float a = bL - v + li; const float amax = wave_max(a);
        wts[F.tid] = __expf(a - amax); mlb[(size_t)bh * SEQ + t0 + F.tid] = v; mlli[(size_t)bh * SEQ + t0 + F.tid] = li;
        if (F.tid == 0) { mlsc[unit * 2 + 0] = amax; mlsc[unit * 2 + 1] = bL; } }
    __syncthreads();
    { v4u xin[4][4]; v4u vin[2];
#pragma unroll
      for (int ii = 0; ii < 4; ++ii) { const int it = F.tid + ii * NTHREADS; const int ch8 = it & 15, s = (it >> 4) & 63, which = it >> 10; const int pcol = (which ? PC_MLK : PC_MLQ) + h * 128 + ch8 * 8;
#pragma unroll
          for (int wv = 0; wv < 4; ++wv) { const int tt = t0 + s - 3 + wv; xin[ii][wv] = (tt >= 0) ? *(const v4u*)(proj + ((size_t)b * SEQ + tt) * PW + pcol) : (v4u){0u, 0u, 0u, 0u}; } }
#pragma unroll
      for (int ii = 0; ii < 2; ++ii) { const int it = F.tid + ii * NTHREADS; const int ch8 = it & 15, s = it >> 4; vin[ii] = *(const v4u*)(proj + (row0 + s) * PW + PC_MLV + h * 128 + ch8 * 8); }
#pragma unroll
      for (int ii = 0; ii < 4; ++ii) { const int it = F.tid + ii * NTHREADS; const int ch8 = it & 15, s = (it >> 4) & 63, which = it >> 10;
        const int cch = which * 512 + h * 128 + ch8 * 8;
        float acc[8];
#pragma unroll
        for (int j = 0; j < 8; ++j) acc[j] = convb[cch + j];
#pragma unroll
        for (int wv = 0; wv < 4; ++wv) { const v4u x = xin[ii][wv];
            const f32x4 w0 = *(const f32x4*)(convw + wv * 1024 + cch), w1 = *(const f32x4*)(convw + wv * 1024 + cch + 4);
            acc[0] += bflo(x.x) * w0[0]; acc[1] += bfhi(x.x) * w0[1]; acc[2] += bflo(x.y) * w0[2]; acc[3] += bfhi(x.y) * w0[3];
            acc[4] += bflo(x.z) * w1[0]; acc[5] += bfhi(x.z) * w1[1]; acc[6] += bflo(x.w) * w1[2]; acc[7] += bfhi(x.w) * w1[3]; }
        const float sc = which ? 0.08838834764831845f : 1.0f;
#pragma unroll
        for (int j = 0; j < 8; ++j) acc[j] = siluf_(acc[j]) * sc;
        v4u o; o.x = pk2(acc[0], acc[1]); o.y = pk2(acc[2], acc[3]); o.z = pk2(acc[4], acc[5]); o.w = pk2(acc[6], acc[7]);
        *(v4u*)((which ? mlk : mlq) + (row0 + s) * 512 + h * 128 + ch8 * 8) = o;
        if (which) { const float ws = wts[s]; v4u kw; kw.x = pk2(acc[0] * ws, acc[1] * ws); kw.y = pk2(acc[2] * ws, acc[3] * ws); kw.z = pk2(acc[4] * ws, acc[5] * ws); kw.w = pk2(acc[6] * ws, acc[7] * ws);
            *(LAS v4u*)(KW + s * W128_SB + ch8 * 16) = kw; } }
#pragma unroll
      for (int ii = 0; ii < 2; ++ii) { const int it = F.tid + ii * NTHREADS; const int ch8 = it & 15, s = it >> 4; *(LAS v4u*)(Vs + s * W128_SB + ch8 * 16) = vin[ii]; } }
    __syncthreads();
    { const int lane = F.lane, gq = lane >> 4, w = F.wave;
      const bf16x8 a0 = tr_frag(KW, W128_SB, 8 * gq, 8 * gq + 4, 16 * w, lane), a1 = tr_frag(KW, W128_SB, 32 + 8 * gq, 32 + 8 * gq + 4, 16 * w, lane);
#pragma unroll
      for (int eb = 0; eb < 8; ++eb) { f32x4 acc = (f32x4){0.f, 0.f, 0.f, 0.f};
          acc = mfma16(a0, tr_frag(Vs, W128_SB, 8 * gq, 8 * gq + 4, 16 * eb, lane), acc); acc = mfma16(a1, tr_frag(Vs, W128_SB, 32 + 8 * gq, 32 + 8 * gq + 4, 16 * eb, lane), acc);
          v2u uw; uw.x = pk2(acc[0], acc[1]); uw.y = pk2(acc[2], acc[3]);        *(v2u*)(mlu + (size_t)(16 * eb + (lane & 15)) * ML_D + 16 * w + 4 * gq) = uw; } }
    if (F.tid < ML_D) { float a = 0.f;
#pragma unroll 8
        for (int s = 0; s < 64; ++s) a += bf2f(*(const LAS unsigned short*)(KW + s * W128_SB + F.tid * 2));
        mlun[F.tid] = a; }
}
__device__ __forceinline__ void ml_stage_b(Ctx& F, int unit) {
    const int sl = unit & 15, bh = unit >> 4;
    const float* mlsc = (const float*)(F.ws + WS_MLSC); float* mlm = (float*)(F.ws + WS_MLSC) + 4096;
    const bf16* mlu = (const bf16*)(F.ws + WS_MLU) + (size_t)bh * 64 * ML_D * ML_D; bf16* mlc = (bf16*)(F.ws + WS_MLC) + (size_t)bh * 64 * ML_D * ML_D;
    const float* mlun = (const float*)(F.ws + WS_MLUN) + (size_t)bh * 64 * ML_D; float* mln = (float*)(F.ws + WS_MLN) + (size_t)bh * 64 * ML_D;
    LAS float* dec = (LAS float*)F.lds; LAS float* scl = dec + 64; LAS float* am = scl + 64; LAS float* bl = am + 64;
    __syncthreads();
    if (F.tid < 64) { const pg8::f32x2 v = *(const pg8::f32x2*)(mlsc + (bh * 64 + F.tid) * 2); am[F.tid] = v.x; bl[F.tid] = v.y; }
    __syncthreads();
    if (F.tid == 0) { float m = 0.f;
        for (int c = 0; c < 64; ++c) { const float amax = am[c], bL = bl[c]; const float mn = fmaxf(bL + m, amax);
            dec[c] = __expf(bL + m - mn); scl[c] = __expf(amax - mn); if (sl == 0) mlm[bh * 64 + c] = m; m = mn; } }
    __syncthreads();
    { const int idx = sl * 1024 + F.tid * 2; float c0 = 0.f, c1 = 0.f;
#pragma unroll 1
      for (int cb = 0; cb < 64; cb += 16) { unsigned u[16];
#pragma unroll
          for (int i = 0; i < 16; ++i) u[i] = *(const unsigned*)(mlu + (size_t)(cb + i) * ML_D * ML_D + idx);
#pragma unroll
          for (int i = 0; i < 16; ++i) { *(unsigned*)(mlc + (size_t)(cb + i) * ML_D * ML_D + idx) = pk2(c0, c1);
              c0 = dec[cb + i] * c0 + scl[cb + i] * bflo(u[i]); c1 = dec[cb + i] * c1 + scl[cb + i] * bfhi(u[i]); } } }
    if (sl == 0 && F.tid < ML_D) { float n = 0.f;
#pragma unroll 1
        for (int cb = 0; cb < 64; cb += 8) { float u[8];
#pragma unroll
            for (int i = 0; i < 8; ++i) u[i] = mlun[(cb + i) * ML_D + F.tid];
#pragma unroll
            for (int i = 0; i < 8; ++i) { mln[(cb + i) * ML_D + F.tid] = n; n = dec[cb + i] * n + scl[cb + i] * u[i]; } } }
}
struct MlcIn { v4u q[2], k[2], v[2], c[4]; float fb, fli, fn, mc; };
__device__ __forceinline__ void ml_stage_c_load(Ctx& F, int unit, MlcIn& r) {
    const int c = unit & 63, bh = unit >> 6, b = bh >> 2, h = bh & 3;
    const bf16* proj = (const bf16*)(F.ws + WS_PROJ); const bf16* mlq = (const bf16*)(F.ws + WS_MLQ); const bf16* mlk = (const bf16*)(F.ws + WS_MLKK);
    const float* mlb = (const float*)(F.ws + WS_MLB); const float* mlli = (const float*)(F.ws + WS_MLLI); const float* mlm = (const float*)(F.ws + WS_MLSC) + 4096;
    const bf16* mlc = (const bf16*)(F.ws + WS_MLC) + (size_t)unit * ML_D * ML_D; const float* mln = (const float*)(F.ws + WS_MLN) + (size_t)unit * ML_D;
    const int t0 = c * ML_L; const size_t row0 = (size_t)b * SEQ + t0;
#pragma unroll
    for (int i = 0; i < 2; ++i) { const int it = F.tid + i * NTHREADS, ch8 = it & 15, s = it >> 4; const size_t go = (row0 + s) * 512 + h * 128 + ch8 * 8;
        r.q[i] = *(const v4u*)(mlq + go); r.k[i] = *(const v4u*)(mlk + go); r.v[i] = *(const v4u*)(proj + (row0 + s) * PW + PC_MLV + h * 128 + ch8 * 8); }
#pragma unroll
    for (int i = 0; i < 4; ++i) { const int it = F.tid + i * NTHREADS, ch8 = it & 15, e = it >> 4; r.c[i] = *(const v4u*)(mlc + e * ML_D + ch8 * 8); }
    r.fb = mlb[(size_t)bh * SEQ + t0 + (F.tid & 63)]; r.fli = mlli[(size_t)bh * SEQ + t0 + (F.tid & 63)]; r.fn = mln[F.tid & 127]; r.mc = mlm[unit];
}
__device__ __forceinline__ void ml_stage_c(Ctx& F, int unit, int next_unit, MlcIn& r) {
    const int c = unit & 63, bh = unit >> 6, b = bh >> 2, h = bh & 3;
    const bf16* proj = (const bf16*)(F.ws + WS_PROJ);
    bf16* oml = (bf16*)(F.ws + WS_OML); const float* ng = F.in[I_MLNG];
    LAS unsigned char* Qs = F.lds; LAS unsigned char* Ks = Qs + 64 * W128_SB; LAS unsigned char* Vs = Ks + 64 * W128_SB; LAS unsigned char* Cs = Vs + 64 * W128_SB;
    LAS float* fb = (LAS float*)(Cs + 128 * W128_SB); LAS float* fli = fb + 64; LAS float* fn = fli + 64; LAS float* ssq = fn + 128;
    const int t0 = c * ML_L; const size_t row0 = (size_t)b * SEQ + t0;
    __syncthreads();
#pragma unroll
    for (int i = 0; i < 2; ++i) { const int it = F.tid + i * NTHREADS, ch8 = it & 15, s = it >> 4;
        *(LAS v4u*)(Qs + s * W128_SB + ch8 * 16) = r.q[i]; *(LAS v4u*)(Ks + s * W128_SB + ch8 * 16) = r.k[i]; *(LAS v4u*)(Vs + s * W128_SB + ch8 * 16) = r.v[i]; }
#pragma unroll
    for (int i = 0; i < 4; ++i) { const int it = F.tid + i * NTHREADS, ch8 = it & 15, e = it >> 4; *(LAS v4u*)(Cs + e * W128_SB + ch8 * 16) = r.c[i]; }
    if (F.tid < 64) { fb[F.tid] = r.fb; fli[F.tid] = r.fli; }
    if (F.tid < ML_D) fn[F.tid] = r.fn;
    const float mc = r.mc;
    __syncthreads();
    if (next_unit >= 0) ml_stage_c_load(F, next_unit, r);
    const int lane = F.lane, gq = lane >> 4, w = F.wave, tb = w & 3, eh = w >> 2;
    const int t = 16 * tb + (lane & 15); const float bt = fb[t];
    f32x4 ggv[4]; v2u owv[4];
#pragma unroll
    for (int ei = 0; ei < 4; ++ei) { const int e0 = 16 * (eh * 4 + ei) + 4 * gq; ggv[ei] = *(const f32x4*)(ng + h * 128 + e0); owv[ei] = *(const v2u*)(proj + (row0 + t) * PW + PC_MLO + h * 128 + e0); }
    bf16x8 qf[4];
#pragma unroll
    for (int st = 0; st < 4; ++st) qf[st] = lds_row8(Qs, W128_SB, t, 32 * st + 8 * gq);
    f32x4 sT[4]; float dmax = NEG_BIG;
#pragma unroll
    for (int sb = 0; sb < 4; ++sb) { sT[sb] = (f32x4){0.f, 0.f, 0.f, 0.f};
        if (sb <= tb) {
#pragma unroll
            for (int st = 0; st < 4; ++st) sT[sb] = mfma16(lds_row8(Ks, W128_SB, 16 * sb + (lane & 15), 32 * st + 8 * gq), qf[st], sT[sb]);
#pragma unroll
            for (int r = 0; r < 4; ++r) { const int s = 16 * sb + 4 * gq + r; if (s <= t) dmax = fmaxf(dmax, bt - fb[s] + fli[s]); } } }
    dmax = grp_max(dmax);
    const float mt = fmaxf(bt + mc, dmax); const float iw = __expf(bt + mc - mt);
    float dsum = 0.f;
#pragma unroll
    for (int sb = 0; sb < 4; ++sb)
#pragma unroll
        for (int r = 0; r < 4; ++r) { const int s = 16 * sb + 4 * gq + r; const float p = (sb <= tb && s <= t) ? sT[sb][r] * __expf(bt - fb[s] + fli[s] - mt) : 0.f; sT[sb][r] = p; dsum += p; }
    dsum = grp_sum(dsum);
    float qn = 0.f;
#pragma unroll 8
    for (int dd = 0; dd < 32; ++dd) { const int d = gq * 32 + dd; qn += bf2f(*(const LAS unsigned short*)(Qs + t * W128_SB + d * 2)) * fn[d]; }
    qn = grp_sum(qn);
    const float den = dsum + iw * qn; const float rden = 1.0f / fmaxf(fabsf(den), __expf(-mt));
    const bf16x8 p0 = pack8(sT[0], sT[1]), p1 = pack8(sT[2], sT[3]);
    f32x4 hv[4]; float sq = 0.f;
#pragma unroll
    for (int ei = 0; ei < 4; ++ei) { const int eb = eh * 4 + ei;
        f32x4 intra = (f32x4){0.f, 0.f, 0.f, 0.f}, inter = (f32x4){0.f, 0.f, 0.f, 0.f};
        intra = mfma16(tr_frag(Vs, W128_SB, 4 * gq, 16 + 4 * gq, 16 * eb, lane), p0, intra);
        if (tb >= 2) intra = mfma16(tr_frag(Vs, W128_SB, 32 + 4 * gq, 48 + 4 * gq, 16 * eb, lane), p1, intra);
#pragma unroll
        for (int st = 0; st < 4; ++st) inter = mfma16(lds_row8(Cs, W128_SB, 16 * eb + (lane & 15), 32 * st + 8 * gq), qf[st], inter);
        hv[ei] = (intra + inter * iw) * rden; sq += (hv[ei][0] * hv[ei][0] + hv[ei][1] * hv[ei][1]) + (hv[ei][2] * hv[ei][2] + hv[ei][3] * hv[ei][3]); }
    sq = grp_sum(sq);
    if (gq == 0) ssq[eh * 64 + t] = sq;
    __syncthreads();
    const float rn = rsqrtf((ssq[t] + ssq[64 + t]) * (1.0f / ML_D) + NORM_EPS);
#pragma unroll
    for (int ei = 0; ei < 4; ++ei) { const int e0 = 16 * (eh * 4 + ei) + 4 * gq; const f32x4 gg = ggv[ei];
        const v2u ow = owv[ei];
        f32x4 v = hv[ei] * rn * gg; v[0] *= sigmoidf_(bflo(ow.x)); v[1] *= sigmoidf_(bfhi(ow.x)); v[2] *= sigmoidf_(bflo(ow.y)); v[3] *= sigmoidf_(bfhi(ow.y));
        v2u o; o.x = pg8::cvt_pk_bf16(v[0], v[1]); o.y = pg8::cvt_pk_bf16(v[2], v[3]); *(v2u*)(oml + (row0 + t) * 512 + h * 128 + e0) = o; }
}

#ifndef REPEAT_PHASE
#define REPEAT_PHASE -1
#endif
__device__ __forceinline__ void ph2(Ctx& F) {
    const int nconv = (F.G * 112) / 256, GC = F.G - nconv;
    if ((int)blockIdx.x < GC) {
        pg8::Gemm g{(const bf16*)(F.ws + WS_A1), (const bf16*)(F.ws + WS_WIN), T, PW, DM}; pg8::StaticOrder S; S.init(T, PW, GC, (int)blockIdx.x);
        EpiStoreScaled E{(bf16*)(F.ws + WS_PROJ), PW, (const float*)(F.ws + WS_SA), (const float*)(F.ws + WS_SW)};
        pg8::gemm_phase<EpiStoreScaled, pg8::StaticOrder, true, true, false, false, true>(F.lds, g, S, E);
    } else moe_convert(F, (int)blockIdx.x - GC, nconv);
}
#ifndef TIME_SUB
#define TIME_SUB 0
#endif
#define SUBT_BEGIN(k) unsigned long long ts_ = 0; if (TIME_SUB == (k)) ts_ = __builtin_amdgcn_s_memrealtime();
#define SUBT_END(k) if (TIME_SUB == (k)) { __syncthreads(); const unsigned long long n_ = __builtin_amdgcn_s_memrealtime(); const unsigned long long e_ = n_ + 4 * (n_ - ts_); while (__builtin_amdgcn_s_memrealtime() < e_) __builtin_amdgcn_s_sleep(8); }
__device__ __forceinline__ void ph3(Ctx& F) {
    { SUBT_BEGIN(3) for (int u = F.vcu; u < 256; u += F.G) nsa_compress_unit(F, u); SUBT_END(3) }
    for (int u = F.vcu; u < ML_BH * ML_NCH; u += F.G) ml_stage_a(F, u);
}
__device__ __forceinline__ void ph4(Ctx& F) {
    { SUBT_BEGIN(4) for (int p = F.vcu; p < 256; p += F.G) { const int bg = p >> 5, x = p & 31; nsa_cmp_unit(F, bg, 63 - x); nsa_cmp_unit(F, bg, x); } SUBT_END(4) }
    for (int u = F.vcu; u < ML_BH * 16; u += F.G) ml_stage_b(F, u);
}
__device__ __forceinline__ void ph5(Ctx& F) {
    { SUBT_BEGIN(5) for (int p = F.vcu; p < 256; p += F.G) { const int bg = p >> 5, x = p & 31; nsa_selwin_unit(F, bg >> 1, bg & 1, x); nsa_selwin_unit(F, bg >> 1, bg & 1, 63 - x); } SUBT_END(5) }
    { MlcIn r; int u = F.vcu; if (u < ML_BH * ML_NCH) ml_stage_c_load(F, u, r);
      for (; u < ML_BH * ML_NCH; u += F.G) { const int nu = u + F.G < ML_BH * ML_NCH ? u + F.G : -1; ml_stage_c(F, u, nu, r); } }
}
struct UpOrder {
    pg8::StaticOrder so;
    __device__ __forceinline__ bool next(int i, Unit& u) const { if (!so.next(i >> 1, u)) return false; if (i & 1) { u.pm += T / 256; u.pn += DM / 256; } return true; }
    __device__ __forceinline__ void a_ready(const Unit&) const {}
    __device__ __forceinline__ void done(const Unit&) const {}
};
struct EpiUpBoth {
    static constexpr bool PERM = true, AFTER_DRAIN = false;
    bf16* U; const bf16* G;
    __device__ __forceinline__ void operator()(const f32x4 (&acc)[2][2][4][2], const Unit& u, int wr, int wc, int fr, int fq) const {
        if (u.pm < T / 256) { EpiUpGate<false> E{U, G, PC_MGA}; E(acc, u, wr, wc, fr, fq); }
        else { Unit v = u; v.pm -= T / 256; v.pn -= DM / 256; EpiUpGate<true> E{U, G, PC_MGB}; E(acc, v, wr, wc, fr, fq); }
    }
};
static_assert(WS_OML == WS_ONSA + (size_t)T * 512 * 2 && WS_WUPB == WS_WUPA + (size_t)DM * 512 * 2, "stacked operands of the up projection");
__device__ __forceinline__ void ph6(Ctx& F) {
    UpOrder S; S.so.init(T, DM, F.G, (int)blockIdx.x);
    pg8::Gemm g{(const bf16*)(F.ws + WS_ONSA), (const bf16*)(F.ws + WS_WUPA), 2 * T, 2 * DM, 512}; EpiUpBoth E{(bf16*)(F.ws + WS_U), (const bf16*)(F.ws + WS_PROJ)};
    pg8::gemm_phase<EpiUpBoth, UpOrder, true, true>(F.lds, g, S, E);
}
__device__ __forceinline__ void ph7(Ctx& F) {
    pg8::Gemm g{(const bf16*)(F.ws + WS_U), (const bf16*)(F.ws + WS_WOUT), T, DM, DM}; pg8::StaticOrder S; S.init(T, DM, F.G, (int)blockIdx.x);
    EpiOutRes E{F.in[I_X], (bf16*)(F.ws + WS_H1), (const float*)(F.ws + WS_MODF)};
    pg8::gemm_phase<EpiOutRes, pg8::StaticOrder, true, true>(F.lds, g, S, E);
}
__device__ __forceinline__ void ph10(Ctx& F) {
    pg8::Gemm g{(const bf16*)(F.ws + WS_A1), (const bf16*)(F.ws + WS_W1T), MOE_P, NEXP * 2048, DM};
    moe_units_to_lds<1>(F.lds, F.ctl + CW_MOETAB, 8, 3, F.G, F.vcu, F.in[I_EB1], nullptr);
    MoeOrder S{(const LAS int*)(F.lds + MOE_UL_OFF), (const int*)(F.ws + WS_ROWT)};
    EpiMoe1 E{F.ws + WS_ACT, (const LAS float*)(F.lds + MOE_BT1_OFF)};
    pg8::gemm_phase<EpiMoe1, MoeOrder, true, true, true, true>(F.lds, g, S, E);
}
__device__ __forceinline__ void ph11(Ctx& F) {
    pg8::Gemm g{(const bf16*)(F.ws + WS_ACT), (const bf16*)(F.ws + WS_W2T), MOE_P, NEXP * DM, DE};
    moe_units_to_lds<2>(F.lds, F.ctl + CW_MOETAB, 4, 2, F.G, F.vcu, F.in[I_EB2], (const float*)(F.ws + WS_ROWG));
    MoeOrder S{(const LAS int*)(F.lds + MOE_UL_OFF), nullptr};
    EpiMoe2 E{F.ws + WS_YR, (const LAS float*)(F.lds + MOE_BT2_OFF)};
    pg8::gemm_phase<EpiMoe2, MoeOrder, true, true, true>(F.lds, g, S, E);
}
#ifndef TIME_PHASE
#define TIME_PHASE -1
#endif
#define RUN(k, call) do { unsigned long long t0_ = 0; if (TIME_PHASE == (k)) t0_ = __builtin_amdgcn_s_memrealtime(); F.tid = threadIdx.x; F.lane = F.tid & 63; call; SEAM(); \
    if (TIME_PHASE == (k)) { const unsigned long long n_ = __builtin_amdgcn_s_memrealtime(); const unsigned long long e_ = n_ + 4 * (n_ - t0_); while (__builtin_amdgcn_s_memrealtime() < e_) __builtin_amdgcn_s_sleep(8); SEAM(); } } while (0)
__global__ void __launch_bounds__(NTHREADS, 2) fwd_kernel(Args args) {
    extern __shared__ __attribute__((aligned(16))) unsigned char lds_raw[];
    Ctx F;
    F.lds = (LAS unsigned char*)lds_raw; F.ws = args.ws; F.ctl = (unsigned*)(args.ws + WS_CTL);
    F.tid = threadIdx.x; F.lane = F.tid & 63; F.wave = __builtin_amdgcn_readfirstlane(F.tid >> 6);
    F.G = gridDim.x; { const int bx = blockIdx.x; F.vcu = (F.G % 8 == 0) ? (bx % 8) * (F.G / 8) + bx / 8 : bx; }
    F.in = args.in; F.out = args.out;
    volatile LAS unsigned* MISC = (volatile LAS unsigned*)(F.lds + MISC_OFF);
    for (int u = F.tid; u < (LDS_BYTES - LDSCTL_OFF) / 4; u += NTHREADS) ((LAS unsigned*)(F.lds + LDSCTL_OFF))[u] = 0u;
    __syncthreads();
    XcdBarrier bar = xcd_barrier_post(F.ctl + CW_BAR, MISC + 8);
#define SEAM() xcd_barrier(bar)
    const float* modf = (const float*)(F.ws + WS_MODF);
    const bf16* H = (const bf16*)(F.ws + WS_H1);
    RUN(0, p0_prologue(F));
    RUN(1, p1_norm1(F));
    RUN(2, ph2(F));
    RUN(3, ph3(F));
    RUN(4, ph4(F));
    RUN(5, ph5(F));
    RUN(6, ph6(F));
    RUN(7, ph7(F));
    RUN(8, p8_norm2_router(F, H, modf));
    RUN(9, p9_permute(F));
    RUN(10, ph10(F));
    RUN(11, ph11(F));
    p_final<true>(F, H, modf);
#undef SEAM
}

extern "C" void kernel_launch(void* const* d_in, const int* in_sizes, int n_in, void* d_out, int out_size, void* d_ws, size_t ws_size, hipStream_t stream) {
    static int grid = 0;
    if (grid == 0) {
        if (n_in != 27 || in_sizes[0] != T * DM || out_size != T * DM || ws_size < WS_END) { fprintf(stderr, "kernel_launch: unexpected shapes (n_in %d, in0 %d, out %d, ws %zu)\n", n_in, n_in > 0 ? in_sizes[0] : -1, out_size, ws_size); grid = -1; return; }
        int dev = 0, cus = 0, per_cu = 0;
        if (hipGetDevice(&dev) != hipSuccess || hipDeviceGetAttribute(&cus, hipDeviceAttributeMultiprocessorCount, dev) != hipSuccess) { grid = -1; return; }
        if (hipFuncSetAttribute((const void*)fwd_kernel, hipFuncAttributeMaxDynamicSharedMemorySize, LDS_BYTES) != hipSuccess) { fprintf(stderr, "kernel_launch: hipFuncSetAttribute failed\n"); grid = -1; return; }
        if (hipOccupancyMaxActiveBlocksPerMultiprocessor(&per_cu, (const void*)fwd_kernel, NTHREADS, LDS_BYTES) != hipSuccess || per_cu < 1) fprintf(stderr, "kernel_launch: occupancy query reports %d\n", per_cu);
        (void)hipGetLastError();
        grid = cus;
    }
    if (grid < 0) return;
    if (hipMemsetAsync((char*)d_ws + WS_CTL, 0, CTL_ZERO_BYTES, stream) != hipSuccess) return;
    Args a{};
    for (int i = 0; i < 27; ++i) a.in[i] = (const float*)d_in[i];
    a.out = (float*)d_out; a.ws = (unsigned char*)d_ws;
    a.ph_lo = 0; a.ph_hi = 64;
    hipLaunchKernelGGL(fwd_kernel, dim3(grid), dim3(NTHREADS), LDS_BYTES, stream, a);
}
```

```cpp
#include <hip/hip_runtime.h>
#include <cstdio>
#include <cstdint>
namespace pg8 {
#define PG8_LAS __attribute__((address_space(3)))
typedef unsigned short bf16_t;
typedef short bf16x8 __attribute__((ext_vector_type(8)));
typedef float f32x4 __attribute__((ext_vector_type(4)));
typedef unsigned u32x4 __attribute__((ext_vector_type(4)));
constexpr int BM = 256, BK = 64, HALF = 128, HTB = HALF * BK * 2  , STAGE_BYTES = 8 * HTB, NXCD = 8, WGM = 8;

__host__ __device__ __forceinline__ int lds_byte(int r, int c) { const int st = (r >> 4) * 2 + (c >> 5), rr = r & 15, cc = c & 31, ob = rr * 64 + cc * 2; return st * 1024 + (ob ^ (((ob >> 9) & 1) << 5)); }
__host__ __device__ __forceinline__ void stage_rc(int b, int& R, int& C) { const int st = b / 1024, sb = b % 1024, swz = sb ^ (((sb >> 9) & 1) << 5); R = (st >> 1) * 16 + swz / 64; C = (st & 1) * 32 + (swz % 64) / 2; }
__host__ __device__ __forceinline__ int perm32(int rho) { const int n = rho >> 4, i = rho & 15; return 8 * (i >> 2) + 4 * n + (i & 3); }

struct Unit { int pm, pn, ix; };
struct Gemm { const bf16_t* A; const bf16_t* Bt; int M, N, K; };

struct StaticOrder {
    int nM, nN, nwg, G, c;
    __host__ __device__ void init(int M, int N, int G_, int c_) { nM = M / BM; nN = N / BM; nwg = nM * nN; G = G_; c = c_; }
    __host__ __device__ bool next(int i, Unit& u) const {
        const long L = (long)i * G + c; if (L >= nwg) return false;
        int wgid = (int)L; { const int q = nwg / NXCD, r = nwg % NXCD, xcd = wgid % NXCD, off = wgid / NXCD; wgid = (xcd < r ? xcd * (q + 1) : r * (q + 1) + (xcd - r) * q) + off; }
        const int nig = WGM * nN, gid = wgid / nig, fm = gid * WGM, gsz = (nM - fm) < WGM ? (nM - fm) : WGM;
        u.pm = fm + ((wgid % nig) % gsz); u.pn = (wgid % nig) / gsz; return true;
    }
    __device__ __forceinline__ void a_ready(const Unit&) const {}
    __device__ __forceinline__ void done(const Unit&) const {}
};

__device__ __forceinline__ unsigned cvt_pk_bf16(float lo, float hi) { unsigned r; asm volatile("v_cvt_pk_bf16_f32 %0, %1, %2" : "=v"(r) : "v"(lo), "v"(hi)); return r; }
typedef float f32x2 __attribute__((ext_vector_type(2)));
typedef int v8i32 __attribute__((ext_vector_type(8)));
typedef int v4i32 __attribute__((ext_vector_type(4)));
template <bool F8> struct FragT { typedef bf16x8 type; }; template <> struct FragT<true> { typedef v8i32 type; };
constexpr int F8_SCALE_A = 0x7F7F7F7F;
constexpr int F8_SCALE_B = 0x7A7A7A7A;
template <class Epi, class Sched, bool ALIGN_EPI = false, bool SP2 = false, bool F8 = false, bool GATHER = false, bool I8 = false>
__device__ __forceinline__ void gemm_phase(PG8_LAS unsigned char* lds, const Gemm g, const Sched& S, const Epi& E) {
    int tid_ = threadIdx.x; asm volatile("" : "+v"(tid_));
    const int tid = tid_, wid = __builtin_amdgcn_readfirstlane(tid >> 6), lane = tid & 63, wr = wid >> 2, wc = wid & 3, fr = lane & 15, fq = lane >> 4;
    const int K = g.K, nt = (F8 || I8) ? K / (2 * BK) : K / BK; const int RB = (F8 || I8) ? K : 2 * K;
    unsigned voffA[2], voffB[2];
#pragma unroll
    for (int i = 0; i < 2; ++i) { int R, C; stage_rc(tid * 16 + i * 8192, R, C); const int Rb = Epi::PERM ? ((R & ~31) + perm32(R & 31)) : R;
        voffA[i] = (unsigned)(R * RB + C * 2); voffB[i] = (unsigned)(Rb * RB + C * 2); }
    const size_t kstep = (size_t)(BK * 2);
    const size_t hstep = (size_t)HALF * RB;
    const size_t tstep = 2 * hstep;
    const unsigned ldsw = (unsigned)wid * 1024u;
    const int aoff = lds_byte(wr * 64 + fr, fq * 8), boff = lds_byte(wc * 32 + fr, fq * 8);
#define PG8_SA(b, h) (((b) * 2 + (h)) * HTB)
#define PG8_SB(b, h) ((4 + (b) * 2 + (h)) * HTB)
#define PG8_STAGE(bufoff, gbase, voff) do { _Pragma("unroll") for (int _i = 0; _i < 2; ++_i) \
        __builtin_amdgcn_global_load_lds((const unsigned*)((const char*)(gbase) + (voff)[_i]), (PG8_LAS unsigned*)(lds + (bufoff) + ldsw + _i * 8192), 16, 0, 0); } while (0)
#define PG8_GO1(ix, h_, i_) ((unsigned)rt[(ix) * BM + (h_) * HALF + (int)(voffA[i_] / (unsigned)RB)] * (unsigned)RB + voffA[i_] % (unsigned)RB)
#define PG8_STAGE_A(bufoff, gbase, h, nx) do { if constexpr (GATHER) { _Pragma("unroll") for (int _i = 0; _i < 2; ++_i) { const unsigned o_ = PG8_GO1((nx) ? nui : ui, h, _i); \
        __builtin_amdgcn_global_load_lds((const unsigned*)((const char*)(gbase) + o_), (PG8_LAS unsigned*)(lds + (bufoff) + ldsw + _i * 8192), 16, 0, 0); } } \
        else { PG8_STAGE(bufoff, (const char*)(gbase) + (h) * hstep, voffA); } } while (0)
#define PG8_GOFFS(v, ix) do { _Pragma("unroll") for (int h_ = 0; h_ < 2; ++h_) _Pragma("unroll") for (int i_ = 0; i_ < 2; ++i_) v[h_][i_] = PG8_GO1(ix, h_, i_); } while (0)
#define PG8_LD16(off) (*(const PG8_LAS v4i32*)(lds + (off)))
#define PG8_LDA(dst, b, h) do { _Pragma("unroll") for (int m = 0; m < 4; ++m) { if constexpr (F8) { const v4i32 lo_ = PG8_LD16(PG8_SA(b, h) + aoff + m * 2048), hi_ = PG8_LD16(PG8_SA(b, h) + aoff + m * 2048 + 1024); dst[m][0] = __builtin_shufflevector(lo_, hi_, 0, 1, 2, 3, 4, 5, 6, 7); } \
        else { _Pragma("unroll") for (int k = 0; k < NK; ++k) dst[m][k] = *(const PG8_LAS frag_t*)(lds + PG8_SA(b, h) + aoff + m * 2048 + k * 1024); } } } while (0)
#define PG8_LDB(dst, b, h) do { _Pragma("unroll") for (int n = 0; n < 2; ++n) { if constexpr (F8) { const v4i32 lo_ = PG8_LD16(PG8_SB(b, h) + boff + n * 2048), hi_ = PG8_LD16(PG8_SB(b, h) + boff + n * 2048 + 1024); dst[n][0] = __builtin_shufflevector(lo_, hi_, 0, 1, 2, 3, 4, 5, 6, 7); } \
        else { _Pragma("unroll") for (int k = 0; k < NK; ++k) dst[n][k] = *(const PG8_LAS frag_t*)(lds + PG8_SB(b, h) + boff + n * 2048 + k * 1024); } } } while (0)
#define PG8_MMA(ai, bj, At, Bt) do { __builtin_amdgcn_s_setprio(1); \
        if constexpr (F8) { _Pragma("unroll") for (int m = 0; m < 4; ++m) _Pragma("unroll") for (int n = 0; n < 2; ++n) \
            asm("v_mfma_scale_f32_16x16x128_f8f6f4 %0, %1, %2, %0, %3, %4 op_sel_hi:[0,0,0]" : "+v"(acc[ai][bj][m][n]) : "v"(Bt[n][0]), "v"(At[m][0]), "v"(f8sb), "v"(f8sa)); } \
        else if constexpr (I8) { _Pragma("unroll") for (int m = 0; m < 4; ++m) _Pragma("unroll") for (int n = 0; n < 2; ++n) _Pragma("unroll") for (int k = 0; k < NK; ++k) \
            acc[ai][bj][m][n] = __builtin_bit_cast(f32x4, __builtin_amdgcn_mfma_i32_16x16x64_i8(__builtin_bit_cast(v4i32, Bt[n][k]), __builtin_bit_cast(v4i32, At[m][k]), __builtin_bit_cast(v4i32, acc[ai][bj][m][n]), 0, 0, 0)); } \
        else { _Pragma("unroll") for (int m = 0; m < 4; ++m) _Pragma("unroll") for (int n = 0; n < 2; ++n) _Pragma("unroll") for (int k = 0; k < NK; ++k) \
            acc[ai][bj][m][n] = __builtin_amdgcn_mfma_f32_16x16x32_bf16(Bt[n][k], At[m][k], acc[ai][bj][m][n], 0, 0, 0); } \
        __builtin_amdgcn_s_setprio(0); } while (0)
#define PG8_WAIT_V(n) asm volatile("s_waitcnt vmcnt(" #n ")" ::: "memory")
#define PG8_WAIT_L(n) asm volatile("s_waitcnt lgkmcnt(" #n ")" ::: "memory")
#define PG8_BAR __builtin_amdgcn_s_barrier()
#define PG8_SCHED __builtin_amdgcn_sched_barrier(0)
    Unit cur, nxt; int ui = 0;
    if (!S.next(0, cur)) return;
    f32x4 acc[2][2][4][2];
#pragma unroll
    for (int a = 0; a < 2; ++a)
#pragma unroll
        for (int b = 0; b < 2; ++b)
#pragma unroll
            for (int m = 0; m < 4; ++m)
#pragma unroll
                for (int n = 0; n < 2; ++n) acc[a][b][m][n] = (f32x4){0.f, 0.f, 0.f, 0.f};
    typedef typename FragT<F8>::type frag_t; constexpr int NK = F8 ? 1 : 2;
    int f8sa = F8_SCALE_A, f8sb = F8_SCALE_B; if constexpr (F8) asm volatile("" : "+v"(f8sa), "+v"(f8sb));
    frag_t At[4][NK], B0[2][NK], B1[2][NK];
    const char* cA = (const char*)g.A + (GATHER ? (size_t)0 : (size_t)cur.pm * tstep); const char* cB = (const char*)g.Bt + (size_t)cur.pn * tstep;
    int nui = 0; PG8_LAS const unsigned short* rt = (PG8_LAS const unsigned short*)(lds + STAGE_BYTES);
    if constexpr (GATHER) {
        Unit tu; for (int i = 0; S.next(i, tu); ++i) if (tid < BM) ((PG8_LAS unsigned short*)(lds + STAGE_BYTES))[i * BM + tid] = (unsigned short)S.rowtok[tu.pm * BM + tid];
        __syncthreads();
    }
    S.a_ready(cur);
    if constexpr (SP2) {
        PG8_STAGE(PG8_SB(0, 0), cB, voffB); PG8_STAGE(PG8_SB(0, 1), cB + hstep, voffB); PG8_STAGE_A(PG8_SA(0, 0), cA, 0, false); PG8_STAGE_A(PG8_SA(0, 1), cA, 1, false);
        if (wr == 1) PG8_BAR;
        PG8_WAIT_V(2); PG8_BAR;
        PG8_STAGE(PG8_SB(1, 0), cB + kstep, voffB); PG8_STAGE_A(PG8_SA(1, 0), cA + kstep, 0, false); PG8_STAGE(PG8_SB(1, 1), cB + hstep + kstep, voffB);
        PG8_WAIT_V(6); PG8_BAR;
    } else {
        PG8_STAGE(PG8_SB(0, 0), cB, voffB); PG8_STAGE_A(PG8_SA(0, 0), cA, 0, false); PG8_STAGE(PG8_SB(0, 1), cB + hstep, voffB); PG8_STAGE_A(PG8_SA(0, 1), cA, 1, false);
        if (wr == 1) PG8_BAR;
        PG8_WAIT_V(4); PG8_BAR;
        PG8_STAGE(PG8_SB(1, 0), cB + kstep, voffB); PG8_STAGE_A(PG8_SA(1, 0), cA + kstep, 0, false); PG8_STAGE(PG8_SB(1, 1), cB + hstep + kstep, voffB);
        PG8_WAIT_V(6); PG8_BAR;
    }
    for (;;) {
        const bool has_next = S.next(ui + 1, nxt);
        const char* nA = (has_next && !GATHER) ? (const char*)g.A + (size_t)nxt.pm * tstep : cA; const char* nB = has_next ? (const char*)g.Bt + (size_t)nxt.pn * tstep : cB;
        nui = has_next ? ui + 1 : ui;
#pragma unroll 1
        for (int t = 0; t < nt; t += 2) {
            const bool last = (t == nt - 2);
            const char* a1 = cA + (size_t)(t + 1) * kstep;
            const char* a2 = last ? nA : cA + (size_t)(t + 2) * kstep; const char* b2 = last ? nB : cB + (size_t)(t + 2) * kstep;
            const char* a3 = a2 + kstep; const char* b3 = b2 + kstep;
            if (last && has_next) S.a_ready(nxt);
            if constexpr (SP2) {
            PG8_LDB(B0, 0, 0); PG8_LDB(B1, 0, 1); PG8_SCHED; PG8_LDA(At, 0, 0); PG8_STAGE_A(PG8_SA(1, 1), a1, 1, false);
            PG8_WAIT_V(8); PG8_WAIT_L(0); PG8_BAR; PG8_MMA(0, 0, At, B0); PG8_MMA(0, 1, At, B1); PG8_BAR; PG8_SCHED;
            PG8_LDA(At, 0, 1); PG8_STAGE(PG8_SB(0, 0), b2, voffB); PG8_STAGE(PG8_SB(0, 1), b2 + hstep, voffB); PG8_STAGE_A(PG8_SA(0, 0), a2, 0, last);
            PG8_WAIT_V(8); PG8_WAIT_L(0); PG8_BAR; PG8_MMA(1, 0, At, B0); PG8_MMA(1, 1, At, B1); PG8_BAR; PG8_SCHED;
            PG8_LDB(B0, 1, 0); PG8_LDB(B1, 1, 1); PG8_SCHED; PG8_LDA(At, 1, 0); PG8_STAGE_A(PG8_SA(0, 1), a2, 1, last);
            PG8_WAIT_V(8); PG8_WAIT_L(0); PG8_BAR; PG8_MMA(0, 0, At, B0); PG8_MMA(0, 1, At, B1); PG8_BAR; PG8_SCHED;
            PG8_LDA(At, 1, 1); PG8_STAGE(PG8_SB(1, 0), b3, voffB); PG8_STAGE(PG8_SB(1, 1), b3 + hstep, voffB); PG8_STAGE_A(PG8_SA(1, 0), a3, 0, last);
            PG8_WAIT_V(8); PG8_WAIT_L(0); PG8_BAR; PG8_MMA(1, 0, At, B0); PG8_MMA(1, 1, At, B1); PG8_BAR; PG8_SCHED;
            } else {
            PG8_LDB(B0, 0, 0); PG8_SCHED; PG8_LDA(At, 0, 0); PG8_STAGE_A(PG8_SA(1, 1), a1, 1, false);
            PG8_WAIT_L(8); PG8_BAR; PG8_WAIT_L(0); PG8_MMA(0, 0, At, B0); PG8_BAR; PG8_SCHED;
            PG8_LDB(B1, 0, 1); PG8_STAGE(PG8_SB(0, 0), b2, voffB);
            PG8_BAR; PG8_WAIT_L(0); PG8_MMA(0, 1, At, B1); PG8_BAR;
            PG8_LDA(At, 0, 1); PG8_STAGE_A(PG8_SA(0, 0), a2, 0, last);
            PG8_BAR; PG8_WAIT_L(0); PG8_MMA(1, 0, At, B0); PG8_BAR; PG8_SCHED;
            PG8_STAGE(PG8_SB(0, 1), b2 + hstep, voffB);
            PG8_WAIT_V(6); PG8_BAR; PG8_MMA(1, 1, At, B1); PG8_BAR;
            PG8_LDB(B0, 1, 0); PG8_SCHED; PG8_LDA(At, 1, 0); PG8_STAGE_A(PG8_SA(0, 1), a2, 1, last);
            PG8_WAIT_L(8); PG8_BAR; PG8_WAIT_L(0); PG8_MMA(0, 0, At, B0); PG8_BAR; PG8_SCHED;
            PG8_LDB(B1, 1, 1); PG8_STAGE(PG8_SB(1, 0), b3, voffB);
            PG8_BAR; PG8_WAIT_L(0); PG8_MMA(0, 1, At, B1); PG8_BAR;
            PG8_LDA(At, 1, 1); PG8_STAGE_A(PG8_SA(1, 0), a3, 0, last);
            PG8_BAR; PG8_WAIT_L(0); PG8_MMA(1, 0, At, B0); PG8_BAR; PG8_SCHED;
            PG8_STAGE(PG8_SB(1, 1), b3 + hstep, voffB);
            PG8_WAIT_V(6); PG8_BAR; PG8_MMA(1, 1, At, B1); PG8_BAR;
            }
        }
        if constexpr (F8) asm volatile("s_nop 15\n\ts_nop 7" ::: "memory");
        if constexpr (ALIGN_EPI) { if (wr == 0) PG8_BAR; }
        if constexpr (I8) {
#pragma unroll
            for (int a = 0; a < 2; ++a)
#pragma unroll
                for (int b = 0; b < 2; ++b)
#pragma unroll
                    for (int m = 0; m < 4; ++m)
#pragma unroll
                        for (int n = 0; n < 2; ++n) acc[a][b][m][n] = __builtin_convertvector(__builtin_bit_cast(v4i32, acc[a][b][m][n]), f32x4); }
        if constexpr (!Epi::AFTER_DRAIN) { E(acc, cur, wr, wc, fr, fq); S.done(cur); }
        if (!has_next) break;
#pragma unroll
        for (int a = 0; a < 2; ++a)
#pragma unroll
            for (int b = 0; b < 2; ++b)
#pragma unroll
                for (int m = 0; m < 4; ++m)
#pragma unroll
                    for (int n = 0; n < 2; ++n) acc[a][b][m][n] = (f32x4){0.f, 0.f, 0.f, 0.f};
        cur = nxt; cA = nA; cB = nB; ++ui;

        if constexpr (ALIGN_EPI) { if (wr == 1) PG8_BAR; }
    }
    PG8_WAIT_V(0);
    if constexpr (!ALIGN_EPI) { if (wr == 0) PG8_BAR; }
    PG8_BAR;
    if constexpr (Epi::AFTER_DRAIN) { E.fused(acc, cur, wr, wc, fr, fq, lds, wid, lane); S.done(cur); }
#undef PG8_SA
#undef PG8_SB
#undef PG8_STAGE
#undef PG8_LDA
#undef PG8_LDB
#undef PG8_LD16
#undef PG8_STAGE_A
#undef PG8_GOFFS
#undef PG8_GO1
#undef PG8_MMA
#undef PG8_WAIT_V
#undef PG8_WAIT_L
#undef PG8_BAR
#undef PG8_SCHED
}
}

constexpr int NWAVES = 8, NTHREADS = 512;
constexpr int BATCH = 4, SEQ = 4096, DM = 1024, T = BATCH * SEQ;
constexpr int INW = 5408, PW = 5632;
constexpr int NEXP = 32, TOPK = 4, DE = 1024, NASSIGN = T * TOPK, MOE_ROWS = 256;
constexpr int MOE_MAXTILES = (NASSIGN + NEXP * (MOE_ROWS - 1) + MOE_ROWS - 1) / MOE_ROWS;
constexpr int MOE_P = MOE_MAXTILES * MOE_ROWS;
constexpr float NORM_EPS = 1e-6f;
constexpr int PC_Q = 0, PC_KV = 512, PC_MLQ = 1280, PC_MLK = 1792, PC_MLV = 2304, PC_MLO = 2816, PC_MGA = 3328, PC_MGB = 4352, PC_NSAG = 5376, PC_MLIF = 5400;
constexpr int ADA_SLICES = 16, PB_SLICES = 16;

constexpr size_t MiB = 1u << 20;
constexpr size_t WS_CTL = 0, CTL_ZERO_BYTES = 1 * MiB;
constexpr size_t WS_MODP = 1 * MiB;
constexpr size_t WS_MODF = 3 * MiB;
constexpr size_t WS_PBP  = 3 * MiB + 512 * 1024;
constexpr size_t WS_WIN  = 4 * MiB;
constexpr size_t WS_WUPA = 16 * MiB, WS_WUPB = 17 * MiB;
constexpr size_t WS_WOUT = 18 * MiB;
constexpr size_t WS_CW1K = 20 * MiB, WS_CW1V = 20 * MiB + 512 * 1024;
constexpr size_t WS_CW2K = 21 * MiB, WS_CW2V = 21 * MiB + 64 * 1024;
constexpr size_t WS_KC = 22 * MiB, WS_VC = 22 * MiB + 512 * 1024;
constexpr size_t WS_SELM = 23 * MiB;
constexpr size_t WS_TOPI = 24 * MiB, WS_GATE = 24 * MiB + 256 * 1024, WS_DEST = 24 * MiB + 512 * 1024;
constexpr size_t WS_ROWT = 30 * MiB;
constexpr size_t WS_ROWG = 25 * MiB;
constexpr size_t WS_MLB = 26 * MiB, WS_MLLI = 26 * MiB + 256 * 1024;
constexpr size_t WS_RWHI = 25 * MiB + 512 * 1024, WS_RWLO = 25 * MiB + 768 * 1024;
constexpr size_t WS_MLSC = 27 * MiB;
constexpr size_t WS_MLUN = 28 * MiB, WS_MLN = 29 * MiB;
constexpr size_t WS_W1T = 32 * MiB;
constexpr size_t WS_WIN8 = 96 * MiB;
constexpr size_t WS_A1F8 = 674 * MiB;
constexpr size_t WS_SA = 31 * MiB;
constexpr size_t WS_SW = 31 * MiB + 128 * 1024;
constexpr size_t WS_W2T = 160 * MiB;
constexpr size_t WS_H1 = 224 * MiB;
constexpr size_t WS_A1 = 288 * MiB;
constexpr size_t WS_PROJ = 320 * MiB;
constexpr size_t WS_XG = 320 * MiB;
constexpr size_t WS_OCMP = 496 * MiB, WS_ONSA = 512 * MiB, WS_OML = 528 * MiB, WS_MLQ = 544 * MiB, WS_MLKK = 560 * MiB;
constexpr size_t WS_MLU = 576 * MiB;
constexpr size_t WS_MLC = 640 * MiB;
constexpr size_t WS_U = 674 * MiB;
constexpr size_t WS_ACT = 496 * MiB;
constexpr size_t WS_YR = 640 * MiB;
constexpr size_t WS_END = 784 * MiB;
constexpr int CW_BAR = 4096;
constexpr int CW_ECNT = 16384;
constexpr int CW_EFILL = 16384 + 64 * 32;
constexpr int CW_CMAX = 65536;
constexpr int CW_MOETAB = 32768;

constexpr int RING_BYTES = 131072;
constexpr int LDSCTL_OFF = 146432, MISC_OFF = LDSCTL_OFF + 320;
constexpr int LDS_BYTES = 147456;

#define GAS __attribute__((address_space(1)))
#define LAS __attribute__((address_space(3)))
typedef unsigned short bf16;
typedef unsigned v4u __attribute__((ext_vector_type(4)));
typedef unsigned v2u __attribute__((ext_vector_type(2)));
typedef float f32x4 __attribute__((ext_vector_type(4)));
typedef short bf16x8 __attribute__((ext_vector_type(8)));
typedef short s16x4 __attribute__((ext_vector_type(4)));
#define LDS_WAIT() asm volatile("s_waitcnt lgkmcnt(0)" ::: "memory")
#define VM_WAIT() asm volatile("s_waitcnt vmcnt(0)" ::: "memory")
__device__ __forceinline__ unsigned f2bf(float f) { unsigned u = __builtin_bit_cast(unsigned, f); return (u + 0x7fffu + ((u >> 16) & 1u)) >> 16; }
__device__ __forceinline__ unsigned pk2(float lo, float hi) { return f2bf(lo) | (f2bf(hi) << 16); }
__device__ __forceinline__ unsigned pk4_fp8(float a, float b, float c, float d) { int w = __builtin_amdgcn_cvt_pk_fp8_f32(a, b, 0, false); w = __builtin_amdgcn_cvt_pk_fp8_f32(c, d, w, true); return (unsigned)w; }
__device__ __forceinline__ float bf2f(unsigned short b) { return __builtin_bit_cast(float, (unsigned)b << 16); }
__device__ __forceinline__ float bflo(unsigned w) { return __builtin_bit_cast(float, w << 16); }
__device__ __forceinline__ float bfhi(unsigned w) { return __builtin_bit_cast(float, w & 0xffff0000u); }
__device__ __forceinline__ float sigmoidf_(float x) { return __builtin_amdgcn_rcpf(1.0f + __builtin_amdgcn_exp2f(x * -1.4426950408889634f)); }
__device__ __forceinline__ float wave_sum(float v) {
#pragma unroll
    for (int o = 1; o < 64; o <<= 1) v += __shfl_xor(v, o);
    return v;
}
__device__ __forceinline__ float wave_max(float v) {
#pragma unroll
    for (int o = 1; o < 64; o <<= 1) v = fmaxf(v, __shfl_xor(v, o));
    return v;
}
#define XB_TMO      128
#define XB_XCNT(j)  (256  + 64 * (j))
#define XB_XSUB(j)  (1280 + 64 * (j))
#define XB_XGEN(j)  (2304 + 64 * (j))
#define XB_TOP      3328
#define XB_TOPGEN   3392
#define XCD_BAR_WORDS 3456
#define XB_SPIN_CAP (1u << 18)

__device__ __forceinline__ unsigned xb_ld(unsigned* p)              { return __hip_atomic_load(p, __ATOMIC_RELAXED, __HIP_MEMORY_SCOPE_AGENT); }
__device__ __forceinline__ unsigned xb_add(unsigned* p, unsigned v) { return __hip_atomic_fetch_add(p, v, __ATOMIC_RELAXED, __HIP_MEMORY_SCOPE_AGENT); }
__device__ __forceinline__ unsigned xb_xcc_id() { return (unsigned)__builtin_amdgcn_s_getreg((3 << 11) | 20) & 0xFu; }
#define XB_SPIN(cond, bar) do { unsigned _sp = 0; while (cond) { __builtin_amdgcn_s_sleep(1); \
    if ((++_sp & 255u) == 0u) { if (xb_ld(&(bar)[XB_TMO])) break; if (_sp > XB_SPIN_CAP) { atomicAdd(&(bar)[XB_TMO], 1u); break; } } } } while (0)

struct XcdBarrier {
    unsigned* bar; unsigned x;
    volatile LAS unsigned* st;
};

__device__ __forceinline__ XcdBarrier xcd_barrier_post(unsigned* bar, volatile LAS unsigned* st) {
    XcdBarrier b; b.bar = bar; b.x = xb_xcc_id(); b.st = st;
    if (threadIdx.x == 0) (void)xb_add(&bar[XB_XCNT(b.x)], 1u);
    return b;
}
__device__ __forceinline__ void xcd_barrier_complete(unsigned* bar, unsigned x, unsigned& nloc, unsigned& nx) {
    const unsigned G = gridDim.x * gridDim.y * gridDim.z;
    unsigned sum, cnt, mine, sp = 0u;
    for (;;) {
        sum = 0u; cnt = 0u; mine = 0u;
#pragma unroll
        for (unsigned j = 0; j < 16; ++j) { const unsigned c = xb_ld(&bar[XB_XCNT(j)]); sum += c; cnt += (c > 0u) ? 1u : 0u; mine = (j == x) ? c : mine; }
        if (sum == G) break;
        __builtin_amdgcn_s_sleep(1);
        if ((++sp & 255u) == 0u) { if (xb_ld(&bar[XB_TMO])) break; if (sp > XB_SPIN_CAP) { atomicAdd(&bar[XB_TMO], 1u); break; } }
    }
    nloc = mine > 0u ? mine : 1u; nx = cnt > 0u ? cnt : 1u;
}

__device__ __forceinline__ void xcd_barrier(const XcdBarrier& b) {
    asm volatile("s_waitcnt vmcnt(0)" ::: "memory");
    __syncthreads();
    if (threadIdx.x == 0) {
        unsigned* bar = b.bar;
        __builtin_amdgcn_s_waitcnt(0);
        unsigned nloc = b.st[0], nx = b.st[1];
        if (nloc == 0u) { xcd_barrier_complete(bar, b.x, nloc, nx); b.st[0] = nloc; b.st[1] = nx; }
        const unsigned old = xb_add(&bar[XB_XSUB(b.x)], 1u);
        const unsigned gen = old / nloc;
        if (old + 1u == (gen + 1u) * nloc) {
            __builtin_amdgcn_fence(__ATOMIC_RELEASE, "agent");
            asm volatile("s_waitcnt vmcnt(0)" ::: "memory");
            const unsigned og = xb_add(&bar[XB_TOP], 1u);
            const unsigned tg = og / nx;
            if (og + 1u == (tg + 1u) * nx) xb_add(&bar[XB_TOPGEN], 1u);
            else XB_SPIN(xb_ld(&bar[XB_TOPGEN]) == tg, bar);
            __builtin_amdgcn_fence(__ATOMIC_ACQUIRE, "agent");
            xb_add(&bar[XB_XGEN(b.x)], 1u);
            asm volatile("s_waitcnt vmcnt(0)" ::: "memory");
        } else {
            XB_SPIN(xb_ld(&bar[XB_XGEN(b.x)]) == gen, bar);
            __builtin_amdgcn_fence(__ATOMIC_ACQUIRE, "agent");
            asm volatile("s_waitcnt vmcnt(0)" ::: "memory");
        }
    }
    __syncthreads();
}

using pg8::Unit; using pg8::HALF; using pg8::BM;
struct EpiStoreBf16 {
    static constexpr bool PERM = true, AFTER_DRAIN = false;
    bf16* O; int ldc;
    __device__ __forceinline__ void operator()(const f32x4 (&acc)[2][2][4][2], const Unit& u, int wr, int wc, int fr, int fq) const {
        const int row0 = u.pm * BM + wr * 64 + fr, col0 = u.pn * BM + wc * 32 + 8 * fq;
#pragma unroll
        for (int ai = 0; ai < 2; ++ai)
#pragma unroll
            for (int m = 0; m < 4; ++m) { bf16* rowp = O + (size_t)(row0 + ai * HALF + m * 16) * ldc + col0;
#pragma unroll
                for (int bj = 0; bj < 2; ++bj) { const f32x4 v0 = acc[ai][bj][m][0], v1 = acc[ai][bj][m][1];
                    v4u w; w.x = pg8::cvt_pk_bf16(v0[0], v0[1]); w.y = pg8::cvt_pk_bf16(v0[2], v0[3]); w.z = pg8::cvt_pk_bf16(v1[0], v1[1]); w.w = pg8::cvt_pk_bf16(v1[2], v1[3]);
                    *(v4u*)(rowp + bj * HALF) = w; } }
    }
};
struct EpiStoreScaled {
    static constexpr bool PERM = true, AFTER_DRAIN = false;
    bf16* O; int ldc; const float* sa; const float* sw;
    __device__ __forceinline__ void operator()(const f32x4 (&acc)[2][2][4][2], const Unit& u, int wr, int wc, int fr, int fq) const {
        const int row0 = u.pm * BM + wr * 64 + fr, col0 = u.pn * BM + wc * 32 + 8 * fq;
        f32x4 cs[2][2];
#pragma unroll
        for (int bj = 0; bj < 2; ++bj)
#pragma unroll
            for (int n = 0; n < 2; ++n) cs[bj][n] = *(const f32x4*)(sw + col0 + bj * HALF + 4 * n);
#pragma unroll
        for (int ai = 0; ai < 2; ++ai)
#pragma unroll
            for (int m = 0; m < 4; ++m) { const int row = row0 + ai * HALF + m * 16; const float rsc = sa[row]; bf16* rowp = O + (size_t)row * ldc + col0;
#pragma unroll
                for (int bj = 0; bj < 2; ++bj) { const f32x4 v0 = acc[ai][bj][m][0] * cs[bj][0] * rsc, v1 = acc[ai][bj][m][1] * cs[bj][1] * rsc;
                    v4u w; w.x = pk2(v0[0], v0[1]); w.y = pk2(v0[2], v0[3]); w.z = pk2(v1[0], v1[1]); w.w = pk2(v1[2], v1[3]);
                    *(v4u*)(rowp + bj * HALF) = w; } }
    }
};
template <bool ADD> struct EpiUpGate {
    static constexpr bool PERM = true, AFTER_DRAIN = false;
    bf16* U; const bf16* G; int goff;
    __device__ __forceinline__ void operator()(const f32x4 (&acc)[2][2][4][2], const Unit& u, int wr, int wc, int fr, int fq) const {
        const int row0 = u.pm * BM + wr * 64 + fr, col0 = u.pn * BM + wc * 32 + 8 * fq;
#pragma unroll
        for (int ai = 0; ai < 2; ++ai)
#pragma unroll
            for (int m = 0; m < 4; ++m) { const size_t row = (size_t)(row0 + ai * HALF + m * 16);
#pragma unroll
                for (int bj = 0; bj < 2; ++bj) { const int col = col0 + bj * HALF;
                    const v4u gw = *(const v4u*)(G + row * PW + goff + col);
                    f32x4 v0 = acc[ai][bj][m][0], v1 = acc[ai][bj][m][1];
                    v0[0] *= sigmoidf_(bflo(gw.x)); v0[1] *= sigmoidf_(bfhi(gw.x)); v0[2] *= sigmoidf_(bflo(gw.y)); v0[3] *= sigmoidf_(bfhi(gw.y));
                    v1[0] *= sigmoidf_(bflo(gw.z)); v1[1] *= sigmoidf_(bfhi(gw.z)); v1[2] *= sigmoidf_(bflo(gw.w)); v1[3] *= sigmoidf_(bfhi(gw.w));
                    if (ADD) { const v4u uw = *(const v4u*)(U + row * DM + col);
                        v0[0] += bflo(uw.x); v0[1] += bfhi(uw.x); v0[2] += bflo(uw.y); v0[3] += bfhi(uw.y); v1[0] += bflo(uw.z); v1[1] += bfhi(uw.z); v1[2] += bflo(uw.w); v1[3] += bfhi(uw.w); }
                    v4u w; w.x = pg8::cvt_pk_bf16(v0[0], v0[1]); w.y = pg8::cvt_pk_bf16(v0[2], v0[3]); w.z = pg8::cvt_pk_bf16(v1[0], v1[1]); w.w = pg8::cvt_pk_bf16(v1[2], v1[3]);
                    *(v4u*)(U + row * DM + col) = w; } }
    }
};
struct EpiOutRes {
    static constexpr bool PERM = true, AFTER_DRAIN = false;
    const float* X; bf16* H; const float* modf;
    __device__ __forceinline__ void operator()(const f32x4 (&acc)[2][2][4][2], const Unit& u, int wr, int wc, int fr, int fq) const {
        const int row0 = u.pm * BM + wr * 64 + fr, col0 = u.pn * BM + wc * 32 + 8 * fq;
        const int b = (u.pm * BM) / SEQ; const float* gt = modf + (size_t)b * 6 * DM + 2 * DM;
        f32x4 gv[2][2];
#pragma unroll
        for (int bj = 0; bj < 2; ++bj)
#pragma unroll
            for (int n = 0; n < 2; ++n) gv[bj][n] = *(const f32x4*)(gt + col0 + bj * HALF + 4 * n) + 1.0f;
#pragma unroll
        for (int ai = 0; ai < 2; ++ai)
#pragma unroll
            for (int m = 0; m < 4; ++m) { const size_t off = (size_t)(row0 + ai * HALF + m * 16) * DM + col0;
#pragma unroll
                for (int bj = 0; bj < 2; ++bj) { const f32x4 x0 = *(const f32x4*)(X + off + bj * HALF), x1 = *(const f32x4*)(X + off + bj * HALF + 4);
                    const f32x4 v0 = x0 + gv[bj][0] * acc[ai][bj][m][0], v1 = x1 + gv[bj][1] * acc[ai][bj][m][1];
                    v4u w; w.x = pk2(v0[0], v0[1]); w.y = pk2(v0[2], v0[3]); w.z = pk2(v1[0], v1[1]); w.w = pk2(v1[2], v1[3]);
                    *(v4u*)(H + off + bj * HALF) = w; } }
    }
};
struct EpiMoe1 {
    static constexpr bool PERM = true, AFTER_DRAIN = false;
    unsigned char* ACT; const LAS float* bt;
    __device__ __forceinline__ void operator()(const f32x4 (&acc)[2][2][4][2], const Unit& u, int wr, int wc, int fr, int fq) const {
        const int e = u.pn >> 3, pnl = u.pn & 7;
        const int row0 = u.pm * BM + wr * 64 + fr, c0 = pnl * 128 + wc * 32 + 8 * fq;
        const LAS float* bg = bt + u.ix * 256 + wc * 32 + 8 * fq; const LAS float* bl = bg + 128; (void)e;
        const f32x4 bg0 = *(const LAS f32x4*)bg, bg1 = *(const LAS f32x4*)(bg + 4), bl0 = *(const LAS f32x4*)bl, bl1 = *(const LAS f32x4*)(bl + 4);
#pragma unroll
        for (int ai = 0; ai < 2; ++ai)
#pragma unroll
            for (int m = 0; m < 4; ++m) { unsigned char* rowp = ACT + (size_t)(row0 + ai * HALF + m * 16) * DE + c0;
                float o[8];
#pragma unroll
                for (int n = 0; n < 2; ++n) { const f32x4 g = acc[ai][0][m][n] + (n ? bg1 : bg0), l = acc[ai][1][m][n] + (n ? bl1 : bl0);
#pragma unroll
                    for (int i = 0; i < 4; ++i) { const float gg = fminf(g[i], 7.0f), ll = fminf(fmaxf(l[i], -7.0f), 7.0f);
                        o[n * 4 + i] = gg * sigmoidf_(1.702f * gg) * (ll + 1.0f); } }
                v2u w; w.x = pk4_fp8(o[0], o[1], o[2], o[3]); w.y = pk4_fp8(o[4], o[5], o[6], o[7]);
                *(v2u*)rowp = w; }
    }
};
struct EpiMoe2 {
    static constexpr bool PERM = true, AFTER_DRAIN = false;
    unsigned char* Y; const LAS float* bt;
    __device__ __forceinline__ void operator()(const f32x4 (&acc)[2][2][4][2], const Unit& u, int wr, int wc, int fr, int fq) const {
        const int pnl = u.pn & 3;
        const int row0 = u.pm * BM + wr * 64 + fr, col0 = pnl * BM + wc * 32 + 8 * fq;
        f32x4 bv[2][2];
#pragma unroll
        for (int bj = 0; bj < 2; ++bj)
#pragma unroll
            for (int n = 0; n < 2; ++n) bv[bj][n] = *(const LAS f32x4*)(bt + u.ix * 512 + wc * 32 + 8 * fq + bj * HALF + 4 * n);
#pragma unroll
        for (int ai = 0; ai < 2; ++ai)
#pragma unroll
            for (int m = 0; m < 4; ++m) { const int row = row0 + ai * HALF + m * 16; const float g = bt[u.ix * 512 + 256 + wr * 64 + fr + ai * HALF + m * 16] * 16.0f; unsigned char* rowp = Y + (size_t)row * DM + col0;
#pragma unroll
                for (int bj = 0; bj < 2; ++bj) { const f32x4 v0 = (acc[ai][bj][m][0] + bv[bj][0]) * g, v1 = (acc[ai][bj][m][1] + bv[bj][1]) * g;
                    v2u w; w.x = pk4_fp8(v0[0], v0[1], v0[2], v0[3]); w.y = pk4_fp8(v1[0], v1[1], v1[2], v1[3]);
                    *(v2u*)(rowp + bj * HALF) = w; } }
    }
};
constexpr int MOE_UL_OFF = 145408;
struct MoeOrder {
    const LAS int* ul; const int* rowtok;
    __device__ __forceinline__ bool next(int i, Unit& u) const { const int pm = ul[2 * i]; if (pm < 0) return false; u.pm = pm; u.pn = ul[2 * i + 1]; u.ix = i; return true; }
    __device__ __forceinline__ void a_ready(const Unit&) const {}
    __device__ __forceinline__ void done(const Unit&) const {}
};
constexpr int MOE_BT1_OFF = 135680, MOE_BT2_OFF = 131072;
template <int WHICH> __device__ __forceinline__ void moe_units_to_lds(LAS unsigned char* lds, const unsigned* tab, int nN, int sh, int G, int v, const float* bias, const float* rg) {
    LAS int* ul = (LAS int*)(lds + MOE_UL_OFF);
    __syncthreads();
    if (threadIdx.x < 16) { const int i = threadIdx.x; const int ntl = (int)tab[0]; const long L = (long)i * G + v; int pm = -1, pn = 0;
        if (L < (long)ntl * nN) { pm = (int)(L >> sh); const int e = (int)tab[64 + pm]; pn = e * nN + (int)(L & (nN - 1)); }
        ul[2 * i] = pm; ul[2 * i + 1] = pn; }
    __syncthreads();
    { float val[9]; const int t = threadIdx.x;
#pragma unroll
      for (int i = 0; i < 9; ++i) { const int pm = ul[2 * i], pn = ul[2 * i + 1]; val[i] = 0.f;
          if (pm >= 0) { if (WHICH == 1) { if (t < 256) { const int e = pn >> 3, pnl = pn & 7; val[i] = bias[(size_t)e * 2048 + (t < 128 ? 128 * pnl + t : 1024 + 128 * pnl + (t - 128))]; } }
                         else { const int e = pn >> 2, pnl = pn & 3; val[i] = t < 256 ? bias[(size_t)e * DM + 256 * pnl + t] : rg[(size_t)pm * 256 + (t - 256)]; } } }
#pragma unroll
      for (int i = 0; i < 9; ++i) { if (WHICH == 1) { if (t < 256) ((LAS float*)(lds + MOE_BT1_OFF))[i * 256 + t] = val[i]; } else if (i < 5) ((LAS float*)(lds + MOE_BT2_OFF))[i * 512 + t] = val[i]; } }
    __syncthreads();
}


struct Args { const float* in[27]; float* out; unsigned char* ws; int ph_lo, ph_hi; };
struct Ctx {
    LAS unsigned char* lds; unsigned char* ws; unsigned* ctl;
    int tid, lane, wave, vcu, G;
    const float* const* in; float* out;
};
enum { I_X = 0, I_C, I_ADAW, I_ADAB, I_N1G, I_WIN, I_PEK, I_PEV, I_CW1K, I_CW2K, I_CW1V, I_CW2V, I_CONVW, I_CONVB, I_GATEB, I_MLNG, I_WUPA, I_WUPB, I_WOUT, I_N2G, I_RW, I_RB, I_EW1, I_EB1, I_EW2, I_EB2, I_FG };

template <class DMap>
__device__ __forceinline__ void p0_transpose_item(const float* W, int K, int N, bf16* WT, const DMap& dmap, LAS float* scr, int item, int lane) {
    const int nblk = N / 32, kb = item / nblk, nb = item % nblk, k0 = 64 * kb, n0 = 32 * nb;
    float tmp[16];
#pragma unroll
    for (int hh = 0; hh < 2; ++hh) {
#pragma unroll
    for (int i = 0; i < 16; ++i) tmp[i] = W[(size_t)(k0 + 2 * (16 * hh + i) + (lane >> 5)) * N + n0 + (lane & 31)];
#pragma unroll
    for (int i = 0; i < 16; ++i) scr[(2 * (16 * hh + i) + (lane >> 5)) * 33 + (lane & 31)] = tmp[i]; }
    LDS_WAIT(); asm volatile("" ::: "memory");
    const int c = lane & 7;
#pragma unroll
    for (int j = 0; j < 4; ++j) { const int n = (lane >> 3) + 8 * j; const LAS float* s = scr + (8 * c) * 33 + n;
        v4u o; o.x = pk2(s[0 * 33], s[1 * 33]); o.y = pk2(s[2 * 33], s[3 * 33]); o.z = pk2(s[4 * 33], s[5 * 33]); o.w = pk2(s[6 * 33], s[7 * 33]);
        *(GAS v4u*)(WT + (size_t)dmap(n0 + n) * K + k0 + 8 * c) = o; }
    LDS_WAIT(); asm volatile("" ::: "memory");
}
struct DMapId { __device__ __forceinline__ int operator()(int n) const { return n; } };
struct DMapWin { __device__ __forceinline__ int operator()(int n) const {
    if (n < 1280) return n;
    if (n < 1304) return PC_NSAG + (n - 1280);
    if (n < 2328) return PC_MLQ + (n - 1304);
    if (n < 2840) return PC_MLV + (n - 2328);
    if (n < 2848) return PC_MLIF + (n - 2840);
    if (n < 3360) return PC_MLO + (n - 2848);
    return PC_MGA + (n - 3360); } };
struct DMapW1 { __device__ __forceinline__ int operator()(int n) const { return n < 1024 ? ((n >> 7) << 8) + (n & 127) : (((n - 1024) >> 7) << 8) + 128 + (n & 127); } };

constexpr int MOE_I1 = (DM / 128) * (2048 / 256), MOE_I2 = (DE / 128) * (DM / 256), MOE_ITEMS = NEXP * (MOE_I1 + MOE_I2);
struct MoeItem { const float* src; unsigned char* dst; int N; bool w1; };
__device__ __forceinline__ MoeItem moe_item(const Ctx& F, int it) {
    MoeItem m;
    if (it < NEXP * MOE_I1) { const int e = it / MOE_I1, l = it % MOE_I1, kb = l >> 3, nb = l & 7; m.w1 = true; m.N = 2048 | (nb << 16);
        m.src = F.in[I_EW1] + (size_t)e * DM * 2048 + (size_t)(128 * kb) * 2048 + 256 * nb; m.dst = F.ws + WS_W1T + (size_t)e * 2048 * DM + 128 * kb; }
    else { const int r = it - NEXP * MOE_I1, e = r / MOE_I2, l = r % MOE_I2, kb = l >> 2, nb = l & 3; m.w1 = false; m.N = DM | (nb << 16);
        m.src = F.in[I_EW2] + (size_t)e * DE * DM + (size_t)(128 * kb) * DM + 256 * nb; m.dst = F.ws + WS_W2T + (size_t)e * DM * DE + 128 * kb; }
    return m;
}
__device__ __forceinline__ void moe_load_item(const Ctx& F, int it, f32x4 (&r)[16]) {
    const MoeItem m = moe_item(F, it); const int N = m.N & 0xffff;
#pragma unroll
    for (int i = 0; i < 16; ++i) r[i] = *(const f32x4*)(m.src + (size_t)(16 * F.wave + i) * N + 4 * F.lane);
}
__device__ __forceinline__ void moe_emit_item(Ctx& F, int it, const f32x4 (&r)[16]) {
    LAS float* tile = (LAS float*)F.lds; const int wave = F.wave, lane = F.lane;
    const MoeItem m = moe_item(F, it); const int nb = m.N >> 16;
    __syncthreads();
#pragma unroll
    for (int i = 0; i < 16; ++i) *(LAS f32x4*)(tile + (16 * wave + i) * 260 + 4 * lane) = r[i] * 32.0f;
    __syncthreads();
    const int n = 32 * wave + (lane >> 1), kh = (lane & 1) * 64; const LAS float* s = tile + kh * 260 + n;
    const int ng = 256 * nb + n; const int drow = m.w1 ? DMapW1()(ng) : ng;
    unsigned char* dst = m.dst + (size_t)drow * DM + kh;
#pragma unroll
    for (int i = 0; i < 4; ++i) { v4u o;
        o.x = pk4_fp8(s[(16 * i + 0) * 260], s[(16 * i + 1) * 260], s[(16 * i + 2) * 260], s[(16 * i + 3) * 260]); o.y = pk4_fp8(s[(16 * i + 4) * 260], s[(16 * i + 5) * 260], s[(16 * i + 6) * 260], s[(16 * i + 7) * 260]);
        o.z = pk4_fp8(s[(16 * i + 8) * 260], s[(16 * i + 9) * 260], s[(16 * i + 10) * 260], s[(16 * i + 11) * 260]); o.w = pk4_fp8(s[(16 * i + 12) * 260], s[(16 * i + 13) * 260], s[(16 * i + 14) * 260], s[(16 * i + 15) * 260]);
        *(GAS v4u*)(dst + 16 * i) = o; }
}
__device__ __forceinline__ void moe_convert(Ctx& F, int first, int stride) {
    f32x4 b0[16], b1[16], b2[16];
    if (first >= MOE_ITEMS) return;
    moe_load_item(F, first, b0);
    if (first + stride < MOE_ITEMS) moe_load_item(F, first + stride, b1);
#pragma unroll 1
    for (int it = first; it < MOE_ITEMS; it += 3 * stride) {
        if (it + 2 * stride < MOE_ITEMS) moe_load_item(F, it + 2 * stride, b2);
        moe_emit_item(F, it, b0);
        if (it + stride >= MOE_ITEMS) break;
        if (it + 3 * stride < MOE_ITEMS) moe_load_item(F, it + 3 * stride, b0);
        moe_emit_item(F, it + stride, b1);
        if (it + 2 * stride >= MOE_ITEMS) break;
        if (it + 4 * stride < MOE_ITEMS) moe_load_item(F, it + 4 * stride, b1);
        moe_emit_item(F, it + 2 * stride, b2);
    }
    __syncthreads();
}
template <class DMap>
__device__ __forceinline__ void p0_transpose_item_f8(const float* W, int K, int N, unsigned char* WT, const DMap& dmap, LAS float* scr, int item, int lane) {
    const int nblk = N / 32, kb = item / nblk, nb = item % nblk, k0 = 128 * kb, n0 = 32 * nb;
    const int lr = lane >> 3, c4 = lane & 7;
    f32x4 tmp[16];
#pragma unroll
    for (int i = 0; i < 16; ++i) tmp[i] = *(const f32x4*)(W + (size_t)(k0 + 8 * i + lr) * N + n0 + 4 * c4);
    const int n = lane >> 1, kq = (lane & 1) * 32;
    unsigned char* dst = WT + (size_t)dmap(n0 + n) * K + k0 + kq;
#pragma unroll
    for (int hh = 0; hh < 2; ++hh) {
#pragma unroll
        for (int i = 0; i < 8; ++i) *(LAS f32x4*)(scr + (8 * i + lr) * 36 + 4 * c4) = tmp[8 * hh + i] * 32.0f;
        LDS_WAIT(); asm volatile("" ::: "memory");
        const LAS float* s = scr + kq * 36 + n;
#pragma unroll
        for (int i = 0; i < 2; ++i) { v4u o;
            o.x = pk4_fp8(s[(16 * i + 0) * 36], s[(16 * i + 1) * 36], s[(16 * i + 2) * 36], s[(16 * i + 3) * 36]); o.y = pk4_fp8(s[(16 * i + 4) * 36], s[(16 * i + 5) * 36], s[(16 * i + 6) * 36], s[(16 * i + 7) * 36]);
            o.z = pk4_fp8(s[(16 * i + 8) * 36], s[(16 * i + 9) * 36], s[(16 * i + 10) * 36], s[(16 * i + 11) * 36]); o.w = pk4_fp8(s[(16 * i + 12) * 36], s[(16 * i + 13) * 36], s[(16 * i + 14) * 36], s[(16 * i + 15) * 36]);
            *(GAS v4u*)(dst + 64 * hh + 16 * i) = o; }
        LDS_WAIT(); asm volatile("" ::: "memory");
    }
}
template <class DMap>
__device__ __forceinline__ void p0_colmax_item(const float* W, int N, unsigned* cmax, const DMap& dmap, int item, int lane) {
    const int nblk = N / 32, kb = item / nblk, nb = item % nblk, k0 = 64 * kb, n0 = 32 * nb;
    float tmp[32];
#pragma unroll
    for (int i = 0; i < 32; ++i) tmp[i] = W[(size_t)(k0 + 2 * i + (lane >> 5)) * N + n0 + (lane & 31)];
    float m = 0.f;
#pragma unroll
    for (int i = 0; i < 32; ++i) m = fmaxf(m, fabsf(tmp[i]));
    m = fmaxf(m, __shfl_xor(m, 32));
    if (lane < 32) atomicMax(cmax + dmap(n0 + lane), __float_as_uint(m));
}
__device__ __forceinline__ unsigned pk4_i8(float a, float b, float c, float d) {
    return (unsigned)(__float2int_rn(a) & 0xff) | ((unsigned)(__float2int_rn(b) & 0xff) << 8) | ((unsigned)(__float2int_rn(c) & 0xff) << 16) | ((unsigned)__float2int_rn(d) << 24);
}
template <class DMap>
__device__ __forceinline__ void p1_quant_item_i8(const float* W, int K, int N, unsigned char* WT, float* sw, const unsigned* cmax, const DMap& dmap, LAS float* scr, int item, int lane) {
    const int nblk = N / 32, kb = item / nblk, nb = item % nblk, k0 = 128 * kb, n0 = 32 * nb;
    const int lr = lane >> 3, c4 = lane & 7;
    f32x4 tmp[16];
#pragma unroll
    for (int i = 0; i < 16; ++i) tmp[i] = *(const f32x4*)(W + (size_t)(k0 + 8 * i + lr) * N + n0 + 4 * c4);
    f32x4 inv;
#pragma unroll
    for (int j = 0; j < 4; ++j) { const float cm = __uint_as_float(cmax[dmap(n0 + 4 * c4 + j)]); inv[j] = cm > 0.f ? 127.0f / cm : 0.f; }
    if (kb == 0 && lane < 32) { const int d = dmap(n0 + lane); sw[d] = __uint_as_float(cmax[d]) * (1.0f / 127.0f); }
    const int n = lane >> 1, kq = (lane & 1) * 32;
    unsigned char* dst = WT + (size_t)dmap(n0 + n) * K + k0 + kq;
#pragma unroll
    for (int hh = 0; hh < 2; ++hh) {
#pragma unroll
        for (int i = 0; i < 8; ++i) *(LAS f32x4*)(scr + (8 * i + lr) * 36 + 4 * c4) = tmp[8 * hh + i] * inv;
        LDS_WAIT(); asm volatile("" ::: "memory");
        const LAS float* s = scr + kq * 36 + n;
#pragma unroll
        for (int i = 0; i < 2; ++i) { v4u o;
            o.x = pk4_i8(s[(16 * i + 0) * 36], s[(16 * i + 1) * 36], s[(16 * i + 2) * 36], s[(16 * i + 3) * 36]); o.y = pk4_i8(s[(16 * i + 4) * 36], s[(16 * i + 5) * 36], s[(16 * i + 6) * 36], s[(16 * i + 7) * 36]);
            o.z = pk4_i8(s[(16 * i + 8) * 36], s[(16 * i + 9) * 36], s[(16 * i + 10) * 36], s[(16 * i + 11) * 36]); o.w = pk4_i8(s[(16 * i + 12) * 36], s[(16 * i + 13) * 36], s[(16 * i + 14) * 36], s[(16 * i + 15) * 36]);
            *(GAS v4u*)(dst + 64 * hh + 16 * i) = o; }
        LDS_WAIT(); asm volatile("" ::: "memory");
    }
}
__device__ __forceinline__ void p0_prologue(Ctx& F) {
    LAS float* scr = (LAS float*)(F.lds + F.wave * 16896);
    const int gw = F.vcu * NWAVES + F.wave, NGW = F.G * NWAVES;
    constexpr int I_IN = (DM / 64) * (INW / 32), I_UP = (512 / 64) * (DM / 32), I_OUT = (DM / 64) * (DM / 32), I_C1 = (2048 / 64) * (128 / 32), I_C2 = (128 / 64) * (64 / 32);
    constexpr int NITEMS = I_IN + 2 * I_UP + I_OUT + 2 * I_C1 + 2 * I_C2;
    for (int it = gw; it < NITEMS; it += NGW) {
        int r = it;
        if (r < I_IN) { p0_colmax_item(F.in[I_WIN], INW, F.ctl + CW_CMAX, DMapWin(), r, F.lane); continue; } r -= I_IN;
        if (r < I_UP) { p0_transpose_item(F.in[I_WUPA], 512, DM, (bf16*)(F.ws + WS_WUPA), DMapId(), scr, r, F.lane); continue; } r -= I_UP;
        if (r < I_UP) { p0_transpose_item(F.in[I_WUPB], 512, DM, (bf16*)(F.ws + WS_WUPB), DMapId(), scr, r, F.lane); continue; } r -= I_UP;
        if (r < I_OUT) { p0_transpose_item(F.in[I_WOUT], DM, DM, (bf16*)(F.ws + WS_WOUT), DMapId(), scr, r, F.lane); continue; } r -= I_OUT;
        if (r < I_C1) { p0_transpose_item(F.in[I_CW1K], 2048, 128, (bf16*)(F.ws + WS_CW1K), DMapId(), scr, r, F.lane); continue; } r -= I_C1;
        if (r < I_C1) { p0_transpose_item(F.in[I_CW1V], 2048, 128, (bf16*)(F.ws + WS_CW1V), DMapId(), scr, r, F.lane); continue; } r -= I_C1;
        if (r < I_C2) { p0_transpose_item(F.in[I_CW2K], 128, 64, (bf16*)(F.ws + WS_CW2K), DMapId(), scr, r, F.lane); continue; } r -= I_C2;
        { p0_transpose_item(F.in[I_CW2V], 128, 64, (bf16*)(F.ws + WS_CW2V), DMapId(), scr, r, F.lane); }
    }
    __syncthreads();
    {
        const int gt = F.vcu * NTHREADS + F.tid, NGT = F.G * NTHREADS;
        const float* c = F.in[I_C]; const float* aw = F.in[I_ADAW]; float* modp = (float*)(F.ws + WS_MODP);
        for (int w = gt; w < ADA_SLICES * 6144; w += NGT) {
            const int s = w / 6144, j = w % 6144; float a0 = 0.f, a1 = 0.f, a2 = 0.f, a3 = 0.f;
#pragma unroll 8
            for (int kk = 0; kk < 64; ++kk) { const int k = s * 64 + kk; const float wv = aw[(size_t)k * 6144 + j];
                const float c0 = c[k], c1 = c[DM + k], c2 = c[2 * DM + k], c3 = c[3 * DM + k];
                a0 += c0 * sigmoidf_(c0) * wv; a1 += c1 * sigmoidf_(c1) * wv; a2 += c2 * sigmoidf_(c2) * wv; a3 += c3 * sigmoidf_(c3) * wv; }
            modp[(size_t)(s * 4 + 0) * 6144 + j] = a0; modp[(size_t)(s * 4 + 1) * 6144 + j] = a1; modp[(size_t)(s * 4 + 2) * 6144 + j] = a2; modp[(size_t)(s * 4 + 3) * 6144 + j] = a3;
        }
        { const float* rw = F.in[I_RW]; bf16* rwhi = (bf16*)(F.ws + WS_RWHI); bf16* rwlo = (bf16*)(F.ws + WS_RWLO);
          for (int w = gt; w < DM * NEXP; w += NGT) { const int e = w >> 10, k = w & 1023; const float x = rw[k * NEXP + e]; const unsigned h = f2bf(x); rwhi[w] = (bf16)h; rwlo[w] = (bf16)f2bf(x - bf2f((unsigned short)h)); } }
        float* pbp = (float*)(F.ws + WS_PBP);
        for (int w = gt; w < PB_SLICES * 2 * 128; w += NGT) {
            const int s = w / 256, kv = (w >> 7) & 1, j = w & 127; const float* pe = F.in[kv ? I_PEV : I_PEK]; const float* w1 = F.in[kv ? I_CW1V : I_CW1K]; float a = 0.f;
#pragma unroll 8
            for (int ii = 0; ii < 128; ++ii) { const int i = s * 128 + ii; a += pe[i] * w1[(size_t)i * 128 + j]; }
            pbp[w] = a;
        }
    }
}

template <bool WITH_MOE>
__device__ __forceinline__ void p_final(Ctx& F, const bf16* H, const float* modf) {
    const unsigned char* Y = F.ws + WS_YR; const int* dest = (const int*)(F.ws + WS_DEST);
    const float* fg = F.in[I_FG];
    f32x4 g[4];
#pragma unroll
    for (int j = 0; j < 4; ++j) g[j] = *(const f32x4*)(fg + 4 * F.lane + 256 * j);
    for (int blk = F.vcu; blk < T / 64; blk += F.G) {
        const int b = (blk * 64) / SEQ, t0 = blk * 64 + F.wave * 8; const float* gt = modf + (size_t)b * 6 * DM + 5 * DM;
        f32x4 gg[4];
#pragma unroll
        for (int j = 0; j < 4; ++j) gg[j] = *(const f32x4*)(gt + 4 * F.lane + 256 * j) + 1.0f;
        int4 dd[8];
#pragma unroll
        for (int i = 0; i < 8; ++i) dd[i] = WITH_MOE ? *(const int4*)(dest + (t0 + i) * 4) : make_int4(0, 0, 0, 0);
#pragma unroll
        for (int i = 0; i < 8; ++i) {
            f32x4 v[4]; unsigned y[4][4]; const int t = t0 + i;
#pragma unroll
            for (int j = 0; j < 4; ++j) { const v2u hw = *(const v2u*)(H + (size_t)t * DM + 4 * F.lane + 256 * j); v[j] = (f32x4){bflo(hw.x), bfhi(hw.x), bflo(hw.y), bfhi(hw.y)}; }
            if (WITH_MOE) {
#pragma unroll
                for (int j = 0; j < 4; ++j) { y[0][j] = *(const unsigned*)(Y + (size_t)dd[i].x * DM + 4 * F.lane + 256 * j); y[1][j] = *(const unsigned*)(Y + (size_t)dd[i].y * DM + 4 * F.lane + 256 * j);
                    y[2][j] = *(const unsigned*)(Y + (size_t)dd[i].z * DM + 4 * F.lane + 256 * j); y[3][j] = *(const unsigned*)(Y + (size_t)dd[i].w * DM + 4 * F.lane + 256 * j); } }
            float ss = 0.f;
#pragma unroll
            for (int j = 0; j < 4; ++j) { f32x4 m = (f32x4){0.f, 0.f, 0.f, 0.f};
                if (WITH_MOE) {
#pragma unroll
                    for (int k = 0; k < TOPK; ++k) { const pg8::f32x2 lo = __builtin_amdgcn_cvt_pk_f32_fp8((int)y[k][j], false), hi = __builtin_amdgcn_cvt_pk_f32_fp8((int)y[k][j], true); m[0] += lo.x; m[1] += lo.y; m[2] += hi.x; m[3] += hi.y; } }
                v[j] = v[j] + gg[j] * m * 0.0625f;
                ss += (v[j][0] * v[j][0] + v[j][1] * v[j][1]) + (v[j][2] * v[j][2] + v[j][3] * v[j][3]); }
            const float rs = rsqrtf(wave_sum(ss) * (1.0f / DM) + NORM_EPS);
#pragma unroll
            for (int j = 0; j < 4; ++j) *(f32x4*)(F.out + (size_t)t * DM + 4 * F.lane + 256 * j) = v[j] * rs * g[j];
        }
    }
}

__device__ __forceinline__ f32x4 mfma16(bf16x8 a, bf16x8 b, f32x4 c) { return __builtin_amdgcn_mfma_f32_16x16x32_bf16(a, b, c, 0, 0, 0); }
typedef short v4i16_t __attribute__((ext_vector_type(4)));
__device__ __forceinline__ s16x4 lds_tr4(const LAS unsigned char* p) { return __builtin_bit_cast(s16x4, __builtin_amdgcn_ds_read_tr16_b64_v4i16((LAS v4i16_t*)p)); }
__device__ __forceinline__ bf16x8 tr_frag(const LAS unsigned char* img, int sb, int r0, int r1, int n0, int lane) {
    const int q = (lane & 15) >> 2, p = lane & 3;
    const s16x4 lo = lds_tr4(img + (r0 + q) * sb + (n0 + 4 * p) * 2), hi = lds_tr4(img + (r1 + q) * sb + (n0 + 4 * p) * 2);
    return (bf16x8){lo[0], lo[1], lo[2], lo[3], hi[0], hi[1], hi[2], hi[3]};
}
__device__ __forceinline__ bf16x8 lds_row8(const LAS unsigned char* img, int sb, int row, int col) { return *(const LAS bf16x8*)(img + row * sb + col * 2); }
__device__ __forceinline__ bf16x8 pack8(const f32x4 a, const f32x4 b) {
    v4u w; w.x = pg8::cvt_pk_bf16(a[0], a[1]); w.y = pg8::cvt_pk_bf16(a[2], a[3]); w.z = pg8::cvt_pk_bf16(b[0], b[1]); w.w = pg8::cvt_pk_bf16(b[2], b[3]);
    return __builtin_bit_cast(bf16x8, w);
}
__device__ __forceinline__ float grp_max(float v) { v = fmaxf(v, __shfl_xor(v, 16)); return fmaxf(v, __shfl_xor(v, 32)); }
__device__ __forceinline__ float grp_sum(float v) { v += __shfl_xor(v, 16); return v + __shfl_xor(v, 32); }
constexpr float NEG_BIG = -1.0e30f;
constexpr float LOG2E = 1.4426950408889634f;
constexpr int KV_SB = 144;
constexpr int W128_SB = 272;

__device__ __forceinline__ float max3f(float a, float b, float c) { return __builtin_fmaxf(__builtin_fmaxf(a, b), c); }
template <int MODE, bool EDGE>
__device__ __forceinline__ void nsa_tile(const LAS unsigned char* Kb, const LAS unsigned char* Vb, int j, int qb, int lane, int gq, int th, const bf16x8 (&qf)[2][2], const unsigned long long (&selm)[2],
                                         f32x4 (&ot)[2][4], float (&lsum)[2], float (&mrun)[2]) {
    f32x4 s[2][4];
#pragma unroll
    for (int kb = 0; kb < 4; ++kb) { const bf16x8 k0 = lds_row8(Kb, KV_SB, 16 * kb + (lane & 15), 8 * gq), k1 = lds_row8(Kb, KV_SB, 16 * kb + (lane & 15), 32 + 8 * gq);
#pragma unroll
        for (int qi = 0; qi < 2; ++qi) { f32x4 a = (f32x4){0.f, 0.f, 0.f, 0.f}; a = mfma16(k0, qf[qi][0], a); a = mfma16(k1, qf[qi][1], a); s[qi][kb] = a; } }
#pragma unroll
    for (int qi = 0; qi < 2; ++qi) {
        bool rowok = true; if (MODE == 0) rowok = (selm[qi] >> j) & 1ull;
        if (EDGE) { const int i = th * 32 + qi * 16 + (lane & 15);
#pragma unroll
            for (int kb = 0; kb < 4; ++kb)
#pragma unroll
                for (int r = 0; r < 4; ++r) { const int kvl = 16 * kb + 4 * gq + r; bool ok;
                    if (MODE == 0) ok = kvl <= i; else { const int rel = (qb - j) * 64 + i - kvl; ok = rel >= 0 && rel < 512; }
                    s[qi][kb][r] = ok ? s[qi][kb][r] : NEG_BIG; } }
        float mx = max3f(max3f(s[qi][0][0], s[qi][0][1], s[qi][0][2]), max3f(s[qi][0][3], s[qi][1][0], s[qi][1][1]), max3f(s[qi][1][2], s[qi][1][3], s[qi][2][0]));
        mx = max3f(mx, max3f(s[qi][2][1], s[qi][2][2], s[qi][2][3]), max3f(s[qi][3][0], s[qi][3][1], max3f(s[qi][3][2], s[qi][3][3], mx)));
        mx = rowok ? mx * (0.125f * LOG2E) : NEG_BIG;
        mx = grp_max(mx);
        const float mnew = fmaxf(mrun[qi], mx);
        if (__any(mnew > mrun[qi])) { const float alpha = __builtin_amdgcn_exp2f(mrun[qi] - mnew); lsum[qi] *= alpha;
#pragma unroll
            for (int db = 0; db < 4; ++db) ot[qi][db] *= alpha; }
        mrun[qi] = mnew;
        const float nb = rowok ? -mnew : -INFINITY;
        float ps = 0.f;
#pragma unroll
        for (int kb = 0; kb < 4; ++kb)
#pragma unroll
            for (int r = 0; r < 4; ++r) { const float p = __builtin_amdgcn_exp2f(fmaf(s[qi][kb][r], 0.125f * LOG2E, nb)); s[qi][kb][r] = p; ps += p; }
        lsum[qi] += ps;
    }
#pragma unroll
    for (int st = 0; st < 2; ++st) {
        const bf16x8 p0 = pack8(s[0][2 * st], s[0][2 * st + 1]), p1 = pack8(s[1][2 * st], s[1][2 * st + 1]);
#pragma unroll
        for (int db = 0; db < 4; ++db) { const bf16x8 vf = tr_frag(Vb, KV_SB, 32 * st + 4 * gq, 32 * st + 16 + 4 * gq, 16 * db, lane);
            ot[0][db] = mfma16(vf, p0, ot[0][db]); ot[1][db] = mfma16(vf, p1, ot[1][db]); }
    }
}
template <int MODE>
__device__ __forceinline__ void nsa_pass(Ctx& F, const bf16* proj, int b, int g, int qb, int kcol, int vcol, const bf16x8 (&qf)[2][2], const unsigned long long (&selm)[2],
                                         f32x4 (&ot)[2][4], float (&lsum)[2]) {
    LAS unsigned char* Kt = F.lds; LAS unsigned char* Vt = F.lds + 2 * 64 * KV_SB;
    const int lane = F.lane, gq = lane >> 4, th = F.wave >> 2;
    const int ntile = MODE == 0 ? qb + 1 : (qb < 8 ? qb + 1 : 9);
    const int lrow = F.tid >> 3, lch = F.tid & 7;
    const size_t rbase = (size_t)b * SEQ;
    float mrun[2] = {NEG_BIG, NEG_BIG};
#pragma unroll
    for (int qi = 0; qi < 2; ++qi) { lsum[qi] = 0.f;
#pragma unroll
        for (int db = 0; db < 4; ++db) ot[qi][db] = (f32x4){0.f, 0.f, 0.f, 0.f}; }
    auto tile_of = [&](int it) { return MODE == 0 ? it : qb - it; };
    v4u kr0, vr0, kr1, vr1;
#define NSA_LOAD(kr, vr, it_) do { const int j_ = tile_of(it_); const bf16* src_ = proj + (rbase + (size_t)j_ * 64 + lrow) * PW + lch * 8; kr = *(const v4u*)(src_ + kcol); vr = *(const v4u*)(src_ + vcol); } while (0)
#define NSA_STEP(kr, vr, it_) do { const int buf_ = (it_) & 1, j_ = tile_of(it_); \
        *(LAS v4u*)(Kt + buf_ * 64 * KV_SB + lrow * KV_SB + lch * 16) = kr; *(LAS v4u*)(Vt + buf_ * 64 * KV_SB + lrow * KV_SB + lch * 16) = vr; \
        __syncthreads(); \
        if ((it_) + 2 < ntile) NSA_LOAD(kr, vr, (it_) + 2); \
        const LAS unsigned char* Kb_ = Kt + buf_ * 64 * KV_SB; const LAS unsigned char* Vb_ = Vt + buf_ * 64 * KV_SB; \
        const bool edge_ = MODE == 0 ? (j_ == qb) : (j_ == qb || j_ == qb - 8); \
        if (edge_) nsa_tile<MODE, true>(Kb_, Vb_, j_, qb, lane, gq, th, qf, selm, ot, lsum, mrun); \
        else       nsa_tile<MODE, false>(Kb_, Vb_, j_, qb, lane, gq, th, qf, selm, ot, lsum, mrun); } while (0)
    NSA_LOAD(kr0, vr0, 0); if (ntile > 1) NSA_LOAD(kr1, vr1, 1);
    __syncthreads();
#pragma unroll 1
    for (int it = 0; it < ntile; it += 2) {
        NSA_STEP(kr0, vr0, it);
        if (it + 1 < ntile) NSA_STEP(kr1, vr1, it + 1);
    }
#undef NSA_LOAD
#undef NSA_STEP
}

__device__ __forceinline__ void nsa_selwin_unit(Ctx& F, int b, int g, int qb) {
    const bf16* proj = (const bf16*)(F.ws + WS_PROJ); const bf16* ocmp = (const bf16*)(F.ws + WS_OCMP); bf16* onsa = (bf16*)(F.ws + WS_ONSA);
    const unsigned long long* selmask = (const unsigned long long*)(F.ws + WS_SELM);
    const int lane = F.lane, gq = lane >> 4, hr = F.wave & 3, th = F.wave >> 2, head = g * 4 + hr;
    bf16x8 qf[2][2]; unsigned long long selm[2]; size_t trow[2];
#pragma unroll
    for (int qi = 0; qi < 2; ++qi) { const int t = qb * 64 + th * 32 + qi * 16 + (lane & 15); trow[qi] = (size_t)b * SEQ + t;
        selm[qi] = selmask[(size_t)(b * 2 + g) * SEQ + t];
#pragma unroll
        for (int st = 0; st < 2; ++st) qf[qi][st] = *(const bf16x8*)(proj + trow[qi] * PW + PC_Q + head * 64 + 32 * st + 8 * gq); }
    f32x4 ot[2][4]; float lsum[2];
    nsa_pass<0>(F, proj, b, g, qb, PC_KV + 2 * 128 + g * 64, PC_KV + 3 * 128 + g * 64, qf, selm, ot, lsum);
#pragma unroll
    for (int qi = 0; qi < 2; ++qi) { const float gate = sigmoidf_(bf2f(proj[trow[qi] * PW + PC_NSAG + 8 + head])) / grp_sum(lsum[qi]);
#pragma unroll
        for (int db = 0; db < 4; ++db) { const size_t o = trow[qi] * 512 + head * 64 + 16 * db + 4 * gq; const v2u c = *(const v2u*)(ocmp + o);
            f32x4 v = ot[qi][db] * gate; v[0] += bflo(c.x); v[1] += bfhi(c.x); v[2] += bflo(c.y); v[3] += bfhi(c.y);
            v2u w; w.x = pg8::cvt_pk_bf16(v[0], v[1]); w.y = pg8::cvt_pk_bf16(v[2], v[3]); *(v2u*)(onsa + o) = w; } }
    nsa_pass<1>(F, proj, b, g, qb, PC_KV + 4 * 128 + g * 64, PC_KV + 5 * 128 + g * 64, qf, selm, ot, lsum);
#pragma unroll
    for (int qi = 0; qi < 2; ++qi) { const float gate = sigmoidf_(bf2f(proj[trow[qi] * PW + PC_NSAG + 16 + head])) / grp_sum(lsum[qi]);
#pragma unroll
        for (int db = 0; db < 4; ++db) { const size_t o = trow[qi] * 512 + head * 64 + 16 * db + 4 * gq; const v2u c = *(const v2u*)(onsa + o);
            f32x4 v = ot[qi][db] * gate; v[0] += bflo(c.x); v[1] += bfhi(c.x); v[2] += bflo(c.y); v[3] += bfhi(c.y);
            v2u w; w.x = pg8::cvt_pk_bf16(v[0], v[1]); w.y = pg8::cvt_pk_bf16(v[2], v[3]); *(v2u*)(onsa + o) = w; } }
}

__device__ __forceinline__ void p1_norm1(Ctx& F) {
    const float* modp = (const float*)(F.ws + WS_MODP); const float* adab = F.in[I_ADAB]; float* modfw = (float*)(F.ws + WS_MODF);
    { const int gt = F.vcu * NTHREADS + F.tid, NGT = F.G * NTHREADS;
      for (int w = gt; w < 4 * 6144; w += NGT) { const int b = w / 6144, j = w % 6144; float a = adab[j];
#pragma unroll
          for (int s = 0; s < ADA_SLICES; ++s) a += modp[(size_t)(s * 4 + b) * 6144 + j];
          modfw[w] = a; } }
    { LAS float* scr = (LAS float*)(F.lds + 16384 + F.wave * 9216); const int gw = F.vcu * NWAVES + F.wave, NGW = F.G * NWAVES;
      for (int it = gw; it < (DM / 128) * (INW / 32); it += NGW) p1_quant_item_i8(F.in[I_WIN], DM, INW, F.ws + WS_WIN, (float*)(F.ws + WS_SW), F.ctl + CW_CMAX, DMapWin(), scr, it, F.lane); }
    LAS float* shs = (LAS float*)F.lds; LAS float* scs = shs + DM;
    const float* x = F.in[I_X]; const float* g1 = F.in[I_N1G]; unsigned char* A1 = F.ws + WS_A1; float* sa = (float*)(F.ws + WS_SA);
    int curb = -1;
    for (int blk = F.vcu; blk < T / 64; blk += F.G) {
        const int b = (blk * 64) / SEQ;
        if (b != curb) { __syncthreads();
            { float pa[4][ADA_SLICES];
#pragma unroll
              for (int q = 0; q < 4; ++q)
#pragma unroll
                  for (int s = 0; s < ADA_SLICES; ++s) pa[q][s] = modp[(size_t)(s * 4 + b) * 6144 + F.tid + q * NTHREADS];
#pragma unroll
              for (int q = 0; q < 4; ++q) { const int j = F.tid + q * NTHREADS; float a = adab[j];
#pragma unroll
                  for (int s = 0; s < ADA_SLICES; ++s) a += pa[q][s];
                  if (j < DM) shs[j] = a; else scs[j - DM] = (1.0f + a) * g1[j - DM]; } }
            __syncthreads(); curb = b; }
        { f32x4 v[8][4];
#pragma unroll
          for (int i = 0; i < 8; ++i)
#pragma unroll
              for (int j = 0; j < 4; ++j) v[i][j] = *(const f32x4*)(x + (size_t)(blk * 64 + F.wave * 8 + i) * DM + 4 * F.lane + 256 * j);
#pragma unroll
          for (int i = 0; i < 8; ++i) { const int t = blk * 64 + F.wave * 8 + i; float ss = 0.f;
#pragma unroll
              for (int j = 0; j < 4; ++j) ss += (v[i][j][0] * v[i][j][0] + v[i][j][1] * v[i][j][1]) + (v[i][j][2] * v[i][j][2] + v[i][j][3] * v[i][j][3]);
              const float rs = rsqrtf(wave_sum(ss) * (1.0f / DM) + NORM_EPS);
              float am = 0.f;
#pragma unroll
              for (int j = 0; j < 4; ++j) { const f32x4 sc = *(const LAS f32x4*)(scs + 4 * F.lane + 256 * j), sh = *(const LAS f32x4*)(shs + 4 * F.lane + 256 * j);
                  v[i][j] = v[i][j] * rs * sc + sh; am = fmaxf(am, fmaxf(fmaxf(fabsf(v[i][j][0]), fabsf(v[i][j][1])), fmaxf(fabsf(v[i][j][2]), fabsf(v[i][j][3])))); }
              am = wave_max(am); const float inv = am > 0.f ? 127.0f / am : 0.f;
              if (F.lane == 0) sa[t] = am * (1.0f / 127.0f);
#pragma unroll
              for (int j = 0; j < 4; ++j) *(unsigned*)(A1 + (size_t)t * DM + 4 * F.lane + 256 * j) = pk4_i8(v[i][j][0] * inv, v[i][j][1] * inv, v[i][j][2] * inv, v[i][j][3] * inv); } }
    }
    __syncthreads();
}

constexpr int RA_SB = 1040;
__device__ __forceinline__ void p8_norm2_router(Ctx& F, const bf16* H, const float* modf) {
    constexpr int QSB = 528;
    LAS unsigned char* Ahi = F.lds; LAS unsigned char* Alo = F.lds + 64 * QSB; LAS unsigned char* Bhi = F.lds + 2 * 64 * QSB; LAS unsigned char* Blo = Bhi + 32 * QSB;
    LAS float* lg = (LAS float*)(F.lds + 2 * 64 * QSB + 2 * 32 * QSB);
    LAS int* hist = (LAS int*)(lg + 64 * 33);
    const float* rb = F.in[I_RB]; const float* g2 = F.in[I_N2G];
    const bf16* rwhi = (const bf16*)(F.ws + WS_RWHI); const bf16* rwlo = (const bf16*)(F.ws + WS_RWLO);
    unsigned char* N2 = F.ws + WS_A1; int* topi = (int*)(F.ws + WS_TOPI); float* gate = (float*)(F.ws + WS_GATE);
    const int lane = F.lane, gq = lane >> 4, w = F.wave;
    if (F.tid < 32) hist[F.tid] = 0;
    f32x4 gv[4];
#pragma unroll
    for (int j = 0; j < 4; ++j) gv[j] = *(const f32x4*)(g2 + 4 * lane + 256 * j);
    for (int blk = F.vcu; blk < T / 64; blk += F.G) {
        const int b = (blk * 64) / SEQ; const float* sh2 = modf + (size_t)b * 6 * DM + 3 * DM; const float* sc2 = sh2 + DM;
        f32x4 scv[4], shv[4];
#pragma unroll
        for (int j = 0; j < 4; ++j) { scv[j] = (*(const f32x4*)(sc2 + 4 * lane + 256 * j) + 1.0f) * gv[j]; shv[j] = *(const f32x4*)(sh2 + 4 * lane + 256 * j); }
#ifndef P8_SEC
#define P8_SEC 0
#endif
#define PS_BEGIN(k) unsigned long long ps##k = 0; if (P8_SEC == (k)) ps##k = __builtin_amdgcn_s_memrealtime();
#define PS_END(k) if (P8_SEC == (k)) { const unsigned long long n_ = __builtin_amdgcn_s_memrealtime(); const unsigned long long e_ = n_ + 4 * (n_ - ps##k); while (__builtin_amdgcn_s_memrealtime() < e_) __builtin_amdgcn_s_sleep(8); }
        PS_BEGIN(1)
        f32x4 v[8][4];
#pragma unroll
        for (int i = 0; i < 8; ++i) { const int t = blk * 64 + w * 8 + i;
#pragma unroll
            for (int j = 0; j < 4; ++j) { const v2u hw = *(const v2u*)(H + (size_t)t * DM + 4 * lane + 256 * j); v[i][j] = (f32x4){bflo(hw.x), bfhi(hw.x), bflo(hw.y), bfhi(hw.y)}; } }
#pragma unroll
        for (int i = 0; i < 8; ++i) { const int t = blk * 64 + w * 8 + i; float ss = 0.f;
#pragma unroll
            for (int j = 0; j < 4; ++j) ss += (v[i][j][0] * v[i][j][0] + v[i][j][1] * v[i][j][1]) + (v[i][j][2] * v[i][j][2] + v[i][j][3] * v[i][j][3]);
            const float rs = rsqrtf(wave_sum(ss) * (1.0f / DM) + NORM_EPS);
#pragma unroll
            for (int j = 0; j < 4; ++j) { v[i][j] = v[i][j] * rs * scv[j] + shv[j];
                *(unsigned*)(N2 + (size_t)t * DM + 4 * lane + 256 * j) = pk4_fp8(v[i][j][0], v[i][j][1], v[i][j][2], v[i][j][3]); } }
        PS_END(1)
        PS_BEGIN(2)
        const int tbk = w & 3, eb = w >> 2; f32x4 acc = (f32x4){0.f, 0.f, 0.f, 0.f};
        const bf16* bsrc_h[2]; const bf16* bsrc_l[2];
#pragma unroll
        for (int i = 0; i < 2; ++i) { const int cc = F.tid + i * NTHREADS, e = cc >> 5, ch = cc & 31; bsrc_h[i] = rwhi + (size_t)e * DM + ch * 8; bsrc_l[i] = rwlo + (size_t)e * DM + ch * 8; }
#pragma unroll
        for (int kq = 0; kq < 4; ++kq) {
            v4u bh[2], bl[2];
#pragma unroll
            for (int i = 0; i < 2; ++i) { bh[i] = *(const v4u*)(bsrc_h[i] + 256 * kq); bl[i] = *(const v4u*)(bsrc_l[i] + 256 * kq); }
            __syncthreads();
#pragma unroll
            for (int i = 0; i < 8; ++i) { const f32x4 x = v[i][kq]; const unsigned h0 = pk2(x[0], x[1]), h1 = pk2(x[2], x[3]);
                const unsigned l0 = pk2(x[0] - bflo(h0), x[1] - bfhi(h0)), l1 = pk2(x[2] - bflo(h1), x[3] - bfhi(h1));
                const int off = (w * 8 + i) * QSB + 8 * lane;
                *(LAS v2u*)(Ahi + off) = (v2u){h0, h1}; *(LAS v2u*)(Alo + off) = (v2u){l0, l1}; }
#pragma unroll
            for (int i = 0; i < 2; ++i) { const int cc = F.tid + i * NTHREADS, e = cc >> 5, ch = cc & 31; *(LAS v4u*)(Bhi + e * QSB + ch * 16) = bh[i]; *(LAS v4u*)(Blo + e * QSB + ch * 16) = bl[i]; }
            __syncthreads();
#pragma unroll
            for (int s = 0; s < 8; ++s) {
                const bf16x8 wh = lds_row8(Bhi, QSB, 16 * eb + (lane & 15), 32 * s + 8 * gq), wl = lds_row8(Blo, QSB, 16 * eb + (lane & 15), 32 * s + 8 * gq);
                const bf16x8 ah = lds_row8(Ahi, QSB, 16 * tbk + (lane & 15), 32 * s + 8 * gq), al = lds_row8(Alo, QSB, 16 * tbk + (lane & 15), 32 * s + 8 * gq);
                acc = mfma16(ah, wh, acc); acc = mfma16(al, wh, acc); acc = mfma16(ah, wl, acc); }
        }
        PS_END(2)
        PS_BEGIN(3)
        { const int e = 16 * eb + (lane & 15); const float rbe = rb[e];
#pragma unroll
          for (int r = 0; r < 4; ++r) lg[(16 * tbk + 4 * gq + r) * 33 + e] = acc[r] + rbe; }
        __syncthreads();
        if (F.tid < 64) { const int t = blk * 64 + F.tid; float lv[32];
#pragma unroll
            for (int e = 0; e < 32; ++e) lv[e] = lg[F.tid * 33 + e];
            int si[4]; float sv[4];
#pragma unroll
            for (int k = 0; k < 4; ++k) { float m = -3.0e38f; int mi = 0;
#pragma unroll
                for (int e = 0; e < 32; ++e) { const bool gt = lv[e] > m; m = gt ? lv[e] : m; mi = gt ? e : mi; }
#pragma unroll
                for (int e = 0; e < 32; ++e) lv[e] = (e == mi) ? -3.0e38f : lv[e];
                si[k] = mi; sv[k] = m; }
            const float e1 = __expf(sv[1] - sv[0]), e2 = __expf(sv[2] - sv[0]), e3 = __expf(sv[3] - sv[0]); const float inv = 1.0f / (1.0f + e1 + e2 + e3);
            *(int4*)(topi + t * 4) = make_int4(si[0], si[1], si[2], si[3]); *(f32x4*)(gate + t * 4) = (f32x4){inv, e1 * inv, e2 * inv, e3 * inv};
#pragma unroll
            for (int k = 0; k < 4; ++k) __hip_atomic_fetch_add(&hist[si[k]], 1, __ATOMIC_RELAXED, __HIP_MEMORY_SCOPE_WORKGROUP); }
        PS_END(3)
    }
    __syncthreads();
    if (F.tid < 32) { const int h = hist[F.tid]; if (h) __hip_atomic_fetch_add(F.ctl + CW_ECNT + 64 * F.tid, (unsigned)h, __ATOMIC_RELAXED, __HIP_MEMORY_SCOPE_AGENT); }
    __syncthreads();
}

__device__ __forceinline__ void p9_permute(Ctx& F) {
    LAS int* sm = (LAS int*)F.lds; LAS int* cnt = sm, *pstart = sm + 32, *lhist = sm + 64, *lbase = sm + 96, *dl = sm + 128;
    if (F.tid < 32) cnt[F.tid] = (int)__hip_atomic_load(F.ctl + CW_ECNT + 64 * F.tid, __ATOMIC_RELAXED, __HIP_MEMORY_SCOPE_AGENT);
    __syncthreads();
    if (F.tid == 0) { int run = 0; unsigned* tab = F.ctl + CW_MOETAB; const bool w0 = (blockIdx.x == 0);
        for (int e = 0; e < NEXP; ++e) { pstart[e] = run; const int nt = (cnt[e] + MOE_ROWS - 1) / MOE_ROWS;
            if (w0) for (int i = 0; i < nt; ++i) tab[64 + run / MOE_ROWS + i] = (unsigned)e;
            run += nt * MOE_ROWS; }
        if (w0) tab[0] = (unsigned)(run / MOE_ROWS); }
    __syncthreads();
    int* rowt = (int*)(F.ws + WS_ROWT);
    for (int e = F.vcu; e < NEXP; e += F.G) { const int c = cnt[e], pe = (c + MOE_ROWS - 1) / MOE_ROWS * MOE_ROWS; for (int r = c + F.tid; r < pe; r += NTHREADS) rowt[pstart[e] + r] = 0; }
    const int* topi = (const int*)(F.ws + WS_TOPI); const float* gate = (const float*)(F.ws + WS_GATE); int* dest = (int*)(F.ws + WS_DEST); float* rowg = (float*)(F.ws + WS_ROWG);
    for (int blk = F.vcu; blk < T / 64; blk += F.G) {
        if (F.tid < 32) lhist[F.tid] = 0;
        __syncthreads();
        int e = 0, rank = 0; const int a = blk * 256 + F.tid;
        if (F.tid < 256) { e = topi[a]; rank = __hip_atomic_fetch_add(&lhist[e], 1, __ATOMIC_RELAXED, __HIP_MEMORY_SCOPE_WORKGROUP); }
        __syncthreads();
        if (F.tid < 32) { const int h = lhist[F.tid]; lbase[F.tid] = pstart[F.tid] + (h ? (int)__hip_atomic_fetch_add(F.ctl + CW_EFILL + 64 * F.tid, (unsigned)h, __ATOMIC_RELAXED, __HIP_MEMORY_SCOPE_AGENT) : 0); }
        __syncthreads();
        if (F.tid < 256) { const int d = lbase[e] + rank; dest[a] = d; rowg[d] = gate[a]; rowt[d] = a >> 2; }
        __syncthreads();
        __syncthreads();
    }
}

__device__ __forceinline__ float gelu_tanh(float x) { const float u = 0.7978845608028654f * (x + 0.044715f * x * x * x); const float e = __builtin_amdgcn_exp2f(u * 2.8853900817779268f); const float th = 1.0f - 2.0f * __builtin_amdgcn_rcpf(e + 1.0f); return 0.5f * x * (1.0f + th); }
__device__ __forceinline__ void nsa_compress_unit(Ctx& F, int unit) {
    const int nt = unit & 15, kv = (unit >> 4) & 1, bg = unit >> 5, b = bg >> 1, g = bg & 1, n0 = nt * 16;
    const bf16* proj = (const bf16*)(F.ws + WS_PROJ);
    const bf16* w1t = (const bf16*)(F.ws + (kv ? WS_CW1V : WS_CW1K)); const bf16* w2t = (const bf16*)(F.ws + (kv ? WS_CW2V : WS_CW2K));
    bf16* outp = (bf16*)(F.ws + (kv ? WS_VC : WS_KC)) + (size_t)bg * 256 * 64;
    const float* pbp = (const float*)(F.ws + WS_PBP);
    LAS float* part = (LAS float*)F.lds;
    LAS unsigned char* Hs = F.lds + 65536;
    const int lane = F.lane, gq = lane >> 4, w = F.wave;
    const int col = PC_KV + kv * 128 + g * 64;
    int nrow = n0 + (lane & 15); if (nrow > 254) nrow = 254;
    const bf16* arow = proj + ((size_t)b * SEQ + 16 * nrow + 4 * w) * PW + col + 8 * gq;
    const bf16* brow = w1t + (size_t)(lane & 15) * 2048 + 256 * w + 8 * gq;
    f32x4 acc[8];
#pragma unroll
    for (int cb = 0; cb < 8; ++cb) acc[cb] = (f32x4){0.f, 0.f, 0.f, 0.f};
#pragma unroll
    for (int h2 = 0; h2 < 2; ++h2) {
        bf16x8 af[4], bfr[4][8];
#pragma unroll
        for (int s4 = 0; s4 < 4; ++s4) { const int s = 4 * h2 + s4; af[s4] = *(const bf16x8*)(arow + (size_t)(s >> 1) * PW + (s & 1) * 32);
#pragma unroll
            for (int cb = 0; cb < 8; ++cb) bfr[s4][cb] = *(const bf16x8*)(brow + (size_t)(16 * cb) * 2048 + 32 * s); }
#pragma unroll
        for (int s4 = 0; s4 < 4; ++s4)
#pragma unroll
            for (int cb = 0; cb < 8; ++cb) acc[cb] = mfma16(af[s4], bfr[s4][cb], acc[cb]);
    }
    __syncthreads();
#pragma unroll
    for (int cb = 0; cb < 8; ++cb)
#pragma unroll
        for (int r = 0; r < 4; ++r) part[(w * 16 + 4 * gq + r) * 128 + 16 * cb + (lane & 15)] = acc[cb][r];
    __syncthreads();
    { const int j = F.tid & 127, r0 = F.tid >> 7; float pb = 0.f;
#pragma unroll
      for (int s = 0; s < PB_SLICES; ++s) pb += pbp[(s * 2 + kv) * 128 + j];
#pragma unroll
      for (int q = 0; q < 4; ++q) { const int row = r0 + 4 * q; float a = pb;
#pragma unroll
          for (int ww = 0; ww < 8; ++ww) a += part[(ww * 16 + row) * 128 + j];
          *(LAS unsigned short*)(Hs + row * W128_SB + j * 2) = (unsigned short)f2bf(gelu_tanh(a)); } }
    __syncthreads();
    if (w < 4) {
        f32x4 o = (f32x4){0.f, 0.f, 0.f, 0.f};
#pragma unroll
        for (int s = 0; s < 4; ++s) { const bf16x8 a = lds_row8(Hs, W128_SB, lane & 15, 32 * s + 8 * gq); const bf16x8 bb = *(const bf16x8*)(w2t + (size_t)(16 * w + (lane & 15)) * 128 + 32 * s + 8 * gq); o = mfma16(a, bb, o); }
#pragma unroll
        for (int r = 0; r < 4; ++r) { const int n = n0 + 4 * gq + r; outp[(size_t)n * 64 + 16 * w + (lane & 15)] = (unsigned short)(n < 255 ? f2bf(o[r]) : 0u); }
    }
}

__device__ __forceinline__ void nsa_cmp_unit(Ctx& F, int bg, int tb) {
    const int b = bg >> 1, g = bg & 1;
    const bf16* proj = (const bf16*)(F.ws + WS_PROJ); bf16* ocmp = (bf16*)(F.ws + WS_OCMP);
    const bf16* kc = (const bf16*)(F.ws + WS_KC) + (size_t)bg * 256 * 64; const bf16* vc = (const bf16*)(F.ws + WS_VC) + (size_t)bg * 256 * 64;
    unsigned long long* selmask = (unsigned long long*)(F.ws + WS_SELM);
    LAS unsigned char* Kt = F.lds; LAS unsigned char* Vt = F.lds + 256 * KV_SB; LAS float* IMP = (LAS float*)(F.lds + 2 * 256 * KV_SB);
    const int lane = F.lane, gq = lane >> 4, w = F.wave, tg = w >> 2, hp = w & 3;
    const int nvmax = 4 * tb + 3;
    const int nkb = (nvmax + 15) >> 4;
#ifndef CMP_SEC
#define CMP_SEC 0
#endif
#define CS_BEGIN(k) unsigned long long cs##k = 0; if (CMP_SEC == (k)) cs##k = __builtin_amdgcn_s_memrealtime();
#define CS_END(k) if (CMP_SEC == (k)) { const unsigned long long n_ = __builtin_amdgcn_s_memrealtime(); const unsigned long long e_ = n_ + 4 * (n_ - cs##k); while (__builtin_amdgcn_s_memrealtime() < e_) __builtin_amdgcn_s_sleep(8); }
    CS_BEGIN(1)
    const int head = g * 4 + hp;
    bf16x8 qv[2][2]; float gatev[2];
#pragma unroll
    for (int qi = 0; qi < 2; ++qi) { const size_t trow = (size_t)b * SEQ + tb * 64 + tg * 32 + qi * 16 + (lane & 15);
        qv[qi][0] = *(const bf16x8*)(proj + trow * PW + PC_Q + head * 64 + 8 * gq); qv[qi][1] = *(const bf16x8*)(proj + trow * PW + PC_Q + head * 64 + 32 + 8 * gq);
        gatev[qi] = bf2f(proj[trow * PW + PC_NSAG + head]); }
    const int nrows = ((nkb + 1) & ~1) * 16;
    { v4u kk[4], vv[4];
#pragma unroll
      for (int i = 0; i < 4; ++i) { const int it = F.tid + i * NTHREADS, row = it >> 3, ch = it & 7; if (row < nrows) { kk[i] = *(const v4u*)(kc + row * 64 + ch * 8); vv[i] = *(const v4u*)(vc + row * 64 + ch * 8); } }
      __syncthreads();
#pragma unroll
      for (int i = 0; i < 4; ++i) { const int it = F.tid + i * NTHREADS, row = it >> 3, ch = it & 7; if (row < nrows) { *(LAS v4u*)(Kt + row * KV_SB + ch * 16) = kk[i]; *(LAS v4u*)(Vt + row * KV_SB + ch * 16) = vv[i]; } } }
    __syncthreads();
    CS_END(1)
    CS_BEGIN(2)
    LAS float* IMPW = IMP + hp * 64 * 64;
#pragma unroll
    for (int qi = 0; qi < 2; ++qi) {
        const int tl = tg * 32 + qi * 16 + (lane & 15), t = tb * 64 + tl; const size_t trow = (size_t)b * SEQ + t;
        const int nv = ((t + 1) >> 4) - 1;
        float imp[16], carry[16];
        {
            const bf16x8 q0 = qv[qi][0], q1 = qv[qi][1];
            float ml = NEG_BIG;
#pragma unroll 2
            for (int kb = 0; kb < nkb; ++kb) { f32x4 a = (f32x4){0.f, 0.f, 0.f, 0.f};
                a = mfma16(lds_row8(Kt, KV_SB, 16 * kb + (lane & 15), 8 * gq), q0, a); a = mfma16(lds_row8(Kt, KV_SB, 16 * kb + (lane & 15), 32 + 8 * gq), q1, a);
#pragma unroll
                for (int r = 0; r < 4; ++r) { const int n = 16 * kb + 4 * gq + r; ml = fmaxf(ml, (n < nv) ? a[r] : NEG_BIG); } }
            const float mx = grp_max(ml) * (0.125f * LOG2E);
            f32x4 o[4]; float psl = 0.f;
#pragma unroll
            for (int db = 0; db < 4; ++db) o[db] = (f32x4){0.f, 0.f, 0.f, 0.f};
#pragma unroll
            for (int st = 0; st < 8; ++st) { imp[2 * st] = 0.f; imp[2 * st + 1] = 0.f; carry[2 * st] = 0.f; carry[2 * st + 1] = 0.f; if (2 * st < nkb) {
                f32x4 pp[2];
#pragma unroll
                for (int k2 = 0; k2 < 2; ++k2) { const int kb = 2 * st + k2; f32x4 a = (f32x4){0.f, 0.f, 0.f, 0.f};
                    a = mfma16(lds_row8(Kt, KV_SB, 16 * kb + (lane & 15), 8 * gq), q0, a); a = mfma16(lds_row8(Kt, KV_SB, 16 * kb + (lane & 15), 32 + 8 * gq), q1, a);
#pragma unroll
                    for (int r = 0; r < 4; ++r) { const int n = 16 * kb + 4 * gq + r; a[r] = (n < nv) ? __builtin_amdgcn_exp2f(fmaf(a[r], 0.125f * LOG2E, -mx)) : 0.f; }
                    pp[k2] = a; psl += (a[0] + a[1]) + (a[2] + a[3]); imp[kb] = (a[0] + a[1]) + (a[2] + 0.5f * a[3]); carry[kb] = 0.5f * a[3]; }
                const bf16x8 pf = pack8(pp[0], pp[1]);
#pragma unroll
                for (int db = 0; db < 4; ++db) o[db] = mfma16(tr_frag(Vt, KV_SB, 32 * st + 4 * gq, 32 * st + 16 + 4 * gq, 16 * db, lane), pf, o[db]);
                asm volatile("" ::: "memory"); } }
            const float ps = grp_sum(psl);
            const float inv = ps > 0.f ? __builtin_amdgcn_rcpf(ps) : 0.f;
#pragma unroll
            for (int kb = 0; kb < 16; ++kb) { imp[kb] *= inv; carry[kb] *= inv; }
            const float gate = sigmoidf_(gatev[qi]) * inv;
#pragma unroll
            for (int db = 0; db < 4; ++db) { const f32x4 v = o[db] * gate; v2u wv; wv.x = pg8::cvt_pk_bf16(v[0], v[1]); wv.y = pg8::cvt_pk_bf16(v[2], v[3]);
                *(v2u*)(ocmp + trow * 512 + head * 64 + 16 * db + 4 * gq) = wv; }
        }
#pragma unroll
        for (int kb = 0; kb < 16; ++kb) { const float c1 = __shfl(carry[kb], (lane + 48) & 63); const float c0 = kb > 0 ? __shfl(carry[kb > 0 ? kb - 1 : 0], (lane + 48) & 63) : 0.f;
            IMPW[tl * 64 + 4 * kb + gq] = imp[kb] + (gq > 0 ? c1 : c0); }
    }
    CS_END(2)
    __syncthreads();
    CS_BEGIN(3)
    LAS float* VA = (LAS float*)(F.lds + 2 * 256 * KV_SB + 4 * 64 * 64 * 4) + w * 64;
    for (int tl = w; tl < 64; tl += NWAVES) { const int t = tb * 64 + tl, cur = t >> 6;
        float v = (IMP[tl * 64 + lane] + IMP[4096 + tl * 64 + lane]) + (IMP[2 * 4096 + tl * 64 + lane] + IMP[3 * 4096 + tl * 64 + lane]); const bool forced = (lane == 0) || (lane == cur) || (lane == cur - 1);
        v = (lane > cur) ? NEG_BIG : v + (forced ? 1.0e4f : 0.f);
        unsigned key = __float_as_uint(v); key = (key & 0x80000000u) ? ~key : (key | 0x80000000u); key = (key & ~63u) | (unsigned)(63 - lane);
        ((LAS unsigned*)VA)[lane] = key;
        int rank = 0;
#pragma unroll
        for (int j4 = 0; j4 < 16; ++j4) { const v4u o = *(const LAS v4u*)((LAS unsigned*)VA + 4 * j4);
            rank += (o.x > key ? 1 : 0) + (o.y > key ? 1 : 0) + (o.z > key ? 1 : 0) + (o.w > key ? 1 : 0); }
        const unsigned long long m = __ballot(lane <= cur && rank < 16);
        if (lane == 0) selmask[(size_t)bg * SEQ + t] = m; }
    CS_END(3)
}

constexpr int ML_H = 4, ML_D = 128, ML_L = 64, ML_NCH = SEQ / ML_L, ML_BH = BATCH * ML_H;
__device__ __forceinline__ float log_sigmoid(float x) { return fminf(x, 0.f) - log1pf(__expf(-fabsf(x))); }
__device__ __forceinline__ float siluf_(float x) { return x * sigmoidf_(x); }
__device__ __forceinline__ void ml_stage_a(Ctx& F, int unit) {
    const int c = unit & 63, bh = unit >> 6, b = bh >> 2, h = bh & 3;
    const bf16* proj = (const bf16*)(F.ws + WS_PROJ); bf16* mlq = (bf16*)(F.ws + WS_MLQ); bf16* mlk = (bf16*)(F.ws + WS_MLKK);
    float* mlb = (float*)(F.ws + WS_MLB); float* mlli = (float*)(F.ws + WS_MLLI); float* mlsc = (float*)(F.ws + WS_MLSC);
    bf16* mlu = (bf16*)(F.ws + WS_MLU) + (size_t)unit * ML_D * ML_D; float* mlun = (float*)(F.ws + WS_MLUN) + (size_t)unit * ML_D;
    const float* convw = F.in[I_CONVW]; const float* convb = F.in[I_CONVB]; const float* gateb = F.in[I_GATEB];
    LAS unsigned char* KW = F.lds; LAS unsigned char* Vs = F.lds + 64 * W128_SB; LAS float* wts = (LAS float*)(F.lds + 2 * 64 * W128_SB); LAS float* gsc = wts + 64;
    const int t0 = c * ML_L; const size_t row0 = (size_t)b * SEQ + t0;
    __syncthreads();
    if (F.tid < 64) { const int s = F.tid; const float ip = bf2f(proj[(row0 + s) * PW + PC_MLIF + h]) + gateb[h], fp = bf2f(proj[(row0 + s) * PW + PC_MLIF + 4 + h]) + gateb[4 + h];
        gsc[s] = log_sigmoid(fp); gsc[64 + s] = ip; }
    __syncthreads();
    if (F.tid < 64) {
        float v = gsc[F.tid];
#pragma unroll
        for (int o = 1; o < 64; o <<= 1) { const float u = __shfl_up(v, o); if (F.lane >= o) v += u; }
        const float bL = __shfl(v, 63); const float li = gsc[64 + F.tid]; const float a = bL - v + li; const float amax = wave_max(a);
        wts[F.tid] = __expf(a - amax); mlb[(size_t)bh * SEQ + t0 + F.tid] = v; mlli[(size_t)bh * SEQ + t0 + F.tid] = li;
        if (F.tid == 0) { mlsc[unit * 2 + 0] = amax; mlsc[unit * 2 + 1] = bL; } }
    __syncthreads();
    { v4u xin[4][4]; v4u vin[2];
#pragma unroll
      for (int ii = 0; ii < 4; ++ii) { const int it = F.tid + ii * NTHREADS; const int ch8 = it & 15, s = (it >> 4) & 63, which = it >> 10; const int pcol = (which ? PC_MLK : PC_MLQ) + h * 128 + ch8 * 8;
#pragma unroll
          for (int wv = 0; wv < 4; ++wv) { const int tt = t0 + s - 3 + wv; xin[ii][wv] = (tt >= 0) ? *(const v4u*)(proj + ((size_t)b * SEQ + tt) * PW + pcol) : (v4u){0u, 0u, 0u, 0u}; } }
#pragma unroll
      for (int ii = 0; ii < 2; ++ii) { const int it = F.tid + ii * NTHREADS; const int ch8 = it & 15, s = it >> 4; vin[ii] = *(const v4u*)(proj + (row0 + s) * PW + PC_MLV + h * 128 + ch8 * 8); }
#pragma unroll
      for (int ii = 0; ii < 4; ++ii) { const int it = F.tid + ii * NTHREADS; const int ch8 = it & 15, s = (it >> 4) & 63, which = it >> 10;
        const int cch = which * 512 + h * 128 + ch8 * 8;
        float acc[8];
#pragma unroll
        for (int j = 0; j < 8; ++j) acc[j] = convb[cch + j];
#pragma unroll
        for (int wv = 0; wv < 4; ++wv) { const v4u x = xin[ii][wv];
            const f32x4 w0 = *(const f32x4*)(convw + wv * 1024 + cch), w1 = *(const f32x4*)(convw + wv * 1024 + cch + 4);
            acc[0] += bflo(x.x) * w0[0]; acc[1] += bfhi(x.x) * w0[1]; acc[2] += bflo(x.y) * w0[2]; acc[3] += bfhi(x.y) * w0[3];
            acc[4] += bflo(x.z) * w1[0]; acc[5] += bfhi(x.z) * w1[1]; acc[6] += bflo(x.w) * w1[2]; acc[7] += bfhi(x.w) * w1[3]; }
        const float sc = which ? 0.08838834764831845f : 1.0f;
#pragma unroll
        for (int j = 0; j < 8; ++j) acc[j] = siluf_(acc[j]) * sc;
        v4u o; o.x = pk2(acc[0], acc[1]); o.y = pk2(acc[2], acc[3]); o.z = pk2(acc[4], acc[5]); o.w = pk2(acc[6], acc[7]);
        *(v4u*)((which ? mlk : mlq) + (row0 + s) * 512 + h * 128 + ch8 * 8) = o;
        if (which) { const float ws = wts[s]; v4u kw; kw.x = pk2(acc[0] * ws, acc[1] * ws); kw.y = pk2(acc[2] * ws, acc[3] * ws); kw.z = pk2(acc[4] * ws, acc[5] * ws); kw.w = pk2(acc[6] * ws, acc[7] * ws);
            *(LAS v4u*)(KW + s * W128_SB + ch8 * 16) = kw; } }
#pragma unroll
      for (int ii = 0; ii < 2; ++ii) { const int it = F.tid + ii * NTHREADS; const int ch8 = it & 15, s = it >> 4; *(LAS v4u*)(Vs + s * W128_SB + ch8 * 16) = vin[ii]; } }
    __syncthreads();
    { const int lane = F.lane, gq = lane >> 4, w = F.wave;
      const bf16x8 a0 = tr_frag(KW, W128_SB, 8 * gq, 8 * gq + 4, 16 * w, lane), a1 = tr_frag(KW, W128_SB, 32 + 8 * gq, 32 + 8 * gq + 4, 16 * w, lane);
#pragma unroll
      for (int eb = 0; eb < 8; ++eb) { f32x4 acc = (f32x4){0.f, 0.f, 0.f, 0.f};
          acc = mfma16(a0, tr_frag(Vs, W128_SB, 8 * gq, 8 * gq + 4, 16 * eb, lane), acc); acc = mfma16(a1, tr_frag(Vs, W128_SB, 32 + 8 * gq, 32 + 8 * gq + 4, 16 * eb, lane), acc);
          v2u uw; uw.x = pk2(acc[0], acc[1]); uw.y = pk2(acc[2], acc[3]);        *(v2u*)(mlu + (size_t)(16 * eb + (lane & 15)) * ML_D + 16 * w + 4 * gq) = uw; } }
    if (F.tid < ML_D) { float a = 0.f;
#pragma unroll 8
        for (int s = 0; s < 64; ++s) a += bf2f(*(const LAS unsigned short*)(KW + s * W128_SB + F.tid * 2));
        mlun[F.tid] = a; }
}
__device__ __forceinline__ void ml_stage_b(Ctx& F, int unit) {
    const int sl = unit & 15, bh = unit >> 4;
    const float* mlsc = (const float*)(F.ws + WS_MLSC); float* mlm = (float*)(F.ws + WS_MLSC) + 4096;
    const bf16* mlu = (const bf16*)(F.ws + WS_MLU) + (size_t)bh * 64 * ML_D * ML_D; bf16* mlc = (bf16*)(F.ws + WS_MLC) + (size_t)bh * 64 * ML_D * ML_D;
    const float* mlun = (const float*)(F.ws + WS_MLUN) + (size_t)bh * 64 * ML_D; float* mln = (float*)(F.ws + WS_MLN) + (size_t)bh * 64 * ML_D;
    LAS float* dec = (LAS float*)F.lds; LAS float* scl = dec + 64; LAS float* am = scl + 64; LAS float* bl = am + 64;
    __syncthreads();
    if (F.tid < 64) { const pg8::f32x2 v = *(const pg8::f32x2*)(mlsc + (bh * 64 + F.tid) * 2); am[F.tid] = v.x; bl[F.tid] = v.y; }
    __syncthreads();
    if (F.tid == 0) { float m = 0.f;
        for (int c = 0; c < 64; ++c) { const float amax = am[c], bL = bl[c]; const float mn = fmaxf(bL + m, amax);
            dec[c] = __expf(bL + m - mn); scl[c] = __expf(amax - mn); if (sl == 0) mlm[bh * 64 + c] = m; m = mn; } }
    __syncthreads();
    { const int idx = sl * 1024 + F.tid * 2; float c0 = 0.f, c1 = 0.f;
#pragma unroll 1
      for (int cb = 0; cb < 64; cb += 16) { unsigned u[16];
#pragma unroll
          for (int i = 0; i < 16; ++i) u[i] = *(const unsigned*)(mlu + (size_t)(cb + i) * ML_D * ML_D + idx);
#pragma unroll
          for (int i = 0; i < 16; ++i) { *(unsigned*)(mlc + (size_t)(cb + i) * ML_D * ML_D + idx) = pk2(c0, c1);
              c0 = dec[cb + i] * c0 + scl[cb + i] * bflo(u[i]); c1 = dec[cb + i] * c1 + scl[cb + i] * bfhi(u[i]); } } }
    if (sl == 0 && F.tid < ML_D) { float n = 0.f;
#pragma unroll 1
        for (int cb = 0; cb < 64; cb += 8) { float u[8];
#pragma unroll
            for (int i = 0; i < 8; ++i) u[i] = mlun[(cb + i) * ML_D + F.tid];
#pragma unroll
            for (int i = 0; i < 8; ++i) { mln[(cb + i) * ML_D + F.tid] = n; n = dec[cb + i] * n + scl[cb + i] * u[i]; } } }
}
struct MlcIn { v4u q[2], k[2], v[2], c[4]; float fb, fli, fn, mc; };
__device__ __forceinline__ void ml_stage_c_load(Ctx& F, int unit, MlcIn& r) {
    const int c = unit & 63, bh = unit >> 6, b = bh >> 2, h = bh & 3;
    const bf16* proj = (const bf16*)(F.ws + WS_PROJ); const bf16* mlq = (const bf16*)(F.ws + WS_MLQ); const bf16* mlk = (const bf16*)(F.ws + WS_MLKK);
    const float* mlb = (const float*)(F.ws + WS_MLB); const float* mlli = (const float*)(F.ws + WS_MLLI); const float* mlm = (const float*)(F.ws + WS_MLSC) + 4096;
    const bf16* mlc = (const bf16*)(F.ws + WS_MLC) + (size_t)unit * ML_D * ML_D; const float* mln = (const float*)(F.ws + WS_MLN) + (size_t)unit * ML_D;
    const int t0 = c * ML_L; const size_t row0 = (size_t)b * SEQ + t0;
#pragma unroll
    for (int i = 0; i < 2; ++i) { const int it = F.tid + i * NTHREADS, ch8 = it & 15, s = it >> 4; const size_t go = (row0 + s) * 512 + h * 128 + ch8 * 8;
        r.q[i] = *(const v4u*)(mlq + go); r.k[i] = *(const v4u*)(mlk + go); r.v[i] = *(const v4u*)(proj + (row0 + s) * PW + PC_MLV + h * 128 + ch8 * 8); }
#pragma unroll
    for (int i = 0; i < 4; ++i) { const int it = F.tid + i * NTHREADS, ch8 = it & 15, e = it >> 4; r.c[i] = *(const v4u*)(mlc + e * ML_D + ch8 * 8); }
    r.fb = mlb[(size_t)bh * SEQ + t0 + (F.tid & 63)]; r.fli = mlli[(size_t)bh * SEQ + t0 + (F.tid & 63)]; r.fn = mln[F.tid & 127]; r.mc = mlm[unit];
}
__device__ __forceinline__ void ml_stage_c(Ctx& F, int unit, int next_unit, MlcIn& r) {
    const int c = unit & 63, bh = unit >> 6, b = bh >> 2, h = bh & 3;
    const bf16* proj = (const bf16*)(F.ws + WS_PROJ);
    bf16* oml = (bf16*)(F.ws + WS_OML); const float* ng = F.in[I_MLNG];
    LAS unsigned char* Qs = F.lds; LAS unsigned char* Ks = Qs + 64 * W128_SB; LAS unsigned char* Vs = Ks + 64 * W128_SB; LAS unsigned char* Cs = Vs + 64 * W128_SB;
    LAS float* fb = (LAS float*)(Cs + 128 * W128_SB); LAS float* fli = fb + 64; LAS float* fn = fli + 64; LAS float* ssq = fn + 128;
    const int t0 = c * ML_L; const size_t row0 = (size_t)b * SEQ + t0;
#ifndef MLC_SEC
#define MLC_SEC 0
#endif
#define MS_BEGIN(k) unsigned long long ms##k = 0; if (MLC_SEC == (k)) ms##k = __builtin_amdgcn_s_memrealtime();
#define MS_END(k) if (MLC_SEC == (k)) { const unsigned long long n_ = __builtin_amdgcn_s_memrealtime(); const unsigned long long e_ = n_ + 4 * (n_ - ms##k); while (__builtin_amdgcn_s_memrealtime() < e_) __builtin_amdgcn_s_sleep(8); }
    MS_BEGIN(1)
    __syncthreads();
#pragma unroll
    for (int i = 0; i < 2; ++i) { const int it = F.tid + i * NTHREADS, ch8 = it & 15, s = it >> 4;
        *(LAS v4u*)(Qs + s * W128_SB + ch8 * 16) = r.q[i]; *(LAS v4u*)(Ks + s * W128_SB + ch8 * 16) = r.k[i]; *(LAS v4u*)(Vs + s * W128_SB + ch8 * 16) = r.v[i]; }
#pragma unroll
    for (int i = 0; i < 4; ++i) { const int it = F.tid + i * NTHREADS, ch8 = it & 15, e = it >> 4; *(LAS v4u*)(Cs + e * W128_SB + ch8 * 16) = r.c[i]; }
    if (F.tid < 64) { fb[F.tid] = r.fb; fli[F.tid] = r.fli; }
    if (F.tid < ML_D) fn[F.tid] = r.fn;
    const float mc = r.mc;
    __syncthreads();
    MS_END(1)
    MS_BEGIN(2)
    if (next_unit >= 0) ml_stage_c_load(F, next_unit, r);
    const int lane = F.lane, gq = lane >> 4, w = F.wave, tb = w & 3, eh = w >> 2;
    const int t = 16 * tb + (lane & 15); const float bt = fb[t];
    f32x4 ggv[4]; v2u owv[4];
#pragma unroll
    for (int ei = 0; ei < 4; ++ei) { const int e0 = 16 * (eh * 4 + ei) + 4 * gq; ggv[ei] = *(const f32x4*)(ng + h * 128 + e0); owv[ei] = *(const v2u*)(proj + (row0 + t) * PW + PC_MLO + h * 128 + e0); }
    bf16x8 qf[4];
#pragma unroll
    for (int st = 0; st < 4; ++st) qf[st] = lds_row8(Qs, W128_SB, t, 32 * st + 8 * gq);
    f32x4 sT[4]; float dmax = NEG_BIG;
#pragma unroll
    for (int sb = 0; sb < 4; ++sb) { sT[sb] = (f32x4){0.f, 0.f, 0.f, 0.f};
        if (sb <= tb) {
#pragma unroll
            for (int st = 0; st < 4; ++st) sT[sb] = mfma16(lds_row8(Ks, W128_SB, 16 * sb + (lane & 15), 32 * st + 8 * gq), qf[st], sT[sb]);
#pragma unroll
            for (int r = 0; r < 4; ++r) { const int s = 16 * sb + 4 * gq + r; if (s <= t) dmax = fmaxf(dmax, bt - fb[s] + fli[s]); } } }
    dmax = grp_max(dmax);
    const float mt = fmaxf(bt + mc, dmax); const float iw = __expf(bt + mc - mt);
    float dsum = 0.f;
#pragma unroll
    for (int sb = 0; sb < 4; ++sb)
#pragma unroll
        for (int r = 0; r < 4; ++r) { const int s = 16 * sb + 4 * gq + r; const float p = (sb <= tb && s <= t) ? sT[sb][r] * __expf(bt - fb[s] + fli[s] - mt) : 0.f; sT[sb][r] = p; dsum += p; }
    dsum = grp_sum(dsum);
    float qn = 0.f;
#pragma unroll 8
    for (int dd = 0; dd < 32; ++dd) { const int d = gq * 32 + dd; qn += bf2f(*(const LAS unsigned short*)(Qs + t * W128_SB + d * 2)) * fn[d]; }
    qn = grp_sum(qn);
    const float den = dsum + iw * qn; const float rden = 1.0f / fmaxf(fabsf(den), __expf(-mt));
    const bf16x8 p0 = pack8(sT[0], sT[1]), p1 = pack8(sT[2], sT[3]);
    f32x4 hv[4]; float sq = 0.f;
#pragma unroll
    for (int ei = 0; ei < 4; ++ei) { const int eb = eh * 4 + ei;
        f32x4 intra = (f32x4){0.f, 0.f, 0.f, 0.f}, inter = (f32x4){0.f, 0.f, 0.f, 0.f};
        intra = mfma16(tr_frag(Vs, W128_SB, 4 * gq, 16 + 4 * gq, 16 * eb, lane), p0, intra);
        if (tb >= 2) intra = mfma16(tr_frag(Vs, W128_SB, 32 + 4 * gq, 48 + 4 * gq, 16 * eb, lane), p1, intra);
#pragma unroll
        for (int st = 0; st < 4; ++st) inter = mfma16(lds_row8(Cs, W128_SB, 16 * eb + (lane & 15), 32 * st + 8 * gq), qf[st], inter);
        hv[ei] = (intra + inter * iw) * rden; sq += (hv[ei][0] * hv[ei][0] + hv[ei][1] * hv[ei][1]) + (hv[ei][2] * hv[ei][2] + hv[ei][3] * hv[ei][3]); }
    sq = grp_sum(sq);
    MS_END(2)
    MS_BEGIN(3)
    if (gq == 0) ssq[eh * 64 + t] = sq;
    __syncthreads();
    const float rn = rsqrtf((ssq[t] + ssq[64 + t]) * (1.0f / ML_D) + NORM_EPS);
#pragma unroll
    for (int ei = 0; ei < 4; ++ei) { const int e0 = 16 * (eh * 4 + ei) + 4 * gq; const f32x4 gg = ggv[ei];
        const v2u ow = owv[ei];
        f32x4 v = hv[ei] * rn * gg; v[0] *= sigmoidf_(bflo(ow.x)); v[1] *= sigmoidf_(bfhi(ow.x)); v[2] *= sigmoidf_(bflo(ow.y)); v[3] *= sigmoidf_(bfhi(ow.y));
        v2u o; o.x = pg8::cvt_pk_bf16(v[0], v[1]); o.y = pg8::cvt_pk_bf16(v[2], v[3]); *(v2u*)(oml + (row0 + t) * 512 + h * 128 + e0) = o; }
    MS_END(3)
}

#ifndef REPEAT_PHASE
#define REPEAT_PHASE -1
#endif
__device__ __forceinline__ void ph2(Ctx& F) {
    const int nconv = (F.G * 112) / 256, GC = F.G - nconv;
    if ((int)blockIdx.x < GC) {
        pg8::Gemm g{(const bf16*)(F.ws + WS_A1), (const bf16*)(F.ws + WS_WIN), T, PW, DM}; pg8::StaticOrder S; S.init(T, PW, GC, (int)blockIdx.x);
        EpiStoreScaled E{(bf16*)(F.ws + WS_PROJ), PW, (const float*)(F.ws + WS_SA), (const float*)(F.ws + WS_SW)};
        pg8::gemm_phase<EpiStoreScaled, pg8::StaticOrder, true, true, false, false, true>(F.lds, g, S, E);
    } else moe_convert(F, (int)blockIdx.x - GC, nconv);
}
#ifndef TIME_SUB
#define TIME_SUB 0
#endif
#define SUBT_BEGIN(k) unsigned long long ts_ = 0; if (TIME_SUB == (k)) ts_ = __builtin_amdgcn_s_memrealtime();
#define SUBT_END(k) if (TIME_SUB == (k)) { __syncthreads(); const unsigned long long n_ = __builtin_amdgcn_s_memrealtime(); const unsigned long long e_ = n_ + 4 * (n_ - ts_); while (__builtin_amdgcn_s_memrealtime() < e_) __builtin_amdgcn_s_sleep(8); }
__device__ __forceinline__ void ph3(Ctx& F) {
    { SUBT_BEGIN(3) for (int u = F.vcu; u < 256; u += F.G) nsa_compress_unit(F, u); SUBT_END(3) }
    for (int u = F.vcu; u < ML_BH * ML_NCH; u += F.G) ml_stage_a(F, u);
}
__device__ __forceinline__ void ph4(Ctx& F) {
    { SUBT_BEGIN(4) for (int p = F.vcu; p < 256; p += F.G) { const int bg = p >> 5, x = p & 31; nsa_cmp_unit(F, bg, 63 - x); nsa_cmp_unit(F, bg, x); } SUBT_END(4) }
    for (int u = F.vcu; u < ML_BH * 16; u += F.G) ml_stage_b(F, u);
}
__device__ __forceinline__ void ph5(Ctx& F) {
    { SUBT_BEGIN(5) for (int p = F.vcu; p < 256; p += F.G) { const int bg = p >> 5, x = p & 31; nsa_selwin_unit(F, bg >> 1, bg & 1, x); nsa_selwin_unit(F, bg >> 1, bg & 1, 63 - x); } SUBT_END(5) }
    { MlcIn r; int u = F.vcu; if (u < ML_BH * ML_NCH) ml_stage_c_load(F, u, r);
      for (; u < ML_BH * ML_NCH; u += F.G) { const int nu = u + F.G < ML_BH * ML_NCH ? u + F.G : -1; ml_stage_c(F, u, nu, r); } }
}
struct UpOrder {
    pg8::StaticOrder so;
    __device__ __forceinline__ bool next(int i, Unit& u) const { if (!so.next(i >> 1, u)) return false; if (i & 1) { u.pm += T / 256; u.pn += DM / 256; } return true; }
    __device__ __forceinline__ void a_ready(const Unit&) const {}
    __device__ __forceinline__ void done(const Unit&) const {}
};
struct EpiUpBoth {
    static constexpr bool PERM = true, AFTER_DRAIN = false;
    bf16* U; const bf16* G;
    __device__ __forceinline__ void operator()(const f32x4 (&acc)[2][2][4][2], const Unit& u, int wr, int wc, int fr, int fq) const {
        if (u.pm < T / 256) { EpiUpGate<false> E{U, G, PC_MGA}; E(acc, u, wr, wc, fr, fq); }
        else { Unit v = u; v.pm -= T / 256; v.pn -= DM / 256; EpiUpGate<true> E{U, G, PC_MGB}; E(acc, v, wr, wc, fr, fq); }
    }
};
static_assert(WS_OML == WS_ONSA + (size_t)T * 512 * 2 && WS_WUPB == WS_WUPA + (size_t)DM * 512 * 2, "stacked operands of the up projection");
__device__ __forceinline__ void ph6(Ctx& F) {
    UpOrder S; S.so.init(T, DM, F.G, (int)blockIdx.x);
    pg8::Gemm g{(const bf16*)(F.ws + WS_ONSA), (const bf16*)(F.ws + WS_WUPA), 2 * T, 2 * DM, 512}; EpiUpBoth E{(bf16*)(F.ws + WS_U), (const bf16*)(F.ws + WS_PROJ)};
    pg8::gemm_phase<EpiUpBoth, UpOrder, true, true>(F.lds, g, S, E);
}
__device__ __forceinline__ void ph7(Ctx& F) {
    pg8::Gemm g{(const bf16*)(F.ws + WS_U), (const bf16*)(F.ws + WS_WOUT), T, DM, DM}; pg8::StaticOrder S; S.init(T, DM, F.G, (int)blockIdx.x);
    EpiOutRes E{F.in[I_X], (bf16*)(F.ws + WS_H1), (const float*)(F.ws + WS_MODF)};
    pg8::gemm_phase<EpiOutRes, pg8::StaticOrder, true, true>(F.lds, g, S, E);
}
__device__ __forceinline__ void ph10(Ctx& F) {
    pg8::Gemm g{(const bf16*)(F.ws + WS_A1), (const bf16*)(F.ws + WS_W1T), MOE_P, NEXP * 2048, DM};
    moe_units_to_lds<1>(F.lds, F.ctl + CW_MOETAB, 8, 3, F.G, F.vcu, F.in[I_EB1], nullptr);
    MoeOrder S{(const LAS int*)(F.lds + MOE_UL_OFF), (const int*)(F.ws + WS_ROWT)};
    EpiMoe1 E{F.ws + WS_ACT, (const LAS float*)(F.lds + MOE_BT1_OFF)};
    pg8::gemm_phase<EpiMoe1, MoeOrder, true, true, true, true>(F.lds, g, S, E);
}
__device__ __forceinline__ void ph11(Ctx& F) {
    pg8::Gemm g{(const bf16*)(F.ws + WS_ACT), (const bf16*)(F.ws + WS_W2T), MOE_P, NEXP * DM, DE};
    moe_units_to_lds<2>(F.lds, F.ctl + CW_MOETAB, 4, 2, F.G, F.vcu, F.in[I_EB2], (const float*)(F.ws + WS_ROWG));
    MoeOrder S{(const LAS int*)(F.lds + MOE_UL_OFF), nullptr};
    EpiMoe2 E{F.ws + WS_YR, (const LAS float*)(F.lds + MOE_BT2_OFF)};
    pg8::gemm_phase<EpiMoe2, MoeOrder, true, true, true>(F.lds, g, S, E);
}
#ifndef TIME_PHASE
#define TIME_PHASE -1
#endif
#define RUN(k, call) do { unsigned long long t0_ = 0; if (TIME_PHASE == (k)) t0_ = __builtin_amdgcn_s_memrealtime(); F.tid = threadIdx.x; F.lane = F.tid & 63; call; SEAM(); \
    if (TIME_PHASE == (k)) { const unsigned long long n_ = __builtin_amdgcn_s_memrealtime(); const unsigned long long e_ = n_ + 4 * (n_ - t0_); while (__builtin_amdgcn_s_memrealtime() < e_) __builtin_amdgcn_s_sleep(8); SEAM(); } } while (0)
__global__ void __launch_bounds__(NTHREADS, 2) fwd_kernel(Args args) {
    extern __shared__ __attribute__((aligned(16))) unsigned char lds_raw[];
    Ctx F;
    F.lds = (LAS unsigned char*)lds_raw; F.ws = args.ws; F.ctl = (unsigned*)(args.ws + WS_CTL);
    F.tid = threadIdx.x; F.lane = F.tid & 63; F.wave = __builtin_amdgcn_readfirstlane(F.tid >> 6);
    F.G = gridDim.x; { const int bx = blockIdx.x; F.vcu = (F.G % 8 == 0) ? (bx % 8) * (F.G / 8) + bx / 8 : bx; }
    F.in = args.in; F.out = args.out;
    volatile LAS unsigned* MISC = (volatile LAS unsigned*)(F.lds + MISC_OFF);
    for (int u = F.tid; u < (LDS_BYTES - LDSCTL_OFF) / 4; u += NTHREADS) ((LAS unsigned*)(F.lds + LDSCTL_OFF))[u] = 0u;
    __syncthreads();
    XcdBarrier bar = xcd_barrier_post(F.ctl + CW_BAR, MISC + 8);
#define SEAM() xcd_barrier(bar)
    const float* modf = (const float*)(F.ws + WS_MODF);
    const bf16* H = (const bf16*)(F.ws + WS_H1);
    RUN(0, p0_prologue(F));
    RUN(1, p1_norm1(F));
    RUN(2, ph2(F));
    RUN(3, ph3(F));
    RUN(4, ph4(F));
    RUN(5, ph5(F));
    RUN(6, ph6(F));
    RUN(7, ph7(F));
    RUN(8, p8_norm2_router(F, H, modf));
    RUN(9, p9_permute(F));
    RUN(10, ph10(F));
    RUN(11, ph11(F));
    p_final<true>(F, H, modf);
#undef SEAM
}

extern "C" void kernel_launch(void* const* d_in, const int* in_sizes, int n_in, void* d_out, int out_size, void* d_ws, size_t ws_size, hipStream_t stream) {
    static int grid = 0;
    if (grid == 0) {
        if (n_in != 27 || in_sizes[0] != T * DM || out_size != T * DM || ws_size < WS_END) { fprintf(stderr, "kernel_launch: unexpected shapes (n_in %d, in0 %d, out %d, ws %zu)\n", n_in, n_in > 0 ? in_sizes[0] : -1, out_size, ws_size); grid = -1; return; }
        int dev = 0, cus = 0, per_cu = 0;
        if (hipGetDevice(&dev) != hipSuccess || hipDeviceGetAttribute(&cus, hipDeviceAttributeMultiprocessorCount, dev) != hipSuccess) { grid = -1; return; }
        if (hipFuncSetAttribute((const void*)fwd_kernel, hipFuncAttributeMaxDynamicSharedMemorySize, LDS_BYTES) != hipSuccess) { fprintf(stderr, "kernel_launch: hipFuncSetAttribute failed\n"); grid = -1; return; }
        if (hipOccupancyMaxActiveBlocksPerMultiprocessor(&per_cu, (const void*)fwd_kernel, NTHREADS, LDS_BYTES) != hipSuccess || per_cu < 1) fprintf(stderr, "kernel_launch: occupancy query reports %d\n", per_cu);
        (void)hipGetLastError();
        grid = cus;
    }
    if (grid < 0) return;
    if (hipMemsetAsync((char*)d_ws + WS_CTL, 0, CTL_ZERO_BYTES, stream) != hipSuccess) return;
    Args a{};
    for (int i = 0; i < 27; ++i) a.in[i] = (const float*)d_in[i];
    a.out = (float*)d_out; a.ws = (unsigned char*)d_ws;
    a.ph_lo = 0; a.ph_hi = 64;
    hipLaunchKernelGGL(fwd_kernel, dim3(grid), dim3(NTHREADS), LDS_BYTES, stream, a);
}
```

```cpp
#include <hip/hip_runtime.h>
#include <cstdio>
#include <cstdint>
namespace pg8 {
#define PG8_LAS __attribute__((address_space(3)))
typedef unsigned short bf16_t;
typedef short bf16x8 __attribute__((ext_vector_type(8)));
typedef float f32x4 __attribute__((ext_vector_type(4)));
typedef unsigned u32x4 __attribute__((ext_vector_type(4)));
constexpr int BM = 256, BK = 64, HALF = 128, HTB = HALF * BK * 2  , STAGE_BYTES = 8 * HTB, NXCD = 8, WGM = 8;

__host__ __device__ __forceinline__ int lds_byte(int r, int c) { const int st = (r >> 4) * 2 + (c >> 5), rr = r & 15, cc = c & 31, ob = rr * 64 + cc * 2; return st * 1024 + (ob ^ (((ob >> 9) & 1) << 5)); }
__host__ __device__ __forceinline__ void stage_rc(int b, int& R, int& C) { const int st = b / 1024, sb = b % 1024, swz = sb ^ (((sb >> 9) & 1) << 5); R = (st >> 1) * 16 + swz / 64; C = (st & 1) * 32 + (swz % 64) / 2; }
__host__ __device__ __forceinline__ int perm32(int rho) { const int n = rho >> 4, i = rho & 15; return 8 * (i >> 2) + 4 * n + (i & 3); }

struct Unit { int pm, pn, ix; };
struct Gemm { const bf16_t* A; const bf16_t* Bt; int M, N, K; };

struct StaticOrder {
    int nM, nN, nwg, G, c;
    __host__ __device__ void init(int M, int N, int G_, int c_) { nM = M / BM; nN = N / BM; nwg = nM * nN; G = G_; c = c_; }
    __host__ __device__ bool next(int i, Unit& u) const {
        const long L = (long)i * G + c; if (L >= nwg) return false;
        int wgid = (int)L; { const int q = nwg / NXCD, r = nwg % NXCD, xcd = wgid % NXCD, off = wgid / NXCD; wgid = (xcd < r ? xcd * (q + 1) : r * (q + 1) + (xcd - r) * q) + off; }
        const int nig = WGM * nN, gid = wgid / nig, fm = gid * WGM, gsz = (nM - fm) < WGM ? (nM - fm) : WGM;
        u.pm = fm + ((wgid % nig) % gsz); u.pn = (wgid % nig) / gsz; return true;
    }
    __device__ __forceinline__ void a_ready(const Unit&) const {}
    __device__ __forceinline__ void done(const Unit&) const {}
};

__device__ __forceinline__ unsigned cvt_pk_bf16(float lo, float hi) { unsigned r; asm volatile("v_cvt_pk_bf16_f32 %0, %1, %2" : "=v"(r) : "v"(lo), "v"(hi)); return r; }
typedef float f32x2 __attribute__((ext_vector_type(2)));
typedef int v8i32 __attribute__((ext_vector_type(8)));
typedef int v4i32 __attribute__((ext_vector_type(4)));
template <bool F8> struct FragT { typedef bf16x8 type; }; template <> struct FragT<true> { typedef v8i32 type; };
constexpr int F8_SCALE_A = 0x7F7F7F7F;
constexpr int F8_SCALE_B = 0x7A7A7A7A;
template <class Epi, class Sched, bool ALIGN_EPI = false, bool SP2 = false, bool F8 = false, bool GATHER = false, bool I8 = false>
__device__ __forceinline__ void gemm_phase(PG8_LAS unsigned char* lds, const Gemm g, const Sched& S, const Epi& E) {
    int tid_ = threadIdx.x; asm volatile("" : "+v"(tid_));
    const int tid = tid_, wid = __builtin_amdgcn_readfirstlane(tid >> 6), lane = tid & 63, wr = wid >> 2, wc = wid & 3, fr = lane & 15, fq = lane >> 4;
    const int K = g.K, nt = (F8 || I8) ? K / (2 * BK) : K / BK; const int RB = (F8 || I8) ? K : 2 * K;
    unsigned voffA[2], voffB[2];
#pragma unroll
    for (int i = 0; i < 2; ++i) { int R, C; stage_rc(tid * 16 + i * 8192, R, C); const int Rb = Epi::PERM ? ((R & ~31) + perm32(R & 31)) : R;
        voffA[i] = (unsigned)(R * RB + C * 2); voffB[i] = (unsigned)(Rb * RB + C * 2); }
    const size_t kstep = (size_t)(BK * 2);
    const size_t hstep = (size_t)HALF * RB;
    const size_t tstep = 2 * hstep;
    const unsigned ldsw = (unsigned)wid * 1024u;
    const int aoff = lds_byte(wr * 64 + fr, fq * 8), boff = lds_byte(wc * 32 + fr, fq * 8);
#define PG8_SA(b, h) (((b) * 2 + (h)) * HTB)
#define PG8_SB(b, h) ((4 + (b) * 2 + (h)) * HTB)
#define PG8_STAGE(bufoff, gbase, voff) do { _Pragma("unroll") for (int _i = 0; _i < 2; ++_i) \
        __builtin_amdgcn_global_load_lds((const unsigned*)((const char*)(gbase) + (voff)[_i]), (PG8_LAS unsigned*)(lds + (bufoff) + ldsw + _i * 8192), 16, 0, 0); } while (0)
#define PG8_GO1(ix, h_, i_) ((unsigned)rt[(ix) * BM + (h_) * HALF + (int)(voffA[i_] / (unsigned)RB)] * (unsigned)RB + voffA[i_] % (unsigned)RB)
#define PG8_STAGE_A(bufoff, gbase, h, nx) do { if constexpr (GATHER) { _Pragma("unroll") for (int _i = 0; _i < 2; ++_i) { const unsigned o_ = PG8_GO1((nx) ? nui : ui, h, _i); \
        __builtin_amdgcn_global_load_lds((const unsigned*)((const char*)(gbase) + o_), (PG8_LAS unsigned*)(lds + (bufoff) + ldsw + _i * 8192), 16, 0, 0); } } \
        else { PG8_STAGE(bufoff, (const char*)(gbase) + (h) * hstep, voffA); } } while (0)
#define PG8_GOFFS(v, ix) do { _Pragma("unroll") for (int h_ = 0; h_ < 2; ++h_) _Pragma("unroll") for (int i_ = 0; i_ < 2; ++i_) v[h_][i_] = PG8_GO1(ix, h_, i_); } while (0)
#define PG8_LD16(off) (*(const PG8_LAS v4i32*)(lds + (off)))
#define PG8_LDA(dst, b, h) do { _Pragma("unroll") for (int m = 0; m < 4; ++m) { if constexpr (F8) { const v4i32 lo_ = PG8_LD16(PG8_SA(b, h) + aoff + m * 2048), hi_ = PG8_LD16(PG8_SA(b, h) + aoff + m * 2048 + 1024); dst[m][0] = __builtin_shufflevector(lo_, hi_, 0, 1, 2, 3, 4, 5, 6, 7); } \
        else { _Pragma("unroll") for (int k = 0; k < NK; ++k) dst[m][k] = *(const PG8_LAS frag_t*)(lds + PG8_SA(b, h) + aoff + m * 2048 + k * 1024); } } } while (0)
#define PG8_LDB(dst, b, h) do { _Pragma("unroll") for (int n = 0; n < 2; ++n) { if constexpr (F8) { const v4i32 lo_ = PG8_LD16(PG8_SB(b, h) + boff + n * 2048), hi_ = PG8_LD16(PG8_SB(b, h) + boff + n * 2048 + 1024); dst[n][0] = __builtin_shufflevector(lo_, hi_, 0, 1, 2, 3, 4, 5, 6, 7); } \
        else { _Pragma("unroll") for (int k = 0; k < NK; ++k) dst[n][k] = *(const PG8_LAS frag_t*)(lds + PG8_SB(b, h) + boff + n * 2048 + k * 1024); } } } while (0)
#define PG8_MMA(ai, bj, At, Bt) do { __builtin_amdgcn_s_setprio(1); \
        if constexpr (F8) { _Pragma("unroll") for (int m = 0; m < 4; ++m) _Pragma("unroll") for (int n = 0; n < 2; ++n) \
            asm("v_mfma_scale_f32_16x16x128_f8f6f4 %0, %1, %2, %0, %3, %4 op_sel_hi:[0,0,0]" : "+v"(acc[ai][bj][m][n]) : "v"(Bt[n][0]), "v"(At[m][0]), "v"(f8sb), "v"(f8sa)); } \
        else if constexpr (I8) { _Pragma("unroll") for (int m = 0; m < 4; ++m) _Pragma("unroll") for (int n = 0; n < 2; ++n) _Pragma("unroll") for (int k = 0; k < NK; ++k) \
            acc[ai][bj][m][n] = __builtin_bit_cast(f32x4, __builtin_amdgcn_mfma_i32_16x16x64_i8(__builtin_bit_cast(v4i32, Bt[n][k]), __builtin_bit_cast(v4i32, At[m][k]), __builtin_bit_cast(v4i32, acc[ai][bj][m][n]), 0, 0, 0)); } \
        else { _Pragma("unroll") for (int m = 0; m < 4; ++m) _Pragma("unroll") for (int n = 0; n < 2; ++n) _Pragma("unroll") for (int k = 0; k < NK; ++k) \
            acc[ai][bj][m][n] = __builtin_amdgcn_mfma_f32_16x16x32_bf16(Bt[n][k], At[m][k], acc[ai][bj][m][n], 0, 0, 0); } \
        __builtin_amdgcn_s_setprio(0); } while (0)
#define PG8_WAIT_V(n) asm volatile("s_waitcnt vmcnt(" #n ")" ::: "memory")
#define PG8_WAIT_L(n) asm volatile("s_waitcnt lgkmcnt(" #n ")" ::: "memory")
#define PG8_BAR __builtin_amdgcn_s_barrier()
#define PG8_SCHED __builtin_amdgcn_sched_barrier(0)
    Unit cur, nxt; int ui = 0;
    if (!S.next(0, cur)) return;
    f32x4 acc[2][2][4][2];
#pragma unroll
    for (int a = 0; a < 2; ++a)
#pragma unroll
        for (int b = 0; b < 2; ++b)
#pragma unroll
            for (int m = 0; m < 4; ++m)
#pragma unroll
                for (int n = 0; n < 2; ++n) acc[a][b][m][n] = (f32x4){0.f, 0.f, 0.f, 0.f};
    typedef typename FragT<F8>::type frag_t; constexpr int NK = F8 ? 1 : 2;
    int f8sa = F8_SCALE_A, f8sb = F8_SCALE_B; if constexpr (F8) asm volatile("" : "+v"(f8sa), "+v"(f8sb));
    frag_t At[4][NK], B0[2][NK], B1[2][NK];
    const char* cA = (const char*)g.A + (GATHER ? (size_t)0 : (size_t)cur.pm * tstep); const char* cB = (const char*)g.Bt + (size_t)cur.pn * tstep;
    int nui = 0; PG8_LAS const unsigned short* rt = (PG8_LAS const unsigned short*)(lds + STAGE_BYTES);
    if constexpr (GATHER) {
        Unit tu; for (int i = 0; S.next(i, tu); ++i) if (tid < BM) ((PG8_LAS unsigned short*)(lds + STAGE_BYTES))[i * BM + tid] = (unsigned short)S.rowtok[tu.pm * BM + tid];
        __syncthreads();
    }
    S.a_ready(cur);
    if constexpr (SP2) {
        PG8_STAGE(PG8_SB(0, 0), cB, voffB); PG8_STAGE(PG8_SB(0, 1), cB + hstep, voffB); PG8_STAGE_A(PG8_SA(0, 0), cA, 0, false); PG8_STAGE_A(PG8_SA(0, 1), cA, 1, false);
        if (wr == 1) PG8_BAR;
        PG8_WAIT_V(2); PG8_BAR;
        PG8_STAGE(PG8_SB(1, 0), cB + kstep, voffB); PG8_STAGE_A(PG8_SA(1, 0), cA + kstep, 0, false); PG8_STAGE(PG8_SB(1, 1), cB + hstep + kstep, voffB);
        PG8_WAIT_V(6); PG8_BAR;
    } else {
        PG8_STAGE(PG8_SB(0, 0), cB, voffB); PG8_STAGE_A(PG8_SA(0, 0), cA, 0, false); PG8_STAGE(PG8_SB(0, 1), cB + hstep, voffB); PG8_STAGE_A(PG8_SA(0, 1), cA, 1, false);
        if (wr == 1) PG8_BAR;
        PG8_WAIT_V(4); PG8_BAR;
        PG8_STAGE(PG8_SB(1, 0), cB + kstep, voffB); PG8_STAGE_A(PG8_SA(1, 0), cA + kstep, 0, false); PG8_STAGE(PG8_SB(1, 1), cB + hstep + kstep, voffB);
        PG8_WAIT_V(6); PG8_BAR;
    }
    for (;;) {
        const bool has_next = S.next(ui + 1, nxt);
        const char* nA = (has_next && !GATHER) ? (const char*)g.A + (size_t)nxt.pm * tstep : cA; const char* nB = has_next ? (const char*)g.Bt + (size_t)nxt.pn * tstep : cB;
        nui = has_next ? ui + 1 : ui;
#pragma unroll 1
        for (int t = 0; t < nt; t += 2) {
            const bool last = (t == nt - 2);
            const char* a1 = cA + (size_t)(t + 1) * kstep;
            const char* a2 = last ? nA : cA + (size_t)(t + 2) * kstep; const char* b2 = last ? nB : cB + (size_t)(t + 2) * kstep;
            const char* a3 = a2 + kstep; const char* b3 = b2 + kstep;
            if (last && has_next) S.a_ready(nxt);
            if constexpr (SP2) {
            PG8_LDB(B0, 0, 0); PG8_LDB(B1, 0, 1); PG8_SCHED; PG8_LDA(At, 0, 0); PG8_STAGE_A(PG8_SA(1, 1), a1, 1, false);
            PG8_WAIT_V(8); PG8_WAIT_L(0); PG8_BAR; PG8_MMA(0, 0, At, B0); PG8_MMA(0, 1, At, B1); PG8_BAR; PG8_SCHED;
            PG8_LDA(At, 0, 1); PG8_STAGE(PG8_SB(0, 0), b2, voffB); PG8_STAGE(PG8_SB(0, 1), b2 + hstep, voffB); PG8_STAGE_A(PG8_SA(0, 0), a2, 0, last);
            PG8_WAIT_V(8); PG8_WAIT_L(0); PG8_BAR; PG8_MMA(1, 0, At, B0); PG8_MMA(1, 1, At, B1); PG8_BAR; PG8_SCHED;
            PG8_LDB(B0, 1, 0); PG8_LDB(B1, 1, 1); PG8_SCHED; PG8_LDA(At, 1, 0); PG8_STAGE_A(PG8_SA(0, 1), a2, 1, last);
            PG8_WAIT_V(8); PG8_WAIT_L(0); PG8_BAR; PG8_MMA(0, 0, At, B0); PG8_MMA(0, 1, At, B1); PG8_BAR; PG8_SCHED;
            PG8_LDA(At, 1, 1); PG8_STAGE(PG8_SB(1, 0), b3, voffB); PG8_STAGE(PG8_SB(1, 1), b3 + hstep, voffB); PG8_STAGE_A(PG8_SA(1, 0), a3, 0, last);
            PG8_WAIT_V(8); PG8_WAIT_L(0); PG8_BAR; PG8_MMA(1, 0, At, B0); PG8_MMA(1, 1, At, B1); PG8_BAR; PG8_SCHED;
            } else {
            PG8_LDB(B0, 0, 0); PG8_SCHED; PG8_LDA(At, 0, 0); PG8_STAGE_A(PG8_SA(1, 1), a1, 1, false);
            PG8_WAIT_L(8); PG8_BAR; PG8_WAIT_L(0); PG8_MMA(0, 0, At, B0); PG8_BAR; PG8_SCHED;
            PG8_LDB(B1, 0, 1); PG8_STAGE(PG8_SB(0, 0), b2, voffB);
            PG8_BAR; PG8_WAIT_L(0); PG8_MMA(0, 1, At, B1); PG8_BAR;
            PG8_LDA(At, 0, 1); PG8_STAGE_A(PG8_SA(0, 0), a2, 0, last);
            PG8_BAR; PG8_WAIT_L(0); PG8_MMA(1, 0, At, B0); PG8_BAR; PG8_SCHED;
            PG8_STAGE(PG8_SB(0, 1), b2 + hstep, voffB);
            PG8_WAIT_V(6); PG8_BAR; PG8_MMA(1, 1, At, B1); PG8_BAR;
            PG8_LDB(B0, 1, 0); PG8_SCHED; PG8_LDA(At, 1, 0); PG8_STAGE_A(PG8_SA(0, 1), a2, 1, last);
            PG8_WAIT_L(8); PG8_BAR; PG8_WAIT_L(0); PG8_MMA(0, 0, At, B0); PG8_BAR; PG8_SCHED;
            PG8_LDB(B1, 1, 1); PG8_STAGE(PG8_SB(1, 0), b3, voffB);
            PG8_BAR; PG8_WAIT_L(0); PG8_MMA(0, 1, At, B1); PG8_BAR;
            PG8_LDA(At, 1, 1); PG8_STAGE_A(PG8_SA(1, 0), a3, 0, last);
            PG8_BAR; PG8_WAIT_L(0); PG8_MMA(1, 0, At, B0); PG8_BAR; PG8_SCHED;
            PG8_STAGE(PG8_SB(1, 1), b3 + hstep, voffB);
            PG8_WAIT_V(6); PG8_BAR; PG8_MMA(1, 1, At, B1); PG8_BAR;
            }
        }
        if constexpr (F8) asm volatile("s_nop 15\n\ts_nop 7" ::: "memory");
        if constexpr (ALIGN_EPI) { if (wr == 0) PG8_BAR; }
        if constexpr (I8) {
#pragma unroll
            for (int a = 0; a < 2; ++a)
#pragma unroll
                for (int b = 0; b < 2; ++b)
#pragma unroll
                    for (int m = 0; m < 4; ++m)
#pragma unroll
                        for (int n = 0; n < 2; ++n) acc[a][b][m][n] = __builtin_convertvector(__builtin_bit_cast(v4i32, acc[a][b][m][n]), f32x4); }
        if constexpr (!Epi::AFTER_DRAIN) { E(acc, cur, wr, wc, fr, fq); S.done(cur); }
        if (!has_next) break;
#pragma unroll
        for (int a = 0; a < 2; ++a)
#pragma unroll
            for (int b = 0; b < 2; ++b)
#pragma unroll
                for (int m = 0; m < 4; ++m)
#pragma unroll
                    for (int n = 0; n < 2; ++n) acc[a][b][m][n] = (f32x4){0.f, 0.f, 0.f, 0.f};
        cur = nxt; cA = nA; cB = nB; ++ui;

        if constexpr (ALIGN_EPI) { if (wr == 1) PG8_BAR; }
    }
    PG8_WAIT_V(0);
    if constexpr (!ALIGN_EPI) { if (wr == 0) PG8_BAR; }
    PG8_BAR;
    if constexpr (Epi::AFTER_DRAIN) { E.fused(acc, cur, wr, wc, fr, fq, lds, wid, lane); S.done(cur); }
#undef PG8_SA
#undef PG8_SB
#undef PG8_STAGE
#undef PG8_LDA
#undef PG8_LDB
#undef PG8_LD16
#undef PG8_STAGE_A
#undef PG8_GOFFS
#undef PG8_GO1
#undef PG8_MMA
#undef PG8_WAIT_V
#undef PG8_WAIT_L
#undef PG8_BAR
#undef PG8_SCHED
}
}

constexpr int NWAVES = 8, NTHREADS = 512;
constexpr int BATCH = 4, SEQ = 4096, DM = 1024, T = BATCH * SEQ;
constexpr int INW = 5408, PW = 5632;
constexpr int NEXP = 32, TOPK = 4, DE = 1024, NASSIGN = T * TOPK, MOE_ROWS = 256;
constexpr int MOE_MAXTILES = (NASSIGN + NEXP * (MOE_ROWS - 1) + MOE_ROWS - 1) / MOE_ROWS;
constexpr int MOE_P = MOE_MAXTILES * MOE_ROWS;
constexpr float NORM_EPS = 1e-6f;
constexpr int PC_Q = 0, PC_KV = 512, PC_MLQ = 1280, PC_MLK = 1792, PC_MLV = 2304, PC_MLO = 2816, PC_MGA = 3328, PC_MGB = 4352, PC_NSAG = 5376, PC_MLIF = 5400;
constexpr int ADA_SLICES = 16, PB_SLICES = 16;

constexpr size_t MiB = 1u << 20;
constexpr size_t WS_CTL = 0, CTL_ZERO_BYTES = 1 * MiB;
constexpr size_t WS_MODP = 1 * MiB;
constexpr size_t WS_MODF = 3 * MiB;
constexpr size_t WS_PBP  = 3 * MiB + 512 * 1024;
constexpr size_t WS_WIN  = 4 * MiB;
constexpr size_t WS_WUPA = 16 * MiB, WS_WUPB = 17 * MiB;
constexpr size_t WS_WOUT = 18 * MiB;
constexpr size_t WS_CW1K = 20 * MiB, WS_CW1V = 20 * MiB + 512 * 1024;
constexpr size_t WS_CW2K = 21 * MiB, WS_CW2V = 21 * MiB + 64 * 1024;
constexpr size_t WS_KC = 22 * MiB, WS_VC = 22 * MiB + 512 * 1024;
constexpr size_t WS_SELM = 23 * MiB;
constexpr size_t WS_TOPI = 24 * MiB, WS_GATE = 24 * MiB + 256 * 1024, WS_DEST = 24 * MiB + 512 * 1024;
constexpr size_t WS_ROWT = 30 * MiB;
constexpr size_t WS_ROWG = 25 * MiB;
constexpr size_t WS_MLB = 26 * MiB, WS_MLLI = 26 * MiB + 256 * 1024;
constexpr size_t WS_RWHI = 25 * MiB + 512 * 1024, WS_RWLO = 25 * MiB + 768 * 1024;
constexpr size_t WS_MLSC = 27 * MiB;
constexpr size_t WS_MLUN = 28 * MiB, WS_MLN = 29 * MiB;
constexpr size_t WS_W1T = 32 * MiB;
constexpr size_t WS_WIN8 = 96 * MiB;
constexpr size_t WS_A1F8 = 674 * MiB;
constexpr size_t WS_SA = 31 * MiB;
constexpr size_t WS_SW = 31 * MiB + 128 * 1024;
constexpr size_t WS_W2T = 160 * MiB;
constexpr size_t WS_H1 = 224 * MiB;
constexpr size_t WS_A1 = 288 * MiB;
constexpr size_t WS_PROJ = 320 * MiB;
constexpr size_t WS_XG = 320 * MiB;
constexpr size_t WS_OCMP = 496 * MiB, WS_ONSA = 512 * MiB, WS_OML = 528 * MiB, WS_MLQ = 544 * MiB, WS_MLKK = 560 * MiB;
constexpr size_t WS_MLU = 576 * MiB;
constexpr size_t WS_MLC = 640 * MiB;
constexpr size_t WS_U = 674 * MiB;
constexpr size_t WS_ACT = 496 * MiB;
constexpr size_t WS_YR = 640 * MiB;
constexpr size_t WS_END = 784 * MiB;
constexpr int CW_BAR = 4096;
constexpr int CW_ECNT = 16384;
constexpr int CW_EFILL = 16384 + 64 * 32;
constexpr int CW_CMAX = 65536;
constexpr int CW_MOETAB = 32768;

constexpr int RING_BYTES = 131072;
constexpr int LDSCTL_OFF = 146432, MISC_OFF = LDSCTL_OFF + 320;
constexpr int LDS_BYTES = 147456;

#define GAS __attribute__((address_space(1)))
#define LAS __attribute__((address_space(3)))
typedef unsigned short bf16;
typedef unsigned v4u __attribute__((ext_vector_type(4)));
typedef unsigned v2u __attribute__((ext_vector_type(2)));
typedef float f32x4 __attribute__((ext_vector_type(4)));
typedef short bf16x8 __attribute__((ext_vector_type(8)));
typedef short s16x4 __attribute__((ext_vector_type(4)));
#define LDS_WAIT() asm volatile("s_waitcnt lgkmcnt(0)" ::: "memory")
#define VM_WAIT() asm volatile("s_waitcnt vmcnt(0)" ::: "memory")
__device__ __forceinline__ unsigned f2bf(float f) { unsigned u = __builtin_bit_cast(unsigned, f); return (u + 0x7fffu + ((u >> 16) & 1u)) >> 16; }
typedef float f32x2_t __attribute__((ext_vector_type(2))); typedef __bf16 bf16x2_t __attribute__((ext_vector_type(2)));
__device__ __forceinline__ unsigned pk2(float lo, float hi) { f32x2_t v = {lo, hi}; bf16x2_t b = __builtin_convertvector(v, bf16x2_t); return __builtin_bit_cast(unsigned, b); }
__device__ __forceinline__ unsigned pk4_fp8(float a, float b, float c, float d) { int w = __builtin_amdgcn_cvt_pk_fp8_f32(a, b, 0, false); w = __builtin_amdgcn_cvt_pk_fp8_f32(c, d, w, true); return (unsigned)w; }
__device__ __forceinline__ float bf2f(unsigned short b) { return __builtin_bit_cast(float, (unsigned)b << 16); }
__device__ __forceinline__ float bflo(unsigned w) { return __builtin_bit_cast(float, w << 16); }
__device__ __forceinline__ float bfhi(unsigned w) { return __builtin_bit_cast(float, w & 0xffff0000u); }
__device__ __forceinline__ float sigmoidf_(float x) { return __builtin_amdgcn_rcpf(1.0f + __builtin_amdgcn_exp2f(x * -1.4426950408889634f)); }
__device__ __forceinline__ float wave_sum(float v) {
#pragma unroll
    for (int o = 1; o < 64; o <<= 1) v += __shfl_xor(v, o);
    return v;
}
__device__ __forceinline__ float wave_max(float v) {
#pragma unroll
    for (int o = 1; o < 64; o <<= 1) v = fmaxf(v, __shfl_xor(v, o));
    return v;
}
#define XB_TMO      128
#define XB_XCNT(j)  (256  + 64 * (j))
#define XB_XSUB(j)  (1280 + 64 * (j))
#define XB_XGEN(j)  (2304 + 64 * (j))
#define XB_TOP      3328
#define XB_TOPGEN   3392
#define XCD_BAR_WORDS 3456
#define XB_SPIN_CAP (1u << 18)

__device__ __forceinline__ unsigned xb_ld(unsigned* p)              { return __hip_atomic_load(p, __ATOMIC_RELAXED, __HIP_MEMORY_SCOPE_AGENT); }
__device__ __forceinline__ unsigned xb_add(unsigned* p, unsigned v) { return __hip_atomic_fetch_add(p, v, __ATOMIC_RELAXED, __HIP_MEMORY_SCOPE_AGENT); }
__device__ __forceinline__ unsigned xb_xcc_id() { return (unsigned)__builtin_amdgcn_s_getreg((3 << 11) | 20) & 0xFu; }
#define XB_SPIN(cond, bar) do { unsigned _sp = 0; while (cond) { __builtin_amdgcn_s_sleep(1); \
    if ((++_sp & 255u) == 0u) { if (xb_ld(&(bar)[XB_TMO])) break; if (_sp > XB_SPIN_CAP) { atomicAdd(&(bar)[XB_TMO], 1u); break; } } } } while (0)

struct XcdBarrier {
    unsigned* bar; unsigned x;
    volatile LAS unsigned* st;
};

__device__ __forceinline__ XcdBarrier xcd_barrier_post(unsigned* bar, volatile LAS unsigned* st) {
    XcdBarrier b; b.bar = bar; b.x = xb_xcc_id(); b.st = st;
    if (threadIdx.x == 0) (void)xb_add(&bar[XB_XCNT(b.x)], 1u);
    return b;
}
__device__ __forceinline__ void xcd_barrier_complete(unsigned* bar, unsigned x, unsigned& nloc, unsigned& nx) {
    const unsigned G = gridDim.x * gridDim.y * gridDim.z;
    unsigned sum, cnt, mine, sp = 0u;
    for (;;) {
        sum = 0u; cnt = 0u; mine = 0u;
#pragma unroll
        for (unsigned j = 0; j < 16; ++j) { const unsigned c = xb_ld(&bar[XB_XCNT(j)]); sum += c; cnt += (c > 0u) ? 1u : 0u; mine = (j == x) ? c : mine; }
        if (sum == G) break;
        __builtin_amdgcn_s_sleep(1);
        if ((++sp & 255u) == 0u) { if (xb_ld(&bar[XB_TMO])) break; if (sp > XB_SPIN_CAP) { atomicAdd(&bar[XB_TMO], 1u); break; } }
    }
    nloc = mine > 0u ? mine : 1u; nx = cnt > 0u ? cnt : 1u;
}

__device__ __forceinline__ void xcd_barrier(const XcdBarrier& b) {
    asm volatile("s_waitcnt vmcnt(0)" ::: "memory");
    __syncthreads();
    if (threadIdx.x == 0) {
        unsigned* bar = b.bar;
        __builtin_amdgcn_s_waitcnt(0);
        unsigned nloc = b.st[0], nx = b.st[1];
        if (nloc == 0u) { xcd_barrier_complete(bar, b.x, nloc, nx); b.st[0] = nloc; b.st[1] = nx; }
        const unsigned old = xb_add(&bar[XB_XSUB(b.x)], 1u);
        const unsigned gen = old / nloc;
        if (old + 1u == (gen + 1u) * nloc) {
            __builtin_amdgcn_fence(__ATOMIC_RELEASE, "agent");
            asm volatile("s_waitcnt vmcnt(0)" ::: "memory");
            const unsigned og = xb_add(&bar[XB_TOP], 1u);
            const unsigned tg = og / nx;
            if (og + 1u == (tg + 1u) * nx) xb_add(&bar[XB_TOPGEN], 1u);
            else XB_SPIN(xb_ld(&bar[XB_TOPGEN]) == tg, bar);
            __builtin_amdgcn_fence(__ATOMIC_ACQUIRE, "agent");
            xb_add(&bar[XB_XGEN(b.x)], 1u);
            asm volatile("s_waitcnt vmcnt(0)" ::: "memory");
        } else {
            XB_SPIN(xb_ld(&bar[XB_XGEN(b.x)]) == gen, bar);
            __builtin_amdgcn_fence(__ATOMIC_ACQUIRE, "agent");
            asm volatile("s_waitcnt vmcnt(0)" ::: "memory");
        }
    }
    __syncthreads();
}

using pg8::Unit; using pg8::HALF; using pg8::BM;
struct EpiStoreBf16 {
    static constexpr bool PERM = true, AFTER_DRAIN = false;
    bf16* O; int ldc;
    __device__ __forceinline__ void operator()(const f32x4 (&acc)[2][2][4][2], const Unit& u, int wr, int wc, int fr, int fq) const {
        const int row0 = u.pm * BM + wr * 64 + fr, col0 = u.pn * BM + wc * 32 + 8 * fq;
#pragma unroll
        for (int ai = 0; ai < 2; ++ai)
#pragma unroll
            for (int m = 0; m < 4; ++m) { bf16* rowp = O + (size_t)(row0 + ai * HALF + m * 16) * ldc + col0;
#pragma unroll
                for (int bj = 0; bj < 2; ++bj) { const f32x4 v0 = acc[ai][bj][m][0], v1 = acc[ai][bj][m][1];
                    v4u w; w.x = pg8::cvt_pk_bf16(v0[0], v0[1]); w.y = pg8::cvt_pk_bf16(v0[2], v0[3]); w.z = pg8::cvt_pk_bf16(v1[0], v1[1]); w.w = pg8::cvt_pk_bf16(v1[2], v1[3]);
                    *(v4u*)(rowp + bj * HALF) = w; } }
    }
};
struct EpiStoreScaled {
    static constexpr bool PERM = true, AFTER_DRAIN = false;
    bf16* O; int ldc; const float* sa; const float* sw;
    __device__ __forceinline__ void operator()(const f32x4 (&acc)[2][2][4][2], const Unit& u, int wr, int wc, int fr, int fq) const {
        const int row0 = u.pm * BM + wr * 64 + fr, col0 = u.pn * BM + wc * 32 + 8 * fq;
        f32x4 cs[2][2];
#pragma unroll
        for (int bj = 0; bj < 2; ++bj)
#pragma unroll
            for (int n = 0; n < 2; ++n) cs[bj][n] = *(const f32x4*)(sw + col0 + bj * HALF + 4 * n);
#pragma unroll
        for (int ai = 0; ai < 2; ++ai)
#pragma unroll
            for (int m = 0; m < 4; ++m) { const int row = row0 + ai * HALF + m * 16; const float rsc = sa[row]; bf16* rowp = O + (size_t)row * ldc + col0;
#pragma unroll
                for (int bj = 0; bj < 2; ++bj) { const f32x4 v0 = acc[ai][bj][m][0] * cs[bj][0] * rsc, v1 = acc[ai][bj][m][1] * cs[bj][1] * rsc;
                    v4u w; w.x = pk2(v0[0], v0[1]); w.y = pk2(v0[2], v0[3]); w.z = pk2(v1[0], v1[1]); w.w = pk2(v1[2], v1[3]);
                    *(v4u*)(rowp + bj * HALF) = w; } }
    }
};
template <bool ADD> struct EpiUpGate {
    static constexpr bool PERM = true, AFTER_DRAIN = false;
    bf16* U; const bf16* G; int goff;
    __device__ __forceinline__ void operator()(const f32x4 (&acc)[2][2][4][2], const Unit& u, int wr, int wc, int fr, int fq) const {
        const int row0 = u.pm * BM + wr * 64 + fr, col0 = u.pn * BM + wc * 32 + 8 * fq;
#pragma unroll
        for (int ai = 0; ai < 2; ++ai)
#pragma unroll
            for (int m = 0; m < 4; ++m) { const size_t row = (size_t)(row0 + ai * HALF + m * 16);
#pragma unroll
                for (int bj = 0; bj < 2; ++bj) { const int col = col0 + bj * HALF;
                    const v4u gw = *(const v4u*)(G + row * PW + goff + col);
                    f32x4 v0 = acc[ai][bj][m][0], v1 = acc[ai][bj][m][1];
                    v0[0] *= sigmoidf_(bflo(gw.x)); v0[1] *= sigmoidf_(bfhi(gw.x)); v0[2] *= sigmoidf_(bflo(gw.y)); v0[3] *= sigmoidf_(bfhi(gw.y));
                    v1[0] *= sigmoidf_(bflo(gw.z)); v1[1] *= sigmoidf_(bfhi(gw.z)); v1[2] *= sigmoidf_(bflo(gw.w)); v1[3] *= sigmoidf_(bfhi(gw.w));
                    if (ADD) { const v4u uw = *(const v4u*)(U + row * DM + col);
                        v0[0] += bflo(uw.x); v0[1] += bfhi(uw.x); v0[2] += bflo(uw.y); v0[3] += bfhi(uw.y); v1[0] += bflo(uw.z); v1[1] += bfhi(uw.z); v1[2] += bflo(uw.w); v1[3] += bfhi(uw.w); }
                    v4u w; w.x = pg8::cvt_pk_bf16(v0[0], v0[1]); w.y = pg8::cvt_pk_bf16(v0[2], v0[3]); w.z = pg8::cvt_pk_bf16(v1[0], v1[1]); w.w = pg8::cvt_pk_bf16(v1[2], v1[3]);
                    *(v4u*)(U + row * DM + col) = w; } }
    }
};
struct EpiOutRes {
    static constexpr bool PERM = true, AFTER_DRAIN = false;
    const float* X; bf16* H; const float* modf;
    __device__ __forceinline__ void operator()(const f32x4 (&acc)[2][2][4][2], const Unit& u, int wr, int wc, int fr, int fq) const {
        const int row0 = u.pm * BM + wr * 64 + fr, col0 = u.pn * BM + wc * 32 + 8 * fq;
        const int b = (u.pm * BM) / SEQ; const float* gt = modf + (size_t)b * 6 * DM + 2 * DM;
        f32x4 gv[2][2];
#pragma unroll
        for (int bj = 0; bj < 2; ++bj)
#pragma unroll
            for (int n = 0; n < 2; ++n) gv[bj][n] = *(const f32x4*)(gt + col0 + bj * HALF + 4 * n) + 1.0f;
#pragma unroll
        for (int ai = 0; ai < 2; ++ai)
#pragma unroll
            for (int m = 0; m < 4; ++m) { const size_t off = (size_t)(row0 + ai * HALF + m * 16) * DM + col0;
#pragma unroll
                for (int bj = 0; bj < 2; ++bj) { const f32x4 x0 = *(const f32x4*)(X + off + bj * HALF), x1 = *(const f32x4*)(X + off + bj * HALF + 4);
                    const f32x4 v0 = x0 + gv[bj][0] * acc[ai][bj][m][0], v1 = x1 + gv[bj][1] * acc[ai][bj][m][1];
                    v4u w; w.x = pk2(v0[0], v0[1]); w.y = pk2(v0[2], v0[3]); w.z = pk2(v1[0], v1[1]); w.w = pk2(v1[2], v1[3]);
                    *(v4u*)(H + off + bj * HALF) = w; } }
    }
};
struct EpiMoe1 {
    static constexpr bool PERM = true, AFTER_DRAIN = false;
    unsigned char* ACT; const LAS float* bt;
    __device__ __forceinline__ void operator()(const f32x4 (&acc)[2][2][4][2], const Unit& u, int wr, int wc, int fr, int fq) const {
        const int e = u.pn >> 3, pnl = u.pn & 7;
        const int row0 = u.pm * BM + wr * 64 + fr, c0 = pnl * 128 + wc * 32 + 8 * fq;
        const LAS float* bg = bt + u.ix * 256 + wc * 32 + 8 * fq; const LAS float* bl = bg + 128; (void)e;
        const f32x4 bg0 = *(const LAS f32x4*)bg, bg1 = *(const LAS f32x4*)(bg + 4), bl0 = *(const LAS f32x4*)bl, bl1 = *(const LAS f32x4*)(bl + 4);
#pragma unroll
        for (int ai = 0; ai < 2; ++ai)
#pragma unroll
            for (int m = 0; m < 4; ++m) { unsigned char* rowp = ACT + (size_t)(row0 + ai * HALF + m * 16) * DE + c0;
                float o[8];
#pragma unroll
                for (int n = 0; n < 2; ++n) { const f32x4 g = acc[ai][0][m][n] + (n ? bg1 : bg0), l = acc[ai][1][m][n] + (n ? bl1 : bl0);
#pragma unroll
                    for (int i = 0; i < 4; ++i) { const float gg = fminf(g[i], 7.0f), ll = fminf(fmaxf(l[i], -7.0f), 7.0f);
                        o[n * 4 + i] = gg * sigmoidf_(1.702f * gg) * (ll + 1.0f); } }
                v2u w; w.x = pk4_fp8(o[0], o[1], o[2], o[3]); w.y = pk4_fp8(o[4], o[5], o[6], o[7]);
                *(v2u*)rowp = w; }
    }
};
struct EpiMoe2 {
    static constexpr bool PERM = true, AFTER_DRAIN = false;
    unsigned char* Y; const LAS float* bt;
    __device__ __forceinline__ void operator()(const f32x4 (&acc)[2][2][4][2], const Unit& u, int wr, int wc, int fr, int fq) const {
        const int pnl = u.pn & 3;
        const int row0 = u.pm * BM + wr * 64 + fr, col0 = pnl * BM + wc * 32 + 8 * fq;
        f32x4 bv[2][2];
#pragma unroll
        for (int bj = 0; bj < 2; ++bj)
#pragma unroll
            for (int n = 0; n < 2; ++n) bv[bj][n] = *(const LAS f32x4*)(bt + u.ix * 512 + wc * 32 + 8 * fq + bj * HALF + 4 * n);
#pragma unroll
        for (int ai = 0; ai < 2; ++ai)
#pragma unroll
            for (int m = 0; m < 4; ++m) { const int row = row0 + ai * HALF + m * 16; const float g = bt[u.ix * 512 + 256 + wr * 64 + fr + ai * HALF + m * 16] * 16.0f; unsigned char* rowp = Y + (size_t)row * DM + col0;
#pragma unroll
                for (int bj = 0; bj < 2; ++bj) { const f32x4 v0 = (acc[ai][bj][m][0] + bv[bj][0]) * g, v1 = (acc[ai][bj][m][1] + bv[bj][1]) * g;
                    v2u w; w.x = pk4_fp8(v0[0], v0[1], v0[2], v0[3]); w.y = pk4_fp8(v1[0], v1[1], v1[2], v1[3]);
                    *(v2u*)(rowp + bj * HALF) = w; } }
    }
};
constexpr int MOE_UL_OFF = 145408;
struct MoeOrder {
    const LAS int* ul; const int* rowtok;
    __device__ __forceinline__ bool next(int i, Unit& u) const { const int pm = ul[2 * i]; if (pm < 0) return false; u.pm = pm; u.pn = ul[2 * i + 1]; u.ix = i; return true; }
    __device__ __forceinline__ void a_ready(const Unit&) const {}
    __device__ __forceinline__ void done(const Unit&) const {}
};
constexpr int MOE_BT1_OFF = 135680, MOE_BT2_OFF = 131072;
template <int WHICH> __device__ __forceinline__ void moe_units_to_lds(LAS unsigned char* lds, const unsigned* tab, int nN, int sh, int G, int v, const float* bias, const float* rg) {
    LAS int* ul = (LAS int*)(lds + MOE_UL_OFF);
    __syncthreads();
    if (threadIdx.x < 16) { const int i = threadIdx.x; const int ntl = (int)tab[0]; const long L = (long)i * G + v; int pm = -1, pn = 0;
        if (L < (long)ntl * nN) { pm = (int)(L >> sh); const int e = (int)tab[64 + pm]; pn = e * nN + (int)(L & (nN - 1)); }
        ul[2 * i] = pm; ul[2 * i + 1] = pn; }
    __syncthreads();
    { float val[9]; const int t = threadIdx.x;
#pragma unroll
      for (int i = 0; i < 9; ++i) { const int pm = ul[2 * i], pn = ul[2 * i + 1]; val[i] = 0.f;
          if (pm >= 0) { if (WHICH == 1) { if (t < 256) { const int e = pn >> 3, pnl = pn & 7; val[i] = bias[(size_t)e * 2048 + (t < 128 ? 128 * pnl + t : 1024 + 128 * pnl + (t - 128))]; } }
                         else { const int e = pn >> 2, pnl = pn & 3; val[i] = t < 256 ? bias[(size_t)e * DM + 256 * pnl + t] : rg[(size_t)pm * 256 + (t - 256)]; } } }
#pragma unroll
      for (int i = 0; i < 9; ++i) { if (WHICH == 1) { if (t < 256) ((LAS float*)(lds + MOE_BT1_OFF))[i * 256 + t] = val[i]; } else if (i < 5) ((LAS float*)(lds + MOE_BT2_OFF))[i * 512 + t] = val[i]; } }
    __syncthreads();
}


struct Args { const float* in[27]; float* out; unsigned char* ws; int ph_lo, ph_hi; };
struct Ctx {
    LAS unsigned char* lds; unsigned char* ws; unsigned* ctl;
    int tid, lane, wave, vcu, G;
    const float* const* in; float* out;
};
enum { I_X = 0, I_C, I_ADAW, I_ADAB, I_N1G, I_WIN, I_PEK, I_PEV, I_CW1K, I_CW2K, I_CW1V, I_CW2V, I_CONVW, I_CONVB, I_GATEB, I_MLNG, I_WUPA, I_WUPB, I_WOUT, I_N2G, I_RW, I_RB, I_EW1, I_EB1, I_EW2, I_EB2, I_FG };

template <class DMap>
__device__ __forceinline__ void p0_transpose_item(const float* W, int K, int N, bf16* WT, const DMap& dmap, LAS float* scr, int item, int lane) {
    const int nblk = N / 32, kb = item / nblk, nb = item % nblk, k0 = 64 * kb, n0 = 32 * nb;
    float tmp[16];
#pragma unroll
    for (int hh = 0; hh < 2; ++hh) {
#pragma unroll
    for (int i = 0; i < 16; ++i) tmp[i] = W[(size_t)(k0 + 2 * (16 * hh + i) + (lane >> 5)) * N + n0 + (lane & 31)];
#pragma unroll
    for (int i = 0; i < 16; ++i) scr[(2 * (16 * hh + i) + (lane >> 5)) * 33 + (lane & 31)] = tmp[i]; }
    LDS_WAIT(); asm volatile("" ::: "memory");
    const int c = lane & 7;
#pragma unroll
    for (int j = 0; j < 4; ++j) { const int n = (lane >> 3) + 8 * j; const LAS float* s = scr + (8 * c) * 33 + n;
        v4u o; o.x = pk2(s[0 * 33], s[1 * 33]); o.y = pk2(s[2 * 33], s[3 * 33]); o.z = pk2(s[4 * 33], s[5 * 33]); o.w = pk2(s[6 * 33], s[7 * 33]);
        *(GAS v4u*)(WT + (size_t)dmap(n0 + n) * K + k0 + 8 * c) = o; }
    LDS_WAIT(); asm volatile("" ::: "memory");
}
struct DMapId { __device__ __forceinline__ int operator()(int n) const { return n; } };
struct DMapWin { __device__ __forceinline__ int operator()(int n) const {
    if (n < 1280) return n;
    if (n < 1304) return PC_NSAG + (n - 1280);
    if (n < 2328) return PC_MLQ + (n - 1304);
    if (n < 2840) return PC_MLV + (n - 2328);
    if (n < 2848) return PC_MLIF + (n - 2840);
    if (n < 3360) return PC_MLO + (n - 2848);
    return PC_MGA + (n - 3360); } };
struct DMapW1 { __device__ __forceinline__ int operator()(int n) const { return n < 1024 ? ((n >> 7) << 8) + (n & 127) : (((n - 1024) >> 7) << 8) + 128 + (n & 127); } };

constexpr int MOE_I1 = (DM / 128) * (2048 / 256), MOE_I2 = (DE / 128) * (DM / 256), MOE_ITEMS = NEXP * (MOE_I1 + MOE_I2);
struct MoeItem { const float* src; unsigned char* dst; int N; bool w1; };
__device__ __forceinline__ MoeItem moe_item(const Ctx& F, int it) {
    MoeItem m;
    if (it < NEXP * MOE_I1) { const int e = it / MOE_I1, l = it % MOE_I1, kb = l >> 3, nb = l & 7; m.w1 = true; m.N = 2048 | (nb << 16);
        m.src = F.in[I_EW1] + (size_t)e * DM * 2048 + (size_t)(128 * kb) * 2048 + 256 * nb; m.dst = F.ws + WS_W1T + (size_t)e * 2048 * DM + 128 * kb; }
    else { const int r = it - NEXP * MOE_I1, e = r / MOE_I2, l = r % MOE_I2, kb = l >> 2, nb = l & 3; m.w1 = false; m.N = DM | (nb << 16);
        m.src = F.in[I_EW2] + (size_t)e * DE * DM + (size_t)(128 * kb) * DM + 256 * nb; m.dst = F.ws + WS_W2T + (size_t)e * DM * DE + 128 * kb; }
    return m;
}
__device__ __forceinline__ void moe_load_item(const Ctx& F, int it, f32x4 (&r)[16]) {
    const MoeItem m = moe_item(F, it); const int N = m.N & 0xffff;
#pragma unroll
    for (int i = 0; i < 16; ++i) r[i] = *(const f32x4*)(m.src + (size_t)(16 * F.wave + i) * N + 4 * F.lane);
}
__device__ __forceinline__ void moe_emit_item(Ctx& F, int it, const f32x4 (&r)[16]) {
    LAS float* tile = (LAS float*)F.lds; const int wave = F.wave, lane = F.lane;
    const MoeItem m = moe_item(F, it); const int nb = m.N >> 16;
    __syncthreads();
#pragma unroll
    for (int i = 0; i < 16; ++i) *(LAS f32x4*)(tile + (16 * wave + i) * 260 + 4 * lane) = r[i] * 32.0f;
    __syncthreads();
    const int n = 32 * wave + (lane >> 1), kh = (lane & 1) * 64; const LAS float* s = tile + kh * 260 + n;
    const int ng = 256 * nb + n; const int drow = m.w1 ? DMapW1()(ng) : ng;
    unsigned char* dst = m.dst + (size_t)drow * DM + kh;
#pragma unroll
    for (int i = 0; i < 4; ++i) { v4u o;
        o.x = pk4_fp8(s[(16 * i + 0) * 260], s[(16 * i + 1) * 260], s[(16 * i + 2) * 260], s[(16 * i + 3) * 260]); o.y = pk4_fp8(s[(16 * i + 4) * 260], s[(16 * i + 5) * 260], s[(16 * i + 6) * 260], s[(16 * i + 7) * 260]);
        o.z = pk4_fp8(s[(16 * i + 8) * 260], s[(16 * i + 9) * 260], s[(16 * i + 10) * 260], s[(16 * i + 11) * 260]); o.w = pk4_fp8(s[(16 * i + 12) * 260], s[(16 * i + 13) * 260], s[(16 * i + 14) * 260], s[(16 * i + 15) * 260]);
        *(GAS v4u*)(dst + 16 * i) = o; }
}
__device__ __forceinline__ void moe_convert(Ctx& F, int first, int stride) {
    f32x4 b0[16], b1[16], b2[16];
    if (first >= MOE_ITEMS) return;
    moe_load_item(F, first, b0);
    if (first + stride < MOE_ITEMS) moe_load_item(F, first + stride, b1);
#pragma unroll 1
    for (int it = first; it < MOE_ITEMS; it += 3 * stride) {
        if (it + 2 * stride < MOE_ITEMS) moe_load_item(F, it + 2 * stride, b2);
        moe_emit_item(F, it, b0);
        if (it + stride >= MOE_ITEMS) break;
        if (it + 3 * stride < MOE_ITEMS) moe_load_item(F, it + 3 * stride, b0);
        moe_emit_item(F, it + stride, b1);
        if (it + 2 * stride >= MOE_ITEMS) break;
        if (it + 4 * stride < MOE_ITEMS) moe_load_item(F, it + 4 * stride, b1);
        moe_emit_item(F, it + 2 * stride, b2);
    }
    __syncthreads();
}
template <class DMap>
__device__ __forceinline__ void p0_transpose_item_f8(const float* W, int K, int N, unsigned char* WT, const DMap& dmap, LAS float* scr, int item, int lane) {
    const int nblk = N / 32, kb = item / nblk, nb = item % nblk, k0 = 128 * kb, n0 = 32 * nb;
    const int lr = lane >> 3, c4 = lane & 7;
    f32x4 tmp[16];
#pragma unroll
    for (int i = 0; i < 16; ++i) tmp[i] = *(const f32x4*)(W + (size_t)(k0 + 8 * i + lr) * N + n0 + 4 * c4);
    const int n = lane >> 1, kq = (lane & 1) * 32;
    unsigned char* dst = WT + (size_t)dmap(n0 + n) * K + k0 + kq;
#pragma unroll
    for (int hh = 0; hh < 2; ++hh) {
#pragma unroll
        for (int i = 0; i < 8; ++i) *(LAS f32x4*)(scr + (8 * i + lr) * 36 + 4 * c4) = tmp[8 * hh + i] * 32.0f;
        LDS_WAIT(); asm volatile("" ::: "memory");
        const LAS float* s = scr + kq * 36 + n;
#pragma unroll
        for (int i = 0; i < 2; ++i) { v4u o;
            o.x = pk4_fp8(s[(16 * i + 0) * 36], s[(16 * i + 1) * 36], s[(16 * i + 2) * 36], s[(16 * i + 3) * 36]); o.y = pk4_fp8(s[(16 * i + 4) * 36], s[(16 * i + 5) * 36], s[(16 * i + 6) * 36], s[(16 * i + 7) * 36]);
            o.z = pk4_fp8(s[(16 * i + 8) * 36], s[(16 * i + 9) * 36], s[(16 * i + 10) * 36], s[(16 * i + 11) * 36]); o.w = pk4_fp8(s[(16 * i + 12) * 36], s[(16 * i + 13) * 36], s[(16 * i + 14) * 36], s[(16 * i + 15) * 36]);
            *(GAS v4u*)(dst + 64 * hh + 16 * i) = o; }
        LDS_WAIT(); asm volatile("" ::: "memory");
    }
}
template <class DMap>
__device__ __forceinline__ void p0_colmax_item(const float* W, int N, unsigned* cmax, const DMap& dmap, int item, int lane) {
    const int nblk = N / 32, kb = item / nblk, nb = item % nblk, k0 = 64 * kb, n0 = 32 * nb;
    float tmp[32];
#pragma unroll
    for (int i = 0; i < 32; ++i) tmp[i] = W[(size_t)(k0 + 2 * i + (lane >> 5)) * N + n0 + (lane & 31)];
    float m = 0.f;
#pragma unroll
    for (int i = 0; i < 32; ++i) m = fmaxf(m, fabsf(tmp[i]));
    m = fmaxf(m, __shfl_xor(m, 32));
    if (lane < 32) atomicMax(cmax + dmap(n0 + lane), __float_as_uint(m));
}
__device__ __forceinline__ unsigned pk4_i8(float a, float b, float c, float d) {
    return (unsigned)(__float2int_rn(a) & 0xff) | ((unsigned)(__float2int_rn(b) & 0xff) << 8) | ((unsigned)(__float2int_rn(c) & 0xff) << 16) | ((unsigned)__float2int_rn(d) << 24);
}
template <class DMap>
__device__ __forceinline__ void p1_quant_item_i8(const float* W, int K, int N, unsigned char* WT, float* sw, const unsigned* cmax, const DMap& dmap, LAS float* scr, int item, int lane) {
    const int nblk = N / 32, kb = item / nblk, nb = item % nblk, k0 = 128 * kb, n0 = 32 * nb;
    const int lr = lane >> 3, c4 = lane & 7;
    f32x4 tmp[16];
#pragma unroll
    for (int i = 0; i < 16; ++i) tmp[i] = *(const f32x4*)(W + (size_t)(k0 + 8 * i + lr) * N + n0 + 4 * c4);
    f32x4 inv;
#pragma unroll
    for (int j = 0; j < 4; ++j) { const float cm = __uint_as_float(cmax[dmap(n0 + 4 * c4 + j)]); inv[j] = cm > 0.f ? 127.0f / cm : 0.f; }
    if (kb == 0 && lane < 32) { const int d = dmap(n0 + lane); sw[d] = __uint_as_float(cmax[d]) * (1.0f / 127.0f); }
    const int n = lane >> 1, kq = (lane & 1) * 32;
    unsigned char* dst = WT + (size_t)dmap(n0 + n) * K + k0 + kq;
#pragma unroll
    for (int hh = 0; hh < 2; ++hh) {
#pragma unroll
        for (int i = 0; i < 8; ++i) *(LAS f32x4*)(scr + (8 * i + lr) * 36 + 4 * c4) = tmp[8 * hh + i] * inv;
        LDS_WAIT(); asm volatile("" ::: "memory");
        const LAS float* s = scr + kq * 36 + n;
#pragma unroll
        for (int i = 0; i < 2; ++i) { v4u o;
            o.x = pk4_i8(s[(16 * i + 0) * 36], s[(16 * i + 1) * 36], s[(16 * i + 2) * 36], s[(16 * i + 3) * 36]); o.y = pk4_i8(s[(16 * i + 4) * 36], s[(16 * i + 5) * 36], s[(16 * i + 6) * 36], s[(16 * i + 7) * 36]);
            o.z = pk4_i8(s[(16 * i + 8) * 36], s[(16 * i + 9) * 36], s[(16 * i + 10) * 36], s[(16 * i + 11) * 36]); o.w = pk4_i8(s[(16 * i + 12) * 36], s[(16 * i + 13) * 36], s[(16 * i + 14) * 36], s[(16 * i + 15) * 36]);
            *(GAS v4u*)(dst + 64 * hh + 16 * i) = o; }
        LDS_WAIT(); asm volatile("" ::: "memory");
    }
}
__device__ __forceinline__ void p0_prologue(Ctx& F) {
    LAS float* scr = (LAS float*)(F.lds + F.wave * 16896);
    const int gw = F.vcu * NWAVES + F.wave, NGW = F.G * NWAVES;
    constexpr int I_IN = (DM / 64) * (INW / 32), I_UP = (512 / 64) * (DM / 32), I_OUT = (DM / 64) * (DM / 32), I_C1 = (2048 / 64) * (128 / 32), I_C2 = (128 / 64) * (64 / 32);
    constexpr int NITEMS = I_IN + 2 * I_UP + I_OUT + 2 * I_C1 + 2 * I_C2;
    for (int it = gw; it < NITEMS; it += NGW) {
        int r = it;
        if (r < I_IN) { p0_colmax_item(F.in[I_WIN], INW, F.ctl + CW_CMAX, DMapWin(), r, F.lane); continue; } r -= I_IN;
        if (r < I_UP) { p0_transpose_item(F.in[I_WUPA], 512, DM, (bf16*)(F.ws + WS_WUPA), DMapId(), scr, r, F.lane); continue; } r -= I_UP;
        if (r < I_UP) { p0_transpose_item(F.in[I_WUPB], 512, DM, (bf16*)(F.ws + WS_WUPB), DMapId(), scr, r, F.lane); continue; } r -= I_UP;
        if (r < I_OUT) { p0_transpose_item(F.in[I_WOUT], DM, DM, (bf16*)(F.ws + WS_WOUT), DMapId(), scr, r, F.lane); continue; } r -= I_OUT;
        if (r < I_C1) { p0_transpose_item(F.in[I_CW1K], 2048, 128, (bf16*)(F.ws + WS_CW1K), DMapId(), scr, r, F.lane); continue; } r -= I_C1;
        if (r < I_C1) { p0_transpose_item(F.in[I_CW1V], 2048, 128, (bf16*)(F.ws + WS_CW1V), DMapId(), scr, r, F.lane); continue; } r -= I_C1;
        if (r < I_C2) { p0_transpose_item(F.in[I_CW2K], 128, 64, (bf16*)(F.ws + WS_CW2K), DMapId(), scr, r, F.lane); continue; } r -= I_C2;
        { p0_transpose_item(F.in[I_CW2V], 128, 64, (bf16*)(F.ws + WS_CW2V), DMapId(), scr, r, F.lane); }
    }
    __syncthreads();
    {
        const int gt = F.vcu * NTHREADS + F.tid, NGT = F.G * NTHREADS;
        const float* c = F.in[I_C]; const float* aw = F.in[I_ADAW]; float* modp = (float*)(F.ws + WS_MODP);
        for (int w = gt; w < ADA_SLICES * 6144; w += NGT) {
            const int s = w / 6144, j = w % 6144; float a0 = 0.f, a1 = 0.f, a2 = 0.f, a3 = 0.f;
#pragma unroll 8
            for (int kk = 0; kk < 64; ++kk) { const int k = s * 64 + kk; const float wv = aw[(size_t)k * 6144 + j];
                const float c0 = c[k], c1 = c[DM + k], c2 = c[2 * DM + k], c3 = c[3 * DM + k];
                a0 += c0 * sigmoidf_(c0) * wv; a1 += c1 * sigmoidf_(c1) * wv; a2 += c2 * sigmoidf_(c2) * wv; a3 += c3 * sigmoidf_(c3) * wv; }
            modp[(size_t)(s * 4 + 0) * 6144 + j] = a0; modp[(size_t)(s * 4 + 1) * 6144 + j] = a1; modp[(size_t)(s * 4 + 2) * 6144 + j] = a2; modp[(size_t)(s * 4 + 3) * 6144 + j] = a3;
        }
        { const float* rw = F.in[I_RW]; bf16* rwhi = (bf16*)(F.ws + WS_RWHI); bf16* rwlo = (bf16*)(F.ws + WS_RWLO);
          for (int w = gt; w < DM * NEXP; w += NGT) { const int e = w >> 10, k = w & 1023; const float x = rw[k * NEXP + e]; const unsigned h = f2bf(x); rwhi[w] = (bf16)h; rwlo[w] = (bf16)f2bf(x - bf2f((unsigned short)h)); } }
        float* pbp = (float*)(F.ws + WS_PBP);
        for (int w = gt; w < PB_SLICES * 2 * 128; w += NGT) {
            const int s = w / 256, kv = (w >> 7) & 1, j = w & 127; const float* pe = F.in[kv ? I_PEV : I_PEK]; const float* w1 = F.in[kv ? I_CW1V : I_CW1K]; float a = 0.f;
#pragma unroll 8
            for (int ii = 0; ii < 128; ++ii) { const int i = s * 128 + ii; a += pe[i] * w1[(size_t)i * 128 + j]; }
            pbp[w] = a;
        }
    }
}

template <bool WITH_MOE>
__device__ __forceinline__ void p_final(Ctx& F, const bf16* H, const float* modf) {
    const unsigned char* Y = F.ws + WS_YR; const int* dest = (const int*)(F.ws + WS_DEST);
    const float* fg = F.in[I_FG];
    f32x4 g[4];
#pragma unroll
    for (int j = 0; j < 4; ++j) g[j] = *(const f32x4*)(fg + 4 * F.lane + 256 * j);
    for (int blk = F.vcu; blk < T / 64; blk += F.G) {
        const int b = (blk * 64) / SEQ, t0 = blk * 64 + F.wave * 8; const float* gt = modf + (size_t)b * 6 * DM + 5 * DM;
        f32x4 gg[4];
#pragma unroll
        for (int j = 0; j < 4; ++j) gg[j] = *(const f32x4*)(gt + 4 * F.lane + 256 * j) + 1.0f;
        int4 dd[8];
#pragma unroll
        for (int i = 0; i < 8; ++i) dd[i] = WITH_MOE ? *(const int4*)(dest + (t0 + i) * 4) : make_int4(0, 0, 0, 0);
#pragma unroll
        for (int i = 0; i < 8; ++i) {
            f32x4 v[4]; unsigned y[4][4]; const int t = t0 + i;
#pragma unroll
            for (int j = 0; j < 4; ++j) { const v2u hw = *(const v2u*)(H + (size_t)t * DM + 4 * F.lane + 256 * j); v[j] = (f32x4){bflo(hw.x), bfhi(hw.x), bflo(hw.y), bfhi(hw.y)}; }
            if (WITH_MOE) {
#pragma unroll
                for (int j = 0; j < 4; ++j) { y[0][j] = *(const unsigned*)(Y + (size_t)dd[i].x * DM + 4 * F.lane + 256 * j); y[1][j] = *(const unsigned*)(Y + (size_t)dd[i].y * DM + 4 * F.lane + 256 * j);
                    y[2][j] = *(const unsigned*)(Y + (size_t)dd[i].z * DM + 4 * F.lane + 256 * j); y[3][j] = *(const unsigned*)(Y + (size_t)dd[i].w * DM + 4 * F.lane + 256 * j); } }
            float ss = 0.f;
#pragma unroll
            for (int j = 0; j < 4; ++j) { f32x4 m = (f32x4){0.f, 0.f, 0.f, 0.f};
                if (WITH_MOE) {
#pragma unroll
                    for (int k = 0; k < TOPK; ++k) { const pg8::f32x2 lo = __builtin_amdgcn_cvt_pk_f32_fp8((int)y[k][j], false), hi = __builtin_amdgcn_cvt_pk_f32_fp8((int)y[k][j], true); m[0] += lo.x; m[1] += lo.y; m[2] += hi.x; m[3] += hi.y; } }
                v[j] = v[j] + gg[j] * m * 0.0625f;
                ss += (v[j][0] * v[j][0] + v[j][1] * v[j][1]) + (v[j][2] * v[j][2] + v[j][3] * v[j][3]); }
            const float rs = rsqrtf(wave_sum(ss) * (1.0f / DM) + NORM_EPS);
#pragma unroll
            for (int j = 0; j < 4; ++j) *(f32x4*)(F.out + (size_t)t * DM + 4 * F.lane + 256 * j) = v[j] * rs * g[j];
        }
    }
}

__device__ __forceinline__ f32x4 mfma16(bf16x8 a, bf16x8 b, f32x4 c) { return __builtin_amdgcn_mfma_f32_16x16x32_bf16(a, b, c, 0, 0, 0); }
typedef short v4i16_t __attribute__((ext_vector_type(4)));
__device__ __forceinline__ s16x4 lds_tr4(const LAS unsigned char* p) { return __builtin_bit_cast(s16x4, __builtin_amdgcn_ds_read_tr16_b64_v4i16((LAS v4i16_t*)p)); }
__device__ __forceinline__ bf16x8 tr_frag(const LAS unsigned char* img, int sb, int r0, int r1, int n0, int lane) {
    const int q = (lane & 15) >> 2, p = lane & 3;
    const s16x4 lo = lds_tr4(img + (r0 + q) * sb + (n0 + 4 * p) * 2), hi = lds_tr4(img + (r1 + q) * sb + (n0 + 4 * p) * 2);
    return (bf16x8){lo[0], lo[1], lo[2], lo[3], hi[0], hi[1], hi[2], hi[3]};
}
__device__ __forceinline__ bf16x8 lds_row8(const LAS unsigned char* img, int sb, int row, int col) { return *(const LAS bf16x8*)(img + row * sb + col * 2); }
__device__ __forceinline__ bf16x8 pack8(const f32x4 a, const f32x4 b) {
    v4u w; w.x = pg8::cvt_pk_bf16(a[0], a[1]); w.y = pg8::cvt_pk_bf16(a[2], a[3]); w.z = pg8::cvt_pk_bf16(b[0], b[1]); w.w = pg8::cvt_pk_bf16(b[2], b[3]);
    return __builtin_bit_cast(bf16x8, w);
}
__device__ __forceinline__ float grp_max(float v) { v = fmaxf(v, __shfl_xor(v, 16)); return fmaxf(v, __shfl_xor(v, 32)); }
__device__ __forceinline__ float grp_sum(float v) { v += __shfl_xor(v, 16); return v + __shfl_xor(v, 32); }
constexpr float NEG_BIG = -1.0e30f;
constexpr float LOG2E = 1.4426950408889634f;
constexpr int KV_SB = 144;
constexpr int W128_SB = 272;

__device__ __forceinline__ float max3f(float a, float b, float c) { return __builtin_fmaxf(__builtin_fmaxf(a, b), c); }
template <int MODE, bool EDGE>
__device__ __forceinline__ void nsa_tile(const LAS unsigned char* Kb, const LAS unsigned char* Vb, int j, int qb, int lane, int gq, int th, const bf16x8 (&qf)[2][2], const unsigned long long (&selm)[2],
                                         f32x4 (&ot)[2][4], float (&lsum)[2], float (&mrun)[2]) {
    f32x4 s[2][4];
#pragma unroll
    for (int kb = 0; kb < 4; ++kb) { const bf16x8 k0 = lds_row8(Kb, KV_SB, 16 * kb + (lane & 15), 8 * gq), k1 = lds_row8(Kb, KV_SB, 16 * kb + (lane & 15), 32 + 8 * gq);
#pragma unroll
        for (int qi = 0; qi < 2; ++qi) { f32x4 a = (f32x4){0.f, 0.f, 0.f, 0.f}; a = mfma16(k0, qf[qi][0], a); a = mfma16(k1, qf[qi][1], a); s[qi][kb] = a; } }
#pragma unroll
    for (int qi = 0; qi < 2; ++qi) {
        bool rowok = true; if (MODE == 0) rowok = (selm[qi] >> j) & 1ull;
        if (EDGE) { const int i = th * 32 + qi * 16 + (lane & 15);
#pragma unroll
            for (int kb = 0; kb < 4; ++kb)
#pragma unroll
                for (int r = 0; r < 4; ++r) { const int kvl = 16 * kb + 4 * gq + r; bool ok;
                    if (MODE == 0) ok = kvl <= i; else { const int rel = (qb - j) * 64 + i - kvl; ok = rel >= 0 && rel < 512; }
                    s[qi][kb][r] = ok ? s[qi][kb][r] : NEG_BIG; } }
        float mx = max3f(max3f(s[qi][0][0], s[qi][0][1], s[qi][0][2]), max3f(s[qi][0][3], s[qi][1][0], s[qi][1][1]), max3f(s[qi][1][2], s[qi][1][3], s[qi][2][0]));
        mx = max3f(mx, max3f(s[qi][2][1], s[qi][2][2], s[qi][2][3]), max3f(s[qi][3][0], s[qi][3][1], max3f(s[qi][3][2], s[qi][3][3], mx)));
        mx = rowok ? mx * (0.125f * LOG2E) : NEG_BIG;
        mx = grp_max(mx);
        const float mnew = fmaxf(mrun[qi], mx);
        if (__any(mnew > mrun[qi])) { const float alpha = __builtin_amdgcn_exp2f(mrun[qi] - mnew); lsum[qi] *= alpha;
#pragma unroll
            for (int db = 0; db < 4; ++db) ot[qi][db] *= alpha; }
        mrun[qi] = mnew;
        const float nb = rowok ? -mnew : -INFINITY;
        float ps = 0.f;
#pragma unroll
        for (int kb = 0; kb < 4; ++kb)
#pragma unroll
            for (int r = 0; r < 4; ++r) { const float p = __builtin_amdgcn_exp2f(fmaf(s[qi][kb][r], 0.125f * LOG2E, nb)); s[qi][kb][r] = p; ps += p; }
        lsum[qi] += ps;
    }
#pragma unroll
    for (int st = 0; st < 2; ++st) {
        const bf16x8 p0 = pack8(s[0][2 * st], s[0][2 * st + 1]), p1 = pack8(s[1][2 * st], s[1][2 * st + 1]);
#pragma unroll
        for (int db = 0; db < 4; ++db) { const bf16x8 vf = tr_frag(Vb, KV_SB, 32 * st + 4 * gq, 32 * st + 16 + 4 * gq, 16 * db, lane);
            ot[0][db] = mfma16(vf, p0, ot[0][db]); ot[1][db] = mfma16(vf, p1, ot[1][db]); }
    }
}
template <int MODE>
__device__ __forceinline__ void nsa_pass(Ctx& F, const bf16* proj, int b, int g, int qb, int kcol, int vcol, const bf16x8 (&qf)[2][2], const unsigned long long (&selm)[2],
                                         f32x4 (&ot)[2][4], float (&lsum)[2]) {
    constexpr int TILEB = 64 * KV_SB, PAIRB = 4 * TILEB;
    const int lane = F.lane, gq = lane >> 4, th = F.wave >> 2;
    const int ntile = MODE == 0 ? qb + 1 : (qb < 8 ? qb + 1 : 9);
    const int lrow = F.tid >> 3, lch = F.tid & 7;
    const size_t rbase = (size_t)b * SEQ;
    float mrun[2] = {NEG_BIG, NEG_BIG};
#pragma unroll
    for (int qi = 0; qi < 2; ++qi) { lsum[qi] = 0.f;
#pragma unroll
        for (int db = 0; db < 4; ++db) ot[qi][db] = (f32x4){0.f, 0.f, 0.f, 0.f}; }
    auto tile_of = [&](int it) { return MODE == 0 ? it : qb - it; };
    v4u ka, va, kb2, vb2;
#define NSA_LOAD(kr, vr, it_) do { const int j_ = tile_of(it_); const bf16* src_ = proj + (rbase + (size_t)j_ * 64 + lrow) * PW + lch * 8; kr = *(const v4u*)(src_ + kcol); vr = *(const v4u*)(src_ + vcol); } while (0)
#define NSA_TILE(pb_, sub_, it_) do { const int j_ = tile_of(it_); const LAS unsigned char* Kb_ = F.lds + (pb_) * PAIRB + (sub_) * 2 * TILEB; const LAS unsigned char* Vb_ = Kb_ + TILEB; \
        const bool edge_ = MODE == 0 ? (j_ == qb) : (j_ == qb || j_ == qb - 8); \
        if (edge_) nsa_tile<MODE, true>(Kb_, Vb_, j_, qb, lane, gq, th, qf, selm, ot, lsum, mrun); \
        else       nsa_tile<MODE, false>(Kb_, Vb_, j_, qb, lane, gq, th, qf, selm, ot, lsum, mrun); } while (0)
    NSA_LOAD(ka, va, 0); if (ntile > 1) NSA_LOAD(kb2, vb2, 1);
    __syncthreads();
#pragma unroll 1
    for (int it = 0, pb = 0; it < ntile; it += 2, pb ^= 1) {
        LAS unsigned char* P = F.lds + pb * PAIRB;
        *(LAS v4u*)(P + lrow * KV_SB + lch * 16) = ka; *(LAS v4u*)(P + TILEB + lrow * KV_SB + lch * 16) = va;
        if (it + 1 < ntile) { *(LAS v4u*)(P + 2 * TILEB + lrow * KV_SB + lch * 16) = kb2; *(LAS v4u*)(P + 3 * TILEB + lrow * KV_SB + lch * 16) = vb2; }
        __syncthreads();
        if (it + 2 < ntile) NSA_LOAD(ka, va, it + 2);
        if (it + 3 < ntile) NSA_LOAD(kb2, vb2, it + 3);
        NSA_TILE(pb, 0, it);
        if (it + 1 < ntile) NSA_TILE(pb, 1, it + 1);
    }
#undef NSA_LOAD
#undef NSA_TILE
}

__device__ __forceinline__ void nsa_selwin_unit(Ctx& F, int b, int g, int qb) {
    const bf16* proj = (const bf16*)(F.ws + WS_PROJ); const bf16* ocmp = (const bf16*)(F.ws + WS_OCMP); bf16* onsa = (bf16*)(F.ws + WS_ONSA);
    const unsigned long long* selmask = (const unsigned long long*)(F.ws + WS_SELM);
    const int lane = F.lane, gq = lane >> 4, hr = F.wave & 3, th = F.wave >> 2, head = g * 4 + hr;
    bf16x8 qf[2][2]; unsigned long long selm[2]; size_t trow[2];
#pragma unroll
    for (int qi = 0; qi < 2; ++qi) { const int t = qb * 64 + th * 32 + qi * 16 + (lane & 15); trow[qi] = (size_t)b * SEQ + t;
        selm[qi] = selmask[(size_t)(b * 2 + g) * SEQ + t];
#pragma unroll
        for (int st = 0; st < 2; ++st) qf[qi][st] = *(const bf16x8*)(proj + trow[qi] * PW + PC_Q + head * 64 + 32 * st + 8 * gq); }
    float g1v[2], g2v[2];
#pragma unroll
    for (int qi = 0; qi < 2; ++qi) { g1v[qi] = bf2f(proj[trow[qi] * PW + PC_NSAG + 8 + head]); g2v[qi] = bf2f(proj[trow[qi] * PW + PC_NSAG + 16 + head]); }
    f32x4 ot[2][4]; float lsum[2];
    nsa_pass<0>(F, proj, b, g, qb, PC_KV + 2 * 128 + g * 64, PC_KV + 3 * 128 + g * 64, qf, selm, ot, lsum);
    LAS v2u* park = (LAS v2u*)(F.lds + 81920 + F.wave * 4096) + lane;
#pragma unroll
    for (int qi = 0; qi < 2; ++qi) { const float gate = sigmoidf_(g1v[qi]) * __builtin_amdgcn_rcpf(grp_sum(lsum[qi]));
#pragma unroll
        for (int db = 0; db < 4; ++db) { const size_t o = trow[qi] * 512 + head * 64 + 16 * db + 4 * gq; const v2u c = *(const v2u*)(ocmp + o);
            f32x4 v = ot[qi][db] * gate; v[0] += bflo(c.x); v[1] += bfhi(c.x); v[2] += bflo(c.y); v[3] += bfhi(c.y);
            v2u pw; pw.x = pk2(v[0], v[1]); pw.y = pk2(v[2], v[3]); park[64 * (qi * 4 + db)] = pw; } }
    nsa_pass<1>(F, proj, b, g, qb, PC_KV + 4 * 128 + g * 64, PC_KV + 5 * 128 + g * 64, qf, selm, ot, lsum);
#pragma unroll
    for (int qi = 0; qi < 2; ++qi) { const float gate = sigmoidf_(g2v[qi]) * __builtin_amdgcn_rcpf(grp_sum(lsum[qi]));
#pragma unroll
        for (int db = 0; db < 4; ++db) { const size_t o = trow[qi] * 512 + head * 64 + 16 * db + 4 * gq; const v2u c = park[64 * (qi * 4 + db)];
            f32x4 v = ot[qi][db] * gate; v[0] += bflo(c.x); v[1] += bfhi(c.x); v[2] += bflo(c.y); v[3] += bfhi(c.y);
            v2u w; w.x = pk2(v[0], v[1]); w.y = pk2(v[2], v[3]); *(v2u*)(onsa + o) = w; } }
}

__device__ __forceinline__ void p1_norm1(Ctx& F) {
    const float* modp = (const float*)(F.ws + WS_MODP); const float* adab = F.in[I_ADAB]; float* modfw = (float*)(F.ws + WS_MODF);
    { const int gt = F.vcu * NTHREADS + F.tid, NGT = F.G * NTHREADS;
      for (int w = gt; w < 4 * 6144; w += NGT) { const int b = w / 6144, j = w % 6144; float a = adab[j];
#pragma unroll
          for (int s = 0; s < ADA_SLICES; ++s) a += modp[(size_t)(s * 4 + b) * 6144 + j];
          modfw[w] = a; } }
    { LAS float* scr = (LAS float*)(F.lds + 16384 + F.wave * 9216); const int gw = F.vcu * NWAVES + F.wave, NGW = F.G * NWAVES;
      for (int it = gw; it < (DM / 128) * (INW / 32); it += NGW) p1_quant_item_i8(F.in[I_WIN], DM, INW, F.ws + WS_WIN, (float*)(F.ws + WS_SW), F.ctl + CW_CMAX, DMapWin(), scr, it, F.lane); }
    LAS float* shs = (LAS float*)F.lds; LAS float* scs = shs + DM;
    const float* x = F.in[I_X]; const float* g1 = F.in[I_N1G]; unsigned char* A1 = F.ws + WS_A1; float* sa = (float*)(F.ws + WS_SA);
    int curb = -1;
    for (int blk = F.vcu; blk < T / 64; blk += F.G) {
        const int b = (blk * 64) / SEQ;
        if (b != curb) { __syncthreads();
            { float pa[4][ADA_SLICES];
#pragma unroll
              for (int q = 0; q < 4; ++q)
#pragma unroll
                  for (int s = 0; s < ADA_SLICES; ++s) pa[q][s] = modp[(size_t)(s * 4 + b) * 6144 + F.tid + q * NTHREADS];
#pragma unroll
              for (int q = 0; q < 4; ++q) { const int j = F.tid + q * NTHREADS; float a = adab[j];
#pragma unroll
                  for (int s = 0; s < ADA_SLICES; ++s) a += pa[q][s];
                  if (j < DM) shs[j] = a; else scs[j - DM] = (1.0f + a) * g1[j - DM]; } }
            __syncthreads(); curb = b; }
        { f32x4 v[8][4];
#pragma unroll
          for (int i = 0; i < 8; ++i)
#pragma unroll
              for (int j = 0; j < 4; ++j) v[i][j] = *(const f32x4*)(x + (size_t)(blk * 64 + F.wave * 8 + i) * DM + 4 * F.lane + 256 * j);
#pragma unroll
          for (int i = 0; i < 8; ++i) { const int t = blk * 64 + F.wave * 8 + i; float ss = 0.f;
#pragma unroll
              for (int j = 0; j < 4; ++j) ss += (v[i][j][0] * v[i][j][0] + v[i][j][1] * v[i][j][1]) + (v[i][j][2] * v[i][j][2] + v[i][j][3] * v[i][j][3]);
              const float rs = rsqrtf(wave_sum(ss) * (1.0f / DM) + NORM_EPS);
              float am = 0.f;
#pragma unroll
              for (int j = 0; j < 4; ++j) { const f32x4 sc = *(const LAS f32x4*)(scs + 4 * F.lane + 256 * j), sh = *(const LAS f32x4*)(shs + 4 * F.lane + 256 * j);
                  v[i][j] = v[i][j] * rs * sc + sh; am = fmaxf(am, fmaxf(fmaxf(fabsf(v[i][j][0]), fabsf(v[i][j][1])), fmaxf(fabsf(v[i][j][2]), fabsf(v[i][j][3])))); }
              am = wave_max(am); const float inv = am > 0.f ? 127.0f / am : 0.f;
              if (F.lane == 0) sa[t] = am * (1.0f / 127.0f);
#pragma unroll
              for (int j = 0; j < 4; ++j) *(unsigned*)(A1 + (size_t)t * DM + 4 * F.lane + 256 * j) = pk4_i8(v[i][j][0] * inv, v[i][j][1] * inv, v[i][j][2] * inv, v[i][j][3] * inv); } }
    }
    __syncthreads();
}

constexpr int RA_SB = 1040;
__device__ __forceinline__ void p8_norm2_router(Ctx& F, const bf16* H, const float* modf) {
    constexpr int QSB = 528;
    LAS unsigned char* Ahi = F.lds; LAS unsigned char* Alo = F.lds + 64 * QSB; LAS unsigned char* Bhi = F.lds + 2 * 64 * QSB; LAS unsigned char* Blo = Bhi + 32 * QSB;
    LAS float* lg = (LAS float*)(F.lds + 2 * 64 * QSB + 2 * 32 * QSB);
    LAS int* hist = (LAS int*)(lg + 64 * 33);
    const float* rb = F.in[I_RB]; const float* g2 = F.in[I_N2G];
    const bf16* rwhi = (const bf16*)(F.ws + WS_RWHI); const bf16* rwlo = (const bf16*)(F.ws + WS_RWLO);
    unsigned char* N2 = F.ws + WS_A1; int* topi = (int*)(F.ws + WS_TOPI); float* gate = (float*)(F.ws + WS_GATE);
    const int lane = F.lane, gq = lane >> 4, w = F.wave;
    if (F.tid < 32) hist[F.tid] = 0;
    f32x4 gv[4];
#pragma unroll
    for (int j = 0; j < 4; ++j) gv[j] = *(const f32x4*)(g2 + 4 * lane + 256 * j);
    for (int blk = F.vcu; blk < T / 64; blk += F.G) {
        const int b = (blk * 64) / SEQ; const float* sh2 = modf + (size_t)b * 6 * DM + 3 * DM; const float* sc2 = sh2 + DM;
        f32x4 scv[4], shv[4];
#pragma unroll
        for (int j = 0; j < 4; ++j) { scv[j] = (*(const f32x4*)(sc2 + 4 * lane + 256 * j) + 1.0f) * gv[j]; shv[j] = *(const f32x4*)(sh2 + 4 * lane + 256 * j); }
#ifndef P8_SEC
#define P8_SEC 0
#endif
#define PS_BEGIN(k) unsigned long long ps##k = 0; if (P8_SEC == (k)) ps##k = __builtin_amdgcn_s_memrealtime();
#define PS_END(k) if (P8_SEC == (k)) { const unsigned long long n_ = __builtin_amdgcn_s_memrealtime(); const unsigned long long e_ = n_ + 4 * (n_ - ps##k); while (__builtin_amdgcn_s_memrealtime() < e_) __builtin_amdgcn_s_sleep(8); }
        PS_BEGIN(1)
        f32x4 v[8][4];
#pragma unroll
        for (int i = 0; i < 8; ++i) { const int t = blk * 64 + w * 8 + i;
#pragma unroll
            for (int j = 0; j < 4; ++j) { const v2u hw = *(const v2u*)(H + (size_t)t * DM + 4 * lane + 256 * j); v[i][j] = (f32x4){bflo(hw.x), bfhi(hw.x), bflo(hw.y), bfhi(hw.y)}; } }
#pragma unroll
        for (int i = 0; i < 8; ++i) { const int t = blk * 64 + w * 8 + i; float ss = 0.f;
#pragma unroll
            for (int j = 0; j < 4; ++j) ss += (v[i][j][0] * v[i][j][0] + v[i][j][1] * v[i][j][1]) + (v[i][j][2] * v[i][j][2] + v[i][j][3] * v[i][j][3]);
            const float rs = rsqrtf(wave_sum(ss) * (1.0f / DM) + NORM_EPS);
#pragma unroll
            for (int j = 0; j < 4; ++j) { v[i][j] = v[i][j] * rs * scv[j] + shv[j];
                *(unsigned*)(N2 + (size_t)t * DM + 4 * lane + 256 * j) = pk4_fp8(v[i][j][0], v[i][j][1], v[i][j][2], v[i][j][3]); } }
        PS_END(1)
        PS_BEGIN(2)
        const int tbk = w & 3, eb = w >> 2; f32x4 acc = (f32x4){0.f, 0.f, 0.f, 0.f};
        const bf16* bsrc_h[2]; const bf16* bsrc_l[2];
#pragma unroll
        for (int i = 0; i < 2; ++i) { const int cc = F.tid + i * NTHREADS, e = cc >> 5, ch = cc & 31; bsrc_h[i] = rwhi + (size_t)e * DM + ch * 8; bsrc_l[i] = rwlo + (size_t)e * DM + ch * 8; }
#pragma unroll
        for (int kq = 0; kq < 4; ++kq) {
            v4u bh[2], bl[2];
#pragma unroll
            for (int i = 0; i < 2; ++i) { bh[i] = *(const v4u*)(bsrc_h[i] + 256 * kq); bl[i] = *(const v4u*)(bsrc_l[i] + 256 * kq); }
            __syncthreads();
#pragma unroll
            for (int i = 0; i < 8; ++i) { const f32x4 x = v[i][kq]; const unsigned h0 = pk2(x[0], x[1]), h1 = pk2(x[2], x[3]);
                const unsigned l0 = pk2(x[0] - bflo(h0), x[1] - bfhi(h0)), l1 = pk2(x[2] - bflo(h1), x[3] - bfhi(h1));
                const int off = (w * 8 + i) * QSB + 8 * lane;
                *(LAS v2u*)(Ahi + off) = (v2u){h0, h1}; *(LAS v2u*)(Alo + off) = (v2u){l0, l1}; }
#pragma unroll
            for (int i = 0; i < 2; ++i) { const int cc = F.tid + i * NTHREADS, e = cc >> 5, ch = cc & 31; *(LAS v4u*)(Bhi + e * QSB + ch * 16) = bh[i]; *(LAS v4u*)(Blo + e * QSB + ch * 16) = bl[i]; }
            __syncthreads();
#pragma unroll
            for (int s = 0; s < 8; ++s) {
                const bf16x8 wh = lds_row8(Bhi, QSB, 16 * eb + (lane & 15), 32 * s + 8 * gq), wl = lds_row8(Blo, QSB, 16 * eb + (lane & 15), 32 * s + 8 * gq);
                const bf16x8 ah = lds_row8(Ahi, QSB, 16 * tbk + (lane & 15), 32 * s + 8 * gq), al = lds_row8(Alo, QSB, 16 * tbk + (lane & 15), 32 * s + 8 * gq);
                acc = mfma16(ah, wh, acc); acc = mfma16(al, wh, acc); acc = mfma16(ah, wl, acc); }
        }
        PS_END(2)
        PS_BEGIN(3)
        { const int e = 16 * eb + (lane & 15); const float rbe = rb[e];
#pragma unroll
          for (int r = 0; r < 4; ++r) lg[(16 * tbk + 4 * gq + r) * 33 + e] = acc[r] + rbe; }
        __syncthreads();
        if (F.tid < 64) { const int t = blk * 64 + F.tid; float lv[32];
#pragma unroll
            for (int e = 0; e < 32; ++e) lv[e] = lg[F.tid * 33 + e];
            int si[4]; float sv[4];
#pragma unroll
            for (int k = 0; k < 4; ++k) { float m = -3.0e38f; int mi = 0;
#pragma unroll
                for (int e = 0; e < 32; ++e) { const bool gt = lv[e] > m; m = gt ? lv[e] : m; mi = gt ? e : mi; }
#pragma unroll
                for (int e = 0; e < 32; ++e) lv[e] = (e == mi) ? -3.0e38f : lv[e];
                si[k] = mi; sv[k] = m; }
            const float e1 = __expf(sv[1] - sv[0]), e2 = __expf(sv[2] - sv[0]), e3 = __expf(sv[3] - sv[0]); const float inv = 1.0f / (1.0f + e1 + e2 + e3);
            *(int4*)(topi + t * 4) = make_int4(si[0], si[1], si[2], si[3]); *(f32x4*)(gate + t * 4) = (f32x4){inv, e1 * inv, e2 * inv, e3 * inv};
#pragma unroll
            for (int k = 0; k < 4; ++k) __hip_atomic_fetch_add(&hist[si[k]], 1, __ATOMIC_RELAXED, __HIP_MEMORY_SCOPE_WORKGROUP); }
        PS_END(3)
    }
    __syncthreads();
    if (F.tid < 32) { const int h = hist[F.tid]; if (h) __hip_atomic_fetch_add(F.ctl + CW_ECNT + 64 * F.tid, (unsigned)h, __ATOMIC_RELAXED, __HIP_MEMORY_SCOPE_AGENT); }
    __syncthreads();
}

__device__ __forceinline__ void p9_permute(Ctx& F) {
    LAS int* sm = (LAS int*)F.lds; LAS int* cnt = sm, *pstart = sm + 32, *lhist = sm + 64, *lbase = sm + 96, *dl = sm + 128;
    if (F.tid < 32) cnt[F.tid] = (int)__hip_atomic_load(F.ctl + CW_ECNT + 64 * F.tid, __ATOMIC_RELAXED, __HIP_MEMORY_SCOPE_AGENT);
    __syncthreads();
    if (F.tid < 64) {
        const int e = F.tid; const int pc = e < NEXP ? (cnt[e < NEXP ? e : 0] + MOE_ROWS - 1) / MOE_ROWS * MOE_ROWS : 0; int inc = pc;
#pragma unroll
        for (int o = 1; o < 32; o <<= 1) { const int u = __shfl_up(inc, o); if (F.lane >= o) inc += u; }
        if (e < NEXP) pstart[e] = inc - pc;
        if (blockIdx.x == 0 && e < NEXP) { unsigned* tab = F.ctl + CW_MOETAB; const int t0 = (inc - pc) / MOE_ROWS, nt = pc / MOE_ROWS;
            for (int i = 0; i < nt; ++i) tab[64 + t0 + i] = (unsigned)e;
            if (e == NEXP - 1) tab[0] = (unsigned)(inc / MOE_ROWS); } }
    __syncthreads();
    int* rowt = (int*)(F.ws + WS_ROWT);
    for (int e = F.vcu; e < NEXP; e += F.G) { const int c = cnt[e], pe = (c + MOE_ROWS - 1) / MOE_ROWS * MOE_ROWS; for (int r = c + F.tid; r < pe; r += NTHREADS) rowt[pstart[e] + r] = 0; }
    const int* topi = (const int*)(F.ws + WS_TOPI); const float* gate = (const float*)(F.ws + WS_GATE); int* dest = (int*)(F.ws + WS_DEST); float* rowg = (float*)(F.ws + WS_ROWG);
    for (int blk = F.vcu; blk < T / 64; blk += F.G) {
        if (F.tid < 32) lhist[F.tid] = 0;
        __syncthreads();
        int e = 0, rank = 0; const int a = blk * 256 + F.tid;
        if (F.tid < 256) { e = topi[a]; rank = __hip_atomic_fetch_add(&lhist[e], 1, __ATOMIC_RELAXED, __HIP_MEMORY_SCOPE_WORKGROUP); }
        __syncthreads();
        if (F.tid < 32) { const int h = lhist[F.tid]; lbase[F.tid] = pstart[F.tid] + (h ? (int)__hip_atomic_fetch_add(F.ctl + CW_EFILL + 64 * F.tid, (unsigned)h, __ATOMIC_RELAXED, __HIP_MEMORY_SCOPE_AGENT) : 0); }
        __syncthreads();
        if (F.tid < 256) { const int d = lbase[e] + rank; dest[a] = d; rowg[d] = gate[a]; rowt[d] = a >> 2; }
        __syncthreads();
        __syncthreads();
    }
}

__device__ __forceinline__ float gelu_tanh(float x) { const float u = 0.7978845608028654f * (x + 0.044715f * x * x * x); const float e = __builtin_amdgcn_exp2f(u * 2.8853900817779268f); const float th = 1.0f - 2.0f * __builtin_amdgcn_rcpf(e + 1.0f); return 0.5f * x * (1.0f + th); }
__device__ __forceinline__ void nsa_compress_unit(Ctx& F, int unit) {
    const int nt = unit & 15, kv = (unit >> 4) & 1, bg = unit >> 5, b = bg >> 1, g = bg & 1, n0 = nt * 16;
    const bf16* proj = (const bf16*)(F.ws + WS_PROJ);
    const bf16* w1t = (const bf16*)(F.ws + (kv ? WS_CW1V : WS_CW1K)); const bf16* w2t = (const bf16*)(F.ws + (kv ? WS_CW2V : WS_CW2K));
    bf16* outp = (bf16*)(F.ws + (kv ? WS_VC : WS_KC)) + (size_t)bg * 256 * 64;
    const float* pbp = (const float*)(F.ws + WS_PBP);
    LAS float* part = (LAS float*)F.lds;
    LAS unsigned char* Hs = F.lds + 65536;
    const int lane = F.lane, gq = lane >> 4, w = F.wave;
    const int col = PC_KV + kv * 128 + g * 64;
    int nrow = n0 + (lane & 15); if (nrow > 254) nrow = 254;
    const bf16* arow = proj + ((size_t)b * SEQ + 16 * nrow + 4 * w) * PW + col + 8 * gq;
    const bf16* brow = w1t + (size_t)(lane & 15) * 2048 + 256 * w + 8 * gq;
    f32x4 acc[8];
#pragma unroll
    for (int cb = 0; cb < 8; ++cb) acc[cb] = (f32x4){0.f, 0.f, 0.f, 0.f};
#pragma unroll
    for (int h2 = 0; h2 < 2; ++h2) {
        bf16x8 af[4], bfr[4][8];
#pragma unroll
        for (int s4 = 0; s4 < 4; ++s4) { const int s = 4 * h2 + s4; af[s4] = *(const bf16x8*)(arow + (size_t)(s >> 1) * PW + (s & 1) * 32);
#pragma unroll
            for (int cb = 0; cb < 8; ++cb) bfr[s4][cb] = *(const bf16x8*)(brow + (size_t)(16 * cb) * 2048 + 32 * s); }
#pragma unroll
        for (int s4 = 0; s4 < 4; ++s4)
#pragma unroll
            for (int cb = 0; cb < 8; ++cb) acc[cb] = mfma16(af[s4], bfr[s4][cb], acc[cb]);
    }
    __syncthreads();
#pragma unroll
    for (int cb = 0; cb < 8; ++cb)
#pragma unroll
        for (int r = 0; r < 4; ++r) part[(w * 16 + 4 * gq + r) * 128 + 16 * cb + (lane & 15)] = acc[cb][r];
    __syncthreads();
    { const int j = F.tid & 127, r0 = F.tid >> 7; float pb = 0.f;
#pragma unroll
      for (int s = 0; s < PB_SLICES; ++s) pb += pbp[(s * 2 + kv) * 128 + j];
#pragma unroll
      for (int q = 0; q < 4; ++q) { const int row = r0 + 4 * q; float a = pb;
#pragma unroll
          for (int ww = 0; ww < 8; ++ww) a += part[(ww * 16 + row) * 128 + j];
          *(LAS unsigned short*)(Hs + row * W128_SB + j * 2) = (unsigned short)f2bf(gelu_tanh(a)); } }
    __syncthreads();
    if (w < 4) {
        f32x4 o = (f32x4){0.f, 0.f, 0.f, 0.f};
#pragma unroll
        for (int s = 0; s < 4; ++s) { const bf16x8 a = lds_row8(Hs, W128_SB, lane & 15, 32 * s + 8 * gq); const bf16x8 bb = *(const bf16x8*)(w2t + (size_t)(16 * w + (lane & 15)) * 128 + 32 * s + 8 * gq); o = mfma16(a, bb, o); }
#pragma unroll
        for (int r = 0; r < 4; ++r) { const int n = n0 + 4 * gq + r; outp[(size_t)n * 64 + 16 * w + (lane & 15)] = (unsigned short)(n < 255 ? f2bf(o[r]) : 0u); }
    }
}

__device__ __forceinline__ void nsa_cmp_unit(Ctx& F, int bg, int tb) {
    const int b = bg >> 1, g = bg & 1;
    const bf16* proj = (const bf16*)(F.ws + WS_PROJ); bf16* ocmp = (bf16*)(F.ws + WS_OCMP);
    const bf16* kc = (const bf16*)(F.ws + WS_KC) + (size_t)bg * 256 * 64; const bf16* vc = (const bf16*)(F.ws + WS_VC) + (size_t)bg * 256 * 64;
    unsigned long long* selmask = (unsigned long long*)(F.ws + WS_SELM);
    LAS unsigned char* Kt = F.lds; LAS unsigned char* Vt = F.lds + 256 * KV_SB; LAS float* IMP = (LAS float*)(F.lds + 2 * 256 * KV_SB);
    const int lane = F.lane, gq = lane >> 4, w = F.wave, tg = w >> 2, hp = w & 3;
    const int nvmax = 4 * tb + 3;
    const int nkb = (nvmax + 15) >> 4;
#ifndef CMP_SEC
#define CMP_SEC 0
#endif
#define CS_BEGIN(k) unsigned long long cs##k = 0; if (CMP_SEC == (k)) cs##k = __builtin_amdgcn_s_memrealtime();
#define CS_END(k) if (CMP_SEC == (k)) { const unsigned long long n_ = __builtin_amdgcn_s_memrealtime(); const unsigned long long e_ = n_ + 4 * (n_ - cs##k); while (__builtin_amdgcn_s_memrealtime() < e_) __builtin_amdgcn_s_sleep(8); }
    CS_BEGIN(1)
    const int head = g * 4 + hp;
    bf16x8 qv[2][2]; float gatev[2];
#pragma unroll
    for (int qi = 0; qi < 2; ++qi) { const size_t trow = (size_t)b * SEQ + tb * 64 + tg * 32 + qi * 16 + (lane & 15);
        qv[qi][0] = *(const bf16x8*)(proj + trow * PW + PC_Q + head * 64 + 8 * gq); qv[qi][1] = *(const bf16x8*)(proj + trow * PW + PC_Q + head * 64 + 32 + 8 * gq);
        gatev[qi] = bf2f(proj[trow * PW + PC_NSAG + head]); }
    const int nrows = ((nkb + 1) & ~1) * 16;
    { v4u kk[4], vv[4];
#pragma unroll
      for (int i = 0; i < 4; ++i) { const int it = F.tid + i * NTHREADS, row = it >> 3, ch = it & 7; if (row < nrows) { kk[i] = *(const v4u*)(kc + row * 64 + ch * 8); vv[i] = *(const v4u*)(vc + row * 64 + ch * 8); } }
      __syncthreads();
#pragma unroll
      for (int i = 0; i < 4; ++i) { const int it = F.tid + i * NTHREADS, row = it >> 3, ch = it & 7; if (row < nrows) { *(LAS v4u*)(Kt + row * KV_SB + ch * 16) = kk[i]; *(LAS v4u*)(Vt + row * KV_SB + ch * 16) = vv[i]; } } }
    __syncthreads();
    CS_END(1)
    CS_BEGIN(2)
    LAS float* IMPW = IMP + hp * 64 * 64;
#pragma unroll
    for (int qi = 0; qi < 2; ++qi) {
        const int tl = tg * 32 + qi * 16 + (lane & 15), t = tb * 64 + tl; const size_t trow = (size_t)b * SEQ + t;
        const int nv = ((t + 1) >> 4) - 1;
        float imp[16], carry[16];
        {
            const bf16x8 q0 = qv[qi][0], q1 = qv[qi][1];
            float ml = NEG_BIG;
#pragma unroll 2
            for (int kb = 0; kb < nkb; ++kb) { f32x4 a = (f32x4){0.f, 0.f, 0.f, 0.f};
                a = mfma16(lds_row8(Kt, KV_SB, 16 * kb + (lane & 15), 8 * gq), q0, a); a = mfma16(lds_row8(Kt, KV_SB, 16 * kb + (lane & 15), 32 + 8 * gq), q1, a);
#pragma unroll
                for (int r = 0; r < 4; ++r) { const int n = 16 * kb + 4 * gq + r; ml = fmaxf(ml, (n < nv) ? a[r] : NEG_BIG); } }
            const float mx = grp_max(ml) * (0.125f * LOG2E);
            f32x4 o[4]; float psl = 0.f;
#pragma unroll
            for (int db = 0; db < 4; ++db) o[db] = (f32x4){0.f, 0.f, 0.f, 0.f};
#pragma unroll
            for (int st = 0; st < 8; ++st) { imp[2 * st] = 0.f; imp[2 * st + 1] = 0.f; carry[2 * st] = 0.f; carry[2 * st + 1] = 0.f; if (2 * st < nkb) {
                f32x4 pp[2];
#pragma unroll
                for (int k2 = 0; k2 < 2; ++k2) { const int kb = 2 * st + k2; f32x4 a = (f32x4){0.f, 0.f, 0.f, 0.f};
                    a = mfma16(lds_row8(Kt, KV_SB, 16 * kb + (lane & 15), 8 * gq), q0, a); a = mfma16(lds_row8(Kt, KV_SB, 16 * kb + (lane & 15), 32 + 8 * gq), q1, a);
#pragma unroll
                    for (int r = 0; r < 4; ++r) { const int n = 16 * kb + 4 * gq + r; a[r] = (n < nv) ? __builtin_amdgcn_exp2f(fmaf(a[r], 0.125f * LOG2E, -mx)) : 0.f; }
                    pp[k2] = a; psl += (a[0] + a[1]) + (a[2] + a[3]); imp[kb] = (a[0] + a[1]) + (a[2] + 0.5f * a[3]); carry[kb] = 0.5f * a[3]; }
                const bf16x8 pf = pack8(pp[0], pp[1]);
#pragma unroll
                for (int db = 0; db < 4; ++db) o[db] = mfma16(tr_frag(Vt, KV_SB, 32 * st + 4 * gq, 32 * st + 16 + 4 * gq, 16 * db, lane), pf, o[db]);
                asm volatile("" ::: "memory"); } }
            const float ps = grp_sum(psl);
            const float inv = ps > 0.f ? __builtin_amdgcn_rcpf(ps) : 0.f;
#pragma unroll
            for (int kb = 0; kb < 16; ++kb) { imp[kb] *= inv; carry[kb] *= inv; }
            const float gate = sigmoidf_(gatev[qi]) * inv;
#pragma unroll
            for (int db = 0; db < 4; ++db) { const f32x4 v = o[db] * gate; v2u wv; wv.x = pg8::cvt_pk_bf16(v[0], v[1]); wv.y = pg8::cvt_pk_bf16(v[2], v[3]);
                *(v2u*)(ocmp + trow * 512 + head * 64 + 16 * db + 4 * gq) = wv; }
        }
#pragma unroll
        for (int kb = 0; kb < 16; ++kb) { const float c1 = __shfl(carry[kb], (lane + 48) & 63); const float c0 = kb > 0 ? __shfl(carry[kb > 0 ? kb - 1 : 0], (lane + 48) & 63) : 0.f;
            IMPW[tl * 64 + 4 * kb + gq] = imp[kb] + (gq > 0 ? c1 : c0); }
    }
    CS_END(2)
    __syncthreads();
    CS_BEGIN(3)
    LAS float* VA = (LAS float*)(F.lds + 2 * 256 * KV_SB + 4 * 64 * 64 * 4) + w * 64;
    for (int tl = w; tl < 64; tl += NWAVES) { const int t = tb * 64 + tl, cur = t >> 6;
        float v = (IMP[tl * 64 + lane] + IMP[4096 + tl * 64 + lane]) + (IMP[2 * 4096 + tl * 64 + lane] + IMP[3 * 4096 + tl * 64 + lane]); const bool forced = (lane == 0) || (lane == cur) || (lane == cur - 1);
        v = (lane > cur) ? NEG_BIG : v + (forced ? 1.0e4f : 0.f);
        unsigned key = __float_as_uint(v); key = (key & 0x80000000u) ? ~key : (key | 0x80000000u); key = (key & ~63u) | (unsigned)(63 - lane);
        ((LAS unsigned*)VA)[lane] = key;
        int rank = 0;
#pragma unroll
        for (int j4 = 0; j4 < 16; ++j4) { const v4u o = *(const LAS v4u*)((LAS unsigned*)VA + 4 * j4);
            rank += (o.x > key ? 1 : 0) + (o.y > key ? 1 : 0) + (o.z > key ? 1 : 0) + (o.w > key ? 1 : 0); }
        const unsigned long long m = __ballot(lane <= cur && rank < 16);
        if (lane == 0) selmask[(size_t)bg * SEQ + t] = m; }
    CS_END(3)
}

constexpr int ML_H = 4, ML_D = 128, ML_L = 64, ML_NCH = SEQ / ML_L, ML_BH = BATCH * ML_H;
__device__ __forceinline__ float log_sigmoid(float x) { return fminf(x, 0.f) - log1pf(__expf(-fabsf(x))); }
__device__ __forceinline__ float siluf_(float x) { return x * sigmoidf_(x); }
constexpr int ML_CW_OFF = 40960;
__device__ __forceinline__ void ml_stage_a_weights(Ctx& F, int h) {
    LAS float* cwl = (LAS float*)(F.lds + ML_CW_OFF); const float* convw = F.in[I_CONVW]; const float* convb = F.in[I_CONVB];
    __syncthreads();
    for (int i = F.tid; i < 1280; i += NTHREADS) { const int tap = i >> 8, r = i & 255, which = r >> 7, ch = r & 127; const int cch = which * 512 + h * 128 + ch;
        cwl[i] = tap < 4 ? convw[tap * 1024 + cch] : convb[cch]; }
    __syncthreads();
}
__device__ __forceinline__ void ml_stage_a(Ctx& F, int unit) {
    const int c = unit & 63, bh = unit >> 6, b = bh >> 2, h = bh & 3;
    const bf16* proj = (const bf16*)(F.ws + WS_PROJ); bf16* mlq = (bf16*)(F.ws + WS_MLQ); bf16* mlk = (bf16*)(F.ws + WS_MLKK);
    float* mlb = (float*)(F.ws + WS_MLB); float* mlli = (float*)(F.ws + WS_MLLI); float* mlsc = (float*)(F.ws + WS_MLSC);
    bf16* mlu = (bf16*)(F.ws + WS_MLU) + (size_t)unit * ML_D * ML_D; float* mlun = (float*)(F.ws + WS_MLUN) + (size_t)unit * ML_D;
    const float* convw = F.in[I_CONVW]; const float* convb = F.in[I_CONVB]; const float* gateb = F.in[I_GATEB];
    LAS unsigned char* KW = F.lds; LAS unsigned char* Vs = F.lds + 64 * W128_SB; LAS float* wts = (LAS float*)(F.lds + 2 * 64 * W128_SB); LAS float* gsc = wts + 64; const LAS float* cwl = (const LAS float*)(F.lds + ML_CW_OFF);
    const int t0 = c * ML_L; const size_t row0 = (size_t)b * SEQ + t0;
#ifndef MLA_SEC
#define MLA_SEC 0
#endif
#define MA_BEGIN(k) unsigned long long ma##k = 0; if (MLA_SEC == (k)) ma##k = __builtin_amdgcn_s_memrealtime();
#define MA_END(k) if (MLA_SEC == (k)) { const unsigned long long n_ = __builtin_amdgcn_s_memrealtime(); const unsigned long long e_ = n_ + 4 * (n_ - ma##k); while (__builtin_amdgcn_s_memrealtime() < e_) __builtin_amdgcn_s_sleep(8); }
    MA_BEGIN(1)
    v4u xin[4][4]; v4u vin[2];
#pragma unroll
      for (int ii = 0; ii < 4; ++ii) { const int it = F.tid + ii * NTHREADS; const int ch8 = it & 15, s = (it >> 4) & 63, which = it >> 10; const int pcol = (which ? PC_MLK : PC_MLQ) + h * 128 + ch8 * 8;
#pragma unroll
          for (int wv = 0; wv < 4; ++wv) { const int tt = t0 + s - 3 + wv; xin[ii][wv] = (tt >= 0) ? *(const v4u*)(proj + ((size_t)b * SEQ + tt) * PW + pcol) : (v4u){0u, 0u, 0u, 0u}; } }
#pragma unroll
      for (int ii = 0; ii < 2; ++ii) { const int it = F.tid + ii * NTHREADS; const int ch8 = it & 15, s = it >> 4; vin[ii] = *(const v4u*)(proj + (row0 + s) * PW + PC_MLV + h * 128 + ch8 * 8); }
    __syncthreads();
    if (F.tid < 64) { const int s = F.tid; const float ip = bf2f(proj[(row0 + s) * PW + PC_MLIF + h]) + gateb[h], fp = bf2f(proj[(row0 + s) * PW + PC_MLIF + 4 + h]) + gateb[4 + h];
        gsc[s] = log_sigmoid(fp); gsc[64 + s] = ip; }
    __syncthreads();
    if (F.tid < 64) {
        float v = gsc[F.tid];
#pragma unroll
        for (int o = 1; o < 64; o <<= 1) { const float u = __shfl_up(v, o); if (F.lane >= o) v += u; }
        const float bL = __shfl(v, 63); const float li = gsc[64 + F.tid]; const float a = bL - v + li; const float amax = wave_max(a);
        wts[F.tid] = __expf(a - amax); mlb[(size_t)bh * SEQ + t0 + F.tid] = v; mlli[(size_t)bh * SEQ + t0 + F.tid] = li;
        if (F.tid == 0) { mlsc[unit * 2 + 0] = amax; mlsc[unit * 2 + 1] = bL; } }
    __syncthreads();
    MA_END(1)
    MA_BEGIN(2)
    {
#pragma unroll
      for (int ii = 0; ii < 4; ++ii) { const int it = F.tid + ii * NTHREADS; const int ch8 = it & 15, s = (it >> 4) & 63, which = it >> 10;
        const int cch = which * 512 + h * 128 + ch8 * 8;
        float acc[8]; const int lc = which * 128 + ch8 * 8;
        { const f32x4 b0 = *(const LAS f32x4*)(cwl + 1024 + lc), b1 = *(const LAS f32x4*)(cwl + 1024 + lc + 4); acc[0] = b0[0]; acc[1] = b0[1]; acc[2] = b0[2]; acc[3] = b0[3]; acc[4] = b1[0]; acc[5] = b1[1]; acc[6] = b1[2]; acc[7] = b1[3]; }
#pragma unroll
        for (int wv = 0; wv < 4; ++wv) { const v4u x = xin[ii][wv];
            const f32x4 w0 = *(const LAS f32x4*)(cwl + wv * 256 + lc), w1 = *(const LAS f32x4*)(cwl + wv * 256 + lc + 4);
            acc[0] += bflo(x.x) * w0[0]; acc[1] += bfhi(x.x) * w0[1]; acc[2] += bflo(x.y) * w0[2]; acc[3] += bfhi(x.y) * w0[3];
            acc[4] += bflo(x.z) * w1[0]; acc[5] += bfhi(x.z) * w1[1]; acc[6] += bflo(x.w) * w1[2]; acc[7] += bfhi(x.w) * w1[3]; }
        const float sc = which ? 0.08838834764831845f : 1.0f;
#pragma unroll
        for (int j = 0; j < 8; ++j) acc[j] = siluf_(acc[j]) * sc;
        v4u o; o.x = pk2(acc[0], acc[1]); o.y = pk2(acc[2], acc[3]); o.z = pk2(acc[4], acc[5]); o.w = pk2(acc[6], acc[7]);
        *(v4u*)((which ? mlk : mlq) + (row0 + s) * 512 + h * 128 + ch8 * 8) = o;
        if (which) { const float ws = wts[s]; v4u kw; kw.x = pk2(acc[0] * ws, acc[1] * ws); kw.y = pk2(acc[2] * ws, acc[3] * ws); kw.z = pk2(acc[4] * ws, acc[5] * ws); kw.w = pk2(acc[6] * ws, acc[7] * ws);
            *(LAS v4u*)(KW + s * W128_SB + ch8 * 16) = kw; } }
#pragma unroll
      for (int ii = 0; ii < 2; ++ii) { const int it = F.tid + ii * NTHREADS; const int ch8 = it & 15, s = it >> 4; *(LAS v4u*)(Vs + s * W128_SB + ch8 * 16) = vin[ii]; } }
    __syncthreads();
    MA_END(2)
    MA_BEGIN(3)
    { const int lane = F.lane, gq = lane >> 4, w = F.wave;
      const bf16x8 a0 = tr_frag(KW, W128_SB, 8 * gq, 8 * gq + 4, 16 * w, lane), a1 = tr_frag(KW, W128_SB, 32 + 8 * gq, 32 + 8 * gq + 4, 16 * w, lane);
#pragma unroll
      for (int eb = 0; eb < 8; ++eb) { f32x4 acc = (f32x4){0.f, 0.f, 0.f, 0.f};
          acc = mfma16(a0, tr_frag(Vs, W128_SB, 8 * gq, 8 * gq + 4, 16 * eb, lane), acc); acc = mfma16(a1, tr_frag(Vs, W128_SB, 32 + 8 * gq, 32 + 8 * gq + 4, 16 * eb, lane), acc);
          v2u uw; uw.x = pk2(acc[0], acc[1]); uw.y = pk2(acc[2], acc[3]);        *(v2u*)(mlu + (size_t)(16 * eb + (lane & 15)) * ML_D + 16 * w + 4 * gq) = uw; } }
    if (F.tid < ML_D) { float a = 0.f;
#pragma unroll 8
        for (int s = 0; s < 64; ++s) a += bf2f(*(const LAS unsigned short*)(KW + s * W128_SB + F.tid * 2));
        mlun[F.tid] = a; }
    MA_END(3)
}
__device__ __forceinline__ void ml_stage_b(Ctx& F, int unit) {
    const int sl = unit & 15, bh = unit >> 4;
    const float* mlsc = (const float*)(F.ws + WS_MLSC); float* mlm = (float*)(F.ws + WS_MLSC) + 4096;
    const bf16* mlu = (const bf16*)(F.ws + WS_MLU) + (size_t)bh * 64 * ML_D * ML_D; bf16* mlc = (bf16*)(F.ws + WS_MLC) + (size_t)bh * 64 * ML_D * ML_D;
    const float* mlun = (const float*)(F.ws + WS_MLUN) + (size_t)bh * 64 * ML_D; float* mln = (float*)(F.ws + WS_MLN) + (size_t)bh * 64 * ML_D;
    LAS float* dec = (LAS float*)F.lds; LAS float* scl = dec + 64; LAS float* am = scl + 64; LAS float* bl = am + 64;
    __syncthreads();
    if (F.tid < 64) { const pg8::f32x2 v = *(const pg8::f32x2*)(mlsc + (bh * 64 + F.tid) * 2); am[F.tid] = v.x; bl[F.tid] = v.y; }
    __syncthreads();
    if (F.tid == 0) { float m = 0.f;
        for (int c = 0; c < 64; ++c) { const float amax = am[c], bL = bl[c]; const float mn = fmaxf(bL + m, amax);
            dec[c] = __expf(bL + m - mn); scl[c] = __expf(amax - mn); if (sl == 0) mlm[bh * 64 + c] = m; m = mn; } }
    __syncthreads();
    { const int idx = sl * 1024 + F.tid * 2; float c0 = 0.f, c1 = 0.f;
#pragma unroll 1
      for (int cb = 0; cb < 64; cb += 16) { unsigned u[16];
#pragma unroll
          for (int i = 0; i < 16; ++i) u[i] = *(const unsigned*)(mlu + (size_t)(cb + i) * ML_D * ML_D + idx);
#pragma unroll
          for (int i = 0; i < 16; ++i) { *(unsigned*)(mlc + (size_t)(cb + i) * ML_D * ML_D + idx) = pk2(c0, c1);
              c0 = dec[cb + i] * c0 + scl[cb + i] * bflo(u[i]); c1 = dec[cb + i] * c1 + scl[cb + i] * bfhi(u[i]); } } }
    if (sl == 0 && F.tid < ML_D) { float n = 0.f;
#pragma unroll 1
        for (int cb = 0; cb < 64; cb += 8) { float u[8];
#pragma unroll
            for (int i = 0; i < 8; ++i) u[i] = mlun[(cb + i) * ML_D + F.tid];
#pragma unroll
            for (int i = 0; i < 8; ++i) { mln[(cb + i) * ML_D + F.tid] = n; n = dec[cb + i] * n + scl[cb + i] * u[i]; } } }
}
struct MlcIn { v4u q[2], k[2], v[2], c[4]; float fb, fli, fn, mc; };
__device__ __forceinline__ void ml_stage_c_load(Ctx& F, int unit, MlcIn& r) {
    const int c = unit & 63, bh = unit >> 6, b = bh >> 2, h = bh & 3;
    const bf16* proj = (const bf16*)(F.ws + WS_PROJ); const bf16* mlq = (const bf16*)(F.ws + WS_MLQ); const bf16* mlk = (const bf16*)(F.ws + WS_MLKK);
    const float* mlb = (const float*)(F.ws + WS_MLB); const float* mlli = (const float*)(F.ws + WS_MLLI); const float* mlm = (const float*)(F.ws + WS_MLSC) + 4096;
    const bf16* mlc = (const bf16*)(F.ws + WS_MLC) + (size_t)unit * ML_D * ML_D; const float* mln = (const float*)(F.ws + WS_MLN) + (size_t)unit * ML_D;
    const int t0 = c * ML_L; const size_t row0 = (size_t)b * SEQ + t0;
#pragma unroll
    for (int i = 0; i < 2; ++i) { const int it = F.tid + i * NTHREADS, ch8 = it & 15, s = it >> 4; const size_t go = (row0 + s) * 512 + h * 128 + ch8 * 8;
        r.q[i] = *(const v4u*)(mlq + go); r.k[i] = *(const v4u*)(mlk + go); r.v[i] = *(const v4u*)(proj + (row0 + s) * PW + PC_MLV + h * 128 + ch8 * 8); }
#pragma unroll
    for (int i = 0; i < 4; ++i) { const int it = F.tid + i * NTHREADS, ch8 = it & 15, e = it >> 4; r.c[i] = *(const v4u*)(mlc + e * ML_D + ch8 * 8); }
    r.fb = mlb[(size_t)bh * SEQ + t0 + (F.tid & 63)]; r.fli = mlli[(size_t)bh * SEQ + t0 + (F.tid & 63)]; r.fn = mln[F.tid & 127]; r.mc = mlm[unit];
}
__device__ __forceinline__ void ml_stage_c(Ctx& F, int unit, int next_unit, MlcIn& r) {
    const int c = unit & 63, bh = unit >> 6, b = bh >> 2, h = bh & 3;
    const bf16* proj = (const bf16*)(F.ws + WS_PROJ);
    bf16* oml = (bf16*)(F.ws + WS_OML); const float* ng = F.in[I_MLNG];
    LAS unsigned char* Qs = F.lds; LAS unsigned char* Ks = Qs + 64 * W128_SB; LAS unsigned char* Vs = Ks + 64 * W128_SB; LAS unsigned char* Cs = Vs + 64 * W128_SB;
    LAS float* fb = (LAS float*)(Cs + 128 * W128_SB); LAS float* fli = fb + 64; LAS float* fn = fli + 64; LAS float* ssq = fn + 128;
    const int t0 = c * ML_L; const size_t row0 = (size_t)b * SEQ + t0;
#ifndef MLC_SEC
#define MLC_SEC 0
#endif
#define MS_BEGIN(k) unsigned long long ms##k = 0; if (MLC_SEC == (k)) ms##k = __builtin_amdgcn_s_memrealtime();
#define MS_END(k) if (MLC_SEC == (k)) { const unsigned long long n_ = __builtin_amdgcn_s_memrealtime(); const unsigned long long e_ = n_ + 4 * (n_ - ms##k); while (__builtin_amdgcn_s_memrealtime() < e_) __builtin_amdgcn_s_sleep(8); }
    MS_BEGIN(1)
    __syncthreads();
#pragma unroll
    for (int i = 0; i < 2; ++i) { const int it = F.tid + i * NTHREADS, ch8 = it & 15, s = it >> 4;
        *(LAS v4u*)(Qs + s * W128_SB + ch8 * 16) = r.q[i]; *(LAS v4u*)(Ks + s * W128_SB + ch8 * 16) = r.k[i]; *(LAS v4u*)(Vs + s * W128_SB + ch8 * 16) = r.v[i]; }
#pragma unroll
    for (int i = 0; i < 4; ++i) { const int it = F.tid + i * NTHREADS, ch8 = it & 15, e = it >> 4; *(LAS v4u*)(Cs + e * W128_SB + ch8 * 16) = r.c[i]; }
    if (F.tid < 64) { fb[F.tid] = r.fb; fli[F.tid] = r.fli; }
    if (F.tid < ML_D) fn[F.tid] = r.fn;
    const float mc = r.mc;
    __syncthreads();
    MS_END(1)
    MS_BEGIN(2)
    if (next_unit >= 0) ml_stage_c_load(F, next_unit, r);
    const int lane = F.lane, gq = lane >> 4, w = F.wave, tb = w & 3, eh = w >> 2;
    const int t = 16 * tb + (lane & 15); const float bt = fb[t];
    f32x4 ggv[4]; v2u owv[4];
#pragma unroll
    for (int ei = 0; ei < 4; ++ei) { const int e0 = 16 * (eh * 4 + ei) + 4 * gq; ggv[ei] = *(const f32x4*)(ng + h * 128 + e0); owv[ei] = *(const v2u*)(proj + (row0 + t) * PW + PC_MLO + h * 128 + e0); }
    bf16x8 qf[4];
#pragma unroll
    for (int st = 0; st < 4; ++st) qf[st] = lds_row8(Qs, W128_SB, t, 32 * st + 8 * gq);
    f32x4 sT[4]; float dmax = NEG_BIG;
#pragma unroll
    for (int sb = 0; sb < 4; ++sb) { sT[sb] = (f32x4){0.f, 0.f, 0.f, 0.f};
        if (sb <= tb) {
#pragma unroll
            for (int st = 0; st < 4; ++st) sT[sb] = mfma16(lds_row8(Ks, W128_SB, 16 * sb + (lane & 15), 32 * st + 8 * gq), qf[st], sT[sb]);
#pragma unroll
            for (int r = 0; r < 4; ++r) { const int s = 16 * sb + 4 * gq + r; if (s <= t) dmax = fmaxf(dmax, bt - fb[s] + fli[s]); } } }
    dmax = grp_max(dmax);
    const float mt = fmaxf(bt + mc, dmax); const float iw = __expf(bt + mc - mt);
    float dsum = 0.f;
#pragma unroll
    for (int sb = 0; sb < 4; ++sb)
#pragma unroll
        for (int r = 0; r < 4; ++r) { const int s = 16 * sb + 4 * gq + r; const float p = (sb <= tb && s <= t) ? sT[sb][r] * __expf(bt - fb[s] + fli[s] - mt) : 0.f; sT[sb][r] = p; dsum += p; }
    dsum = grp_sum(dsum);
    float qn = 0.f;
#pragma unroll 8
    for (int dd = 0; dd < 32; ++dd) { const int d = gq * 32 + dd; qn += bf2f(*(const LAS unsigned short*)(Qs + t * W128_SB + d * 2)) * fn[d]; }
    qn = grp_sum(qn);
    const float den = dsum + iw * qn; const float rden = 1.0f / fmaxf(fabsf(den), __expf(-mt));
    const bf16x8 p0 = pack8(sT[0], sT[1]), p1 = pack8(sT[2], sT[3]);
    f32x4 hv[4]; float sq = 0.f;
#pragma unroll
    for (int ei = 0; ei < 4; ++ei) { const int eb = eh * 4 + ei;
        f32x4 intra = (f32x4){0.f, 0.f, 0.f, 0.f}, inter = (f32x4){0.f, 0.f, 0.f, 0.f};
        intra = mfma16(tr_frag(Vs, W128_SB, 4 * gq, 16 + 4 * gq, 16 * eb, lane), p0, intra);
        if (tb >= 2) intra = mfma16(tr_frag(Vs, W128_SB, 32 + 4 * gq, 48 + 4 * gq, 16 * eb, lane), p1, intra);
#pragma unroll
        for (int st = 0; st < 4; ++st) inter = mfma16(lds_row8(Cs, W128_SB, 16 * eb + (lane & 15), 32 * st + 8 * gq), qf[st], inter);
        hv[ei] = (intra + inter * iw) * rden; sq += (hv[ei][0] * hv[ei][0] + hv[ei][1] * hv[ei][1]) + (hv[ei][2] * hv[ei][2] + hv[ei][3] * hv[ei][3]); }
    sq = grp_sum(sq);
    MS_END(2)
    MS_BEGIN(3)
    if (gq == 0) ssq[eh * 64 + t] = sq;
    __syncthreads();
    const float rn = rsqrtf((ssq[t] + ssq[64 + t]) * (1.0f / ML_D) + NORM_EPS);
#pragma unroll
    for (int ei = 0; ei < 4; ++ei) { const int e0 = 16 * (eh * 4 + ei) + 4 * gq; const f32x4 gg = ggv[ei];
        const v2u ow = owv[ei];
        f32x4 v = hv[ei] * rn * gg; v[0] *= sigmoidf_(bflo(ow.x)); v[1] *= sigmoidf_(bfhi(ow.x)); v[2] *= sigmoidf_(bflo(ow.y)); v[3] *= sigmoidf_(bfhi(ow.y));
        v2u o; o.x = pg8::cvt_pk_bf16(v[0], v[1]); o.y = pg8::cvt_pk_bf16(v[2], v[3]); *(v2u*)(oml + (row0 + t) * 512 + h * 128 + e0) = o; }
    MS_END(3)
}

#ifndef REPEAT_PHASE
#define REPEAT_PHASE -1
#endif
__device__ __forceinline__ void ph2(Ctx& F) {
    const int nconv = (F.G * 112) / 256, GC = F.G - nconv;
    if ((int)blockIdx.x < GC) {
        pg8::Gemm g{(const bf16*)(F.ws + WS_A1), (const bf16*)(F.ws + WS_WIN), T, PW, DM}; pg8::StaticOrder S; S.init(T, PW, GC, (int)blockIdx.x);
        EpiStoreScaled E{(bf16*)(F.ws + WS_PROJ), PW, (const float*)(F.ws + WS_SA), (const float*)(F.ws + WS_SW)};
        pg8::gemm_phase<EpiStoreScaled, pg8::StaticOrder, true, true, false, false, true>(F.lds, g, S, E);
    } else moe_convert(F, (int)blockIdx.x - GC, nconv);
}
#ifndef TIME_SUB
#define TIME_SUB 0
#endif
#define SUBT_BEGIN(k) unsigned long long ts_ = 0; if (TIME_SUB == (k)) ts_ = __builtin_amdgcn_s_memrealtime();
#define SUBT_END(k) if (TIME_SUB == (k)) { __syncthreads(); const unsigned long long n_ = __builtin_amdgcn_s_memrealtime(); const unsigned long long e_ = n_ + 4 * (n_ - ts_); while (__builtin_amdgcn_s_memrealtime() < e_) __builtin_amdgcn_s_sleep(8); }
__device__ __forceinline__ void ph3(Ctx& F) {
    { SUBT_BEGIN(3) for (int u = F.vcu; u < 256; u += F.G) nsa_compress_unit(F, u); SUBT_END(3) }
    if (F.G % 256 == 0) { ml_stage_a_weights(F, (F.vcu >> 6) & 3); for (int u = F.vcu; u < ML_BH * ML_NCH; u += F.G) ml_stage_a(F, u); }
    else for (int u = F.vcu; u < ML_BH * ML_NCH; u += F.G) { ml_stage_a_weights(F, (u >> 6) & 3); ml_stage_a(F, u); }
}
__device__ __forceinline__ void ph4(Ctx& F) {
    { SUBT_BEGIN(4) for (int p = F.vcu; p < 256; p += F.G) { const int bg = p >> 5, x = p & 31; nsa_cmp_unit(F, bg, 63 - x); nsa_cmp_unit(F, bg, x); } SUBT_END(4) }
    for (int u = F.vcu; u < ML_BH * 16; u += F.G) ml_stage_b(F, u);
}
__device__ __forceinline__ void ph5(Ctx& F) {
    { SUBT_BEGIN(5) for (int p = F.vcu; p < 256; p += F.G) { const int bg = p >> 5, x = p & 31; nsa_selwin_unit(F, bg >> 1, bg & 1, x); nsa_selwin_unit(F, bg >> 1, bg & 1, 63 - x); } SUBT_END(5) }
    { MlcIn r; int u = F.vcu; if (u < ML_BH * ML_NCH) ml_stage_c_load(F, u, r);
      for (; u < ML_BH * ML_NCH; u += F.G) { const int nu = u + F.G < ML_BH * ML_NCH ? u + F.G : -1; ml_stage_c(F, u, nu, r); } }
}
struct UpOrder {
    pg8::StaticOrder so;
    __device__ __forceinline__ bool next(int i, Unit& u) const { if (!so.next(i >> 1, u)) return false; if (i & 1) { u.pm += T / 256; u.pn += DM / 256; } return true; }
    __device__ __forceinline__ void a_ready(const Unit&) const {}
    __device__ __forceinline__ void done(const Unit&) const {}
};
struct EpiUpBoth {
    static constexpr bool PERM = true, AFTER_DRAIN = false;
    bf16* U; const bf16* G;
    __device__ __forceinline__ void operator()(const f32x4 (&acc)[2][2][4][2], const Unit& u, int wr, int wc, int fr, int fq) const {
        if (u.pm < T / 256) { EpiUpGate<false> E{U, G, PC_MGA}; E(acc, u, wr, wc, fr, fq); }
        else { Unit v = u; v.pm -= T / 256; v.pn -= DM / 256; EpiUpGate<true> E{U, G, PC_MGB}; E(acc, v, wr, wc, fr, fq); }
    }
};
static_assert(WS_OML == WS_ONSA + (size_t)T * 512 * 2 && WS_WUPB == WS_WUPA + (size_t)DM * 512 * 2, "stacked operands of the up projection");
__device__ __forceinline__ void ph6(Ctx& F) {
    UpOrder S; S.so.init(T, DM, F.G, (int)blockIdx.x);
    pg8::Gemm g{(const bf16*)(F.ws + WS_ONSA), (const bf16*)(F.ws + WS_WUPA), 2 * T, 2 * DM, 512}; EpiUpBoth E{(bf16*)(F.ws + WS_U), (const bf16*)(F.ws + WS_PROJ)};
    pg8::gemm_phase<EpiUpBoth, UpOrder, true, true>(F.lds, g, S, E);
}
__device__ __forceinline__ void ph7(Ctx& F) {
    pg8::Gemm g{(const bf16*)(F.ws + WS_U), (const bf16*)(F.ws + WS_WOUT), T, DM, DM}; pg8::StaticOrder S; S.init(T, DM, F.G, (int)blockIdx.x);
    EpiOutRes E{F.in[I_X], (bf16*)(F.ws + WS_H1), (const float*)(F.ws + WS_MODF)};
    pg8::gemm_phase<EpiOutRes, pg8::StaticOrder, true, true>(F.lds, g, S, E);
}
__device__ __forceinline__ void ph10(Ctx& F) {
    pg8::Gemm g{(const bf16*)(F.ws + WS_A1), (const bf16*)(F.ws + WS_W1T), MOE_P, NEXP * 2048, DM};
    moe_units_to_lds<1>(F.lds, F.ctl + CW_MOETAB, 8, 3, F.G, F.vcu, F.in[I_EB1], nullptr);
    MoeOrder S{(const LAS int*)(F.lds + MOE_UL_OFF), (const int*)(F.ws + WS_ROWT)};
    EpiMoe1 E{F.ws + WS_ACT, (const LAS float*)(F.lds + MOE_BT1_OFF)};
    pg8::gemm_phase<EpiMoe1, MoeOrder, true, true, true, true>(F.lds, g, S, E);
}
__device__ __forceinline__ void ph11(Ctx& F) {
    pg8::Gemm g{(const bf16*)(F.ws + WS_ACT), (const bf16*)(F.ws + WS_W2T), MOE_P, NEXP * DM, DE};
    moe_units_to_lds<2>(F.lds, F.ctl + CW_MOETAB, 4, 2, F.G, F.vcu, F.in[I_EB2], (const float*)(F.ws + WS_ROWG));
    MoeOrder S{(const LAS int*)(F.lds + MOE_UL_OFF), nullptr};
    EpiMoe2 E{F.ws + WS_YR, (const LAS float*)(F.lds + MOE_BT2_OFF)};
    pg8::gemm_phase<EpiMoe2, MoeOrder, true, true, true>(F.lds, g, S, E);
}
#ifndef TIME_PHASE
#define TIME_PHASE -1
#endif
#define RUN(k, call) do { unsigned long long t0_ = 0; if (TIME_PHASE == (k)) t0_ = __builtin_amdgcn_s_memrealtime(); F.tid = threadIdx.x; F.lane = F.tid & 63; call; SEAM(); \
    if (TIME_PHASE == (k)) { const unsigned long long n_ = __builtin_amdgcn_s_memrealtime(); const unsigned long long e_ = n_ + 4 * (n_ - t0_); while (__builtin_amdgcn_s_memrealtime() < e_) __builtin_amdgcn_s_sleep(8); SEAM(); } } while (0)
__global__ void __launch_bounds__(NTHREADS, 2) fwd_kernel(Args args) {
    extern __shared__ __attribute__((aligned(16))) unsigned char lds_raw[];
    Ctx F;
    F.lds = (LAS unsigned char*)lds_raw; F.ws = args.ws; F.ctl = (unsigned*)(args.ws + WS_CTL);
    F.tid = threadIdx.x; F.lane = F.tid & 63; F.wave = __builtin_amdgcn_readfirstlane(F.tid >> 6);
    F.G = gridDim.x; { const int bx = blockIdx.x; F.vcu = (F.G % 8 == 0) ? (bx % 8) * (F.G / 8) + bx / 8 : bx; }
    F.in = args.in; F.out = args.out;
    volatile LAS unsigned* MISC = (volatile LAS unsigned*)(F.lds + MISC_OFF);
    for (int u = F.tid; u < (LDS_BYTES - LDSCTL_OFF) / 4; u += NTHREADS) ((LAS unsigned*)(F.lds + LDSCTL_OFF))[u] = 0u;
    __syncthreads();
    XcdBarrier bar = xcd_barrier_post(F.ctl + CW_BAR, MISC + 8);
#define SEAM() xcd_barrier(bar)
    const float* modf = (const float*)(F.ws + WS_MODF);
    const bf16* H = (const bf16*)(F.ws + WS_H1);
    RUN(0, p0_prologue(F));
    RUN(1, p1_norm1(F));
    RUN(2, ph2(F));
    RUN(3, ph3(F));
    RUN(4, ph4(F));
    RUN(5, ph5(F));
    RUN(6, ph6(F));
    RUN(7, ph7(F));
    RUN(8, p8_norm2_router(F, H, modf));
    RUN(9, p9_permute(F));
    RUN(10, ph10(F));
    RUN(11, ph11(F));
    p_final<true>(F, H, modf);
#undef SEAM
}

extern "C" void kernel_launch(void* const* d_in, const int* in_sizes, int n_in, void* d_out, int out_size, void* d_ws, size_t ws_size, hipStream_t stream) {
    static int grid = 0;
    if (grid == 0) {
        if (n_in != 27 || in_sizes[0] != T * DM || out_size != T * DM || ws_size < WS_END) { fprintf(stderr, "kernel_launch: unexpected shapes (n_in %d, in0 %d, out %d, ws %zu)\n", n_in, n_in > 0 ? in_sizes[0] : -1, out_size, ws_size); grid = -1; return; }
        int dev = 0, cus = 0, per_cu = 0;
        if (hipGetDevice(&dev) != hipSuccess || hipDeviceGetAttribute(&cus, hipDeviceAttributeMultiprocessorCount, dev) != hipSuccess) { grid = -1; return; }
        if (hipFuncSetAttribute((const void*)fwd_kernel, hipFuncAttributeMaxDynamicSharedMemorySize, LDS_BYTES) != hipSuccess) { fprintf(stderr, "kernel_launch: hipFuncSetAttribute failed\n"); grid = -1; return; }
        if (hipOccupancyMaxActiveBlocksPerMultiprocessor(&per_cu, (const void*)fwd_kernel, NTHREADS, LDS_BYTES) != hipSuccess || per_cu < 1) fprintf(stderr, "kernel_launch: occupancy query reports %d\n", per_cu);
        (void)hipGetLastError();
        grid = cus;
    }
    if (grid < 0) return;
    if (hipMemsetAsync((char*)d_ws + WS_CTL, 0, CTL_ZERO_BYTES, stream) != hipSuccess) return;
    Args a{};
    for (int i = 0; i < 27; ++i) a.in[i] = (const float*)d_in[i];
    a.out = (float*)d_out; a.ws = (unsigned char*)d_ws;
    a.ph_lo = 0; a.ph_hi = 64;
    hipLaunchKernelGGL(fwd_kernel, dim3(grid), dim3(NTHREADS), LDS_BYTES, stream, a);
}
```
